# Optimizing an MI355X kernel written in HIP

```python
import math
import jax, jax.numpy as jnp
from jax import lax
import numpy as np

D_MODEL = 1024
BATCH = 4
SEQ = 4096
DEPTH = 2

HEAD_DIM = 64
ROPE_THETA = 10000.0
NORM_EPS = 1e-6
BLOCK = 128
NEG_INF = -1e30
A_Q_HEADS = 8
A_KV_HEADS = 2
A_HALF_WINDOW = 128
B_GROUPS = ((128, 1), (512, 4), (2048, 16))
B_HEADS_PER_GROUP = 4
MOE_GROUPS = 4
EXPERTS_PER_GROUP = 8
N_EXPERTS = MOE_GROUPS * EXPERTS_PER_GROUP
EXPERT_TOP_K = 2
D_EXPERT = 256
MOE_CHUNK = 1024

A_Q_DIM = A_Q_HEADS * HEAD_DIM
A_KV_DIM = A_KV_HEADS * HEAD_DIM
B_DIM = B_HEADS_PER_GROUP * HEAD_DIM
IN_SPLITS = [A_Q_DIM, A_KV_DIM, A_KV_DIM] + [B_DIM] * (3 * len(B_GROUPS)) + [D_MODEL, D_MODEL]
D_IN = sum(IN_SPLITS)
IN_OFFSETS = [int(v) for v in np.cumsum(IN_SPLITS)[:-1]]

kernel_name = 'hybrid_gqa_dilated_hmoe_encoder'


def rms_norm(x, g):
    xf = x.astype(jnp.float32)
    y = xf * lax.rsqrt(jnp.mean(xf * xf, axis=-1, keepdims=True) + NORM_EPS)
    return (y * g.astype(jnp.float32)).astype(x.dtype)


def rotary_tables(seq_len):
    inv = 1.0 / (ROPE_THETA ** (jnp.arange(0, HEAD_DIM, 2, dtype=jnp.float32) / HEAD_DIM))
    ang = jnp.arange(seq_len, dtype=jnp.float32)[:, None] * inv[None, :]
    return jnp.cos(ang), jnp.sin(ang)


def apply_rope(t, cos, sin):
    half = t.shape[-1] // 2
    t1 = t[..., :half].astype(jnp.float32)
    t2 = t[..., half:].astype(jnp.float32)
    c = cos[None, :, None, :]
    s = sin[None, :, None, :]
    return jnp.concatenate([t1 * c - t2 * s, t2 * c + t1 * s], axis=-1).astype(t.dtype)


def banded_attention(q, k, v, half_window, sink):
    B, L, Hq, dh = q.shape
    Hkv = k.shape[2]
    G = Hq // Hkv
    blk = math.gcd(L, BLOCK)
    nb = L // blk
    kw = blk + 2 * half_window
    pad = ((0, 0), (half_window, half_window), (0, 0), (0, 0))
    kp = jnp.pad(k, pad)
    vp = jnp.pad(v, pad)
    key_idx = jnp.arange(nb)[:, None] * blk + jnp.arange(kw)[None, :]
    kb = kp[:, key_idx]
    vb = vp[:, key_idx]
    qb = q.reshape(B, nb, blk, Hkv, G, dh)
    s = jnp.einsum('bnqhgd,bnkhd->bnhgqk', qb, kb).astype(jnp.float32) * (dh ** -0.5)
    qpos = jnp.arange(nb)[:, None] * blk + jnp.arange(blk)[None, :]
    kpos = key_idx - half_window
    rel = kpos[:, None, :] - qpos[:, :, None]
    valid = (jnp.abs(rel) <= half_window) & (kpos >= 0)[:, None, :] & (kpos < L)[:, None, :]
    s = jnp.where(valid[None, :, None, None], s, NEG_INF)
    m = jnp.max(s, axis=-1)
    if sink is not None:
        sk = sink.astype(jnp.float32).reshape(Hkv, G)[None, None, :, :, None]
        m = jnp.maximum(m, sk)
        denom = jnp.sum(jnp.exp(s - m[..., None]), axis=-1) + jnp.exp(sk - m)
    else:
        denom = jnp.sum(jnp.exp(s - m[..., None]), axis=-1)
    lse = m + jnp.log(denom)
    p = jnp.exp(s - lse[..., None]).astype(v.dtype)
    out = jnp.einsum('bnhgqk,bnkhd->bnqhgd', p, vb).reshape(B, L, Hq, dh)
    lse = lse.transpose(0, 1, 4, 2, 3).reshape(B, L, Hq)
    return out, lse


def dilated_attention(q, k, v, window, dilation):
    B, S, H, dh = q.shape
    L = S // dilation

    def to_sub(t):
        return t.reshape(B, L, dilation, H, dh).transpose(0, 2, 1, 3, 4).reshape(B * dilation, L, H, dh)

    o, lse = banded_attention(to_sub(q), to_sub(k), to_sub(v), (window // 2) // dilation, None)
    o = o.reshape(B, dilation, L, H, dh).transpose(0, 2, 1, 3, 4).reshape(B, S, H, dh)
    lse = lse.reshape(B, dilation, L, H).transpose(0, 2, 1, 3).reshape(B, S, H)
    return o, lse


def hier_moe(h, w_rg, b_rg, w_re, b_re, w_g, w_u, w_d):
    B, S, D = h.shape
    t = h.reshape(B * S, D)
    T = t.shape[0]
    glog = (t @ w_rg).astype(jnp.float32) + b_rg.astype(jnp.float32)
    gprob = jax.nn.softmax(glog, axis=-1)
    gidx = jnp.argmax(glog, axis=-1)
    gw = jnp.take_along_axis(gprob, gidx[:, None], axis=1)
    elog = ((t @ w_re).astype(jnp.float32) + b_re.astype(jnp.float32)).reshape(T, MOE_GROUPS, EXPERTS_PER_GROUP)
    elog = jnp.take_along_axis(elog, gidx[:, None, None], axis=1)[:, 0]
    top_v, top_i = lax.top_k(elog, EXPERT_TOP_K)
    top_w = jax.nn.softmax(top_v, axis=-1) * gw
    eid = gidx[:, None] * EXPERTS_PER_GROUP + top_i
    combine = jnp.sum(jax.nn.one_hot(eid, N_EXPERTS, dtype=jnp.float32) * top_w[..., None], axis=1)
    C = math.gcd(T, MOE_CHUNK)

    def run(args):
        tc, cc = args
        a = jnp.einsum('cd,edf->cef', tc, w_g)
        u = jnp.einsum('cd,edf->cef', tc, w_u)
        z = jax.nn.silu(a) * u * cc[..., None].astype(tc.dtype)
        return jnp.einsum('cef,efd->cd', z, w_d)

    y = lax.map(run, (t.reshape(T // C, C, D), combine.reshape(T // C, C, N_EXPERTS)))
    return y.reshape(B, S, D)


def setup_inputs(seed: int = 0) -> dict:
    key = jax.random.key(seed)
    ks = jax.random.split(key, 16)
    f32 = jnp.float32
    nrm = lambda k, shape, scale: jax.random.normal(k, shape, f32) * scale
    return {
        'x': jax.random.normal(ks[0], (BATCH, SEQ, D_MODEL), f32),
        'attn_norm_g': 1.0 + nrm(ks[1], (DEPTH, D_MODEL), 0.01),
        'w_in': nrm(ks[2], (DEPTH, D_MODEL, D_IN), D_MODEL ** -0.5),
        'a_sink': nrm(ks[3], (DEPTH, A_Q_HEADS), 0.5),
        'w_branch_a': nrm(ks[4], (DEPTH, A_Q_DIM, D_MODEL), A_Q_DIM ** -0.5),
        'w_branch_b': nrm(ks[5], (DEPTH, B_DIM, D_MODEL), B_DIM ** -0.5),
        'w_out': nrm(ks[6], (DEPTH, D_MODEL, D_MODEL), D_MODEL ** -0.5),
        'ffn_norm_g': 1.0 + nrm(ks[7], (DEPTH, D_MODEL), 0.01),
        'w_router_group': nrm(ks[8], (DEPTH, D_MODEL, MOE_GROUPS), D_MODEL ** -0.5),
        'b_router_group': nrm(ks[9], (DEPTH, MOE_GROUPS), 0.01),
        'w_router_expert': nrm(ks[10], (DEPTH, D_MODEL, N_EXPERTS), D_MODEL ** -0.5),
        'b_router_expert': nrm(ks[11], (DEPTH, N_EXPERTS), 0.01),
        'w_exp_gate': nrm(ks[12], (DEPTH, N_EXPERTS, D_MODEL, D_EXPERT), D_MODEL ** -0.5),
        'w_exp_up': nrm(ks[13], (DEPTH, N_EXPERTS, D_MODEL, D_EXPERT), D_MODEL ** -0.5),
        'w_exp_down': nrm(ks[14], (DEPTH, N_EXPERTS, D_EXPERT, D_MODEL), D_EXPERT ** -0.5),
        'final_norm_g': 1.0 + nrm(ks[15], (D_MODEL,), 0.01),
    }


def reference(x, attn_norm_g, w_in, a_sink, w_branch_a, w_branch_b, w_out, ffn_norm_g,
              w_router_group, b_router_group, w_router_expert, b_router_expert,
              w_exp_gate, w_exp_up, w_exp_down, final_norm_g):
    B, S, D = x.shape
    cos, sin = rotary_tables(S)
    for l in range(DEPTH):
        h = rms_norm(x, attn_norm_g[l])
        proj = jnp.einsum('bsd,de->bse', h, w_in[l])
        parts = jnp.split(proj, IN_OFFSETS, axis=-1)
        qa = apply_rope(parts[0].reshape(B, S, A_Q_HEADS, HEAD_DIM), cos, sin)
        ka = apply_rope(parts[1].reshape(B, S, A_KV_HEADS, HEAD_DIM), cos, sin)
        va = parts[2].reshape(B, S, A_KV_HEADS, HEAD_DIM)
        ya, _ = banded_attention(qa, ka, va, A_HALF_WINDOW, a_sink[l])
        ya = jnp.einsum('bse,ed->bsd', ya.reshape(B, S, A_Q_DIM), w_branch_a[l])
        outs, lses = [], []
        for gi, (win, dil) in enumerate(B_GROUPS):
            qg = apply_rope(parts[3 + 3 * gi].reshape(B, S, B_HEADS_PER_GROUP, HEAD_DIM), cos, sin)
            kg = apply_rope(parts[4 + 3 * gi].reshape(B, S, B_HEADS_PER_GROUP, HEAD_DIM), cos, sin)
            vg = parts[5 + 3 * gi].reshape(B, S, B_HEADS_PER_GROUP, HEAD_DIM)
            o, lse = dilated_attention(qg, kg, vg, win, dil)
            outs.append(o)
            lses.append(lse)
        wg = jax.nn.softmax(jnp.stack(lses, axis=0), axis=0)
        yb = jnp.sum(wg[..., None].astype(x.dtype) * jnp.stack(outs, axis=0), axis=0)
        yb = jnp.einsum('bse,ed->bsd', yb.reshape(B, S, B_DIM), w_branch_b[l])
        merged = jax.nn.sigmoid(parts[-2]) * ya + jax.nn.sigmoid(parts[-1]) * yb
        x = x + jnp.einsum('bsd,de->bse', merged, w_out[l])
        x = x + hier_moe(rms_norm(x, ffn_norm_g[l]), w_router_group[l], b_router_group[l],
                         w_router_expert[l], b_router_expert[l],
                         w_exp_gate[l], w_exp_up[l], w_exp_down[l])
    return rms_norm(x, final_norm_g)
```

```cpp
#include <hip/hip_runtime.h>
#include <hip/hip_cooperative_groups.h>
#include <cstdio>
#include <cstdint>
namespace cg = cooperative_groups;

#ifndef PHMASK
#define PHMASK 1023
#endif
#ifndef MK_MULTI
#define MK_MULTI 0
#endif

#define LAS __attribute__((address_space(3)))
#define GAS __attribute__((address_space(1)))
typedef unsigned short bf16;
typedef short bf16x8 __attribute__((ext_vector_type(8)));
typedef short s16x4 __attribute__((ext_vector_type(4)));
typedef float f32x2 __attribute__((ext_vector_type(2)));
typedef float f32x4 __attribute__((ext_vector_type(4)));
typedef float f32x16 __attribute__((ext_vector_type(16)));
typedef unsigned u32x2 __attribute__((ext_vector_type(2)));
typedef unsigned u32x4 __attribute__((ext_vector_type(4)));
typedef int i32x4 __attribute__((ext_vector_type(4)));
typedef __bf16 bf16x2_t __attribute__((ext_vector_type(2)));

constexpr int BATCH = 4, SEQ = 4096, DM = 1024, DEPTH = 2, MTOK = BATCH * SEQ;
constexpr int NQKV = 3072, NGATE = 2048, DIN = NQKV + NGATE;
constexpr int NEXP = 32, DEXP = 256;
constexpr float NORM_EPS = 1e-6f;
constexpr float LOG2E = 1.4426950408889634f, LN2 = 0.6931471805599453f;
constexpr float QSCALE = 0.125f * LOG2E;
constexpr int NWAVES = 8, NTHREADS = 512;

constexpr size_t MiB = 1u << 20;
constexpr size_t WS_CTL = 0, CTL_BYTES = 1 * MiB;
constexpr size_t WS_ROPE = 1 * MiB;
constexpr size_t WS_WR = 2 * MiB;
constexpr size_t WS_RS1 = 3 * MiB, WS_RS2 = 3 * MiB + 65536;
constexpr size_t WS_TOKINFO = 5 * MiB;
constexpr size_t WS_LTOK = 6 * MiB, WS_LW = 8 * MiB;
constexpr size_t WS_LSE = 10 * MiB;
constexpr size_t WS_WIN = 12 * MiB, WS_WA = 22 * MiB, WS_WB = 23 * MiB, WS_WOUT = 24 * MiB, WS_WGU = 26 * MiB, WS_WD = 58 * MiB;
constexpr size_t WS_XB = 74 * MiB;
constexpr size_t WS_OBUF = 74 * MiB;
constexpr size_t WS_YA = 106 * MiB, WS_YB = 122 * MiB;
constexpr size_t WS_PQ = 130 * MiB;
constexpr size_t WS_M1 = 130 * MiB, WS_MRG = 162 * MiB, WS_H = 194 * MiB;
constexpr size_t WS_PG = 226 * MiB;
constexpr size_t WS_Y = 226 * MiB;
constexpr size_t WS_END = 290 * MiB;
constexpr int CW_CNT = 64;
constexpr int CW_BAR = 4096;

constexpr int RING_BYTES = 131072;
constexpr int MISC_OFF = RING_BYTES;
constexpr int LDS_BYTES = 147456;

#define LDS_WAIT() asm volatile("s_waitcnt lgkmcnt(0)" ::: "memory")
#define VM_WAIT() asm volatile("s_waitcnt vmcnt(0)" ::: "memory")
__device__ __forceinline__ unsigned cvtpk(float lo, float hi) { f32x2 v = {lo, hi}; bf16x2_t b = __builtin_convertvector(v, bf16x2_t); return __builtin_bit_cast(unsigned, b); }
__device__ __forceinline__ float bf2f(unsigned short h) { return __uint_as_float(((unsigned)h) << 16); }
__device__ __forceinline__ float bflo(unsigned w) { return __uint_as_float(w << 16); }
__device__ __forceinline__ float bfhi(unsigned w) { return __uint_as_float(w & 0xffff0000u); }
__device__ __forceinline__ float fast_exp2(float x) { return __builtin_amdgcn_exp2f(x); }
__device__ __forceinline__ float fast_rcp(float x) { return __builtin_amdgcn_rcpf(x); }
__device__ __forceinline__ float sigmoidf_fast(float v) { return fast_rcp(1.0f + fast_exp2(-v * LOG2E)); }

namespace pg8 {
constexpr int BM = 256, BK = 64, HALF = 128, HTB = HALF * BK * 2, STAGE_BYTES = 8 * HTB, NXCD = 8, WGM = 8;
__host__ __device__ __forceinline__ int lds_byte(int r, int c) { const int st = (r >> 4) * 2 + (c >> 5), rr = r & 15, cc = c & 31, ob = rr * 64 + cc * 2; return st * 1024 + (ob ^ (((ob >> 9) & 1) << 5)); }
__host__ __device__ __forceinline__ void stage_rc(int b, int& R, int& C) { const int st = b / 1024, sb = b % 1024, swz = sb ^ (((sb >> 9) & 1) << 5); R = (st >> 1) * 16 + swz / 64; C = (st & 1) * 32 + (swz % 64) / 2; }
__host__ __device__ __forceinline__ int perm32(int rho) { const int n = rho >> 4, i = rho & 15; return 8 * (i >> 2) + 4 * n + (i & 3); }

struct Unit { int pm, pn, e, nvalid, slot0, lpos0; };

struct StaticOrder {
    int nM, nN, nwg, G, c;
    __device__ void init(int M, int N, int G_, int c_) { nM = M / BM; nN = N / BM; nwg = nM * nN; G = G_; c = c_; }
    __device__ bool next(int i, int& pm, int& pn) const {
        const long L = (long)i * G + c; if (L >= nwg) return false;
        int wgid = (int)L; { const int q = nwg / NXCD, r = nwg % NXCD, xcd = wgid % NXCD, off = wgid / NXCD; wgid = (xcd < r ? xcd * (q + 1) : r * (q + 1) + (xcd - r) * q) + off; }
        const int nig = WGM * nN, gid = wgid / nig, fm = gid * WGM, gsz = (nM - fm) < WGM ? (nM - fm) : WGM;
        pm = fm + ((wgid % nig) % gsz); pn = (wgid % nig) / gsz; return true;
    }
};

template <class Epi, class Sched>
__device__ __forceinline__ void gemm_phase(LAS unsigned char* lds, const Sched& S, const Epi& E) {
    int tid_ = threadIdx.x; asm volatile("" : "+v"(tid_));
    const int tid = tid_, wid = __builtin_amdgcn_readfirstlane(tid >> 6), lane = tid & 63, wr = wid >> 2, wc = wid & 3, fr = lane & 15, fq = lane >> 4;
    const int K = S.K, nt = K / BK;
    unsigned voffA[2], voffB[2];
#pragma unroll
    for (int i = 0; i < 2; ++i) { int R, C; stage_rc(tid * 16 + i * 8192, R, C); const int Rb = Epi::PERM ? ((R & ~31) + perm32(R & 31)) : R;
        voffA[i] = (unsigned)(R * S.lda + C) * 2u; voffB[i] = (unsigned)(Rb * K + C) * 2u; }
    const size_t kstep = (size_t)(BK * 2);
    const size_t hstepB = (size_t)HALF * K * 2, hstepA = (size_t)HALF * S.lda * 2;
    const unsigned ldsw = (unsigned)wid * 1024u;
    const int aoff = lds_byte(wr * 64 + fr, fq * 8), boff = lds_byte(wc * 32 + fr, fq * 8);
#define PG8_SA(b, h) (((b) * 2 + (h)) * HTB)
#define PG8_SB(b, h) ((4 + (b) * 2 + (h)) * HTB)
#define PG8_GLDS(src, dstoff) __builtin_amdgcn_global_load_lds((const unsigned*)(src), (LAS unsigned*)(lds + (dstoff)), 16, 0, 0)
#define PG8_STAGE_A(bufoff, up, h, VO) do { if constexpr (Sched::GATHER) { _Pragma("unroll") for (int _i = 0; _i < 2; ++_i) PG8_GLDS((up) + VO[_i], (bufoff) + ldsw + _i * 8192); } \
        else { const char* _b = (up) + (size_t)(h) * hstepA; _Pragma("unroll") for (int _i = 0; _i < 2; ++_i) PG8_GLDS(_b + voffA[_i], (bufoff) + ldsw + _i * 8192); } } while (0)
#define PG8_STAGE_B(bufoff, bp) do { _Pragma("unroll") for (int _i = 0; _i < 2; ++_i) PG8_GLDS((bp) + voffB[_i], (bufoff) + ldsw + _i * 8192); } while (0)
#define PG8_LDA(dst, b, h) do { _Pragma("unroll") for (int m = 0; m < 4; ++m) _Pragma("unroll") for (int k = 0; k < 2; ++k) dst[m][k] = *(const LAS bf16x8*)(lds + PG8_SA(b, h) + aoff + m * 2048 + k * 1024); } while (0)
#define PG8_LDB(dst, b, h) do { _Pragma("unroll") for (int n = 0; n < 2; ++n) _Pragma("unroll") for (int k = 0; k < 2; ++k) dst[n][k] = *(const LAS bf16x8*)(lds + PG8_SB(b, h) + boff + n * 2048 + k * 1024); } while (0)
#define PG8_MMA(ai, bj, At, Bt) do { __builtin_amdgcn_s_setprio(1); _Pragma("unroll") for (int m = 0; m < 4; ++m) _Pragma("unroll") for (int n = 0; n < 2; ++n) _Pragma("unroll") for (int k = 0; k < 2; ++k) \
        acc[ai][bj][m][n] = __builtin_amdgcn_mfma_f32_16x16x32_bf16(Bt[n][k], At[m][k], acc[ai][bj][m][n], 0, 0, 0); __builtin_amdgcn_s_setprio(0); } while (0)
#define PG8_WAIT_V(n) asm volatile("s_waitcnt vmcnt(" #n ")" ::: "memory")
#define PG8_WAIT_L(n) asm volatile("s_waitcnt lgkmcnt(" #n ")" ::: "memory")
#define PG8_BAR __builtin_amdgcn_s_barrier()
#define PG8_SCHED __builtin_amdgcn_sched_barrier(0)
    Unit cur, nxt; int ui = 0;
    if (!S.next(0, cur)) return;
    f32x4 acc[2][2][4][2];
#pragma unroll
    for (int a = 0; a < 2; ++a)
#pragma unroll
        for (int b = 0; b < 2; ++b)
#pragma unroll
            for (int m = 0; m < 4; ++m)
#pragma unroll
                for (int n = 0; n < 2; ++n) acc[a][b][m][n] = (f32x4){0.f, 0.f, 0.f, 0.f};
    bf16x8 At[4][2], B0[2][2], B1[2][2];
    const char* Ab = S.a_base();
    const char* cA = Ab; const char* cB = S.b_base(cur);
    unsigned vF0[2], vF1[2], vK[2];
    if constexpr (Sched::GATHER) {
#pragma unroll
        for (int i = 0; i < 2; ++i) { int R, C; stage_rc(tid * 16 + i * 8192, R, C); vF0[i] = S.a_off(cur, R) + (unsigned)(C * 2); vF1[i] = S.a_off(cur, HALF + R) + (unsigned)(C * 2); vK[i] = vF1[i]; }
    } else cA = Ab + S.a_unit_off(cur);
    PG8_STAGE_B(PG8_SB(0, 0), cB); PG8_STAGE_B(PG8_SB(0, 1), cB + hstepB); PG8_STAGE_A(PG8_SA(0, 0), cA, 0, vF0); PG8_STAGE_A(PG8_SA(0, 1), cA, 1, vF1);
    if (wr == 1) PG8_BAR;
    PG8_WAIT_V(2); PG8_BAR;
    PG8_STAGE_B(PG8_SB(1, 0), cB + kstep); PG8_STAGE_A(PG8_SA(1, 0), cA + kstep, 0, vF0); PG8_STAGE_B(PG8_SB(1, 1), cB + hstepB + kstep);
    PG8_WAIT_V(6); PG8_BAR;
    for (;;) {
        const bool has_next = S.next(ui + 1, nxt);
        const char* nA = cA; const char* nB = cB;
        if (has_next) { nB = S.b_base(nxt); if constexpr (!Sched::GATHER) nA = Ab + S.a_unit_off(nxt); }
#pragma unroll 1
        for (int t = 0; t < nt; t += 2) {
            const bool last = (t == nt - 2);
            const char* a1 = cA + (size_t)(t + 1) * kstep;
            const char* a2 = last ? nA : cA + (size_t)(t + 2) * kstep; const char* b2 = last ? nB : cB + (size_t)(t + 2) * kstep;
            const char* a3 = a2 + kstep; const char* b3 = b2 + kstep;
            if constexpr (Sched::GATHER) {
                if (last && has_next) {
#pragma unroll
                    for (int i = 0; i < 2; ++i) { int R, C; stage_rc(tid * 16 + i * 8192, R, C); vF0[i] = S.a_off(nxt, R) + (unsigned)(C * 2); vF1[i] = S.a_off(nxt, HALF + R) + (unsigned)(C * 2); }
                }
            }
            PG8_LDB(B0, 0, 0); PG8_LDB(B1, 0, 1); PG8_SCHED; PG8_LDA(At, 0, 0); PG8_STAGE_A(PG8_SA(1, 1), a1, 1, vK);
            PG8_WAIT_V(8); PG8_WAIT_L(0); PG8_BAR; PG8_MMA(0, 0, At, B0); PG8_MMA(0, 1, At, B1); PG8_BAR; PG8_SCHED;
            PG8_LDA(At, 0, 1); PG8_STAGE_B(PG8_SB(0, 0), b2); PG8_STAGE_B(PG8_SB(0, 1), b2 + hstepB); PG8_STAGE_A(PG8_SA(0, 0), a2, 0, vF0);
            PG8_WAIT_V(8); PG8_WAIT_L(0); PG8_BAR; PG8_MMA(1, 0, At, B0); PG8_MMA(1, 1, At, B1); PG8_BAR; PG8_SCHED;
            PG8_LDB(B0, 1, 0); PG8_LDB(B1, 1, 1); PG8_SCHED; PG8_LDA(At, 1, 0); PG8_STAGE_A(PG8_SA(0, 1), a2, 1, vF1);
            PG8_WAIT_V(8); PG8_WAIT_L(0); PG8_BAR; PG8_MMA(0, 0, At, B0); PG8_MMA(0, 1, At, B1); PG8_BAR; PG8_SCHED;
            PG8_LDA(At, 1, 1); PG8_STAGE_B(PG8_SB(1, 0), b3); PG8_STAGE_B(PG8_SB(1, 1), b3 + hstepB); PG8_STAGE_A(PG8_SA(1, 0), a3, 0, vF0);
            PG8_WAIT_V(8); PG8_WAIT_L(0); PG8_BAR; PG8_MMA(1, 0, At, B0); PG8_MMA(1, 1, At, B1); PG8_BAR; PG8_SCHED;
        }
        if (wr == 0) PG8_BAR;
        E(acc, cur, wr, wc, fr, fq);
        if (!has_next) break;
#pragma unroll
        for (int a = 0; a < 2; ++a)
#pragma unroll
            for (int b = 0; b < 2; ++b)
#pragma unroll
                for (int m = 0; m < 4; ++m)
#pragma unroll
                    for (int n = 0; n < 2; ++n) acc[a][b][m][n] = (f32x4){0.f, 0.f, 0.f, 0.f};
        cur = nxt; cA = nA; cB = nB; ++ui;
        if constexpr (Sched::GATHER) { vK[0] = vF1[0]; vK[1] = vF1[1]; }
        if (wr == 1) PG8_BAR;
    }
    PG8_WAIT_V(0);
    PG8_BAR;
#undef PG8_SA
#undef PG8_SB
#undef PG8_GLDS
#undef PG8_STAGE_A
#undef PG8_STAGE_B
#undef PG8_LDA
#undef PG8_LDB
#undef PG8_MMA
#undef PG8_WAIT_V
#undef PG8_WAIT_L
#undef PG8_BAR
#undef PG8_SCHED
}
}
using pg8::Unit;

struct DenseSched {
    static constexpr bool GATHER = false;
    const char* A; const char* Bt; int K; int lda; pg8::StaticOrder so;
    __device__ __forceinline__ bool next(int i, Unit& u) const { int pm, pn; if (!so.next(i, pm, pn)) return false; u.pm = pm; u.pn = pn; u.e = 0; u.nvalid = 256; u.slot0 = pm * 256; u.lpos0 = 0; return true; }
    __device__ __forceinline__ const char* a_base() const { return A; }
    __device__ __forceinline__ unsigned a_off(const Unit& u, int r) const { return 0u; }
    __device__ __forceinline__ size_t a_unit_off(const Unit& u) const { return (size_t)u.pm * 256 * lda * 2; }
    __device__ __forceinline__ const char* b_base(const Unit& u) const { return Bt + (size_t)u.pn * 256 * K * 2; }
};
struct MoeTab { const volatile LAS int* cnt; const volatile LAS int* mtpref; const volatile LAS int* spref; };
template <bool GATHER_> struct MoeSched {
    static constexpr bool GATHER = GATHER_;
    const char* A; const char* Bt; int K; int lda; int ntn; size_t bstride_e; const int* ltok; MoeTab T; int G, c;
    __device__ __forceinline__ bool next(int i, Unit& u) const {
        const int L = i * G + c; const int total = T.mtpref[32] * ntn; if (L >= total) return false;
        const int tix = L / ntn; u.pn = L - tix * ntn; u.pm = tix;
        int e = 0;
#pragma unroll 1
        for (int k = 1; k < 32; ++k) if (T.mtpref[k] <= tix) e = k;
        const int mt = tix - T.mtpref[e]; u.e = e; u.slot0 = T.spref[e] + 256 * mt; const int rem = T.cnt[e] - 256 * mt; u.nvalid = rem < 256 ? rem : 256; u.lpos0 = e * MTOK + 256 * mt; return true;
    }
    __device__ __forceinline__ const char* a_base() const { return A; }
    __device__ __forceinline__ unsigned a_off(const Unit& u, int r) const { const int rr = r < u.nvalid ? r : u.nvalid - 1; return (unsigned)ltok[u.lpos0 + rr] * (unsigned)(lda * 2); }
    __device__ __forceinline__ size_t a_unit_off(const Unit& u) const { return (size_t)u.slot0 * lda * 2; }
    __device__ __forceinline__ const char* b_base(const Unit& u) const { return Bt + (size_t)u.e * bstride_e + (size_t)u.pn * 256 * K * 2; }
};

#define OPAQUE(p) asm volatile("" : "+v"(p))
struct EpiProj {
    static constexpr bool PERM = true;
    bf16* Pq; bf16* Pg; const float* rs; const f32x4* rope;
    __device__ __forceinline__ void operator()(const f32x4 (&acc)[2][2][4][2], const Unit& u, int wr, int wc, int fr, int fq) const {
        const int colh = wc * 32 + fq * 8;
        const int ib = (colh & 63) >> 2;
        const int row0 = u.pm * 256 + wr * 64 + fr;
        int mode[2]; bf16* ob[2]; size_t ostep[2];
#pragma unroll
        for (int bj = 0; bj < 2; ++bj) {
            const int h128 = 2 * u.pn + bj;
            if (h128 >= 24) mode[bj] = 3;
            else if (h128 < 6) mode[bj] = h128 < 4 ? 1 : (h128 == 4 ? 2 : 0);
            else { const int j = (h128 - 6) % 6; mode[bj] = j < 2 ? 1 : (j < 4 ? 2 : 0); }
            const int opitch = (h128 < 24) ? NQKV : NGATE;
            ob[bj] = ((h128 < 24) ? Pq + h128 * 128 + colh : Pg + (h128 - 24) * 128 + colh) + (size_t)row0 * opitch;
            ostep[bj] = (size_t)opitch * 16;
        }
        const float* rsp = rs + row0;
        const f32x4* rp = rope + (size_t)(row0 & (SEQ - 1)) * 16 + ib;
#pragma unroll
        for (int ai = 0; ai < 2; ++ai)
#pragma unroll
            for (int m = 0; m < 4; ++m) {
                OPAQUE(rsp); OPAQUE(rp); OPAQUE(ob[0]); OPAQUE(ob[1]);
                const float s = *rsp;
                f32x4 c0 = {0.f, 0.f, 0.f, 0.f}, c1 = c0;
                if (mode[0] == 1 || mode[0] == 2 || mode[1] == 1 || mode[1] == 2) { c0 = rp[0]; c1 = rp[1]; }
#pragma unroll
                for (int bj = 0; bj < 2; ++bj) {
                    f32x4 v0 = acc[ai][bj][m][0] * s, v1 = acc[ai][bj][m][1] * s;
                    if (mode[bj] == 1 || mode[bj] == 2) {
                        f32x4 o0, o1;
                        o0[0] = v0[0] * c0[0] - v0[1] * c0[1]; o0[1] = v0[1] * c0[0] + v0[0] * c0[1];
                        o0[2] = v0[2] * c0[2] - v0[3] * c0[3]; o0[3] = v0[3] * c0[2] + v0[2] * c0[3];
                        o1[0] = v1[0] * c1[0] - v1[1] * c1[1]; o1[1] = v1[1] * c1[0] + v1[0] * c1[1];
                        o1[2] = v1[2] * c1[2] - v1[3] * c1[3]; o1[3] = v1[3] * c1[2] + v1[2] * c1[3];
                        const float qs = (mode[bj] == 1) ? QSCALE : 1.0f;
                        v0 = o0 * qs; v1 = o1 * qs;
                    } else if (mode[bj] == 3) {
#pragma unroll
                        for (int j = 0; j < 4; ++j) { v0[j] = sigmoidf_fast(v0[j]); v1[j] = sigmoidf_fast(v1[j]); }
                    }
                    u32x4 w; w.x = cvtpk(v0[0], v0[1]); w.y = cvtpk(v0[2], v0[3]); w.z = cvtpk(v1[0], v1[1]); w.w = cvtpk(v1[2], v1[3]);
                    *(u32x4*)(ob[bj]) = w;
                }
                const int adv = (m == 3) ? 5 : 1;
                rsp += 16 * adv; rp += (size_t)16 * 16 * adv; ob[0] += ostep[0] * adv; ob[1] += ostep[1] * adv;
            }
    }
};
template <bool ADD> struct EpiGate {
    static constexpr bool PERM = true;
    const bf16* gate; const bf16* prev; bf16* out;
    __device__ __forceinline__ void operator()(const f32x4 (&acc)[2][2][4][2], const Unit& u, int wr, int wc, int fr, int fq) const {
        const int row0 = u.pm * 256 + wr * 64 + fr, col0 = u.pn * 256 + wc * 32 + fq * 8;
        const bf16* gp = gate + (size_t)row0 * NGATE + col0; const bf16* pp = prev + (size_t)row0 * DM + col0; bf16* op = out + (size_t)row0 * DM + col0;
#pragma unroll
        for (int ai = 0; ai < 2; ++ai)
#pragma unroll
            for (int m = 0; m < 4; ++m) {
                OPAQUE(gp); OPAQUE(op); if (ADD) OPAQUE(pp);
#pragma unroll
                for (int bj = 0; bj < 2; ++bj) {
                    const u32x4 g = *(const u32x4*)(gp + bj * 128);
                    const f32x4 a0 = acc[ai][bj][m][0], a1 = acc[ai][bj][m][1];
                    float r[8];
                    r[0] = a0[0] * bflo(g.x); r[1] = a0[1] * bfhi(g.x); r[2] = a0[2] * bflo(g.y); r[3] = a0[3] * bfhi(g.y);
                    r[4] = a1[0] * bflo(g.z); r[5] = a1[1] * bfhi(g.z); r[6] = a1[2] * bflo(g.w); r[7] = a1[3] * bfhi(g.w);
                    if (ADD) { const u32x4 p = *(const u32x4*)(pp + bj * 128);
                        r[0] += bflo(p.x); r[1] += bfhi(p.x); r[2] += bflo(p.y); r[3] += bfhi(p.y); r[4] += bflo(p.z); r[5] += bfhi(p.z); r[6] += bflo(p.w); r[7] += bfhi(p.w); }
                    u32x4 w; w.x = cvtpk(r[0], r[1]); w.y = cvtpk(r[2], r[3]); w.z = cvtpk(r[4], r[5]); w.w = cvtpk(r[6], r[7]);
                    *(u32x4*)(op + bj * 128) = w;
                }
                const int adv = (m == 3) ? 5 : 1;
                gp += (size_t)16 * NGATE * adv; pp += (size_t)16 * DM * adv; op += (size_t)16 * DM * adv;
            }
    }
};
struct EpiResid {
    static constexpr bool PERM = false;
    const float* base; float* xout; bf16* xb;
    __device__ __forceinline__ void operator()(const f32x4 (&acc)[2][2][4][2], const Unit& u, int wr, int wc, int fr, int fq) const {
#pragma unroll
        for (int ai = 0; ai < 2; ++ai)
#pragma unroll
            for (int m = 0; m < 4; ++m) {
                const size_t row = (size_t)(u.pm * 256 + ai * 128 + wr * 64 + m * 16 + fr);
#pragma unroll
                for (int bj = 0; bj < 2; ++bj)
#pragma unroll
                    for (int n = 0; n < 2; ++n) {
                        const int col = u.pn * 256 + bj * 128 + wc * 32 + n * 16 + fq * 4;
                        const f32x4 b = *(const f32x4*)(base + row * DM + col);
                        const f32x4 v = b + acc[ai][bj][m][n];
                        *(f32x4*)(xout + row * DM + col) = v;
                        u32x2 w; w.x = cvtpk(v[0], v[1]); w.y = cvtpk(v[2], v[3]);
                        *(u32x2*)(xb + row * DM + col) = w;
                    }
            }
    }
};
struct EpiSwiglu {
    static constexpr bool PERM = true;
    const int* ltok; const float* lw; const float* rs; bf16* H;
    __device__ __forceinline__ void operator()(const f32x4 (&acc)[2][2][4][2], const Unit& u, int wr, int wc, int fr, int fq) const {
#pragma unroll
        for (int ai = 0; ai < 2; ++ai)
#pragma unroll
            for (int m = 0; m < 4; ++m) {
                const int rr = ai * 128 + wr * 64 + m * 16 + fr;
                if (rr < u.nvalid) {
                    const int tok = ltok[u.lpos0 + rr]; const float w = lw[u.lpos0 + rr]; const float s = rs[tok];
#pragma unroll
                    for (int bj = 0; bj < 2; ++bj) {
                        const f32x4 a0 = acc[ai][bj][m][0] * s, a1 = acc[ai][bj][m][1] * s;
                        const float h0 = a0[0] * sigmoidf_fast(a0[0]) * a0[1] * w, h1 = a0[2] * sigmoidf_fast(a0[2]) * a0[3] * w;
                        const float h2 = a1[0] * sigmoidf_fast(a1[0]) * a1[1] * w, h3 = a1[2] * sigmoidf_fast(a1[2]) * a1[3] * w;
                        u32x2 o; o.x = cvtpk(h0, h1); o.y = cvtpk(h2, h3);
                        *(u32x2*)(H + (size_t)(u.slot0 + rr) * DEXP + u.pn * 128 + bj * 64 + wc * 16 + fq * 4) = o;
                    }
                }
            }
    }
};
struct EpiY {
    static constexpr bool PERM = true;
    bf16* Y;
    __device__ __forceinline__ void operator()(const f32x4 (&acc)[2][2][4][2], const Unit& u, int wr, int wc, int fr, int fq) const {
#pragma unroll
        for (int ai = 0; ai < 2; ++ai)
#pragma unroll
            for (int m = 0; m < 4; ++m) {
                const int rr = ai * 128 + wr * 64 + m * 16 + fr;
                if (rr < u.nvalid) {
#pragma unroll
                    for (int bj = 0; bj < 2; ++bj) {
                        const f32x4 a0 = acc[ai][bj][m][0], a1 = acc[ai][bj][m][1];
                        u32x4 w; w.x = cvtpk(a0[0], a0[1]); w.y = cvtpk(a0[2], a0[3]); w.z = cvtpk(a1[0], a1[1]); w.w = cvtpk(a1[2], a1[3]);
                        *(u32x4*)(Y + (size_t)(u.slot0 + rr) * DM + u.pn * 256 + bj * 128 + wc * 32 + fq * 8) = w;
                    }
                }
            }
    }
};

#define XB_TMO      128
#define XB_XCNT(j)  (256  + 64 * (j))
#define XB_XSUB(j)  (1280 + 64 * (j))
#define XB_XGEN(j)  (2304 + 64 * (j))
#define XB_TOP      3328
#define XB_TOPGEN   3392
#define XCD_BAR_WORDS 3456
#define XB_SPIN_CAP (1u << 18)
__device__ __forceinline__ unsigned xb_ld(unsigned* p)              { return __hip_atomic_load(p, __ATOMIC_RELAXED, __HIP_MEMORY_SCOPE_AGENT); }
__device__ __forceinline__ unsigned xb_add(unsigned* p, unsigned v) { return __hip_atomic_fetch_add(p, v, __ATOMIC_RELAXED, __HIP_MEMORY_SCOPE_AGENT); }
__device__ __forceinline__ unsigned xb_xcc_id() { return (unsigned)__builtin_amdgcn_s_getreg((3 << 11) | 20) & 0xFu; }
#define XB_SPIN(cond, bar) do { unsigned _sp = 0; while (cond) { __builtin_amdgcn_s_sleep(1); \
    if ((++_sp & 255u) == 0u) { if (xb_ld(&(bar)[XB_TMO])) break; if (_sp > XB_SPIN_CAP) { atomicAdd(&(bar)[XB_TMO], 1u); break; } } } } while (0)
struct XcdBarrier { unsigned* bar; unsigned x; volatile LAS unsigned* st; };
__device__ __forceinline__ XcdBarrier xcd_barrier_post(unsigned* bar, volatile LAS unsigned* st) {
    XcdBarrier b; b.bar = bar; b.x = xb_xcc_id(); b.st = st;
    if (threadIdx.x == 0) (void)xb_add(&bar[XB_XCNT(b.x)], 1u);
    return b;
}
__device__ __forceinline__ void xcd_barrier_complete(unsigned* bar, unsigned x, unsigned& nloc, unsigned& nx) {
    const unsigned G = gridDim.x * gridDim.y * gridDim.z;
    unsigned sum, cnt, mine, sp = 0u;
    for (;;) {
        sum = 0u; cnt = 0u; mine = 0u;
#pragma unroll
        for (unsigned j = 0; j < 16; ++j) { const unsigned c = xb_ld(&bar[XB_XCNT(j)]); sum += c; cnt += (c > 0u) ? 1u : 0u; mine = (j == x) ? c : mine; }
        if (sum == G) break;
        __builtin_amdgcn_s_sleep(1);
        if ((++sp & 255u) == 0u) { if (xb_ld(&bar[XB_TMO])) break; if (sp > XB_SPIN_CAP) { atomicAdd(&bar[XB_TMO], 1u); break; } }
    }
    nloc = mine > 0u ? mine : 1u; nx = cnt > 0u ? cnt : 1u;
}
__device__ __forceinline__ void xcd_barrier(const XcdBarrier& b) {
    asm volatile("s_waitcnt vmcnt(0)" ::: "memory");
    __syncthreads();
    if (threadIdx.x == 0) {
        unsigned* bar = b.bar;
        __builtin_amdgcn_s_waitcnt(0);
        unsigned nloc = b.st[0], nx = b.st[1];
        if (nloc == 0u) { xcd_barrier_complete(bar, b.x, nloc, nx); b.st[0] = nloc; b.st[1] = nx; }
        const unsigned old = xb_add(&bar[XB_XSUB(b.x)], 1u);
        const unsigned gen = old / nloc;
        if (old + 1u == (gen + 1u) * nloc) {
            __builtin_amdgcn_fence(__ATOMIC_RELEASE, "agent");
            asm volatile("s_waitcnt vmcnt(0)" ::: "memory");
            const unsigned og = xb_add(&bar[XB_TOP], 1u);
            const unsigned tg = og / nx;
            if (og + 1u == (tg + 1u) * nx) xb_add(&bar[XB_TOPGEN], 1u);
            else XB_SPIN(xb_ld(&bar[XB_TOPGEN]) == tg, bar);
            __builtin_amdgcn_fence(__ATOMIC_ACQUIRE, "agent");
            xb_add(&bar[XB_XGEN(b.x)], 1u);
            asm volatile("s_waitcnt vmcnt(0)" ::: "memory");
        } else {
            XB_SPIN(xb_ld(&bar[XB_XGEN(b.x)]) == gen, bar);
            __builtin_amdgcn_fence(__ATOMIC_ACQUIRE, "agent");
            asm volatile("s_waitcnt vmcnt(0)" ::: "memory");
        }
    }
    __syncthreads();
}

struct Args {
    const float* x; const float* attn_g; const float* w_in; const float* a_sink; const float* w_a; const float* w_b; const float* w_out; const float* ffn_g;
    const float* w_rg; const float* b_rg; const float* w_re; const float* b_re; const float* w_eg; const float* w_eu; const float* w_ed; const float* fin_g;
    float* out; unsigned char* ws; int ph_lo, ph_hi;
};
typedef const __attribute__((address_space(4))) Args* CArgs;
struct Frame {
    LAS unsigned char* lds; volatile LAS int* misc;
    int wave, G, vcu, gw, ngw;
};
__device__ __forceinline__ int otid() { int t = threadIdx.x; asm volatile("" : "+v"(t)); return t; }
__device__ __forceinline__ float wave_sum(float v) {
#pragma unroll
    for (int o = 1; o < 64; o <<= 1) v += __shfl_xor(v, o);
    return v;
}

struct SrcPlain { const float* W; __device__ __forceinline__ const float* col(int n) const { return W + n; } };
struct SrcWin { const float* W;
    __device__ __forceinline__ const float* col(int n) const {
        bool rope = false;
        if (n < 640) rope = true; else if (n >= 768 && n < NQKV) rope = ((n - 768) % 768) < 512;
        int nl = n; if (rope) { const int p = n & 63; nl = (n & ~63) + (p >> 1) + 32 * (p & 1); }
        return W + nl; } };
struct SrcGU { const float* Wg; const float* Wu; __device__ __forceinline__ const float* col(int n) const { const uintptr_t g = (uintptr_t)Wg, d = (uintptr_t)Wu - (uintptr_t)Wg; return (const float*)(g + (uintptr_t)(n & 1) * d) + (n >> 1); } };
template <class Src> __device__ __forceinline__ void transpose_item(const Src& src, int ldn, int K, bf16* WT, const float* gk, LAS float* scr, int kb, int nb, int lane) {
    const int k0 = 64 * kb, n0 = 32 * nb;
    const float* cp = src.col(n0 + (lane & 31));
#pragma unroll 8
    for (int i = 0; i < 32; ++i) { const int kk = 2 * i + (lane >> 5); float v = cp[(size_t)(k0 + kk) * ldn]; if (gk) v *= gk[k0 + kk]; scr[kk * 33 + (lane & 31)] = v; }
    LDS_WAIT(); asm volatile("" ::: "memory");
    const int c = lane & 7;
#pragma unroll
    for (int j = 0; j < 4; ++j) { const int n = (lane >> 3) + 8 * j; const LAS float* s = scr + (8 * c) * 33 + n;
        u32x4 o; o.x = cvtpk(s[0 * 33], s[1 * 33]); o.y = cvtpk(s[2 * 33], s[3 * 33]); o.z = cvtpk(s[4 * 33], s[5 * 33]); o.w = cvtpk(s[6 * 33], s[7 * 33]);
        *(u32x4*)(WT + (size_t)(n0 + n) * K + k0 + 8 * c) = o; }
    LDS_WAIT(); asm volatile("" ::: "memory");
}
__device__ __forceinline__ void prep_phase(const Frame& F, CArgs a, int l) {
    const int tid = otid(), lane = tid & 63; (void)tid; (void)lane;
    unsigned char* ws = a->ws;
    LAS float* scr = (LAS float*)(F.lds + F.wave * 16384);
    constexpr int I_IN = 16 * 160, I_A = 8 * 32, I_B = 4 * 32, I_O = 16 * 32, I_GU = 16 * 16, I_D = 4 * 32;
    constexpr int NIT = I_IN + I_A + I_B + I_O + NEXP * (I_GU + I_D);
    const float* ag = a->attn_g + l * DM; const float* fg = a->ffn_g + l * DM;
    for (int it = F.gw; it < NIT; it += F.ngw) {
        int r = it;
        if (r < I_IN) { SrcWin s{a->w_in + (size_t)l * DM * DIN}; transpose_item(s, DIN, DM, (bf16*)(ws + WS_WIN), ag, scr, r / 160, r % 160, lane); continue; } r -= I_IN;
        if (r < I_A) { SrcPlain s{a->w_a + (size_t)l * 512 * DM}; transpose_item(s, DM, 512, (bf16*)(ws + WS_WA), nullptr, scr, r / 32, r % 32, lane); continue; } r -= I_A;
        if (r < I_B) { SrcPlain s{a->w_b + (size_t)l * 256 * DM}; transpose_item(s, DM, 256, (bf16*)(ws + WS_WB), nullptr, scr, r / 32, r % 32, lane); continue; } r -= I_B;
        if (r < I_O) { SrcPlain s{a->w_out + (size_t)l * DM * DM}; transpose_item(s, DM, DM, (bf16*)(ws + WS_WOUT), nullptr, scr, r / 32, r % 32, lane); continue; } r -= I_O;
        const int e = r / (I_GU + I_D); r -= e * (I_GU + I_D);
        const size_t eo = ((size_t)l * NEXP + e) * DM * DEXP;
        if (r < I_GU) { SrcGU s{a->w_eg + eo, a->w_eu + eo}; transpose_item(s, DEXP, DM, (bf16*)(ws + WS_WGU) + (size_t)e * 512 * DM, fg, scr, r / 16, r % 16, lane); continue; } r -= I_GU;
        { SrcPlain s{a->w_ed + eo}; transpose_item(s, DM, DEXP, (bf16*)(ws + WS_WD) + (size_t)e * DM * DEXP, nullptr, scr, r / 32, r % 32, lane); }
    }
    {
        float* wrp = (float*)(ws + WS_WR);
        const float* wg = a->w_rg + (size_t)l * DM * 4; const float* we = a->w_re + (size_t)l * DM * NEXP;
        for (int idx = blockIdx.x * NTHREADS + tid; idx < 64 * 3 * 64 * 4; idx += F.G * NTHREADS) {
            const int s = idx & 3, ln = (idx >> 2) & 63, q = idx >> 8, nt = q % 3, i = q / 3;
            const int k = 16 * i + 4 * (ln >> 4) + s, n = 16 * nt + (ln & 15);
            float v = 0.f; if (n < 4) v = wg[k * 4 + n]; else if (n < 36) v = we[k * NEXP + (n - 4)];
            wrp[idx] = v * fg[k];
        }
    }
    if (l == 0) {
        float* rt = (float*)(ws + WS_ROPE);
        for (int idx = blockIdx.x * NTHREADS + tid; idx < SEQ * 32; idx += F.G * NTHREADS) {
            const int pos = idx >> 5, i = idx & 31;
            const float inv = 1.0f / powf(10000.0f, (float)(2 * i) / 64.0f);
            const float ang = (float)pos * inv;
            const double ad = (double)ang, kd = __builtin_rint(ad * 0.15915494309189535);
            const float rf = (float)__builtin_fma(-kd, 6.283185307179586, ad);
            rt[idx * 2] = cosf(rf); rt[idx * 2 + 1] = sinf(rf);
        }
        bf16* xb = (bf16*)(ws + WS_XB); float* rs1 = (float*)(ws + WS_RS1);
        for (int m = F.gw; m < MTOK; m += F.ngw) {
            const f32x4* xr = (const f32x4*)(a->x + (size_t)m * DM) + lane;
            f32x4 v[4]; float s = 0.f;
#pragma unroll
            for (int j = 0; j < 4; ++j) { v[j] = xr[64 * j]; s += (v[j][0] * v[j][0] + v[j][1] * v[j][1]) + (v[j][2] * v[j][2] + v[j][3] * v[j][3]); }
            s = wave_sum(s);
            u32x2* o = (u32x2*)(xb + (size_t)m * DM) + lane;
#pragma unroll
            for (int j = 0; j < 4; ++j) { u32x2 w; w.x = cvtpk(v[j][0], v[j][1]); w.y = cvtpk(v[j][2], v[j][3]); o[64 * j] = w; }
            if (lane == 0) rs1[m] = 1.0f / sqrtf(s * (1.0f / DM) + NORM_EPS);
        }
    }
}

__device__ __forceinline__ int crow(int r, int hi) { return (r & 3) + 8 * (r >> 2) + 4 * hi; }
__device__ __forceinline__ void attn_task(const bf16* P, int qcol, int kcol, int vcol, int b, int d, int r, int t, int W, float m0, float l0,
                                          bf16* outp, int opitch, float* lsep, LAS unsigned char* vl, int lane) {
    const int r32 = lane & 31, hi = lane >> 5;
    const int L32 = (SEQ / d) >> 5;
    const size_t tok0 = (size_t)b * SEQ + r;
    const size_t qtok = tok0 + (size_t)(32 * t + r32) * d;
    bf16x8 qf[4];
#pragma unroll
    for (int s = 0; s < 4; ++s) qf[s] = *(const bf16x8*)(P + qtok * NQKV + qcol + 16 * s + 8 * hi);
    f32x16 o0 = {}, o1 = {};
    float mrun = m0, lrun = l0;
    const int jlo = (t - W) < 0 ? 0 : (t - W), jhi = (t + W) > (L32 - 1) ? (L32 - 1) : (t + W);
    const LAS unsigned char* vrd = vl + (4 * hi + ((lane & 15) >> 2)) * 128 + (16 * ((lane >> 4) & 1) + 4 * (lane & 3)) * 2;
    for (int j = jlo; j <= jhi; ++j) {
        const size_t ktok = tok0 + (size_t)(32 * j + r32) * d;
        bf16x8 kf[4];
#pragma unroll
        for (int s = 0; s < 4; ++s) kf[s] = *(const bf16x8*)(P + ktok * NQKV + kcol + 16 * s + 8 * hi);
        u32x4 vv[4];
#pragma unroll
        for (int i = 0; i < 4; ++i) { const int row = (lane >> 3) + 8 * i; vv[i] = *(const u32x4*)(P + (tok0 + (size_t)(32 * j + row) * d) * NQKV + vcol + (lane & 7) * 8); }
#pragma unroll
        for (int i = 0; i < 4; ++i) { const int row = (lane >> 3) + 8 * i; *(LAS u32x4*)(vl + row * 128 + (lane & 7) * 16) = vv[i]; }
        f32x16 sc = {};
#pragma unroll
        for (int s = 0; s < 4; ++s) sc = __builtin_amdgcn_mfma_f32_32x32x16_bf16(kf[s], qf[s], sc, 0, 0, 0);
        if (j == t - W) {
#pragma unroll
            for (int g = 0; g < 16; ++g) if (crow(g, hi) < r32) sc[g] = -INFINITY;
        }
        if (j == t + W) {
#pragma unroll
            for (int g = 0; g < 16; ++g) if (crow(g, hi) > r32) sc[g] = -INFINITY;
        }
        float mx = sc[0];
#pragma unroll
        for (int g = 1; g < 16; ++g) mx = fmaxf(mx, sc[g]);
        mx = fmaxf(mx, __shfl_xor(mx, 32));
        const float mnew = fmaxf(mrun, mx);
        const float alpha = fast_exp2(mrun - mnew);
        float psum = 0.f;
#pragma unroll
        for (int g = 0; g < 16; ++g) { sc[g] = fast_exp2(sc[g] - mnew); psum += sc[g]; }
        psum += __shfl_xor(psum, 32);
        lrun = lrun * alpha + psum; mrun = mnew;
#pragma unroll
        for (int g = 0; g < 16; ++g) { o0[g] *= alpha; o1[g] *= alpha; }
        u32x4 p0, p1;
        p0.x = cvtpk(sc[0], sc[1]); p0.y = cvtpk(sc[2], sc[3]); p0.z = cvtpk(sc[4], sc[5]); p0.w = cvtpk(sc[6], sc[7]);
        p1.x = cvtpk(sc[8], sc[9]); p1.y = cvtpk(sc[10], sc[11]); p1.z = cvtpk(sc[12], sc[13]); p1.w = cvtpk(sc[14], sc[15]);
        const bf16x8 pf0 = __builtin_bit_cast(bf16x8, p0), pf1 = __builtin_bit_cast(bf16x8, p1);
        LDS_WAIT();
#define VTR(off) __builtin_bit_cast(s16x4, __builtin_amdgcn_ds_read_tr16_b64_v4i16((LAS s16x4*)(vrd + (off))))
#define VFRAG(s, dh) ({ const s16x4 _a = VTR((16 * (s)) * 128 + (dh) * 64), _b = VTR((16 * (s) + 8) * 128 + (dh) * 64); (bf16x8){_a[0], _a[1], _a[2], _a[3], _b[0], _b[1], _b[2], _b[3]}; })
        const bf16x8 v00 = VFRAG(0, 0), v10 = VFRAG(1, 0), v01 = VFRAG(0, 1), v11 = VFRAG(1, 1);
        o0 = __builtin_amdgcn_mfma_f32_32x32x16_bf16(v00, pf0, o0, 0, 0, 0);
        o0 = __builtin_amdgcn_mfma_f32_32x32x16_bf16(v10, pf1, o0, 0, 0, 0);
        o1 = __builtin_amdgcn_mfma_f32_32x32x16_bf16(v01, pf0, o1, 0, 0, 0);
        o1 = __builtin_amdgcn_mfma_f32_32x32x16_bf16(v11, pf1, o1, 0, 0, 0);
#undef VTR
#undef VFRAG
        LDS_WAIT();
    }
    const float inv = 1.0f / lrun;
    bf16* orow = outp + qtok * opitch;
#pragma unroll
    for (int g4 = 0; g4 < 4; ++g4) {
        u32x2 w0, w1;
        w0.x = cvtpk(o0[4 * g4] * inv, o0[4 * g4 + 1] * inv); w0.y = cvtpk(o0[4 * g4 + 2] * inv, o0[4 * g4 + 3] * inv);
        w1.x = cvtpk(o1[4 * g4] * inv, o1[4 * g4 + 1] * inv); w1.y = cvtpk(o1[4 * g4 + 2] * inv, o1[4 * g4 + 3] * inv);
        *(u32x2*)(orow + 8 * g4 + 4 * hi) = w0;
        *(u32x2*)(orow + 32 + 8 * g4 + 4 * hi) = w1;
    }
    if (lsep && hi == 0) lsep[qtok * 12] = (mrun + log2f(lrun)) * LN2;
}
__device__ __forceinline__ void attn_phase(const Frame& F, CArgs a, int l) {
    const int tid = otid(), lane = tid & 63; (void)tid; (void)lane;
    unsigned char* ws = a->ws;
    const bf16* P = (const bf16*)(ws + WS_PQ);
    bf16* ya = (bf16*)(ws + WS_YA); bf16* ob = (bf16*)(ws + WS_OBUF); float* lse = (float*)(ws + WS_LSE);
    LAS unsigned char* vl = F.lds + F.wave * 4096;
    constexpr int NA = BATCH * 2 * 128 * 4, NB1 = BATCH * 4 * 128;
    constexpr int NTASK = NA + 3 * NB1;
    for (int it = F.gw; it < NTASK; it += F.ngw) {
        if (it < NA) {
            const int g = it & 3, qt = (it >> 2) & 127, kvh = (it >> 9) & 1, b = it >> 10;
            const int hq = kvh * 4 + g;
            const float sk = a->a_sink[l * 8 + hq] * LOG2E;
            attn_task(P, hq * 64, 512 + kvh * 64, 640 + kvh * 64, b, 1, 0, qt, 4, sk, 1.0f, ya + hq * 64, 512, nullptr, vl, lane);
        } else {
            int r = it - NA; const int grp = r / NB1; r -= grp * NB1;
            const int d = grp == 0 ? 1 : (grp == 1 ? 4 : 16);
            const int tpr = 128 / d;
            const int tl = r % tpr; int q = r / tpr; const int res = q % d; q /= d; const int h = q & 3, b = q >> 2;
            const int base = 768 + 768 * grp;
            attn_task(P, base + h * 64, base + 256 + h * 64, base + 512 + h * 64, b, d, res, tl, 2, -1e30f, 0.0f, ob + grp * 256 + h * 64, 768, lse + grp * 4 + h, vl, lane);
        }
    }
}
__device__ __forceinline__ void comb_phase(const Frame& F, CArgs a) {
    const int tid = otid(), lane = tid & 63; (void)tid; (void)lane;
    unsigned char* ws = a->ws;
    const bf16* ob = (const bf16*)(ws + WS_OBUF); const float* lse = (const float*)(ws + WS_LSE); bf16* yb = (bf16*)(ws + WS_YB);
    for (int idx = blockIdx.x * NTHREADS + tid; idx < MTOK * 32; idx += F.G * NTHREADS) {
        const int tok = idx >> 5, c = idx & 31, h = c >> 3;
        const float l0 = lse[tok * 12 + h], l1 = lse[tok * 12 + 4 + h], l2 = lse[tok * 12 + 8 + h];
        const float mx = fmaxf(l0, fmaxf(l1, l2));
        float w0 = __expf(l0 - mx), w1 = __expf(l1 - mx), w2 = __expf(l2 - mx);
        const float inv = 1.0f / (w0 + w1 + w2); w0 *= inv; w1 *= inv; w2 *= inv;
        const u32x4 a0 = *(const u32x4*)(ob + (size_t)tok * 768 + c * 8), a1 = *(const u32x4*)(ob + (size_t)tok * 768 + 256 + c * 8), a2 = *(const u32x4*)(ob + (size_t)tok * 768 + 512 + c * 8);
        u32x4 o;
#define CMB(f) o.f = cvtpk(w0 * bflo(a0.f) + w1 * bflo(a1.f) + w2 * bflo(a2.f), w0 * bfhi(a0.f) + w1 * bfhi(a1.f) + w2 * bfhi(a2.f))
        CMB(x); CMB(y); CMB(z); CMB(w);
#undef CMB
        *(u32x4*)(yb + (size_t)tok * 256 + c * 8) = o;
    }
}

__device__ __forceinline__ void route_phase(const Frame& F, CArgs a, int l) {
    const int tid = otid(), lane = tid & 63; (void)tid; (void)lane;
    unsigned char* ws = a->ws;
    const float* x = a->out; const f32x4* wrp = (const f32x4*)(ws + WS_WR);
    float* rs2 = (float*)(ws + WS_RS2); i32x4* tokinfo = (i32x4*)(ws + WS_TOKINFO); int* ltok = (int*)(ws + WS_LTOK); float* lw = (float*)(ws + WS_LW);
    int* cnt = (int*)(ws + WS_CTL) + CW_CNT + l * 32;
    const float* brg = a->b_rg + l * 4; const float* bre = a->b_re + l * NEXP;
    LAS float* Lw = (LAS float*)(F.lds + F.wave * 4096);
    for (int task = F.gw; task < MTOK / 16; task += F.ngw) {
        const int row0 = task * 16;
        const f32x4* xr = (const f32x4*)(x + (size_t)(row0 + (lane & 15)) * DM) + (lane >> 4);
        f32x4 acc0 = {0.f, 0.f, 0.f, 0.f}, acc1 = acc0, acc2 = acc0; float ss = 0.f;
#pragma unroll 4
        for (int i = 0; i < 64; ++i) {
            const f32x4 xv = xr[4 * i];
            ss += (xv[0] * xv[0] + xv[1] * xv[1]) + (xv[2] * xv[2] + xv[3] * xv[3]);
            const f32x4 w0 = wrp[(i * 3 + 0) * 64 + lane], w1 = wrp[(i * 3 + 1) * 64 + lane], w2 = wrp[(i * 3 + 2) * 64 + lane];
#pragma unroll
            for (int s = 0; s < 4; ++s) {
                acc0 = __builtin_amdgcn_mfma_f32_16x16x4f32(xv[s], w0[s], acc0, 0, 0, 0);
                acc1 = __builtin_amdgcn_mfma_f32_16x16x4f32(xv[s], w1[s], acc1, 0, 0, 0);
                acc2 = __builtin_amdgcn_mfma_f32_16x16x4f32(xv[s], w2[s], acc2, 0, 0, 0);
            }
        }
        ss += __shfl_xor(ss, 16); ss += __shfl_xor(ss, 32);
        const float rsv = 1.0f / sqrtf(ss * (1.0f / DM) + NORM_EPS);
#pragma unroll
        for (int g = 0; g < 4; ++g) { const int rw = 4 * (lane >> 4) + g; Lw[rw * 48 + (lane & 15)] = acc0[g]; Lw[rw * 48 + 16 + (lane & 15)] = acc1[g]; Lw[rw * 48 + 32 + (lane & 15)] = acc2[g]; }
        LDS_WAIT(); asm volatile("" ::: "memory");
        if (lane < 16) {
            const int tok = row0 + lane;
            const LAS float* Lr = Lw + lane * 48;
            float gl[4];
#pragma unroll
            for (int g = 0; g < 4; ++g) gl[g] = Lr[g] * rsv + brg[g];
            int gi = 0; float gm = gl[0];
#pragma unroll
            for (int g = 1; g < 4; ++g) if (gl[g] > gm) { gm = gl[g]; gi = g; }
            float den = 0.f;
#pragma unroll
            for (int g = 0; g < 4; ++g) den += expf(gl[g] - gm);
            const float gw = 1.0f / den;
            float v1 = -INFINITY, v2 = -INFINITY; int i1 = 0, i2 = 0;
#pragma unroll
            for (int e = 0; e < 8; ++e) {
                const float v = Lr[4 + 8 * gi + e] * rsv + bre[8 * gi + e];
                if (v > v1) { v2 = v1; i2 = i1; v1 = v; i1 = e; } else if (v > v2) { v2 = v; i2 = e; }
            }
            const float p1 = 1.0f / (1.0f + expf(v2 - v1)), p2 = 1.0f - p1;
            const int e1 = 8 * gi + i1, e2 = 8 * gi + i2;
            const int pos1 = atomicAdd(&cnt[e1], 1), pos2 = atomicAdd(&cnt[e2], 1);
            ltok[e1 * MTOK + pos1] = tok; lw[e1 * MTOK + pos1] = p1 * gw;
            ltok[e2 * MTOK + pos2] = tok; lw[e2 * MTOK + pos2] = p2 * gw;
            tokinfo[tok] = (i32x4){e1, pos1, e2, pos2};
            rs2[tok] = rsv;
        }
        LDS_WAIT(); asm volatile("" ::: "memory");
    }
}
__device__ __forceinline__ MoeTab moe_tables(const Frame& F, CArgs a, int l) {
    const int tid = otid(), lane = tid & 63; (void)tid; (void)lane;
    volatile LAS int* cntL = F.misc + 64; volatile LAS int* mtp = F.misc + 128; volatile LAS int* sp = F.misc + 192;
    const int* cnt = (const int*)(a->ws + WS_CTL) + CW_CNT + l * 32;
    __syncthreads();
    if (tid < 32) cntL[tid] = __hip_atomic_load(cnt + tid, __ATOMIC_RELAXED, __HIP_MEMORY_SCOPE_AGENT);
    __syncthreads();
    if (tid == 0) { int mt = 0, s = 0; for (int e = 0; e < 32; ++e) { mtp[e] = mt; sp[e] = s; const int c = cntL[e]; mt += (c + 255) >> 8; s += c; } mtp[32] = mt; sp[32] = s; }
    __syncthreads();
    MoeTab T; T.cnt = cntL; T.mtpref = mtp; T.spref = sp; return T;
}
__device__ __forceinline__ void fin_phase(const Frame& F, CArgs a, int l, const MoeTab& T) {
    const int tid = otid(), lane = tid & 63; (void)tid; (void)lane;
    unsigned char* ws = a->ws;
    const i32x4* tokinfo = (const i32x4*)(ws + WS_TOKINFO); const bf16* Y = (const bf16*)(ws + WS_Y);
    bf16* xb = (bf16*)(ws + WS_XB); float* rs1 = (float*)(ws + WS_RS1);
    for (int m = F.gw; m < MTOK; m += F.ngw) {
        const i32x4 ti = tokinfo[m];
        const int s1 = T.spref[ti[0]] + ti[1], s2 = T.spref[ti[2]] + ti[3];
        f32x4* xr = (f32x4*)(a->out + (size_t)m * DM) + lane;
        const u32x2* y1 = (const u32x2*)(Y + (size_t)s1 * DM) + lane; const u32x2* y2 = (const u32x2*)(Y + (size_t)s2 * DM) + lane;
        f32x4 v[4]; float s = 0.f;
#pragma unroll
        for (int j = 0; j < 4; ++j) {
            v[j] = xr[64 * j]; const u32x2 p = y1[64 * j], q = y2[64 * j];
            v[j][0] += bflo(p.x) + bflo(q.x); v[j][1] += bfhi(p.x) + bfhi(q.x); v[j][2] += bflo(p.y) + bflo(q.y); v[j][3] += bfhi(p.y) + bfhi(q.y);
            s += (v[j][0] * v[j][0] + v[j][1] * v[j][1]) + (v[j][2] * v[j][2] + v[j][3] * v[j][3]);
        }
        s = wave_sum(s);
        const float rsv = 1.0f / sqrtf(s * (1.0f / DM) + NORM_EPS);
        if (l == DEPTH - 1) {
            const f32x4* g = (const f32x4*)a->fin_g + lane;
#pragma unroll
            for (int j = 0; j < 4; ++j) xr[64 * j] = v[j] * rsv * g[64 * j];
        } else {
            u32x2* o = (u32x2*)(xb + (size_t)m * DM) + lane;
#pragma unroll
            for (int j = 0; j < 4; ++j) { xr[64 * j] = v[j]; u32x2 w; w.x = cvtpk(v[j][0], v[j][1]); w.y = cvtpk(v[j][2], v[j][3]); o[64 * j] = w; }
            if (lane == 0) rs1[m] = rsv;
        }
    }
}

constexpr int PH_PREP = 0, PH_GEMM1 = 1, PH_ATTN = 2, PH_COMB = 3, PH_MERGE = 4, PH_OUT = 5, PH_ROUTE = 6, PH_UP = 7, PH_DOWN = 8, PH_FIN = 9, PH_PER_LAYER = 10, NPHASE = PH_PER_LAYER * DEPTH;

__global__ void __launch_bounds__(NTHREADS, 2) fwd_kernel(Args a_by_value) {
    extern __shared__ __attribute__((aligned(16))) unsigned char lds_raw[];
    Frame F;
    F.lds = (LAS unsigned char*)lds_raw; F.misc = (volatile LAS int*)(F.lds + MISC_OFF);
    F.wave = __builtin_amdgcn_readfirstlane((int)threadIdx.x >> 6);
    F.G = gridDim.x; { const int bx = blockIdx.x; F.vcu = (F.G % 8 == 0) ? (bx % 8) * (F.G / 8) + bx / 8 : bx; }
    F.gw = blockIdx.x * NWAVES + F.wave; F.ngw = F.G * NWAVES;
    CArgs a = (CArgs)__builtin_amdgcn_kernarg_segment_ptr();
    unsigned char* ws = a->ws;
    const int ph_lo = a->ph_lo, ph_hi = a->ph_hi;
    for (int u = threadIdx.x; u < 1024; u += NTHREADS) F.misc[u] = 0;
    __syncthreads();
#if !MK_MULTI
    XcdBarrier bar = xcd_barrier_post((unsigned*)(ws + WS_CTL) + CW_BAR, (volatile LAS unsigned*)(F.misc + 8));
#define GRID_BAR() xcd_barrier(bar)
#else
#define GRID_BAR() do { } while (0)
#endif
    for (int ph = ph_lo; ph < ph_hi; ++ph) {
        const int l = ph / PH_PER_LAYER, k = ph % PH_PER_LAYER;
        {
            int tv = threadIdx.x; asm volatile("" : "+v"(tv)); int bx = blockIdx.x; asm volatile("" : "+s"(bx)); asm volatile("" : "+s"(a)); ws = a->ws;
            F.wave = __builtin_amdgcn_readfirstlane(tv >> 6); F.gw = bx * NWAVES + F.wave;
        }
        if (k == PH_PREP && (PHMASK & 1)) {
            prep_phase(F, a, l);
        } else if (k == PH_GEMM1 && (PHMASK & 2)) {
            DenseSched S; S.A = (const char*)(ws + WS_XB); S.Bt = (const char*)(ws + WS_WIN); S.K = DM; S.lda = DM; S.so.init(MTOK, DIN, F.G, (int)blockIdx.x);
            EpiProj E{(bf16*)(ws + WS_PQ), (bf16*)(ws + WS_PG), (const float*)(ws + WS_RS1), (const f32x4*)(ws + WS_ROPE)};
            pg8::gemm_phase(F.lds, S, E);
        } else if (k == PH_ATTN && (PHMASK & 4)) {
            attn_phase(F, a, l);
        } else if (k == PH_COMB && (PHMASK & 8)) {
            comb_phase(F, a);
        } else if (k == PH_MERGE && (PHMASK & 16)) {
            { DenseSched S; S.A = (const char*)(ws + WS_YA); S.Bt = (const char*)(ws + WS_WA); S.K = 512; S.lda = 512; S.so.init(MTOK, DM, F.G, (int)blockIdx.x);
              EpiGate<false> E{(const bf16*)(ws + WS_PG), nullptr, (bf16*)(ws + WS_M1)};
              pg8::gemm_phase(F.lds, S, E); }
            { DenseSched S; S.A = (const char*)(ws + WS_YB); S.Bt = (const char*)(ws + WS_WB); S.K = 256; S.lda = 256; S.so.init(MTOK, DM, F.G, (int)blockIdx.x);
              EpiGate<true> E{(const bf16*)(ws + WS_PG) + DM, (const bf16*)(ws + WS_M1), (bf16*)(ws + WS_MRG)};
              pg8::gemm_phase(F.lds, S, E); }
        } else if (k == PH_OUT && (PHMASK & 32)) {
            DenseSched S; S.A = (const char*)(ws + WS_MRG); S.Bt = (const char*)(ws + WS_WOUT); S.K = DM; S.lda = DM; S.so.init(MTOK, DM, F.G, (int)blockIdx.x);
            EpiResid E{l == 0 ? a->x : a->out, a->out, (bf16*)(ws + WS_XB)};
            pg8::gemm_phase(F.lds, S, E);
        } else if (k == PH_ROUTE && (PHMASK & 64)) {
            route_phase(F, a, l);
        } else if (k == PH_UP && (PHMASK & 128)) {
            const MoeTab T = moe_tables(F, a, l);
            MoeSched<true> S; S.A = (const char*)(ws + WS_XB); S.Bt = (const char*)(ws + WS_WGU); S.K = DM; S.lda = DM; S.ntn = 2; S.bstride_e = (size_t)512 * DM * 2; S.ltok = (const int*)(ws + WS_LTOK); S.T = T; S.G = F.G; S.c = (int)blockIdx.x;
            EpiSwiglu E{(const int*)(ws + WS_LTOK), (const float*)(ws + WS_LW), (const float*)(ws + WS_RS2), (bf16*)(ws + WS_H)};
            pg8::gemm_phase(F.lds, S, E);
        } else if (k == PH_DOWN && (PHMASK & 256)) {
            const MoeTab T = moe_tables(F, a, l);
            MoeSched<false> S; S.A = (const char*)(ws + WS_H); S.Bt = (const char*)(ws + WS_WD); S.K = DEXP; S.lda = DEXP; S.ntn = 4; S.bstride_e = (size_t)DM * DEXP * 2; S.ltok = nullptr; S.T = T; S.G = F.G; S.c = (int)blockIdx.x;
            EpiY E{(bf16*)(ws + WS_Y)};
            pg8::gemm_phase(F.lds, S, E);
        } else if (k == PH_FIN && (PHMASK & 512)) {
            const MoeTab T = moe_tables(F, a, l);
            fin_phase(F, a, l, T);
        }
        if (ph + 1 < ph_hi) GRID_BAR();
    }
}

extern "C" void kernel_launch(void* const* d_in, const int* in_sizes, int n_in, void* d_out, int out_size, void* d_ws, size_t ws_size, hipStream_t stream) {
    static int grid = 0;
    if (grid == 0) {
        if (n_in != 16 || out_size != MTOK * DM || ws_size < WS_END) { fprintf(stderr, "kernel_launch: unexpected shapes (n_in %d out %d ws %zu)\n", n_in, out_size, ws_size); grid = -1; return; }
        int dev = 0, cus = 0, per_cu = 0;
        if (hipGetDevice(&dev) != hipSuccess || hipDeviceGetAttribute(&cus, hipDeviceAttributeMultiprocessorCount, dev) != hipSuccess) { grid = -1; return; }
        if (hipFuncSetAttribute((const void*)fwd_kernel, hipFuncAttributeMaxDynamicSharedMemorySize, LDS_BYTES) != hipSuccess) { fprintf(stderr, "kernel_launch: hipFuncSetAttribute failed\n"); grid = -1; return; }
        if (hipOccupancyMaxActiveBlocksPerMultiprocessor(&per_cu, (const void*)fwd_kernel, NTHREADS, LDS_BYTES) != hipSuccess || per_cu < 1) { fprintf(stderr, "kernel_launch: occupancy query says %d\n", per_cu); (void)hipGetLastError(); }
        grid = cus;
    }
    if (grid < 0) return;
    (void)hipMemsetAsync((char*)d_ws + WS_CTL, 0, CTL_BYTES, stream);
    Args a{};
    a.x = (const float*)d_in[0]; a.attn_g = (const float*)d_in[1]; a.w_in = (const float*)d_in[2]; a.a_sink = (const float*)d_in[3]; a.w_a = (const float*)d_in[4]; a.w_b = (const float*)d_in[5];
    a.w_out = (const float*)d_in[6]; a.ffn_g = (const float*)d_in[7]; a.w_rg = (const float*)d_in[8]; a.b_rg = (const float*)d_in[9]; a.w_re = (const float*)d_in[10]; a.b_re = (const float*)d_in[11];
    a.w_eg = (const float*)d_in[12]; a.w_eu = (const float*)d_in[13]; a.w_ed = (const float*)d_in[14]; a.fin_g = (const float*)d_in[15];
    a.out = (float*)d_out; a.ws = (unsigned char*)d_ws;
#if MK_MULTI
    for (int ph = 0; ph < NPHASE; ++ph) { a.ph_lo = ph; a.ph_hi = ph + 1; hipLaunchKernelGGL(fwd_kernel, dim3(grid), dim3(NTHREADS), LDS_BYTES, stream, a); }
#else
    a.ph_lo = 0; a.ph_hi = NPHASE;
    void* kargs[] = {&a};
    const hipError_t le = hipLaunchCooperativeKernel((const void*)fwd_kernel, dim3(grid), dim3(NTHREADS), kargs, LDS_BYTES, stream);
    if (le != hipSuccess) fprintf(stderr, "kernel_launch: cooperative launch failed: %s (grid %d)\n", hipGetErrorString(le), grid);
#endif
}
```

```cpp
#include <hip/hip_runtime.h>
#include <hip/hip_cooperative_groups.h>
#include <cstdio>
#include <cstdint>
namespace cg = cooperative_groups;

#ifndef PHMASK
#define PHMASK 1023
#endif
#ifndef MK_MULTI
#define MK_MULTI 0
#endif

#define LAS __attribute__((address_space(3)))
#define GAS __attribute__((address_space(1)))
typedef unsigned short bf16;
typedef short bf16x8 __attribute__((ext_vector_type(8)));
typedef short s16x4 __attribute__((ext_vector_type(4)));
typedef float f32x2 __attribute__((ext_vector_type(2)));
typedef float f32x4 __attribute__((ext_vector_type(4)));
typedef float f32x16 __attribute__((ext_vector_type(16)));
typedef unsigned u32x2 __attribute__((ext_vector_type(2)));
typedef unsigned u32x4 __attribute__((ext_vector_type(4)));
typedef int i32x4 __attribute__((ext_vector_type(4)));
typedef __bf16 bf16x2_t __attribute__((ext_vector_type(2)));

constexpr int BATCH = 4, SEQ = 4096, DM = 1024, DEPTH = 2, MTOK = BATCH * SEQ;
constexpr int NQKV = 3072, NGATE = 2048, DIN = NQKV + NGATE;
constexpr int NEXP = 32, DEXP = 256;
constexpr float NORM_EPS = 1e-6f;
constexpr float LOG2E = 1.4426950408889634f, LN2 = 0.6931471805599453f;
constexpr float QSCALE = 0.125f * LOG2E;
constexpr int NWAVES = 8, NTHREADS = 512;

constexpr size_t MiB = 1u << 20;
constexpr size_t WS_CTL = 0, CTL_BYTES = 1 * MiB;
constexpr size_t WS_ROPE = 1 * MiB;
constexpr size_t WS_WR = 2 * MiB;
constexpr size_t WS_RS1 = 3 * MiB, WS_RS2 = 3 * MiB + 65536;
constexpr size_t WS_TOKINFO = 5 * MiB;
constexpr size_t WS_LTOK = 6 * MiB, WS_LW = 8 * MiB;
constexpr size_t WS_LSE = 10 * MiB;
constexpr size_t WS_WIN = 12 * MiB, WS_WA = 22 * MiB, WS_WB = 23 * MiB, WS_WOUT = 24 * MiB, WS_WGU = 26 * MiB, WS_WD = 58 * MiB;
constexpr size_t WS_XB = 74 * MiB;
constexpr size_t WS_OBUF = 74 * MiB;
constexpr size_t WS_YA = 106 * MiB, WS_YB = 122 * MiB;
constexpr size_t WS_PQ = 130 * MiB;
constexpr size_t WS_M1 = 130 * MiB, WS_MRG = 162 * MiB, WS_H = 194 * MiB;
constexpr size_t WS_PG = 226 * MiB;
constexpr size_t WS_Y = 226 * MiB;
constexpr size_t WS_END = 290 * MiB;
constexpr int CW_CNT = 64, CNT_STRIDE = 64;
constexpr int CW_BAR = 8192;

constexpr int RING_BYTES = 131072;
constexpr int PREP_SCR = 16896;
constexpr int MISC_OFF = 8 * PREP_SCR;
constexpr int LDS_BYTES = 147456;

#define LDS_WAIT() asm volatile("s_waitcnt lgkmcnt(0)" ::: "memory")
#define VM_WAIT() asm volatile("s_waitcnt vmcnt(0)" ::: "memory")
__device__ __forceinline__ unsigned cvtpk(float lo, float hi) { f32x2 v = {lo, hi}; bf16x2_t b = __builtin_convertvector(v, bf16x2_t); return __builtin_bit_cast(unsigned, b); }
__device__ __forceinline__ float bf2f(unsigned short h) { return __uint_as_float(((unsigned)h) << 16); }
__device__ __forceinline__ float bflo(unsigned w) { return __uint_as_float(w << 16); }
__device__ __forceinline__ float bfhi(unsigned w) { return __uint_as_float(w & 0xffff0000u); }
__device__ __forceinline__ float fast_exp2(float x) { return __builtin_amdgcn_exp2f(x); }
__device__ __forceinline__ float fast_rcp(float x) { return __builtin_amdgcn_rcpf(x); }
__device__ __forceinline__ float sigmoidf_fast(float v) { return fast_rcp(1.0f + fast_exp2(-v * LOG2E)); }

namespace pg8 {
constexpr int BM = 256, BK = 64, HALF = 128, HTB = HALF * BK * 2, STAGE_BYTES = 8 * HTB, NXCD = 8, WGM = 8;
__host__ __device__ __forceinline__ int lds_byte(int r, int c) { const int st = (r >> 4) * 2 + (c >> 5), rr = r & 15, cc = c & 31, ob = rr * 64 + cc * 2; return st * 1024 + (ob ^ (((ob >> 9) & 1) << 5)); }
__host__ __device__ __forceinline__ void stage_rc(int b, int& R, int& C) { const int st = b / 1024, sb = b % 1024, swz = sb ^ (((sb >> 9) & 1) << 5); R = (st >> 1) * 16 + swz / 64; C = (st & 1) * 32 + (swz % 64) / 2; }
__host__ __device__ __forceinline__ int perm32(int rho) { const int n = rho >> 4, i = rho & 15; return 8 * (i >> 2) + 4 * n + (i & 3); }

struct Unit { int pm, pn, e, nvalid, slot0, lpos0; };

struct StaticOrder {
    int nM, nN, nwg, G, c;
    __device__ void init(int M, int N, int G_, int c_) { nM = M / BM; nN = N / BM; nwg = nM * nN; G = G_; c = c_; }
    __device__ bool next(int i, int& pm, int& pn) const {
        const long L = (long)i * G + c; if (L >= nwg) return false;
        int wgid = (int)L; { const int q = nwg / NXCD, r = nwg % NXCD, xcd = wgid % NXCD, off = wgid / NXCD; wgid = (xcd < r ? xcd * (q + 1) : r * (q + 1) + (xcd - r) * q) + off; }
        const int nig = WGM * nN, gid = wgid / nig, fm = gid * WGM, gsz = (nM - fm) < WGM ? (nM - fm) : WGM;
        pm = fm + ((wgid % nig) % gsz); pn = (wgid % nig) / gsz; return true;
    }
};

template <class Epi, class Sched>
__device__ __forceinline__ void gemm_phase(LAS unsigned char* lds, const Sched& S, const Epi& E) {
    int tid_ = threadIdx.x; asm volatile("" : "+v"(tid_));
    const int tid = tid_, wid = __builtin_amdgcn_readfirstlane(tid >> 6), lane = tid & 63, wr = wid >> 2, wc = wid & 3, fr = lane & 15, fq = lane >> 4;
    const int K = S.K, nt = K / BK;
    unsigned voffA[2], voffB[2];
#pragma unroll
    for (int i = 0; i < 2; ++i) { int R, C; stage_rc(tid * 16 + i * 8192, R, C); const int Rb = Epi::PERM ? ((R & ~31) + perm32(R & 31)) : R;
        voffA[i] = (unsigned)(R * S.lda + C) * 2u; voffB[i] = (unsigned)(Rb * K + C) * 2u; }
    const size_t kstep = (size_t)(BK * 2);
    const size_t hstepB = (size_t)HALF * K * 2, hstepA = (size_t)HALF * S.lda * 2;
    const unsigned ldsw = (unsigned)wid * 1024u;
    const int aoff = lds_byte(wr * 64 + fr, fq * 8), boff = lds_byte(wc * 32 + fr, fq * 8);
#define PG8_SA(b, h) (((b) * 2 + (h)) * HTB)
#define PG8_SB(b, h) ((4 + (b) * 2 + (h)) * HTB)
#define PG8_GLDS(src, dstoff) __builtin_amdgcn_global_load_lds((const unsigned*)(src), (LAS unsigned*)(lds + (dstoff)), 16, 0, 0)
#define PG8_STAGE_A(bufoff, up, h, VO) do { if constexpr (Sched::GATHER) { _Pragma("unroll") for (int _i = 0; _i < 2; ++_i) PG8_GLDS((up) + VO[_i], (bufoff) + ldsw + _i * 8192); } \
        else { const char* _b = (up) + (size_t)(h) * hstepA; _Pragma("unroll") for (int _i = 0; _i < 2; ++_i) PG8_GLDS(_b + voffA[_i], (bufoff) + ldsw + _i * 8192); } } while (0)
#define PG8_STAGE_B(bufoff, bp) do { _Pragma("unroll") for (int _i = 0; _i < 2; ++_i) PG8_GLDS((bp) + voffB[_i], (bufoff) + ldsw + _i * 8192); } while (0)
#define PG8_LDA(dst, b, h) do { _Pragma("unroll") for (int m = 0; m < 4; ++m) _Pragma("unroll") for (int k = 0; k < 2; ++k) dst[m][k] = *(const LAS bf16x8*)(lds + PG8_SA(b, h) + aoff + m * 2048 + k * 1024); } while (0)
#define PG8_LDB(dst, b, h) do { _Pragma("unroll") for (int n = 0; n < 2; ++n) _Pragma("unroll") for (int k = 0; k < 2; ++k) dst[n][k] = *(const LAS bf16x8*)(lds + PG8_SB(b, h) + boff + n * 2048 + k * 1024); } while (0)
#define PG8_MMA(ai, bj, At, Bt) do { __builtin_amdgcn_s_setprio(1); _Pragma("unroll") for (int m = 0; m < 4; ++m) _Pragma("unroll") for (int n = 0; n < 2; ++n) _Pragma("unroll") for (int k = 0; k < 2; ++k) \
        acc[ai][bj][m][n] = __builtin_amdgcn_mfma_f32_16x16x32_bf16(Bt[n][k], At[m][k], acc[ai][bj][m][n], 0, 0, 0); __builtin_amdgcn_s_setprio(0); } while (0)
#define PG8_WAIT_V(n) asm volatile("s_waitcnt vmcnt(" #n ")" ::: "memory")
#define PG8_WAIT_L(n) asm volatile("s_waitcnt lgkmcnt(" #n ")" ::: "memory")
#define PG8_BAR __builtin_amdgcn_s_barrier()
#define PG8_SCHED __builtin_amdgcn_sched_barrier(0)
    Unit cur, nxt; int ui = 0;
    if (!S.next(0, cur)) return;
    f32x4 acc[2][2][4][2];
#pragma unroll
    for (int a = 0; a < 2; ++a)
#pragma unroll
        for (int b = 0; b < 2; ++b)
#pragma unroll
            for (int m = 0; m < 4; ++m)
#pragma unroll
                for (int n = 0; n < 2; ++n) acc[a][b][m][n] = (f32x4){0.f, 0.f, 0.f, 0.f};
    bf16x8 At[4][2], B0[2][2], B1[2][2];
    const char* Ab = S.a_base();
    const char* cA = Ab; const char* cB = S.b_base(cur);
    unsigned vF0[2], vF1[2], vK[2];
    if constexpr (Sched::GATHER) {
#pragma unroll
        for (int i = 0; i < 2; ++i) { int R, C; stage_rc(tid * 16 + i * 8192, R, C); vF0[i] = S.a_off(cur, R) + (unsigned)(C * 2); vF1[i] = S.a_off(cur, HALF + R) + (unsigned)(C * 2); vK[i] = vF1[i]; }
    } else cA = Ab + S.a_unit_off(cur);
    PG8_STAGE_B(PG8_SB(0, 0), cB); PG8_STAGE_B(PG8_SB(0, 1), cB + hstepB); PG8_STAGE_A(PG8_SA(0, 0), cA, 0, vF0); PG8_STAGE_A(PG8_SA(0, 1), cA, 1, vF1);
    if (wr == 1) PG8_BAR;
    PG8_WAIT_V(2); PG8_BAR;
    PG8_STAGE_B(PG8_SB(1, 0), cB + kstep); PG8_STAGE_A(PG8_SA(1, 0), cA + kstep, 0, vF0); PG8_STAGE_B(PG8_SB(1, 1), cB + hstepB + kstep);
    PG8_WAIT_V(6); PG8_BAR;
    for (;;) {
        const bool has_next = S.next(ui + 1, nxt);
        const char* nA = cA; const char* nB = cB;
        if (has_next) { nB = S.b_base(nxt); if constexpr (!Sched::GATHER) nA = Ab + S.a_unit_off(nxt); }
#pragma unroll 1
        for (int t = 0; t < nt; t += 2) {
            const bool last = (t == nt - 2);
            const char* a1 = cA + (size_t)(t + 1) * kstep;
            const char* a2 = last ? nA : cA + (size_t)(t + 2) * kstep; const char* b2 = last ? nB : cB + (size_t)(t + 2) * kstep;
            const char* a3 = a2 + kstep; const char* b3 = b2 + kstep;
            if constexpr (Sched::GATHER) {
                if (last && has_next) {
#pragma unroll
                    for (int i = 0; i < 2; ++i) { int R, C; stage_rc(tid * 16 + i * 8192, R, C); vF0[i] = S.a_off(nxt, R) + (unsigned)(C * 2); vF1[i] = S.a_off(nxt, HALF + R) + (unsigned)(C * 2); }
                }
            }
            PG8_LDB(B0, 0, 0); PG8_LDB(B1, 0, 1); PG8_SCHED; PG8_LDA(At, 0, 0); PG8_STAGE_A(PG8_SA(1, 1), a1, 1, vK);
            PG8_WAIT_V(8); PG8_WAIT_L(0); PG8_BAR; PG8_MMA(0, 0, At, B0); PG8_MMA(0, 1, At, B1); PG8_BAR; PG8_SCHED;
            PG8_LDA(At, 0, 1); PG8_STAGE_B(PG8_SB(0, 0), b2); PG8_STAGE_B(PG8_SB(0, 1), b2 + hstepB); PG8_STAGE_A(PG8_SA(0, 0), a2, 0, vF0);
            PG8_WAIT_V(8); PG8_WAIT_L(0); PG8_BAR; PG8_MMA(1, 0, At, B0); PG8_MMA(1, 1, At, B1); PG8_BAR; PG8_SCHED;
            PG8_LDB(B0, 1, 0); PG8_LDB(B1, 1, 1); PG8_SCHED; PG8_LDA(At, 1, 0); PG8_STAGE_A(PG8_SA(0, 1), a2, 1, vF1);
            PG8_WAIT_V(8); PG8_WAIT_L(0); PG8_BAR; PG8_MMA(0, 0, At, B0); PG8_MMA(0, 1, At, B1); PG8_BAR; PG8_SCHED;
            PG8_LDA(At, 1, 1); PG8_STAGE_B(PG8_SB(1, 0), b3); PG8_STAGE_B(PG8_SB(1, 1), b3 + hstepB); PG8_STAGE_A(PG8_SA(1, 0), a3, 0, vF0);
            PG8_WAIT_V(8); PG8_WAIT_L(0); PG8_BAR; PG8_MMA(1, 0, At, B0); PG8_MMA(1, 1, At, B1); PG8_BAR; PG8_SCHED;
        }
        if (wr == 0) PG8_BAR;
        E(acc, cur, wr, wc, fr, fq);
        if (!has_next) break;
#pragma unroll
        for (int a = 0; a < 2; ++a)
#pragma unroll
            for (int b = 0; b < 2; ++b)
#pragma unroll
                for (int m = 0; m < 4; ++m)
#pragma unroll
                    for (int n = 0; n < 2; ++n) acc[a][b][m][n] = (f32x4){0.f, 0.f, 0.f, 0.f};
        cur = nxt; cA = nA; cB = nB; ++ui;
        if constexpr (Sched::GATHER) { vK[0] = vF1[0]; vK[1] = vF1[1]; }
        if (wr == 1) PG8_BAR;
    }
    PG8_WAIT_V(0);
    PG8_BAR;
#undef PG8_SA
#undef PG8_SB
#undef PG8_GLDS
#undef PG8_STAGE_A
#undef PG8_STAGE_B
#undef PG8_LDA
#undef PG8_LDB
#undef PG8_MMA
#undef PG8_WAIT_V
#undef PG8_WAIT_L
#undef PG8_BAR
#undef PG8_SCHED
}
}
using pg8::Unit;

struct DenseSched {
    static constexpr bool GATHER = false;
    const char* A; const char* Bt; int K; int lda; pg8::StaticOrder so;
    __device__ __forceinline__ bool next(int i, Unit& u) const { int pm, pn; if (!so.next(i, pm, pn)) return false; u.pm = pm; u.pn = pn; u.e = 0; u.nvalid = 256; u.slot0 = pm * 256; u.lpos0 = 0; return true; }
    __device__ __forceinline__ const char* a_base() const { return A; }
    __device__ __forceinline__ unsigned a_off(const Unit& u, int r) const { return 0u; }
    __device__ __forceinline__ size_t a_unit_off(const Unit& u) const { return (size_t)u.pm * 256 * lda * 2; }
    __device__ __forceinline__ const char* b_base(const Unit& u) const { return Bt + (size_t)u.pn * 256 * K * 2; }
};
struct MoeTab { const volatile LAS int* cnt; const volatile LAS int* mtpref; const volatile LAS int* spref; };
template <bool GATHER_> struct MoeSched {
    static constexpr bool GATHER = GATHER_;
    const char* A; const char* Bt; int K; int lda; int ntn; size_t bstride_e; const int* ltok; MoeTab T; int G, c;
    __device__ __forceinline__ bool next(int i, Unit& u) const {
        const int L = i * G + c; const int total = T.mtpref[32] * ntn; if (L >= total) return false;
        const int tix = L / ntn; u.pn = L - tix * ntn; u.pm = tix;
        int e = 0;
#pragma unroll 1
        for (int k = 1; k < 32; ++k) if (T.mtpref[k] <= tix) e = k;
        const int mt = tix - T.mtpref[e]; u.e = e; u.slot0 = T.spref[e] + 256 * mt; const int rem = T.cnt[e] - 256 * mt; u.nvalid = rem < 256 ? rem : 256; u.lpos0 = e * MTOK + 256 * mt; return true;
    }
    __device__ __forceinline__ const char* a_base() const { return A; }
    __device__ __forceinline__ unsigned a_off(const Unit& u, int r) const { const int rr = r < u.nvalid ? r : u.nvalid - 1; return (unsigned)ltok[u.lpos0 + rr] * (unsigned)(lda * 2); }
    __device__ __forceinline__ size_t a_unit_off(const Unit& u) const { return (size_t)u.slot0 * lda * 2; }
    __device__ __forceinline__ const char* b_base(const Unit& u) const { return Bt + (size_t)u.e * bstride_e + (size_t)u.pn * 256 * K * 2; }
};

#define OPAQUE(p) asm volatile("" : "+v"(p))
struct EpiProj {
    static constexpr bool PERM = true;
    bf16* Pq; bf16* Pg; const float* rs; const f32x4* rope;
    __device__ __forceinline__ void operator()(const f32x4 (&acc)[2][2][4][2], const Unit& u, int wr, int wc, int fr, int fq) const {
        const int colh = wc * 32 + fq * 8;
        const int ib = (colh & 63) >> 2;
        const int row0 = u.pm * 256 + wr * 64 + fr;
        int mode[2]; bf16* ob[2]; size_t ostep[2];
#pragma unroll
        for (int bj = 0; bj < 2; ++bj) {
            const int h128 = 2 * u.pn + bj;
            if (h128 >= 24) mode[bj] = 3;
            else if (h128 < 6) mode[bj] = h128 < 4 ? 1 : (h128 == 4 ? 2 : 0);
            else { const int j = (h128 - 6) % 6; mode[bj] = j < 2 ? 1 : (j < 4 ? 2 : 0); }
            const int opitch = (h128 < 24) ? NQKV : NGATE;
            ob[bj] = ((h128 < 24) ? Pq + h128 * 128 + colh : Pg + (h128 - 24) * 128 + colh) + (size_t)row0 * opitch;
            ostep[bj] = (size_t)opitch * 16;
        }
        const float* rsp = rs + row0;
        const f32x4* rp = rope + (size_t)(row0 & (SEQ - 1)) * 16 + ib;
#pragma unroll
        for (int ai = 0; ai < 2; ++ai)
#pragma unroll
            for (int m = 0; m < 4; ++m) {
                OPAQUE(rsp); OPAQUE(rp); OPAQUE(ob[0]); OPAQUE(ob[1]);
                const float s = *rsp;
                f32x4 c0 = {0.f, 0.f, 0.f, 0.f}, c1 = c0;
                if (mode[0] == 1 || mode[0] == 2 || mode[1] == 1 || mode[1] == 2) { c0 = rp[0]; c1 = rp[1]; }
#pragma unroll
                for (int bj = 0; bj < 2; ++bj) {
                    f32x4 v0 = acc[ai][bj][m][0] * s, v1 = acc[ai][bj][m][1] * s;
                    if (mode[bj] == 1 || mode[bj] == 2) {
                        f32x4 o0, o1;
                        o0[0] = v0[0] * c0[0] - v0[1] * c0[1]; o0[1] = v0[1] * c0[0] + v0[0] * c0[1];
                        o0[2] = v0[2] * c0[2] - v0[3] * c0[3]; o0[3] = v0[3] * c0[2] + v0[2] * c0[3];
                        o1[0] = v1[0] * c1[0] - v1[1] * c1[1]; o1[1] = v1[1] * c1[0] + v1[0] * c1[1];
                        o1[2] = v1[2] * c1[2] - v1[3] * c1[3]; o1[3] = v1[3] * c1[2] + v1[2] * c1[3];
                        const float qs = (mode[bj] == 1) ? QSCALE : 1.0f;
                        v0 = o0 * qs; v1 = o1 * qs;
                    } else if (mode[bj] == 3) {
#pragma unroll
                        for (int j = 0; j < 4; ++j) { v0[j] = sigmoidf_fast(v0[j]); v1[j] = sigmoidf_fast(v1[j]); }
                    }
                    u32x4 w; w.x = cvtpk(v0[0], v0[1]); w.y = cvtpk(v0[2], v0[3]); w.z = cvtpk(v1[0], v1[1]); w.w = cvtpk(v1[2], v1[3]);
                    *(u32x4*)(ob[bj]) = w;
                }
                const int adv = (m == 3) ? 5 : 1;
                rsp += 16 * adv; rp += (size_t)16 * 16 * adv; ob[0] += ostep[0] * adv; ob[1] += ostep[1] * adv;
            }
    }
};
template <bool ADD> struct EpiGate {
    static constexpr bool PERM = true;
    const bf16* gate; const bf16* prev; bf16* out;
    __device__ __forceinline__ void operator()(const f32x4 (&acc)[2][2][4][2], const Unit& u, int wr, int wc, int fr, int fq) const {
        const int row0 = u.pm * 256 + wr * 64 + fr, col0 = u.pn * 256 + wc * 32 + fq * 8;
        const bf16* gp = gate + (size_t)row0 * NGATE + col0; const bf16* pp = prev + (size_t)row0 * DM + col0; bf16* op = out + (size_t)row0 * DM + col0;
#pragma unroll
        for (int ai = 0; ai < 2; ++ai)
#pragma unroll
            for (int m = 0; m < 4; ++m) {
                OPAQUE(gp); OPAQUE(op); if (ADD) OPAQUE(pp);
#pragma unroll
                for (int bj = 0; bj < 2; ++bj) {
                    const u32x4 g = *(const u32x4*)(gp + bj * 128);
                    const f32x4 a0 = acc[ai][bj][m][0], a1 = acc[ai][bj][m][1];
                    float r[8];
                    r[0] = a0[0] * bflo(g.x); r[1] = a0[1] * bfhi(g.x); r[2] = a0[2] * bflo(g.y); r[3] = a0[3] * bfhi(g.y);
                    r[4] = a1[0] * bflo(g.z); r[5] = a1[1] * bfhi(g.z); r[6] = a1[2] * bflo(g.w); r[7] = a1[3] * bfhi(g.w);
                    if (ADD) { const u32x4 p = *(const u32x4*)(pp + bj * 128);
                        r[0] += bflo(p.x); r[1] += bfhi(p.x); r[2] += bflo(p.y); r[3] += bfhi(p.y); r[4] += bflo(p.z); r[5] += bfhi(p.z); r[6] += bflo(p.w); r[7] += bfhi(p.w); }
                    u32x4 w; w.x = cvtpk(r[0], r[1]); w.y = cvtpk(r[2], r[3]); w.z = cvtpk(r[4], r[5]); w.w = cvtpk(r[6], r[7]);
                    *(u32x4*)(op + bj * 128) = w;
                }
                const int adv = (m == 3) ? 5 : 1;
                gp += (size_t)16 * NGATE * adv; pp += (size_t)16 * DM * adv; op += (size_t)16 * DM * adv;
            }
    }
};
struct EpiResid {
    static constexpr bool PERM = false;
    const float* base; float* xout; bf16* xb;
    __device__ __forceinline__ void operator()(const f32x4 (&acc)[2][2][4][2], const Unit& u, int wr, int wc, int fr, int fq) const {
#pragma unroll
        for (int ai = 0; ai < 2; ++ai)
#pragma unroll
            for (int m = 0; m < 4; ++m) {
                const size_t row = (size_t)(u.pm * 256 + ai * 128 + wr * 64 + m * 16 + fr);
#pragma unroll
                for (int bj = 0; bj < 2; ++bj)
#pragma unroll
                    for (int n = 0; n < 2; ++n) {
                        const int col = u.pn * 256 + bj * 128 + wc * 32 + n * 16 + fq * 4;
                        const f32x4 b = *(const f32x4*)(base + row * DM + col);
                        const f32x4 v = b + acc[ai][bj][m][n];
                        *(f32x4*)(xout + row * DM + col) = v;
                        u32x2 w; w.x = cvtpk(v[0], v[1]); w.y = cvtpk(v[2], v[3]);
                        *(u32x2*)(xb + row * DM + col) = w;
                    }
            }
    }
};
struct EpiSwiglu {
    static constexpr bool PERM = true;
    const int* ltok; const float* lw; const float* rs; bf16* H;
    __device__ __forceinline__ void operator()(const f32x4 (&acc)[2][2][4][2], const Unit& u, int wr, int wc, int fr, int fq) const {
#pragma unroll
        for (int ai = 0; ai < 2; ++ai)
#pragma unroll
            for (int m = 0; m < 4; ++m) {
                const int rr = ai * 128 + wr * 64 + m * 16 + fr;
                if (rr < u.nvalid) {
                    const int tok = ltok[u.lpos0 + rr]; const float w = lw[u.lpos0 + rr]; const float s = rs[tok];
#pragma unroll
                    for (int bj = 0; bj < 2; ++bj) {
                        const f32x4 a0 = acc[ai][bj][m][0] * s, a1 = acc[ai][bj][m][1] * s;
                        const float h0 = a0[0] * sigmoidf_fast(a0[0]) * a0[1] * w, h1 = a0[2] * sigmoidf_fast(a0[2]) * a0[3] * w;
                        const float h2 = a1[0] * sigmoidf_fast(a1[0]) * a1[1] * w, h3 = a1[2] * sigmoidf_fast(a1[2]) * a1[3] * w;
                        u32x2 o; o.x = cvtpk(h0, h1); o.y = cvtpk(h2, h3);
                        *(u32x2*)(H + (size_t)(u.slot0 + rr) * DEXP + u.pn * 128 + bj * 64 + wc * 16 + fq * 4) = o;
                    }
                }
            }
    }
};
struct EpiY {
    static constexpr bool PERM = true;
    bf16* Y;
    __device__ __forceinline__ void operator()(const f32x4 (&acc)[2][2][4][2], const Unit& u, int wr, int wc, int fr, int fq) const {
#pragma unroll
        for (int ai = 0; ai < 2; ++ai)
#pragma unroll
            for (int m = 0; m < 4; ++m) {
                const int rr = ai * 128 + wr * 64 + m * 16 + fr;
                if (rr < u.nvalid) {
#pragma unroll
                    for (int bj = 0; bj < 2; ++bj) {
                        const f32x4 a0 = acc[ai][bj][m][0], a1 = acc[ai][bj][m][1];
                        u32x4 w; w.x = cvtpk(a0[0], a0[1]); w.y = cvtpk(a0[2], a0[3]); w.z = cvtpk(a1[0], a1[1]); w.w = cvtpk(a1[2], a1[3]);
                        *(u32x4*)(Y + (size_t)(u.slot0 + rr) * DM + u.pn * 256 + bj * 128 + wc * 32 + fq * 8) = w;
                    }
                }
            }
    }
};

#define XB_TMO      128
#define XB_XCNT(j)  (256  + 64 * (j))
#define XB_XSUB(j)  (1280 + 64 * (j))
#define XB_XGEN(j)  (2304 + 64 * (j))
#define XB_TOP      3328
#define XB_TOPGEN   3392
#define XCD_BAR_WORDS 3456
#define XB_SPIN_CAP (1u << 18)
__device__ __forceinline__ unsigned xb_ld(unsigned* p)              { return __hip_atomic_load(p, __ATOMIC_RELAXED, __HIP_MEMORY_SCOPE_AGENT); }
__device__ __forceinline__ unsigned xb_add(unsigned* p, unsigned v) { return __hip_atomic_fetch_add(p, v, __ATOMIC_RELAXED, __HIP_MEMORY_SCOPE_AGENT); }
__device__ __forceinline__ unsigned xb_xcc_id() { return (unsigned)__builtin_amdgcn_s_getreg((3 << 11) | 20) & 0xFu; }
#define XB_SPIN(cond, bar) do { unsigned _sp = 0; while (cond) { __builtin_amdgcn_s_sleep(1); \
    if ((++_sp & 255u) == 0u) { if (xb_ld(&(bar)[XB_TMO])) break; if (_sp > XB_SPIN_CAP) { atomicAdd(&(bar)[XB_TMO], 1u); break; } } } } while (0)
struct XcdBarrier { unsigned* bar; unsigned x; volatile LAS unsigned* st; };
__device__ __forceinline__ XcdBarrier xcd_barrier_post(unsigned* bar, volatile LAS unsigned* st) {
    XcdBarrier b; b.bar = bar; b.x = xb_xcc_id(); b.st = st;
    if (threadIdx.x == 0) (void)xb_add(&bar[XB_XCNT(b.x)], 1u);
    return b;
}
__device__ __forceinline__ void xcd_barrier_complete(unsigned* bar, unsigned x, unsigned& nloc, unsigned& nx) {
    const unsigned G = gridDim.x * gridDim.y * gridDim.z;
    unsigned sum, cnt, mine, sp = 0u;
    for (;;) {
        sum = 0u; cnt = 0u; mine = 0u;
#pragma unroll
        for (unsigned j = 0; j < 16; ++j) { const unsigned c = xb_ld(&bar[XB_XCNT(j)]); sum += c; cnt += (c > 0u) ? 1u : 0u; mine = (j == x) ? c : mine; }
        if (sum == G) break;
        __builtin_amdgcn_s_sleep(1);
        if ((++sp & 255u) == 0u) { if (xb_ld(&bar[XB_TMO])) break; if (sp > XB_SPIN_CAP) { atomicAdd(&bar[XB_TMO], 1u); break; } }
    }
    nloc = mine > 0u ? mine : 1u; nx = cnt > 0u ? cnt : 1u;
}
__device__ __forceinline__ void xcd_barrier(const XcdBarrier& b) {
    asm volatile("s_waitcnt vmcnt(0)" ::: "memory");
    __syncthreads();
    if (threadIdx.x == 0) {
        unsigned* bar = b.bar;
        __builtin_amdgcn_s_waitcnt(0);
        unsigned nloc = b.st[0], nx = b.st[1];
        if (nloc == 0u) { xcd_barrier_complete(bar, b.x, nloc, nx); b.st[0] = nloc; b.st[1] = nx; }
        const unsigned old = xb_add(&bar[XB_XSUB(b.x)], 1u);
        const unsigned gen = old / nloc;
        if (old + 1u == (gen + 1u) * nloc) {
            __builtin_amdgcn_fence(__ATOMIC_RELEASE, "agent");
            asm volatile("s_waitcnt vmcnt(0)" ::: "memory");
            const unsigned og = xb_add(&bar[XB_TOP], 1u);
            const unsigned tg = og / nx;
            if (og + 1u == (tg + 1u) * nx) xb_add(&bar[XB_TOPGEN], 1u);
            else XB_SPIN(xb_ld(&bar[XB_TOPGEN]) == tg, bar);
            __builtin_amdgcn_fence(__ATOMIC_ACQUIRE, "agent");
            xb_add(&bar[XB_XGEN(b.x)], 1u);
            asm volatile("s_waitcnt vmcnt(0)" ::: "memory");
        } else {
            XB_SPIN(xb_ld(&bar[XB_XGEN(b.x)]) == gen, bar);
            __builtin_amdgcn_fence(__ATOMIC_ACQUIRE, "agent");
            asm volatile("s_waitcnt vmcnt(0)" ::: "memory");
        }
    }
    __syncthreads();
}

struct Args {
    const float* x; const float* attn_g; const float* w_in; const float* a_sink; const float* w_a; const float* w_b; const float* w_out; const float* ffn_g;
    const float* w_rg; const float* b_rg; const float* w_re; const float* b_re; const float* w_eg; const float* w_eu; const float* w_ed; const float* fin_g;
    float* out; unsigned char* ws; int ph_lo, ph_hi;
};
typedef const __attribute__((address_space(4))) Args* CArgs;
struct Frame {
    LAS unsigned char* lds; volatile LAS int* misc;
    int wave, G, vcu, gw, ngw;
};
__device__ __forceinline__ int otid() { int t = threadIdx.x; asm volatile("" : "+v"(t)); return t; }
__device__ __forceinline__ float wave_sum(float v) {
#pragma unroll
    for (int o = 1; o < 64; o <<= 1) v += __shfl_xor(v, o);
    return v;
}

struct MapPlain { __device__ __forceinline__ int operator()(int n) const { return n; } };
struct MapWin { __device__ __forceinline__ int operator()(int n) const {
        bool rope = false;
        if (n < 640) rope = true; else if (n >= 768 && n < NQKV) rope = ((n - 768) % 768) < 512;
        if (!rope) return n; const int d = n & 63; return (n & ~63) + 2 * (d & 31) + (d >> 5); } };
struct MapGU { int t; __device__ __forceinline__ int operator()(int n) const { return 2 * n + t; } };
template <class Map> __device__ __forceinline__ void transpose_item64(const float* W, int ldn, int k0, int n0, const float* gk, bf16* WT, int Kd, const Map& map, LAS float* scr, int lane) {
    const int kq = lane >> 4, n4 = (lane & 15) * 4;
    const float* src = W + (size_t)(k0 + kq) * ldn + n0 + n4;
    f32x4 v[16];
#pragma unroll
    for (int i = 0; i < 16; ++i) v[i] = *(const f32x4*)(src + (size_t)(4 * i) * ldn);
    if (gk) {
#pragma unroll
        for (int i = 0; i < 16; ++i) v[i] = v[i] * gk[k0 + 4 * i + kq];
    }
#pragma unroll
    for (int i = 0; i < 16; ++i) { LAS float* d = scr + (4 * i + kq) * 65 + n4; d[0] = v[i][0]; d[1] = v[i][1]; d[2] = v[i][2]; d[3] = v[i][3]; }
    LDS_WAIT(); asm volatile("" ::: "memory");
    const int c = lane & 7;
#pragma unroll
    for (int j = 0; j < 8; ++j) { const int n = (lane >> 3) + 8 * j; const LAS float* p = scr + (8 * c) * 65 + n;
        u32x4 o; o.x = cvtpk(p[0 * 65], p[1 * 65]); o.y = cvtpk(p[2 * 65], p[3 * 65]); o.z = cvtpk(p[4 * 65], p[5 * 65]); o.w = cvtpk(p[6 * 65], p[7 * 65]);
        *(u32x4*)(WT + (size_t)map(n0 + n) * Kd + k0 + 8 * c) = o; }
    LDS_WAIT(); asm volatile("" ::: "memory");
}
__device__ __forceinline__ void prep_phase(const Frame& F, CArgs a, int l) {
    const int tid = otid(), lane = tid & 63; (void)tid; (void)lane;
    unsigned char* ws = a->ws;
    LAS float* scr = (LAS float*)(F.lds + F.wave * PREP_SCR);
    constexpr int I_IN = 16 * 80, I_A = 8 * 16, I_B = 4 * 16, I_O = 16 * 16, I_G = 16 * 4, I_D = 4 * 16, I_E = 2 * I_G + I_D;
    constexpr int NIT = I_IN + I_A + I_B + I_O + NEXP * I_E;
    const float* ag = a->attn_g + l * DM; const float* fg = a->ffn_g + l * DM;
    for (int it = F.gw; it < NIT; it += F.ngw) {
        int r = it;
        if (r < I_IN) { transpose_item64(a->w_in + (size_t)l * DM * DIN, DIN, 64 * (r / 80), 64 * (r % 80), ag, (bf16*)(ws + WS_WIN), DM, MapWin{}, scr, lane); continue; } r -= I_IN;
        if (r < I_A) { transpose_item64(a->w_a + (size_t)l * 512 * DM, DM, 64 * (r / 16), 64 * (r % 16), nullptr, (bf16*)(ws + WS_WA), 512, MapPlain{}, scr, lane); continue; } r -= I_A;
        if (r < I_B) { transpose_item64(a->w_b + (size_t)l * 256 * DM, DM, 64 * (r / 16), 64 * (r % 16), nullptr, (bf16*)(ws + WS_WB), 256, MapPlain{}, scr, lane); continue; } r -= I_B;
        if (r < I_O) { transpose_item64(a->w_out + (size_t)l * DM * DM, DM, 64 * (r / 16), 64 * (r % 16), nullptr, (bf16*)(ws + WS_WOUT), DM, MapPlain{}, scr, lane); continue; } r -= I_O;
        const int e = r / I_E; r -= e * I_E;
        const size_t eo = ((size_t)l * NEXP + e) * DM * DEXP;
        if (r < 2 * I_G) { const int t = r / I_G; r -= t * I_G; const float* W = (t ? a->w_eu : a->w_eg) + eo;
            transpose_item64(W, DEXP, 64 * (r / 4), 64 * (r % 4), fg, (bf16*)(ws + WS_WGU) + (size_t)e * 512 * DM, DM, MapGU{t}, scr, lane); continue; } r -= 2 * I_G;
        transpose_item64(a->w_ed + eo, DM, 64 * (r / 16), 64 * (r % 16), nullptr, (bf16*)(ws + WS_WD) + (size_t)e * DM * DEXP, DEXP, MapPlain{}, scr, lane);
    }
    {
        float* wrp = (float*)(ws + WS_WR);
        const float* wg = a->w_rg + (size_t)l * DM * 4; const float* we = a->w_re + (size_t)l * DM * NEXP;
        for (int idx = blockIdx.x * NTHREADS + tid; idx < 64 * 3 * 64 * 4; idx += F.G * NTHREADS) {
            const int s = idx & 3, ln = (idx >> 2) & 63, q = idx >> 8, nt = q % 3, i = q / 3;
            const int k = 16 * i + 4 * (ln >> 4) + s, n = 16 * nt + (ln & 15);
            float v = 0.f; if (n < 4) v = wg[k * 4 + n]; else if (n < 36) v = we[k * NEXP + (n - 4)];
            wrp[idx] = v * fg[k];
        }
    }
    if (l == 0) {
        float* rt = (float*)(ws + WS_ROPE);
        for (int idx = blockIdx.x * NTHREADS + tid; idx < SEQ * 32; idx += F.G * NTHREADS) {
            const int pos = idx >> 5, i = idx & 31;
            const float inv = 1.0f / powf(10000.0f, (float)(2 * i) / 64.0f);
            const float ang = (float)pos * inv;
            const double ad = (double)ang, kd = __builtin_rint(ad * 0.15915494309189535);
            const float rf = (float)__builtin_fma(-kd, 6.283185307179586, ad);
            rt[idx * 2] = cosf(rf); rt[idx * 2 + 1] = sinf(rf);
        }
        bf16* xb = (bf16*)(ws + WS_XB); float* rs1 = (float*)(ws + WS_RS1);
        for (int m = F.gw; m < MTOK; m += F.ngw) {
            const f32x4* xr = (const f32x4*)(a->x + (size_t)m * DM) + lane;
            f32x4 v[4]; float s = 0.f;
#pragma unroll
            for (int j = 0; j < 4; ++j) { v[j] = xr[64 * j]; s += (v[j][0] * v[j][0] + v[j][1] * v[j][1]) + (v[j][2] * v[j][2] + v[j][3] * v[j][3]); }
            s = wave_sum(s);
            u32x2* o = (u32x2*)(xb + (size_t)m * DM) + lane;
#pragma unroll
            for (int j = 0; j < 4; ++j) { u32x2 w; w.x = cvtpk(v[j][0], v[j][1]); w.y = cvtpk(v[j][2], v[j][3]); o[64 * j] = w; }
            if (lane == 0) rs1[m] = 1.0f / sqrtf(s * (1.0f / DM) + NORM_EPS);
        }
    }
}

__device__ __forceinline__ int crow(int r, int hi) { return (r & 3) + 8 * (r >> 2) + 4 * hi; }
__device__ __forceinline__ void attn_task(const bf16* P, int qcol, int kcol, int vcol, int b, int d, int r, int t, int W, float m0, float l0,
                                          bf16* outp, int opitch, float* lsep, LAS unsigned char* vl, int lane) {
    const int r32 = lane & 31, hi = lane >> 5;
    const int L32 = (SEQ / d) >> 5;
    const size_t tok0 = (size_t)b * SEQ + r;
    const size_t qtok = tok0 + (size_t)(32 * t + r32) * d;
    bf16x8 qf[4];
#pragma unroll
    for (int s = 0; s < 4; ++s) qf[s] = *(const bf16x8*)(P + qtok * NQKV + qcol + 16 * s + 8 * hi);
    f32x16 o0 = {}, o1 = {};
    float mrun = m0, lrun = l0;
    const int jlo = (t - W) < 0 ? 0 : (t - W), jhi = (t + W) > (L32 - 1) ? (L32 - 1) : (t + W);
    const LAS unsigned char* vrd = vl + (4 * hi + ((lane & 15) >> 2)) * 128 + (16 * ((lane >> 4) & 1) + 4 * (lane & 3)) * 2;
    for (int j = jlo; j <= jhi; ++j) {
        const size_t ktok = tok0 + (size_t)(32 * j + r32) * d;
        bf16x8 kf[4];
#pragma unroll
        for (int s = 0; s < 4; ++s) kf[s] = *(const bf16x8*)(P + ktok * NQKV + kcol + 16 * s + 8 * hi);
        u32x4 vv[4];
#pragma unroll
        for (int i = 0; i < 4; ++i) { const int row = (lane >> 3) + 8 * i; vv[i] = *(const u32x4*)(P + (tok0 + (size_t)(32 * j + row) * d) * NQKV + vcol + (lane & 7) * 8); }
#pragma unroll
        for (int i = 0; i < 4; ++i) { const int row = (lane >> 3) + 8 * i; *(LAS u32x4*)(vl + row * 128 + (lane & 7) * 16) = vv[i]; }
        f32x16 sc = {};
#pragma unroll
        for (int s = 0; s < 4; ++s) sc = __builtin_amdgcn_mfma_f32_32x32x16_bf16(kf[s], qf[s], sc, 0, 0, 0);
        if (j == t - W) {
#pragma unroll
            for (int g = 0; g < 16; ++g) if (crow(g, hi) < r32) sc[g] = -INFINITY;
        }
        if (j == t + W) {
#pragma unroll
            for (int g = 0; g < 16; ++g) if (crow(g, hi) > r32) sc[g] = -INFINITY;
        }
        float mx = sc[0];
#pragma unroll
        for (int g = 1; g < 16; ++g) mx = fmaxf(mx, sc[g]);
        mx = fmaxf(mx, __shfl_xor(mx, 32));
        const float mnew = fmaxf(mrun, mx);
        const float alpha = fast_exp2(mrun - mnew);
        float psum = 0.f;
#pragma unroll
        for (int g = 0; g < 16; ++g) { sc[g] = fast_exp2(sc[g] - mnew); psum += sc[g]; }
        psum += __shfl_xor(psum, 32);
        lrun = lrun * alpha + psum; mrun = mnew;
#pragma unroll
        for (int g = 0; g < 16; ++g) { o0[g] *= alpha; o1[g] *= alpha; }
        u32x4 p0, p1;
        p0.x = cvtpk(sc[0], sc[1]); p0.y = cvtpk(sc[2], sc[3]); p0.z = cvtpk(sc[4], sc[5]); p0.w = cvtpk(sc[6], sc[7]);
        p1.x = cvtpk(sc[8], sc[9]); p1.y = cvtpk(sc[10], sc[11]); p1.z = cvtpk(sc[12], sc[13]); p1.w = cvtpk(sc[14], sc[15]);
        const bf16x8 pf0 = __builtin_bit_cast(bf16x8, p0), pf1 = __builtin_bit_cast(bf16x8, p1);
        LDS_WAIT();
#define VTR(off) __builtin_bit_cast(s16x4, __builtin_amdgcn_ds_read_tr16_b64_v4i16((LAS s16x4*)(vrd + (off))))
#define VFRAG(s, dh) ({ const s16x4 _a = VTR((16 * (s)) * 128 + (dh) * 64), _b = VTR((16 * (s) + 8) * 128 + (dh) * 64); (bf16x8){_a[0], _a[1], _a[2], _a[3], _b[0], _b[1], _b[2], _b[3]}; })
        const bf16x8 v00 = VFRAG(0, 0), v10 = VFRAG(1, 0), v01 = VFRAG(0, 1), v11 = VFRAG(1, 1);
        o0 = __builtin_amdgcn_mfma_f32_32x32x16_bf16(v00, pf0, o0, 0, 0, 0);
        o0 = __builtin_amdgcn_mfma_f32_32x32x16_bf16(v10, pf1, o0, 0, 0, 0);
        o1 = __builtin_amdgcn_mfma_f32_32x32x16_bf16(v01, pf0, o1, 0, 0, 0);
        o1 = __builtin_amdgcn_mfma_f32_32x32x16_bf16(v11, pf1, o1, 0, 0, 0);
#undef VTR
#undef VFRAG
        LDS_WAIT();
    }
    const float inv = 1.0f / lrun;
    bf16* orow = outp + qtok * opitch;
#pragma unroll
    for (int g4 = 0; g4 < 4; ++g4) {
        u32x2 w0, w1;
        w0.x = cvtpk(o0[4 * g4] * inv, o0[4 * g4 + 1] * inv); w0.y = cvtpk(o0[4 * g4 + 2] * inv, o0[4 * g4 + 3] * inv);
        w1.x = cvtpk(o1[4 * g4] * inv, o1[4 * g4 + 1] * inv); w1.y = cvtpk(o1[4 * g4 + 2] * inv, o1[4 * g4 + 3] * inv);
        *(u32x2*)(orow + 8 * g4 + 4 * hi) = w0;
        *(u32x2*)(orow + 32 + 8 * g4 + 4 * hi) = w1;
    }
    if (lsep && hi == 0) lsep[qtok * 12] = (mrun + log2f(lrun)) * LN2;
}
__device__ __forceinline__ void attn_phase(const Frame& F, CArgs a, int l) {
    const int tid = otid(), lane = tid & 63; (void)tid; (void)lane;
    unsigned char* ws = a->ws;
    const bf16* P = (const bf16*)(ws + WS_PQ);
    bf16* ya = (bf16*)(ws + WS_YA); bf16* ob = (bf16*)(ws + WS_OBUF); float* lse = (float*)(ws + WS_LSE);
    LAS unsigned char* vl = F.lds + F.wave * 4096;
    constexpr int NA = BATCH * 2 * 128 * 4, NB1 = BATCH * 4 * 128;
    constexpr int NTASK = NA + 3 * NB1;
    for (int it = F.gw; it < NTASK; it += F.ngw) {
        if (it < NA) {
            const int g = it & 3, qt = (it >> 2) & 127, kvh = (it >> 9) & 1, b = it >> 10;
            const int hq = kvh * 4 + g;
            const float sk = a->a_sink[l * 8 + hq] * LOG2E;
            attn_task(P, hq * 64, 512 + kvh * 64, 640 + kvh * 64, b, 1, 0, qt, 4, sk, 1.0f, ya + hq * 64, 512, nullptr, vl, lane);
        } else {
            int r = it - NA; const int grp = r / NB1; r -= grp * NB1;
            const int d = grp == 0 ? 1 : (grp == 1 ? 4 : 16);
            const int tpr = 128 / d;
            const int tl = r % tpr; int q = r / tpr; const int res = q % d; q /= d; const int h = q & 3, b = q >> 2;
            const int base = 768 + 768 * grp;
            attn_task(P, base + h * 64, base + 256 + h * 64, base + 512 + h * 64, b, d, res, tl, 2, -1e30f, 0.0f, ob + grp * 256 + h * 64, 768, lse + grp * 4 + h, vl, lane);
        }
    }
}
__device__ __forceinline__ void comb_phase(const Frame& F, CArgs a) {
    const int tid = otid(), lane = tid & 63; (void)tid; (void)lane;
    unsigned char* ws = a->ws;
    const bf16* ob = (const bf16*)(ws + WS_OBUF); const float* lse = (const float*)(ws + WS_LSE); bf16* yb = (bf16*)(ws + WS_YB);
    for (int idx = blockIdx.x * NTHREADS + tid; idx < MTOK * 32; idx += F.G * NTHREADS) {
        const int tok = idx >> 5, c = idx & 31, h = c >> 3;
        const float l0 = lse[tok * 12 + h], l1 = lse[tok * 12 + 4 + h], l2 = lse[tok * 12 + 8 + h];
        const float mx = fmaxf(l0, fmaxf(l1, l2));
        float w0 = __expf(l0 - mx), w1 = __expf(l1 - mx), w2 = __expf(l2 - mx);
        const float inv = 1.0f / (w0 + w1 + w2); w0 *= inv; w1 *= inv; w2 *= inv;
        const u32x4 a0 = *(const u32x4*)(ob + (size_t)tok * 768 + c * 8), a1 = *(const u32x4*)(ob + (size_t)tok * 768 + 256 + c * 8), a2 = *(const u32x4*)(ob + (size_t)tok * 768 + 512 + c * 8);
        u32x4 o;
#define CMB(f) o.f = cvtpk(w0 * bflo(a0.f) + w1 * bflo(a1.f) + w2 * bflo(a2.f), w0 * bfhi(a0.f) + w1 * bfhi(a1.f) + w2 * bfhi(a2.f))
        CMB(x); CMB(y); CMB(z); CMB(w);
#undef CMB
        *(u32x4*)(yb + (size_t)tok * 256 + c * 8) = o;
    }
}

__device__ __forceinline__ void route_phase(const Frame& F, CArgs a, int l) {
    const int tid = otid(), lane = tid & 63;
    unsigned char* ws = a->ws;
    const float* x = a->out; const f32x4* wrp = (const f32x4*)(ws + WS_WR);
    float* rs2 = (float*)(ws + WS_RS2); i32x4* tokinfo = (i32x4*)(ws + WS_TOKINFO); int* ltok = (int*)(ws + WS_LTOK); float* lw = (float*)(ws + WS_LW);
    int* cnt = (int*)(ws + WS_CTL) + CW_CNT + l * 32 * CNT_STRIDE;
    const float* brg = a->b_rg + l * 4; const float* bre = a->b_re + l * NEXP;
    LAS f32x4* part = (LAS f32x4*)(F.lds);
    LAS float* ssp = (LAS float*)(F.lds + 12288);
    LAS float* Lg = (LAS float*)(F.lds + 16384);
    LAS float* rsL = (LAS float*)(F.lds + 16384 + 12288);
    LAS int* lcnt = (LAS int*)(F.lds + 16384 + 12288 + 256);
    LAS int* lbase = lcnt + 32;
    const int rt = F.wave & 3, kh = F.wave >> 2;
    if (tid < 32) lcnt[tid] = 0;
    __syncthreads();
    for (int blk = blockIdx.x; blk < MTOK / 64; blk += F.G) {
        const int row0 = blk * 64 + rt * 16;
        const f32x4* xr = (const f32x4*)(x + (size_t)(row0 + (lane & 15)) * DM + kh * 512) + (lane >> 4);
        const f32x4* wp = wrp + (size_t)(kh * 32) * 3 * 64 + lane;
        f32x4 acc0 = {0.f, 0.f, 0.f, 0.f}, acc1 = acc0, acc2 = acc0; float ss = 0.f;
#pragma unroll 8
        for (int i = 0; i < 32; ++i) {
            const f32x4 xv = xr[4 * i];
            const f32x4 w0 = wp[(i * 3 + 0) * 64], w1 = wp[(i * 3 + 1) * 64], w2 = wp[(i * 3 + 2) * 64];
            ss += (xv[0] * xv[0] + xv[1] * xv[1]) + (xv[2] * xv[2] + xv[3] * xv[3]);
#pragma unroll
            for (int s = 0; s < 4; ++s) {
                acc0 = __builtin_amdgcn_mfma_f32_16x16x4f32(xv[s], w0[s], acc0, 0, 0, 0);
                acc1 = __builtin_amdgcn_mfma_f32_16x16x4f32(xv[s], w1[s], acc1, 0, 0, 0);
                acc2 = __builtin_amdgcn_mfma_f32_16x16x4f32(xv[s], w2[s], acc2, 0, 0, 0);
            }
        }
        ss += __shfl_xor(ss, 16); ss += __shfl_xor(ss, 32);
        if (kh == 1) { part[(rt * 3 + 0) * 64 + lane] = acc0; part[(rt * 3 + 1) * 64 + lane] = acc1; part[(rt * 3 + 2) * 64 + lane] = acc2; if (lane < 16) ssp[rt * 16 + lane] = ss; }
        __syncthreads();
        if (kh == 0) {
            acc0 += part[(rt * 3 + 0) * 64 + lane]; acc1 += part[(rt * 3 + 1) * 64 + lane]; acc2 += part[(rt * 3 + 2) * 64 + lane];
            ss += ssp[rt * 16 + (lane & 15)];
#pragma unroll
            for (int g = 0; g < 4; ++g) { const int rw = rt * 16 + 4 * (lane >> 4) + g; Lg[rw * 48 + (lane & 15)] = acc0[g]; Lg[rw * 48 + 16 + (lane & 15)] = acc1[g]; Lg[rw * 48 + 32 + (lane & 15)] = acc2[g]; }
            if (lane < 16) rsL[rt * 16 + lane] = 1.0f / sqrtf(ss * (1.0f / DM) + NORM_EPS);
        }
        __syncthreads();
        int e1 = 0, e2 = 0, r1 = 0, r2 = 0; float w1 = 0.f, w2 = 0.f, rsv = 0.f;
        if (tid < 64) {
            const LAS float* Lr = Lg + tid * 48; rsv = rsL[tid];
            float gl[4];
#pragma unroll
            for (int g = 0; g < 4; ++g) gl[g] = Lr[g] * rsv + brg[g];
            int gi = 0; float gm = gl[0];
#pragma unroll
            for (int g = 1; g < 4; ++g) if (gl[g] > gm) { gm = gl[g]; gi = g; }
            float den = 0.f;
#pragma unroll
            for (int g = 0; g < 4; ++g) den += expf(gl[g] - gm);
            const float gw = 1.0f / den;
            float v1 = -INFINITY, v2 = -INFINITY; int i1 = 0, i2 = 0;
#pragma unroll
            for (int e = 0; e < 8; ++e) {
                const float v = Lr[4 + 8 * gi + e] * rsv + bre[8 * gi + e];
                if (v > v1) { v2 = v1; i2 = i1; v1 = v; i1 = e; } else if (v > v2) { v2 = v; i2 = e; }
            }
            const float p1 = 1.0f / (1.0f + expf(v2 - v1));
            e1 = 8 * gi + i1; e2 = 8 * gi + i2; w1 = p1 * gw; w2 = (1.0f - p1) * gw;
            r1 = __hip_atomic_fetch_add(&lcnt[e1], 1, __ATOMIC_RELAXED, __HIP_MEMORY_SCOPE_WORKGROUP); r2 = __hip_atomic_fetch_add(&lcnt[e2], 1, __ATOMIC_RELAXED, __HIP_MEMORY_SCOPE_WORKGROUP);
        }
        __syncthreads();
        if (tid < 32) { const int c = lcnt[tid]; lbase[tid] = c ? atomicAdd(&cnt[tid * CNT_STRIDE], c) : 0; lcnt[tid] = 0; }
        __syncthreads();
        if (tid < 64) {
            const int tok = blk * 64 + tid;
            const int pos1 = lbase[e1] + r1, pos2 = lbase[e2] + r2;
            ltok[e1 * MTOK + pos1] = tok; lw[e1 * MTOK + pos1] = w1;
            ltok[e2 * MTOK + pos2] = tok; lw[e2 * MTOK + pos2] = w2;
            tokinfo[tok] = (i32x4){e1, pos1, e2, pos2};
            rs2[tok] = rsv;
        }
        __syncthreads();
    }
}
__device__ __forceinline__ MoeTab moe_tables(const Frame& F, CArgs a, int l) {
    const int tid = otid(), lane = tid & 63; (void)tid; (void)lane;
    volatile LAS int* cntL = F.misc + 64; volatile LAS int* mtp = F.misc + 128; volatile LAS int* sp = F.misc + 192;
    const int* cnt = (const int*)(a->ws + WS_CTL) + CW_CNT + l * 32 * CNT_STRIDE;
    __syncthreads();
    if (tid < 32) cntL[tid] = __hip_atomic_load(cnt + tid * CNT_STRIDE, __ATOMIC_RELAXED, __HIP_MEMORY_SCOPE_AGENT);
    __syncthreads();
    if (tid == 0) { int mt = 0, s = 0; for (int e = 0; e < 32; ++e) { mtp[e] = mt; sp[e] = s; const int c = cntL[e]; mt += (c + 255) >> 8; s += c; } mtp[32] = mt; sp[32] = s; }
    __syncthreads();
    MoeTab T; T.cnt = cntL; T.mtpref = mtp; T.spref = sp; return T;
}
__device__ __forceinline__ void fin_phase(const Frame& F, CArgs a, int l, const MoeTab& T) {
    const int tid = otid(), lane = tid & 63; (void)tid; (void)lane;
    unsigned char* ws = a->ws;
    const i32x4* tokinfo = (const i32x4*)(ws + WS_TOKINFO); const bf16* Y = (const bf16*)(ws + WS_Y);
    bf16* xb = (bf16*)(ws + WS_XB); float* rs1 = (float*)(ws + WS_RS1);
    for (int m = F.gw; m < MTOK; m += F.ngw) {
        const i32x4 ti = tokinfo[m];
        const int s1 = T.spref[ti[0]] + ti[1], s2 = T.spref[ti[2]] + ti[3];
        f32x4* xr = (f32x4*)(a->out + (size_t)m * DM) + lane;
        const u32x2* y1 = (const u32x2*)(Y + (size_t)s1 * DM) + lane; const u32x2* y2 = (const u32x2*)(Y + (size_t)s2 * DM) + lane;
        f32x4 v[4]; float s = 0.f;
#pragma unroll
        for (int j = 0; j < 4; ++j) {
            v[j] = xr[64 * j]; const u32x2 p = y1[64 * j], q = y2[64 * j];
            v[j][0] += bflo(p.x) + bflo(q.x); v[j][1] += bfhi(p.x) + bfhi(q.x); v[j][2] += bflo(p.y) + bflo(q.y); v[j][3] += bfhi(p.y) + bfhi(q.y);
            s += (v[j][0] * v[j][0] + v[j][1] * v[j][1]) + (v[j][2] * v[j][2] + v[j][3] * v[j][3]);
        }
        s = wave_sum(s);
        const float rsv = 1.0f / sqrtf(s * (1.0f / DM) + NORM_EPS);
        if (l == DEPTH - 1) {
            const f32x4* g = (const f32x4*)a->fin_g + lane;
#pragma unroll
            for (int j = 0; j < 4; ++j) xr[64 * j] = v[j] * rsv * g[64 * j];
        } else {
            u32x2* o = (u32x2*)(xb + (size_t)m * DM) + lane;
#pragma unroll
            for (int j = 0; j < 4; ++j) { xr[64 * j] = v[j]; u32x2 w; w.x = cvtpk(v[j][0], v[j][1]); w.y = cvtpk(v[j][2], v[j][3]); o[64 * j] = w; }
            if (lane == 0) rs1[m] = rsv;
        }
    }
}

constexpr int PH_PREP = 0, PH_GEMM1 = 1, PH_ATTN = 2, PH_COMB = 3, PH_MERGE = 4, PH_OUT = 5, PH_ROUTE = 6, PH_UP = 7, PH_DOWN = 8, PH_FIN = 9, PH_PER_LAYER = 10, NPHASE = PH_PER_LAYER * DEPTH;

__global__ void __launch_bounds__(NTHREADS, 2) fwd_kernel(Args a_by_value) {
    extern __shared__ __attribute__((aligned(16))) unsigned char lds_raw[];
    Frame F;
    F.lds = (LAS unsigned char*)lds_raw; F.misc = (volatile LAS int*)(F.lds + MISC_OFF);
    F.wave = __builtin_amdgcn_readfirstlane((int)threadIdx.x >> 6);
    F.G = gridDim.x; { const int bx = blockIdx.x; F.vcu = (F.G % 8 == 0) ? (bx % 8) * (F.G / 8) + bx / 8 : bx; }
    F.gw = blockIdx.x * NWAVES + F.wave; F.ngw = F.G * NWAVES;
    CArgs a = (CArgs)__builtin_amdgcn_kernarg_segment_ptr();
    unsigned char* ws = a->ws;
    const int ph_lo = a->ph_lo, ph_hi = a->ph_hi;
    for (int u = threadIdx.x; u < 1024; u += NTHREADS) F.misc[u] = 0;
    __syncthreads();
#if !MK_MULTI
    XcdBarrier bar = xcd_barrier_post((unsigned*)(ws + WS_CTL) + CW_BAR, (volatile LAS unsigned*)(F.misc + 8));
#define GRID_BAR() xcd_barrier(bar)
#else
#define GRID_BAR() do { } while (0)
#endif
    for (int ph = ph_lo; ph < ph_hi; ++ph) {
        const int l = ph / PH_PER_LAYER, k = ph % PH_PER_LAYER;
        {
            int tv = threadIdx.x; asm volatile("" : "+v"(tv)); int bx = blockIdx.x; asm volatile("" : "+s"(bx)); asm volatile("" : "+s"(a)); ws = a->ws;
            F.wave = __builtin_amdgcn_readfirstlane(tv >> 6); F.gw = bx * NWAVES + F.wave;
        }
        if (k == PH_PREP && (PHMASK & 1)) {
            prep_phase(F, a, l);
        } else if (k == PH_GEMM1 && (PHMASK & 2)) {
            DenseSched S; S.A = (const char*)(ws + WS_XB); S.Bt = (const char*)(ws + WS_WIN); S.K = DM; S.lda = DM; S.so.init(MTOK, DIN, F.G, (int)blockIdx.x);
            EpiProj E{(bf16*)(ws + WS_PQ), (bf16*)(ws + WS_PG), (const float*)(ws + WS_RS1), (const f32x4*)(ws + WS_ROPE)};
            pg8::gemm_phase(F.lds, S, E);
        } else if (k == PH_ATTN && (PHMASK & 4)) {
            attn_phase(F, a, l);
        } else if (k == PH_COMB && (PHMASK & 8)) {
            comb_phase(F, a);
        } else if (k == PH_MERGE && (PHMASK & 16)) {
            { DenseSched S; S.A = (const char*)(ws + WS_YA); S.Bt = (const char*)(ws + WS_WA); S.K = 512; S.lda = 512; S.so.init(MTOK, DM, F.G, (int)blockIdx.x);
              EpiGate<false> E{(const bf16*)(ws + WS_PG), nullptr, (bf16*)(ws + WS_M1)};
              pg8::gemm_phase(F.lds, S, E); }
            { DenseSched S; S.A = (const char*)(ws + WS_YB); S.Bt = (const char*)(ws + WS_WB); S.K = 256; S.lda = 256; S.so.init(MTOK, DM, F.G, (int)blockIdx.x);
              EpiGate<true> E{(const bf16*)(ws + WS_PG) + DM, (const bf16*)(ws + WS_M1), (bf16*)(ws + WS_MRG)};
              pg8::gemm_phase(F.lds, S, E); }
        } else if (k == PH_OUT && (PHMASK & 32)) {
            DenseSched S; S.A = (const char*)(ws + WS_MRG); S.Bt = (const char*)(ws + WS_WOUT); S.K = DM; S.lda = DM; S.so.init(MTOK, DM, F.G, (int)blockIdx.x);
            EpiResid E{l == 0 ? a->x : a->out, a->out, (bf16*)(ws + WS_XB)};
            pg8::gemm_phase(F.lds, S, E);
        } else if (k == PH_ROUTE && (PHMASK & 64)) {
            route_phase(F, a, l);
        } else if (k == PH_UP && (PHMASK & 128)) {
            const MoeTab T = moe_tables(F, a, l);
            MoeSched<true> S; S.A = (const char*)(ws + WS_XB); S.Bt = (const char*)(ws + WS_WGU); S.K = DM; S.lda = DM; S.ntn = 2; S.bstride_e = (size_t)512 * DM * 2; S.ltok = (const int*)(ws + WS_LTOK); S.T = T; S.G = F.G; S.c = (int)blockIdx.x;
            EpiSwiglu E{(const int*)(ws + WS_LTOK), (const float*)(ws + WS_LW), (const float*)(ws + WS_RS2), (bf16*)(ws + WS_H)};
            pg8::gemm_phase(F.lds, S, E);
        } else if (k == PH_DOWN && (PHMASK & 256)) {
            const MoeTab T = moe_tables(F, a, l);
            MoeSched<false> S; S.A = (const char*)(ws + WS_H); S.Bt = (const char*)(ws + WS_WD); S.K = DEXP; S.lda = DEXP; S.ntn = 4; S.bstride_e = (size_t)DM * DEXP * 2; S.ltok = nullptr; S.T = T; S.G = F.G; S.c = (int)blockIdx.x;
            EpiY E{(bf16*)(ws + WS_Y)};
            pg8::gemm_phase(F.lds, S, E);
        } else if (k == PH_FIN && (PHMASK & 512)) {
            const MoeTab T = moe_tables(F, a, l);
            fin_phase(F, a, l, T);
        }
        if (ph + 1 < ph_hi) GRID_BAR();
    }
}

extern "C" void kernel_launch(void* const* d_in, const int* in_sizes, int n_in, void* d_out, int out_size, void* d_ws, size_t ws_size, hipStream_t stream) {
    static int grid = 0;
    if (grid == 0) {
        if (n_in != 16 || out_size != MTOK * DM || ws_size < WS_END) { fprintf(stderr, "kernel_launch: unexpected shapes (n_in %d out %d ws %zu)\n", n_in, out_size, ws_size); grid = -1; return; }
        int dev = 0, cus = 0, per_cu = 0;
        if (hipGetDevice(&dev) != hipSuccess || hipDeviceGetAttribute(&cus, hipDeviceAttributeMultiprocessorCount, dev) != hipSuccess) { grid = -1; return; }
        if (hipFuncSetAttribute((const void*)fwd_kernel, hipFuncAttributeMaxDynamicSharedMemorySize, LDS_BYTES) != hipSuccess) { fprintf(stderr, "kernel_launch: hipFuncSetAttribute failed\n"); grid = -1; return; }
        if (hipOccupancyMaxActiveBlocksPerMultiprocessor(&per_cu, (const void*)fwd_kernel, NTHREADS, LDS_BYTES) != hipSuccess || per_cu < 1) { fprintf(stderr, "kernel_launch: occupancy query says %d\n", per_cu); (void)hipGetLastError(); }
        grid = cus;
    }
    if (grid < 0) return;
    (void)hipMemsetAsync((char*)d_ws + WS_CTL, 0, CTL_BYTES, stream);
    Args a{};
    a.x = (const float*)d_in[0]; a.attn_g = (const float*)d_in[1]; a.w_in = (const float*)d_in[2]; a.a_sink = (const float*)d_in[3]; a.w_a = (const float*)d_in[4]; a.w_b = (const float*)d_in[5];
    a.w_out = (const float*)d_in[6]; a.ffn_g = (const float*)d_in[7]; a.w_rg = (const float*)d_in[8]; a.b_rg = (const float*)d_in[9]; a.w_re = (const float*)d_in[10]; a.b_re = (const float*)d_in[11];
    a.w_eg = (const float*)d_in[12]; a.w_eu = (const float*)d_in[13]; a.w_ed = (const float*)d_in[14]; a.fin_g = (const float*)d_in[15];
    a.out = (float*)d_out; a.ws = (unsigned char*)d_ws;
#if MK_MULTI
    for (int ph = 0; ph < NPHASE; ++ph) { a.ph_lo = ph; a.ph_hi = ph + 1; hipLaunchKernelGGL(fwd_kernel, dim3(grid), dim3(NTHREADS), LDS_BYTES, stream, a); }
#else
    a.ph_lo = 0; a.ph_hi = NPHASE;
    void* kargs[] = {&a};
    const hipError_t le = hipLaunchCooperativeKernel((const void*)fwd_kernel, dim3(grid), dim3(NTHREADS), kargs, LDS_BYTES, stream);
    if (le != hipSuccess) fprintf(stderr, "kernel_launch: cooperative launch failed: %s (grid %d)\n", hipGetErrorString(le), grid);
#endif
}
```

```cpp
#include <hip/hip_runtime.h>
#include <hip/hip_cooperative_groups.h>
#include <cstdio>
#include <cstdint>
namespace cg = cooperative_groups;

#ifndef PHMASK
#define PHMASK 1023
#endif
#ifndef MK_MULTI
#define MK_MULTI 0
#endif

#define LAS __attribute__((address_space(3)))
#define GAS __attribute__((address_space(1)))
typedef unsigned short bf16;
typedef short bf16x8 __attribute__((ext_vector_type(8)));
typedef short s16x4 __attribute__((ext_vector_type(4)));
typedef float f32x2 __attribute__((ext_vector_type(2)));
typedef float f32x4 __attribute__((ext_vector_type(4)));
typedef float f32x16 __attribute__((ext_vector_type(16)));
typedef unsigned u32x2 __attribute__((ext_vector_type(2)));
typedef unsigned u32x4 __attribute__((ext_vector_type(4)));
typedef int i32x4 __attribute__((ext_vector_type(4)));
typedef __bf16 bf16x2_t __attribute__((ext_vector_type(2)));

constexpr int BATCH = 4, SEQ = 4096, DM = 1024, DEPTH = 2, MTOK = BATCH * SEQ;
constexpr int NQKV = 3072, NGATE = 2048, DIN = NQKV + NGATE;
constexpr int NEXP = 32, DEXP = 256;
constexpr float NORM_EPS = 1e-6f;
constexpr float LOG2E = 1.4426950408889634f, LN2 = 0.6931471805599453f;
constexpr float QSCALE = 0.125f * LOG2E;
constexpr int NWAVES = 8, NTHREADS = 512;

constexpr size_t MiB = 1u << 20;
constexpr size_t WS_CTL = 0, CTL_BYTES = 1 * MiB;
constexpr size_t WS_ROPE = 1 * MiB;
constexpr size_t WS_WR = 2 * MiB;
constexpr size_t WS_RS1 = 3 * MiB, WS_RS2 = 3 * MiB + 65536;
constexpr size_t WS_TOKINFO = 5 * MiB;
constexpr size_t WS_LTOK = 6 * MiB, WS_LW = 8 * MiB;
constexpr size_t WS_LSE = 10 * MiB;
constexpr size_t WS_WIN = 12 * MiB, WS_WA = 22 * MiB, WS_WB = 23 * MiB, WS_WOUT = 24 * MiB, WS_WGU = 26 * MiB, WS_WD = 58 * MiB;
constexpr size_t WS_XB = 74 * MiB;
constexpr size_t WS_OBUF = 74 * MiB;
constexpr size_t WS_YA = 106 * MiB, WS_YB = 122 * MiB;
constexpr size_t WS_PQ = 130 * MiB;
constexpr size_t WS_M1 = 130 * MiB, WS_MRG = 162 * MiB, WS_H = 194 * MiB;
constexpr size_t WS_PG = 226 * MiB;
constexpr size_t WS_Y = 226 * MiB;
constexpr size_t WS_END = 290 * MiB;
constexpr int CW_CNT = 64, CNT_STRIDE = 64;
constexpr int CW_BAR = 8192;

constexpr int RING_BYTES = 131072;
constexpr int PREP_SCR = 16896;
constexpr int MISC_OFF = 8 * PREP_SCR;
constexpr int LDS_BYTES = 147456;

#define LDS_WAIT() asm volatile("s_waitcnt lgkmcnt(0)" ::: "memory")
#define VM_WAIT() asm volatile("s_waitcnt vmcnt(0)" ::: "memory")
__device__ __forceinline__ unsigned cvtpk(float lo, float hi) { f32x2 v = {lo, hi}; bf16x2_t b = __builtin_convertvector(v, bf16x2_t); return __builtin_bit_cast(unsigned, b); }
__device__ __forceinline__ float bf2f(unsigned short h) { return __uint_as_float(((unsigned)h) << 16); }
__device__ __forceinline__ float bflo(unsigned w) { return __uint_as_float(w << 16); }
__device__ __forceinline__ float bfhi(unsigned w) { return __uint_as_float(w & 0xffff0000u); }
__device__ __forceinline__ float fast_exp2(float x) { return __builtin_amdgcn_exp2f(x); }
__device__ __forceinline__ float fast_rcp(float x) { return __builtin_amdgcn_rcpf(x); }
__device__ __forceinline__ float sigmoidf_fast(float v) { return fast_rcp(1.0f + fast_exp2(-v * LOG2E)); }

namespace pg8 {
constexpr int BM = 256, BK = 64, HALF = 128, HTB = HALF * BK * 2, STAGE_BYTES = 8 * HTB, NXCD = 8, WGM = 8;
__host__ __device__ __forceinline__ int lds_byte(int r, int c) { const int st = (r >> 4) * 2 + (c >> 5), rr = r & 15, cc = c & 31, ob = rr * 64 + cc * 2; return st * 1024 + (ob ^ (((ob >> 9) & 1) << 5)); }
__host__ __device__ __forceinline__ void stage_rc(int b, int& R, int& C) { const int st = b / 1024, sb = b % 1024, swz = sb ^ (((sb >> 9) & 1) << 5); R = (st >> 1) * 16 + swz / 64; C = (st & 1) * 32 + (swz % 64) / 2; }
__host__ __device__ __forceinline__ int perm32(int rho) { const int n = rho >> 4, i = rho & 15; return 8 * (i >> 2) + 4 * n + (i & 3); }

struct Unit { int pm, pn, e, nvalid, slot0, lpos0; };

struct StaticOrder {
    int nM, nN, nwg, G, c;
    __device__ void init(int M, int N, int G_, int c_) { nM = M / BM; nN = N / BM; nwg = nM * nN; G = G_; c = c_; }
    __device__ bool next(int i, int& pm, int& pn) const {
        const long L = (long)i * G + c; if (L >= nwg) return false;
        int wgid = (int)L; { const int q = nwg / NXCD, r = nwg % NXCD, xcd = wgid % NXCD, off = wgid / NXCD; wgid = (xcd < r ? xcd * (q + 1) : r * (q + 1) + (xcd - r) * q) + off; }
        const int nig = WGM * nN, gid = wgid / nig, fm = gid * WGM, gsz = (nM - fm) < WGM ? (nM - fm) : WGM;
        pm = fm + ((wgid % nig) % gsz); pn = (wgid % nig) / gsz; return true;
    }
};

template <class Epi, class Sched>
__device__ __forceinline__ void gemm_phase(LAS unsigned char* lds, const Sched& S, const Epi& E) {
    unsigned z_ = 0u; asm volatile("" : "+v"(z_)); const int tid_ = (int)__builtin_amdgcn_mbcnt_hi(~0u, __builtin_amdgcn_mbcnt_lo(~0u, z_)) + S.wave * 64;
    const int tid = tid_, wid = S.wave, lane = tid & 63, wr = wid >> 2, wc = wid & 3, fr = lane & 15, fq = lane >> 4;
    const int K = S.K, nt = K / BK;
    unsigned voffA[2], voffB[2];
#pragma unroll
    for (int i = 0; i < 2; ++i) { int R, C; stage_rc(tid * 16 + i * 8192, R, C); const int Rb = Epi::PERM ? ((R & ~31) + perm32(R & 31)) : R;
        voffA[i] = (unsigned)(R * S.lda + C) * 2u; voffB[i] = (unsigned)(Rb * K + C) * 2u; }
    const size_t kstep = (size_t)(BK * 2);
    const size_t hstepB = (size_t)HALF * K * 2, hstepA = (size_t)HALF * S.lda * 2;
    const unsigned ldsw = (unsigned)wid * 1024u;
    const int aoff = lds_byte(wr * 64 + fr, fq * 8), boff = lds_byte(wc * 32 + fr, fq * 8);
#define PG8_SA(b, h) (((b) * 2 + (h)) * HTB)
#define PG8_SB(b, h) ((4 + (b) * 2 + (h)) * HTB)
#define PG8_GLDS(src, dstoff) __builtin_amdgcn_global_load_lds((const unsigned*)(src), (LAS unsigned*)(lds + (dstoff)), 16, 0, 0)
#define PG8_STAGE_A(bufoff, up, h, VO) do { if constexpr (Sched::GATHER) { _Pragma("unroll") for (int _i = 0; _i < 2; ++_i) PG8_GLDS((up) + VO[_i], (bufoff) + ldsw + _i * 8192); } \
        else { const char* _b = (up) + (size_t)(h) * hstepA; _Pragma("unroll") for (int _i = 0; _i < 2; ++_i) PG8_GLDS(_b + voffA[_i], (bufoff) + ldsw + _i * 8192); } } while (0)
#define PG8_STAGE_B(bufoff, bp) do { _Pragma("unroll") for (int _i = 0; _i < 2; ++_i) PG8_GLDS((bp) + voffB[_i], (bufoff) + ldsw + _i * 8192); } while (0)
#define PG8_LDA(dst, b, h) do { _Pragma("unroll") for (int m = 0; m < 4; ++m) _Pragma("unroll") for (int k = 0; k < 2; ++k) dst[m][k] = *(const LAS bf16x8*)(lds + PG8_SA(b, h) + aoff + m * 2048 + k * 1024); } while (0)
#define PG8_LDB(dst, b, h) do { _Pragma("unroll") for (int n = 0; n < 2; ++n) _Pragma("unroll") for (int k = 0; k < 2; ++k) dst[n][k] = *(const LAS bf16x8*)(lds + PG8_SB(b, h) + boff + n * 2048 + k * 1024); } while (0)
#define PG8_MMA(ai, bj, At, Bt) do { __builtin_amdgcn_s_setprio(1); _Pragma("unroll") for (int m = 0; m < 4; ++m) _Pragma("unroll") for (int n = 0; n < 2; ++n) _Pragma("unroll") for (int k = 0; k < 2; ++k) \
        acc[ai][bj][m][n] = __builtin_amdgcn_mfma_f32_16x16x32_bf16(Bt[n][k], At[m][k], acc[ai][bj][m][n], 0, 0, 0); __builtin_amdgcn_s_setprio(0); } while (0)
#define PG8_WAIT_V(n) asm volatile("s_waitcnt vmcnt(" #n ")" ::: "memory")
#define PG8_WAIT_L(n) asm volatile("s_waitcnt lgkmcnt(" #n ")" ::: "memory")
#define PG8_BAR __builtin_amdgcn_s_barrier()
#define PG8_SCHED __builtin_amdgcn_sched_barrier(0)
    Unit cur, nxt; int ui = 0;
    if (!S.next(0, cur)) return;
    f32x4 acc[2][2][4][2];
#pragma unroll
    for (int a = 0; a < 2; ++a)
#pragma unroll
        for (int b = 0; b < 2; ++b)
#pragma unroll
            for (int m = 0; m < 4; ++m)
#pragma unroll
                for (int n = 0; n < 2; ++n) acc[a][b][m][n] = (f32x4){0.f, 0.f, 0.f, 0.f};
    bf16x8 At[4][2], B0[2][2], B1[2][2];
    const char* Ab = S.a_base();
    const char* cA = Ab; const char* cB = S.b_base(cur);
    unsigned vF0[2], vF1[2], vK[2];
    if constexpr (Sched::GATHER) {
#pragma unroll
        for (int i = 0; i < 2; ++i) { int R, C; stage_rc(tid * 16 + i * 8192, R, C); vF0[i] = S.a_off(cur, R) + (unsigned)(C * 2); vF1[i] = S.a_off(cur, HALF + R) + (unsigned)(C * 2); vK[i] = vF1[i]; }
    } else cA = Ab + S.a_unit_off(cur);
    PG8_STAGE_B(PG8_SB(0, 0), cB); PG8_STAGE_B(PG8_SB(0, 1), cB + hstepB); PG8_STAGE_A(PG8_SA(0, 0), cA, 0, vF0); PG8_STAGE_A(PG8_SA(0, 1), cA, 1, vF1);
    if (wr == 1) PG8_BAR;
    PG8_WAIT_V(2); PG8_BAR;
    PG8_STAGE_B(PG8_SB(1, 0), cB + kstep); PG8_STAGE_A(PG8_SA(1, 0), cA + kstep, 0, vF0); PG8_STAGE_B(PG8_SB(1, 1), cB + hstepB + kstep);
    PG8_WAIT_V(6); PG8_BAR;
    for (;;) {
        const bool has_next = S.next(ui + 1, nxt);
        const char* nA = cA; const char* nB = cB;
        if (has_next) { nB = S.b_base(nxt); if constexpr (!Sched::GATHER) nA = Ab + S.a_unit_off(nxt); }
#pragma unroll 1
        for (int t = 0; t < nt; t += 2) {
            const bool last = (t == nt - 2);
            const char* a1 = cA + (size_t)(t + 1) * kstep;
            const char* a2 = last ? nA : cA + (size_t)(t + 2) * kstep; const char* b2 = last ? nB : cB + (size_t)(t + 2) * kstep;
            const char* a3 = a2 + kstep; const char* b3 = b2 + kstep;
            if constexpr (Sched::GATHER) {
                if (last && has_next) {
#pragma unroll
                    for (int i = 0; i < 2; ++i) { int R, C; stage_rc(tid * 16 + i * 8192, R, C); vF0[i] = S.a_off(nxt, R) + (unsigned)(C * 2); vF1[i] = S.a_off(nxt, HALF + R) + (unsigned)(C * 2); }
                }
            }
            PG8_LDB(B0, 0, 0); PG8_LDB(B1, 0, 1); PG8_SCHED; PG8_LDA(At, 0, 0); PG8_STAGE_A(PG8_SA(1, 1), a1, 1, vK);
            PG8_WAIT_V(8); PG8_WAIT_L(0); PG8_BAR; PG8_MMA(0, 0, At, B0); PG8_MMA(0, 1, At, B1); PG8_BAR; PG8_SCHED;
            PG8_LDA(At, 0, 1); PG8_STAGE_B(PG8_SB(0, 0), b2); PG8_STAGE_B(PG8_SB(0, 1), b2 + hstepB); PG8_STAGE_A(PG8_SA(0, 0), a2, 0, vF0);
            PG8_WAIT_V(8); PG8_WAIT_L(0); PG8_BAR; PG8_MMA(1, 0, At, B0); PG8_MMA(1, 1, At, B1); PG8_BAR; PG8_SCHED;
            PG8_LDB(B0, 1, 0); PG8_LDB(B1, 1, 1); PG8_SCHED; PG8_LDA(At, 1, 0); PG8_STAGE_A(PG8_SA(0, 1), a2, 1, vF1);
            PG8_WAIT_V(8); PG8_WAIT_L(0); PG8_BAR; PG8_MMA(0, 0, At, B0); PG8_MMA(0, 1, At, B1); PG8_BAR; PG8_SCHED;
            PG8_LDA(At, 1, 1); PG8_STAGE_B(PG8_SB(1, 0), b3); PG8_STAGE_B(PG8_SB(1, 1), b3 + hstepB); PG8_STAGE_A(PG8_SA(1, 0), a3, 0, vF0);
            PG8_WAIT_V(8); PG8_WAIT_L(0); PG8_BAR; PG8_MMA(1, 0, At, B0); PG8_MMA(1, 1, At, B1); PG8_BAR; PG8_SCHED;
        }
        if (wr == 0) PG8_BAR;
        E(acc, cur, wr, wc, fr, fq);
        if (!has_next) break;
#pragma unroll
        for (int a = 0; a < 2; ++a)
#pragma unroll
            for (int b = 0; b < 2; ++b)
#pragma unroll
                for (int m = 0; m < 4; ++m)
#pragma unroll
                    for (int n = 0; n < 2; ++n) acc[a][b][m][n] = (f32x4){0.f, 0.f, 0.f, 0.f};
        cur = nxt; cA = nA; cB = nB; ++ui;
        if constexpr (Sched::GATHER) { vK[0] = vF1[0]; vK[1] = vF1[1]; }
        if (wr == 1) PG8_BAR;
    }
    PG8_WAIT_V(0);
    PG8_BAR;
#undef PG8_SA
#undef PG8_SB
#undef PG8_GLDS
#undef PG8_STAGE_A
#undef PG8_STAGE_B
#undef PG8_LDA
#undef PG8_LDB
#undef PG8_MMA
#undef PG8_WAIT_V
#undef PG8_WAIT_L
#undef PG8_BAR
#undef PG8_SCHED
}
}
using pg8::Unit;

struct DenseSched {
    static constexpr bool GATHER = false;
    const char* A; const char* Bt; int K; int lda; int wave; pg8::StaticOrder so;
    __device__ __forceinline__ bool next(int i, Unit& u) const { int pm, pn; if (!so.next(i, pm, pn)) return false; u.pm = pm; u.pn = pn; u.e = 0; u.nvalid = 256; u.slot0 = pm * 256; u.lpos0 = 0; return true; }
    __device__ __forceinline__ const char* a_base() const { return A; }
    __device__ __forceinline__ unsigned a_off(const Unit& u, int r) const { return 0u; }
    __device__ __forceinline__ size_t a_unit_off(const Unit& u) const { return (size_t)u.pm * 256 * lda * 2; }
    __device__ __forceinline__ const char* b_base(const Unit& u) const { return Bt + (size_t)u.pn * 256 * K * 2; }
};
struct MoeTab { const volatile LAS int* cnt; const volatile LAS int* mtpref; const volatile LAS int* spref; };
template <bool GATHER_> struct MoeSched {
    static constexpr bool GATHER = GATHER_;
    const char* A; const char* Bt; int K; int lda; int wave; int ntn; size_t bstride_e; const int* ltok; MoeTab T; int G, c;
    __device__ __forceinline__ bool next(int i, Unit& u) const {
        const int L = i * G + c; const int total = T.mtpref[32] * ntn; if (L >= total) return false;
        const int tix = L / ntn; u.pn = L - tix * ntn; u.pm = tix;
        int e = 0;
#pragma unroll 1
        for (int k = 1; k < 32; ++k) if (T.mtpref[k] <= tix) e = k;
        const int mt = tix - T.mtpref[e]; u.e = e; u.slot0 = T.spref[e] + 256 * mt; const int rem = T.cnt[e] - 256 * mt; u.nvalid = rem < 256 ? rem : 256; u.lpos0 = e * MTOK + 256 * mt; return true;
    }
    __device__ __forceinline__ const char* a_base() const { return A; }
    __device__ __forceinline__ unsigned a_off(const Unit& u, int r) const { const int rr = r < u.nvalid ? r : u.nvalid - 1; return (unsigned)ltok[u.lpos0 + rr] * (unsigned)(lda * 2); }
    __device__ __forceinline__ size_t a_unit_off(const Unit& u) const { return (size_t)u.slot0 * lda * 2; }
    __device__ __forceinline__ const char* b_base(const Unit& u) const { return Bt + (size_t)u.e * bstride_e + (size_t)u.pn * 256 * K * 2; }
};

#define OPAQUE(p) asm volatile("" : "+v"(p))
struct EpiProj {
    static constexpr bool PERM = true;
    bf16* Pq; bf16* Pg; const float* rs; const f32x4* rope;
    __device__ __forceinline__ void operator()(const f32x4 (&acc)[2][2][4][2], const Unit& u, int wr, int wc, int fr, int fq) const {
        const int colh = wc * 32 + fq * 8;
        const int ib = (colh & 63) >> 2;
        const int row0 = u.pm * 256 + wr * 64 + fr;
        int mode[2]; bf16* ob[2]; size_t ostep[2];
#pragma unroll
        for (int bj = 0; bj < 2; ++bj) {
            const int h128 = 2 * u.pn + bj;
            if (h128 >= 24) mode[bj] = 3;
            else if (h128 < 6) mode[bj] = h128 < 4 ? 1 : (h128 == 4 ? 2 : 0);
            else { const int j = (h128 - 6) % 6; mode[bj] = j < 2 ? 1 : (j < 4 ? 2 : 0); }
            const int opitch = (h128 < 24) ? NQKV : NGATE;
            ob[bj] = ((h128 < 24) ? Pq + h128 * 128 + colh : Pg + (h128 - 24) * 128 + colh) + (size_t)row0 * opitch;
            ostep[bj] = (size_t)opitch * 16;
        }
        const float* rsp = rs + row0;
        const f32x4* rp = rope + (size_t)(row0 & (SEQ - 1)) * 16 + ib;
#pragma unroll
        for (int ai = 0; ai < 2; ++ai)
#pragma unroll
            for (int m = 0; m < 4; ++m) {
                OPAQUE(rsp); OPAQUE(rp); OPAQUE(ob[0]); OPAQUE(ob[1]);
                const float s = *rsp;
                f32x4 c0 = {0.f, 0.f, 0.f, 0.f}, c1 = c0;
                if (mode[0] == 1 || mode[0] == 2 || mode[1] == 1 || mode[1] == 2) { c0 = rp[0]; c1 = rp[1]; }
#pragma unroll
                for (int bj = 0; bj < 2; ++bj) {
                    f32x4 v0 = acc[ai][bj][m][0] * s, v1 = acc[ai][bj][m][1] * s;
                    if (mode[bj] == 1 || mode[bj] == 2) {
                        f32x4 o0, o1;
                        o0[0] = v0[0] * c0[0] - v0[1] * c0[1]; o0[1] = v0[1] * c0[0] + v0[0] * c0[1];
                        o0[2] = v0[2] * c0[2] - v0[3] * c0[3]; o0[3] = v0[3] * c0[2] + v0[2] * c0[3];
                        o1[0] = v1[0] * c1[0] - v1[1] * c1[1]; o1[1] = v1[1] * c1[0] + v1[0] * c1[1];
                        o1[2] = v1[2] * c1[2] - v1[3] * c1[3]; o1[3] = v1[3] * c1[2] + v1[2] * c1[3];
                        const float qs = (mode[bj] == 1) ? QSCALE : 1.0f;
                        v0 = o0 * qs; v1 = o1 * qs;
                    } else if (mode[bj] == 3) {
#pragma unroll
                        for (int j = 0; j < 4; ++j) { v0[j] = sigmoidf_fast(v0[j]); v1[j] = sigmoidf_fast(v1[j]); }
                    }
                    u32x4 w; w.x = cvtpk(v0[0], v0[1]); w.y = cvtpk(v0[2], v0[3]); w.z = cvtpk(v1[0], v1[1]); w.w = cvtpk(v1[2], v1[3]);
                    *(u32x4*)(ob[bj]) = w;
                }
                const int adv = (m == 3) ? 5 : 1;
                rsp += 16 * adv; rp += (size_t)16 * 16 * adv; ob[0] += ostep[0] * adv; ob[1] += ostep[1] * adv;
            }
    }
};
template <bool ADD> struct EpiGate {
    static constexpr bool PERM = true;
    const bf16* gate; const bf16* prev; bf16* out;
    __device__ __forceinline__ void operator()(const f32x4 (&acc)[2][2][4][2], const Unit& u, int wr, int wc, int fr, int fq) const {
        const int row0 = u.pm * 256 + wr * 64 + fr, col0 = u.pn * 256 + wc * 32 + fq * 8;
        const bf16* gp = gate + (size_t)row0 * NGATE + col0; const bf16* pp = prev + (size_t)row0 * DM + col0; bf16* op = out + (size_t)row0 * DM + col0;
#pragma unroll
        for (int ai = 0; ai < 2; ++ai)
#pragma unroll
            for (int m = 0; m < 4; ++m) {
                OPAQUE(gp); OPAQUE(op); if (ADD) OPAQUE(pp);
#pragma unroll
                for (int bj = 0; bj < 2; ++bj) {
                    const u32x4 g = *(const u32x4*)(gp + bj * 128);
                    const f32x4 a0 = acc[ai][bj][m][0], a1 = acc[ai][bj][m][1];
                    float r[8];
                    r[0] = a0[0] * bflo(g.x); r[1] = a0[1] * bfhi(g.x); r[2] = a0[2] * bflo(g.y); r[3] = a0[3] * bfhi(g.y);
                    r[4] = a1[0] * bflo(g.z); r[5] = a1[1] * bfhi(g.z); r[6] = a1[2] * bflo(g.w); r[7] = a1[3] * bfhi(g.w);
                    if (ADD) { const u32x4 p = *(const u32x4*)(pp + bj * 128);
                        r[0] += bflo(p.x); r[1] += bfhi(p.x); r[2] += bflo(p.y); r[3] += bfhi(p.y); r[4] += bflo(p.z); r[5] += bfhi(p.z); r[6] += bflo(p.w); r[7] += bfhi(p.w); }
                    u32x4 w; w.x = cvtpk(r[0], r[1]); w.y = cvtpk(r[2], r[3]); w.z = cvtpk(r[4], r[5]); w.w = cvtpk(r[6], r[7]);
                    *(u32x4*)(op + bj * 128) = w;
                }
                const int adv = (m == 3) ? 5 : 1;
                gp += (size_t)16 * NGATE * adv; pp += (size_t)16 * DM * adv; op += (size_t)16 * DM * adv;
            }
    }
};
struct EpiResid {
    static constexpr bool PERM = false;
    const float* base; float* xout; bf16* xb;
    __device__ __forceinline__ void operator()(const f32x4 (&acc)[2][2][4][2], const Unit& u, int wr, int wc, int fr, int fq) const {
#pragma unroll
        for (int ai = 0; ai < 2; ++ai)
#pragma unroll
            for (int m = 0; m < 4; ++m) {
                const size_t row = (size_t)(u.pm * 256 + ai * 128 + wr * 64 + m * 16 + fr);
#pragma unroll
                for (int bj = 0; bj < 2; ++bj)
#pragma unroll
                    for (int n = 0; n < 2; ++n) {
                        const int col = u.pn * 256 + bj * 128 + wc * 32 + n * 16 + fq * 4;
                        const f32x4 b = *(const f32x4*)(base + row * DM + col);
                        const f32x4 v = b + acc[ai][bj][m][n];
                        *(f32x4*)(xout + row * DM + col) = v;
                        u32x2 w; w.x = cvtpk(v[0], v[1]); w.y = cvtpk(v[2], v[3]);
                        *(u32x2*)(xb + row * DM + col) = w;
                    }
            }
    }
};
struct EpiSwiglu {
    static constexpr bool PERM = true;
    const int* ltok; const float* lw; const float* rs; bf16* H;
    __device__ __forceinline__ void operator()(const f32x4 (&acc)[2][2][4][2], const Unit& u, int wr, int wc, int fr, int fq) const {
#pragma unroll
        for (int ai = 0; ai < 2; ++ai)
#pragma unroll
            for (int m = 0; m < 4; ++m) {
                const int rr = ai * 128 + wr * 64 + m * 16 + fr;
                if (rr < u.nvalid) {
                    const int tok = ltok[u.lpos0 + rr]; const float w = lw[u.lpos0 + rr]; const float s = rs[tok];
#pragma unroll
                    for (int bj = 0; bj < 2; ++bj) {
                        const f32x4 a0 = acc[ai][bj][m][0] * s, a1 = acc[ai][bj][m][1] * s;
                        const float h0 = a0[0] * sigmoidf_fast(a0[0]) * a0[1] * w, h1 = a0[2] * sigmoidf_fast(a0[2]) * a0[3] * w;
                        const float h2 = a1[0] * sigmoidf_fast(a1[0]) * a1[1] * w, h3 = a1[2] * sigmoidf_fast(a1[2]) * a1[3] * w;
                        u32x2 o; o.x = cvtpk(h0, h1); o.y = cvtpk(h2, h3);
                        *(u32x2*)(H + (size_t)(u.slot0 + rr) * DEXP + u.pn * 128 + bj * 64 + wc * 16 + fq * 4) = o;
                    }
                }
            }
    }
};
struct EpiY {
    static constexpr bool PERM = true;
    bf16* Y;
    __device__ __forceinline__ void operator()(const f32x4 (&acc)[2][2][4][2], const Unit& u, int wr, int wc, int fr, int fq) const {
#pragma unroll
        for (int ai = 0; ai < 2; ++ai)
#pragma unroll
            for (int m = 0; m < 4; ++m) {
                const int rr = ai * 128 + wr * 64 + m * 16 + fr;
                if (rr < u.nvalid) {
#pragma unroll
                    for (int bj = 0; bj < 2; ++bj) {
                        const f32x4 a0 = acc[ai][bj][m][0], a1 = acc[ai][bj][m][1];
                        u32x4 w; w.x = cvtpk(a0[0], a0[1]); w.y = cvtpk(a0[2], a0[3]); w.z = cvtpk(a1[0], a1[1]); w.w = cvtpk(a1[2], a1[3]);
                        *(u32x4*)(Y + (size_t)(u.slot0 + rr) * DM + u.pn * 256 + bj * 128 + wc * 32 + fq * 8) = w;
                    }
                }
            }
    }
};

#define XB_TMO      128
#define XB_XCNT(j)  (256  + 64 * (j))
#define XB_XSUB(j)  (1280 + 64 * (j))
#define XB_XGEN(j)  (2304 + 64 * (j))
#define XB_TOP      3328
#define XB_TOPGEN   3392
#define XCD_BAR_WORDS 3456
#define XB_SPIN_CAP (1u << 18)
__device__ __forceinline__ unsigned xb_ld(unsigned* p)              { return __hip_atomic_load(p, __ATOMIC_RELAXED, __HIP_MEMORY_SCOPE_AGENT); }
__device__ __forceinline__ unsigned xb_add(unsigned* p, unsigned v) { return __hip_atomic_fetch_add(p, v, __ATOMIC_RELAXED, __HIP_MEMORY_SCOPE_AGENT); }
__device__ __forceinline__ unsigned xb_xcc_id() { return (unsigned)__builtin_amdgcn_s_getreg((3 << 11) | 20) & 0xFu; }
#define XB_SPIN(cond, bar) do { unsigned _sp = 0; while (cond) { __builtin_amdgcn_s_sleep(1); \
    if ((++_sp & 255u) == 0u) { if (xb_ld(&(bar)[XB_TMO])) break; if (_sp > XB_SPIN_CAP) { atomicAdd(&(bar)[XB_TMO], 1u); break; } } } } while (0)
struct XcdBarrier { unsigned* bar; unsigned x; volatile LAS unsigned* st; };
__device__ __forceinline__ XcdBarrier xcd_barrier_post(unsigned* bar, volatile LAS unsigned* st) {
    XcdBarrier b; b.bar = bar; b.x = xb_xcc_id(); b.st = st;
    if (threadIdx.x == 0) (void)xb_add(&bar[XB_XCNT(b.x)], 1u);
    return b;
}
__device__ __forceinline__ void xcd_barrier_complete(unsigned* bar, unsigned x, unsigned& nloc, unsigned& nx) {
    const unsigned G = gridDim.x * gridDim.y * gridDim.z;
    unsigned sum, cnt, mine, sp = 0u;
    for (;;) {
        sum = 0u; cnt = 0u; mine = 0u;
#pragma unroll
        for (unsigned j = 0; j < 16; ++j) { const unsigned c = xb_ld(&bar[XB_XCNT(j)]); sum += c; cnt += (c > 0u) ? 1u : 0u; mine = (j == x) ? c : mine; }
        if (sum == G) break;
        __builtin_amdgcn_s_sleep(1);
        if ((++sp & 255u) == 0u) { if (xb_ld(&bar[XB_TMO])) break; if (sp > XB_SPIN_CAP) { atomicAdd(&bar[XB_TMO], 1u); break; } }
    }
    nloc = mine > 0u ? mine : 1u; nx = cnt > 0u ? cnt : 1u;
}
__device__ __forceinline__ void xcd_barrier(const XcdBarrier& b, int wave) {
    asm volatile("s_waitcnt vmcnt(0)" ::: "memory");
    __syncthreads();
    unsigned zb_ = 0u; asm volatile("" : "+v"(zb_));
    if (wave == 0 && __builtin_amdgcn_mbcnt_hi(~0u, __builtin_amdgcn_mbcnt_lo(~0u, zb_)) == 0u) {
        unsigned* bar = b.bar;
        __builtin_amdgcn_s_waitcnt(0);
        unsigned nloc = b.st[0], nx = b.st[1];
        if (nloc == 0u) { xcd_barrier_complete(bar, b.x, nloc, nx); b.st[0] = nloc; b.st[1] = nx; }
        const unsigned old = xb_add(&bar[XB_XSUB(b.x)], 1u);
        const unsigned gen = old / nloc;
        if (old + 1u == (gen + 1u) * nloc) {
            __builtin_amdgcn_fence(__ATOMIC_RELEASE, "agent");
            asm volatile("s_waitcnt vmcnt(0)" ::: "memory");
            const unsigned og = xb_add(&bar[XB_TOP], 1u);
            const unsigned tg = og / nx;
            if (og + 1u == (tg + 1u) * nx) xb_add(&bar[XB_TOPGEN], 1u);
            else XB_SPIN(xb_ld(&bar[XB_TOPGEN]) == tg, bar);
            __builtin_amdgcn_fence(__ATOMIC_ACQUIRE, "agent");
            xb_add(&bar[XB_XGEN(b.x)], 1u);
            asm volatile("s_waitcnt vmcnt(0)" ::: "memory");
        } else {
            XB_SPIN(xb_ld(&bar[XB_XGEN(b.x)]) == gen, bar);
            __builtin_amdgcn_fence(__ATOMIC_ACQUIRE, "agent");
            asm volatile("s_waitcnt vmcnt(0)" ::: "memory");
        }
    }
    __syncthreads();
}

struct Args {
    const float* x; const float* attn_g; const float* w_in; const float* a_sink; const float* w_a; const float* w_b; const float* w_out; const float* ffn_g;
    const float* w_rg; const float* b_rg; const float* w_re; const float* b_re; const float* w_eg; const float* w_eu; const float* w_ed; const float* fin_g;
    float* out; unsigned char* ws; int ph_lo, ph_hi;
};
typedef const __attribute__((address_space(4))) Args* CArgs;
struct Frame {
    LAS unsigned char* lds; volatile LAS int* misc;
    int wave, G, vcu, gw, ngw;
};
__device__ __forceinline__ int otid() { unsigned z = 0u; asm volatile("" : "+v"(z)); return (int)__builtin_amdgcn_mbcnt_hi(~0u, __builtin_amdgcn_mbcnt_lo(~0u, z)); }
__device__ __forceinline__ float shx(float v, int o, int lane) { return __int_as_float(__builtin_amdgcn_ds_bpermute((lane ^ o) << 2, __float_as_int(v))); }
__device__ __forceinline__ float wave_sum(float v, int lane) {
#pragma unroll
    for (int o = 1; o < 64; o <<= 1) v += shx(v, o, lane);
    return v;
}

struct MapPlain { __device__ __forceinline__ int operator()(int n) const { return n; } };
struct MapWin { __device__ __forceinline__ int operator()(int n) const {
        bool rope = false;
        if (n < 640) rope = true; else if (n >= 768 && n < NQKV) rope = ((n - 768) % 768) < 512;
        if (!rope) return n; const int d = n & 63; return (n & ~63) + 2 * (d & 31) + (d >> 5); } };
struct MapGU { int t; __device__ __forceinline__ int operator()(int n) const { return 2 * n + t; } };
template <class Map> __device__ __forceinline__ void transpose_item64(const float* W, int ldn, int k0, int n0, const float* gk, bf16* WT, int Kd, const Map& map, LAS float* scr, int lane) {
    const int kq = lane >> 4, n4 = (lane & 15) * 4;
    const float* src = W + (size_t)(k0 + kq) * ldn + n0 + n4;
    f32x4 v[16];
#pragma unroll
    for (int i = 0; i < 16; ++i) v[i] = *(const f32x4*)(src + (size_t)(4 * i) * ldn);
    if (gk) {
#pragma unroll
        for (int i = 0; i < 16; ++i) v[i] = v[i] * gk[k0 + 4 * i + kq];
    }
#pragma unroll
    for (int i = 0; i < 16; ++i) { LAS float* d = scr + (4 * i + kq) * 65 + n4; d[0] = v[i][0]; d[1] = v[i][1]; d[2] = v[i][2]; d[3] = v[i][3]; }
    LDS_WAIT(); asm volatile("" ::: "memory");
    const int c = lane & 7;
#pragma unroll
    for (int j = 0; j < 8; ++j) { const int n = (lane >> 3) + 8 * j; const LAS float* p = scr + (8 * c) * 65 + n;
        u32x4 o; o.x = cvtpk(p[0 * 65], p[1 * 65]); o.y = cvtpk(p[2 * 65], p[3 * 65]); o.z = cvtpk(p[4 * 65], p[5 * 65]); o.w = cvtpk(p[6 * 65], p[7 * 65]);
        *(u32x4*)(WT + (size_t)map(n0 + n) * Kd + k0 + 8 * c) = o; }
    LDS_WAIT(); asm volatile("" ::: "memory");
}
__device__ __forceinline__ void prep_phase(const Frame& F, CArgs a, int l) {
    const int lane = otid(), tid = F.wave * 64 + lane; (void)tid; (void)lane;
    unsigned char* ws = a->ws;
    LAS float* scr = (LAS float*)(F.lds + F.wave * PREP_SCR);
    constexpr int I_IN = 16 * 80, I_A = 8 * 16, I_B = 4 * 16, I_O = 16 * 16, I_G = 16 * 4, I_D = 4 * 16, I_E = 2 * I_G + I_D;
    constexpr int NIT = I_IN + I_A + I_B + I_O + NEXP * I_E;
    const float* ag = a->attn_g + l * DM; const float* fg = a->ffn_g + l * DM;
    for (int it = F.gw; it < NIT; it += F.ngw) {
        int r = it;
        if (r < I_IN) { transpose_item64(a->w_in + (size_t)l * DM * DIN, DIN, 64 * (r / 80), 64 * (r % 80), ag, (bf16*)(ws + WS_WIN), DM, MapWin{}, scr, lane); continue; } r -= I_IN;
        if (r < I_A) { transpose_item64(a->w_a + (size_t)l * 512 * DM, DM, 64 * (r / 16), 64 * (r % 16), nullptr, (bf16*)(ws + WS_WA), 512, MapPlain{}, scr, lane); continue; } r -= I_A;
        if (r < I_B) { transpose_item64(a->w_b + (size_t)l * 256 * DM, DM, 64 * (r / 16), 64 * (r % 16), nullptr, (bf16*)(ws + WS_WB), 256, MapPlain{}, scr, lane); continue; } r -= I_B;
        if (r < I_O) { transpose_item64(a->w_out + (size_t)l * DM * DM, DM, 64 * (r / 16), 64 * (r % 16), nullptr, (bf16*)(ws + WS_WOUT), DM, MapPlain{}, scr, lane); continue; } r -= I_O;
        const int e = r / I_E; r -= e * I_E;
        const size_t eo = ((size_t)l * NEXP + e) * DM * DEXP;
        if (r < 2 * I_G) { const int t = r / I_G; r -= t * I_G; const float* W = (t ? a->w_eu : a->w_eg) + eo;
            transpose_item64(W, DEXP, 64 * (r / 4), 64 * (r % 4), fg, (bf16*)(ws + WS_WGU) + (size_t)e * 512 * DM, DM, MapGU{t}, scr, lane); continue; } r -= 2 * I_G;
        transpose_item64(a->w_ed + eo, DM, 64 * (r / 16), 64 * (r % 16), nullptr, (bf16*)(ws + WS_WD) + (size_t)e * DM * DEXP, DEXP, MapPlain{}, scr, lane);
    }
    {
        float* wrp = (float*)(ws + WS_WR);
        const float* wg = a->w_rg + (size_t)l * DM * 4; const float* we = a->w_re + (size_t)l * DM * NEXP;
        for (int idx = blockIdx.x * NTHREADS + tid; idx < 64 * 3 * 64 * 4; idx += F.G * NTHREADS) {
            const int s = idx & 3, ln = (idx >> 2) & 63, q = idx >> 8, nt = q % 3, i = q / 3;
            const int k = 16 * i + 4 * (ln >> 4) + s, n = 16 * nt + (ln & 15);
            float v = 0.f; if (n < 4) v = wg[k * 4 + n]; else if (n < 36) v = we[k * NEXP + (n - 4)];
            wrp[idx] = v * fg[k];
        }
    }
    if (l == 0) {
        float* rt = (float*)(ws + WS_ROPE);
        for (int idx = blockIdx.x * NTHREADS + tid; idx < SEQ * 32; idx += F.G * NTHREADS) {
            const int pos = idx >> 5, i = idx & 31;
            const float inv = 1.0f / powf(10000.0f, (float)(2 * i) / 64.0f);
            const float ang = (float)pos * inv;
            const double ad = (double)ang, kd = __builtin_rint(ad * 0.15915494309189535);
            const float rf = (float)__builtin_fma(-kd, 6.283185307179586, ad);
            rt[idx * 2] = cosf(rf); rt[idx * 2 + 1] = sinf(rf);
        }
        bf16* xb = (bf16*)(ws + WS_XB); float* rs1 = (float*)(ws + WS_RS1);
        for (int m = F.gw; m < MTOK; m += F.ngw) {
            const f32x4* xr = (const f32x4*)(a->x + (size_t)m * DM) + lane;
            f32x4 v[4]; float s = 0.f;
#pragma unroll
            for (int j = 0; j < 4; ++j) { v[j] = xr[64 * j]; s += (v[j][0] * v[j][0] + v[j][1] * v[j][1]) + (v[j][2] * v[j][2] + v[j][3] * v[j][3]); }
            s = wave_sum(s, lane);
            u32x2* o = (u32x2*)(xb + (size_t)m * DM) + lane;
#pragma unroll
            for (int j = 0; j < 4; ++j) { u32x2 w; w.x = cvtpk(v[j][0], v[j][1]); w.y = cvtpk(v[j][2], v[j][3]); o[64 * j] = w; }
            if (lane == 0) rs1[m] = 1.0f / sqrtf(s * (1.0f / DM) + NORM_EPS);
        }
    }
}

__device__ __forceinline__ int crow(int r, int hi) { return (r & 3) + 8 * (r >> 2) + 4 * hi; }
__device__ __forceinline__ void attn_task(const bf16* P, int qcol, int kcol, int vcol, int b, int d, int r, int t, int W, float m0, float l0,
                                          bf16* outp, int opitch, float* lsep, LAS unsigned char* vl, int lane) {
    const int r32 = lane & 31, hi = lane >> 5;
    const int L32 = (SEQ / d) >> 5;
    const size_t tok0 = (size_t)b * SEQ + r;
    const size_t qtok = tok0 + (size_t)(32 * t + r32) * d;
    bf16x8 qf[4];
#pragma unroll
    for (int s = 0; s < 4; ++s) qf[s] = *(const bf16x8*)(P + qtok * NQKV + qcol + 16 * s + 8 * hi);
    f32x16 o0 = {}, o1 = {};
    float mrun = m0, lrun = l0;
    const int jlo = (t - W) < 0 ? 0 : (t - W), jhi = (t + W) > (L32 - 1) ? (L32 - 1) : (t + W);
    const LAS unsigned char* vrd = vl + (4 * hi + ((lane & 15) >> 2)) * 128 + (16 * ((lane >> 4) & 1) + 4 * (lane & 3)) * 2;
    const bf16* kvbase = P + (tok0 + (size_t)(lane >> 3) * d) * NQKV + (lane & 7) * 8;
    const size_t tstride = (size_t)32 * d * NQKV, vstride = (size_t)8 * d * NQKV;
    LAS unsigned char* kl = vl + 4096;
    const int kwr = (lane >> 3) * 128 + (((lane & 7) ^ ((lane >> 3) & 7)) * 16);
    const int krd = r32 * 128;
    u32x4 kn[4], vn[4];
#pragma unroll
    for (int i = 0; i < 4; ++i) { kn[i] = *(const u32x4*)(kvbase + jlo * tstride + i * vstride + kcol); vn[i] = *(const u32x4*)(kvbase + jlo * tstride + i * vstride + vcol); }
    for (int j = jlo; j <= jhi; ++j) {
#pragma unroll
        for (int i = 0; i < 4; ++i) { *(LAS u32x4*)(kl + kwr + i * 1024) = kn[i]; *(LAS u32x4*)(vl + (lane >> 3) * 128 + (lane & 7) * 16 + i * 1024) = vn[i]; }
        if (j < jhi) {
#pragma unroll
            for (int i = 0; i < 4; ++i) { kn[i] = *(const u32x4*)(kvbase + (j + 1) * tstride + i * vstride + kcol); vn[i] = *(const u32x4*)(kvbase + (j + 1) * tstride + i * vstride + vcol); }
        }
        bf16x8 kf[4];
#pragma unroll
        for (int s = 0; s < 4; ++s) kf[s] = *(const LAS bf16x8*)(kl + krd + (((2 * s + hi) ^ (r32 & 7)) * 16));
        f32x16 sc = {};
#pragma unroll
        for (int s = 0; s < 4; ++s) sc = __builtin_amdgcn_mfma_f32_32x32x16_bf16(kf[s], qf[s], sc, 0, 0, 0);
        if (j == t - W) {
#pragma unroll
            for (int g = 0; g < 16; ++g) if (crow(g, hi) < r32) sc[g] = -INFINITY;
        }
        if (j == t + W) {
#pragma unroll
            for (int g = 0; g < 16; ++g) if (crow(g, hi) > r32) sc[g] = -INFINITY;
        }
        float mx = sc[0];
#pragma unroll
        for (int g = 1; g < 16; ++g) mx = fmaxf(mx, sc[g]);
        mx = fmaxf(mx, shx(mx, 32, lane));
        const float mnew = fmaxf(mrun, mx);
        const float alpha = fast_exp2(mrun - mnew);
        float psum = 0.f;
#pragma unroll
        for (int g = 0; g < 16; ++g) { sc[g] = fast_exp2(sc[g] - mnew); psum += sc[g]; }
        psum += shx(psum, 32, lane);
        lrun = lrun * alpha + psum; mrun = mnew;
#pragma unroll
        for (int g = 0; g < 16; ++g) { o0[g] *= alpha; o1[g] *= alpha; }
        u32x4 p0, p1;
        p0.x = cvtpk(sc[0], sc[1]); p0.y = cvtpk(sc[2], sc[3]); p0.z = cvtpk(sc[4], sc[5]); p0.w = cvtpk(sc[6], sc[7]);
        p1.x = cvtpk(sc[8], sc[9]); p1.y = cvtpk(sc[10], sc[11]); p1.z = cvtpk(sc[12], sc[13]); p1.w = cvtpk(sc[14], sc[15]);
        const bf16x8 pf0 = __builtin_bit_cast(bf16x8, p0), pf1 = __builtin_bit_cast(bf16x8, p1);
#define VTR(off) __builtin_bit_cast(s16x4, __builtin_amdgcn_ds_read_tr16_b64_v4i16((LAS s16x4*)(vrd + (off))))
#define VFRAG(s, dh) ({ const s16x4 _a = VTR((16 * (s)) * 128 + (dh) * 64), _b = VTR((16 * (s) + 8) * 128 + (dh) * 64); (bf16x8){_a[0], _a[1], _a[2], _a[3], _b[0], _b[1], _b[2], _b[3]}; })
        const bf16x8 v00 = VFRAG(0, 0), v10 = VFRAG(1, 0), v01 = VFRAG(0, 1), v11 = VFRAG(1, 1);
        o0 = __builtin_amdgcn_mfma_f32_32x32x16_bf16(v00, pf0, o0, 0, 0, 0);
        o0 = __builtin_amdgcn_mfma_f32_32x32x16_bf16(v10, pf1, o0, 0, 0, 0);
        o1 = __builtin_amdgcn_mfma_f32_32x32x16_bf16(v01, pf0, o1, 0, 0, 0);
        o1 = __builtin_amdgcn_mfma_f32_32x32x16_bf16(v11, pf1, o1, 0, 0, 0);
#undef VTR
#undef VFRAG
    }
    const float inv = 1.0f / lrun;
    bf16* orow = outp + qtok * opitch;
#pragma unroll
    for (int g4 = 0; g4 < 4; ++g4) {
        u32x2 w0, w1;
        w0.x = cvtpk(o0[4 * g4] * inv, o0[4 * g4 + 1] * inv); w0.y = cvtpk(o0[4 * g4 + 2] * inv, o0[4 * g4 + 3] * inv);
        w1.x = cvtpk(o1[4 * g4] * inv, o1[4 * g4 + 1] * inv); w1.y = cvtpk(o1[4 * g4 + 2] * inv, o1[4 * g4 + 3] * inv);
        *(u32x2*)(orow + 8 * g4 + 4 * hi) = w0;
        *(u32x2*)(orow + 32 + 8 * g4 + 4 * hi) = w1;
    }
    if (lsep && hi == 0) lsep[qtok * 12] = (mrun + log2f(lrun)) * LN2;
}
__device__ __forceinline__ void attn_phase(const Frame& F, CArgs a, int l) {
    const int lane = otid(), tid = F.wave * 64 + lane; (void)tid; (void)lane;
    unsigned char* ws = a->ws;
    const bf16* P = (const bf16*)(ws + WS_PQ);
    bf16* ya = (bf16*)(ws + WS_YA); bf16* ob = (bf16*)(ws + WS_OBUF); float* lse = (float*)(ws + WS_LSE);
    LAS unsigned char* vl = F.lds + F.wave * 8192;
    constexpr int NA = BATCH * 2 * 128 * 4, NB1 = BATCH * 4 * 128;
    constexpr int NTASK = NA + 3 * NB1;
    for (int it = F.gw; it < NTASK; it += F.ngw) {
        if (it < NA) {
            const int g = it & 3, qt = (it >> 2) & 127, kvh = (it >> 9) & 1, b = it >> 10;
            const int hq = kvh * 4 + g;
            const float sk = a->a_sink[l * 8 + hq] * LOG2E;
            attn_task(P, hq * 64, 512 + kvh * 64, 640 + kvh * 64, b, 1, 0, qt, 4, sk, 1.0f, ya + hq * 64, 512, nullptr, vl, lane);
        } else {
            int r = it - NA; const int grp = r / NB1; r -= grp * NB1;
            const int d = grp == 0 ? 1 : (grp == 1 ? 4 : 16);
            const int tpr = 128 / d;
            const int tl = r % tpr; int q = r / tpr; const int res = q % d; q /= d; const int h = q & 3, b = q >> 2;
            const int base = 768 + 768 * grp;
            attn_task(P, base + h * 64, base + 256 + h * 64, base + 512 + h * 64, b, d, res, tl, 2, -1e30f, 0.0f, ob + grp * 256 + h * 64, 768, lse + grp * 4 + h, vl, lane);
        }
    }
}
__device__ __forceinline__ void comb_phase(const Frame& F, CArgs a) {
    const int lane = otid(), tid = F.wave * 64 + lane; (void)tid; (void)lane;
    unsigned char* ws = a->ws;
    const bf16* ob = (const bf16*)(ws + WS_OBUF); const float* lse = (const float*)(ws + WS_LSE); bf16* yb = (bf16*)(ws + WS_YB);
    for (int idx = blockIdx.x * NTHREADS + tid; idx < MTOK * 32; idx += F.G * NTHREADS) {
        const int tok = idx >> 5, c = idx & 31, h = c >> 3;
        const float l0 = lse[tok * 12 + h], l1 = lse[tok * 12 + 4 + h], l2 = lse[tok * 12 + 8 + h];
        const float mx = fmaxf(l0, fmaxf(l1, l2));
        float w0 = __expf(l0 - mx), w1 = __expf(l1 - mx), w2 = __expf(l2 - mx);
        const float inv = 1.0f / (w0 + w1 + w2); w0 *= inv; w1 *= inv; w2 *= inv;
        const u32x4 a0 = *(const u32x4*)(ob + (size_t)tok * 768 + c * 8), a1 = *(const u32x4*)(ob + (size_t)tok * 768 + 256 + c * 8), a2 = *(const u32x4*)(ob + (size_t)tok * 768 + 512 + c * 8);
        u32x4 o;
#define CMB(f) o.f = cvtpk(w0 * bflo(a0.f) + w1 * bflo(a1.f) + w2 * bflo(a2.f), w0 * bfhi(a0.f) + w1 * bfhi(a1.f) + w2 * bfhi(a2.f))
        CMB(x); CMB(y); CMB(z); CMB(w);
#undef CMB
        *(u32x4*)(yb + (size_t)tok * 256 + c * 8) = o;
    }
}

__device__ __forceinline__ void route_phase(const Frame& F, CArgs a, int l) {
    const int lane = otid(), tid = F.wave * 64 + lane;
    unsigned char* ws = a->ws;
    const float* x = a->out; const f32x4* wrp = (const f32x4*)(ws + WS_WR);
    float* rs2 = (float*)(ws + WS_RS2); i32x4* tokinfo = (i32x4*)(ws + WS_TOKINFO); int* ltok = (int*)(ws + WS_LTOK); float* lw = (float*)(ws + WS_LW);
    int* cnt = (int*)(ws + WS_CTL) + CW_CNT + l * 32 * CNT_STRIDE;
    const float* brg = a->b_rg + l * 4; const float* bre = a->b_re + l * NEXP;
    LAS f32x4* part = (LAS f32x4*)(F.lds);
    LAS float* ssp = (LAS float*)(F.lds + 12288);
    LAS float* Lg = (LAS float*)(F.lds + 16384);
    LAS float* rsL = (LAS float*)(F.lds + 16384 + 12288);
    LAS int* lcnt = (LAS int*)(F.lds + 16384 + 12288 + 256);
    LAS int* lbase = lcnt + 32;
    const int rt = F.wave & 3, kh = F.wave >> 2;
    if (tid < 32) lcnt[tid] = 0;
    __syncthreads();
    for (int blk = blockIdx.x; blk < MTOK / 64; blk += F.G) {
        const int row0 = blk * 64 + rt * 16;
        const f32x4* xr = (const f32x4*)(x + (size_t)(row0 + (lane & 15)) * DM + kh * 512) + (lane >> 4);
        const f32x4* wp = wrp + (size_t)(kh * 32) * 3 * 64 + lane;
        f32x4 acc0 = {0.f, 0.f, 0.f, 0.f}, acc1 = acc0, acc2 = acc0; float ss = 0.f;
#pragma unroll 8
        for (int i = 0; i < 32; ++i) {
            const f32x4 xv = xr[4 * i];
            const f32x4 w0 = wp[(i * 3 + 0) * 64], w1 = wp[(i * 3 + 1) * 64], w2 = wp[(i * 3 + 2) * 64];
            ss += (xv[0] * xv[0] + xv[1] * xv[1]) + (xv[2] * xv[2] + xv[3] * xv[3]);
#pragma unroll
            for (int s = 0; s < 4; ++s) {
                acc0 = __builtin_amdgcn_mfma_f32_16x16x4f32(xv[s], w0[s], acc0, 0, 0, 0);
                acc1 = __builtin_amdgcn_mfma_f32_16x16x4f32(xv[s], w1[s], acc1, 0, 0, 0);
                acc2 = __builtin_amdgcn_mfma_f32_16x16x4f32(xv[s], w2[s], acc2, 0, 0, 0);
            }
        }
        ss += shx(ss, 16, lane); ss += shx(ss, 32, lane);
        if (kh == 1) { part[(rt * 3 + 0) * 64 + lane] = acc0; part[(rt * 3 + 1) * 64 + lane] = acc1; part[(rt * 3 + 2) * 64 + lane] = acc2; if (lane < 16) ssp[rt * 16 + lane] = ss; }
        __syncthreads();
        if (kh == 0) {
            acc0 += part[(rt * 3 + 0) * 64 + lane]; acc1 += part[(rt * 3 + 1) * 64 + lane]; acc2 += part[(rt * 3 + 2) * 64 + lane];
            ss += ssp[rt * 16 + (lane & 15)];
#pragma unroll
            for (int g = 0; g < 4; ++g) { const int rw = rt * 16 + 4 * (lane >> 4) + g; Lg[rw * 48 + (lane & 15)] = acc0[g]; Lg[rw * 48 + 16 + (lane & 15)] = acc1[g]; Lg[rw * 48 + 32 + (lane & 15)] = acc2[g]; }
            if (lane < 16) rsL[rt * 16 + lane] = 1.0f / sqrtf(ss * (1.0f / DM) + NORM_EPS);
        }
        __syncthreads();
        int e1 = 0, e2 = 0, r1 = 0, r2 = 0; float w1 = 0.f, w2 = 0.f, rsv = 0.f;
        if (tid < 64) {
            const LAS float* Lr = Lg + tid * 48; rsv = rsL[tid];
            float gl[4];
#pragma unroll
            for (int g = 0; g < 4; ++g) gl[g] = Lr[g] * rsv + brg[g];
            int gi = 0; float gm = gl[0];
#pragma unroll
            for (int g = 1; g < 4; ++g) if (gl[g] > gm) { gm = gl[g]; gi = g; }
            float den = 0.f;
#pragma unroll
            for (int g = 0; g < 4; ++g) den += expf(gl[g] - gm);
            const float gw = 1.0f / den;
            float v1 = -INFINITY, v2 = -INFINITY; int i1 = 0, i2 = 0;
#pragma unroll
            for (int e = 0; e < 8; ++e) {
                const float v = Lr[4 + 8 * gi + e] * rsv + bre[8 * gi + e];
                if (v > v1) { v2 = v1; i2 = i1; v1 = v; i1 = e; } else if (v > v2) { v2 = v; i2 = e; }
            }
            const float p1 = 1.0f / (1.0f + expf(v2 - v1));
            e1 = 8 * gi + i1; e2 = 8 * gi + i2; w1 = p1 * gw; w2 = (1.0f - p1) * gw;
            r1 = __hip_atomic_fetch_add(&lcnt[e1], 1, __ATOMIC_RELAXED, __HIP_MEMORY_SCOPE_WORKGROUP); r2 = __hip_atomic_fetch_add(&lcnt[e2], 1, __ATOMIC_RELAXED, __HIP_MEMORY_SCOPE_WORKGROUP);
        }
        __syncthreads();
        if (tid < 32) { const int c = lcnt[tid]; lbase[tid] = c ? atomicAdd(&cnt[tid * CNT_STRIDE], c) : 0; lcnt[tid] = 0; }
        __syncthreads();
        if (tid < 64) {
            const int tok = blk * 64 + tid;
            const int pos1 = lbase[e1] + r1, pos2 = lbase[e2] + r2;
            ltok[e1 * MTOK + pos1] = tok; lw[e1 * MTOK + pos1] = w1;
            ltok[e2 * MTOK + pos2] = tok; lw[e2 * MTOK + pos2] = w2;
            tokinfo[tok] = (i32x4){e1, pos1, e2, pos2};
            rs2[tok] = rsv;
        }
        __syncthreads();
    }
}
__device__ __forceinline__ MoeTab moe_tables(const Frame& F, CArgs a, int l) {
    const int lane = otid(), tid = F.wave * 64 + lane; (void)tid; (void)lane;
    volatile LAS int* cntL = F.misc + 64; volatile LAS int* mtp = F.misc + 128; volatile LAS int* sp = F.misc + 192;
    const int* cnt = (const int*)(a->ws + WS_CTL) + CW_CNT + l * 32 * CNT_STRIDE;
    __syncthreads();
    if (tid < 32) cntL[tid] = __hip_atomic_load(cnt + tid * CNT_STRIDE, __ATOMIC_RELAXED, __HIP_MEMORY_SCOPE_AGENT);
    __syncthreads();
    if (tid == 0) { int mt = 0, s = 0; for (int e = 0; e < 32; ++e) { mtp[e] = mt; sp[e] = s; const int c = cntL[e]; mt += (c + 255) >> 8; s += c; } mtp[32] = mt; sp[32] = s; }
    __syncthreads();
    MoeTab T; T.cnt = cntL; T.mtpref = mtp; T.spref = sp; return T;
}
__device__ __forceinline__ void fin_phase(const Frame& F, CArgs a, int l, const MoeTab& T) {
    const int lane = otid(), tid = F.wave * 64 + lane; (void)tid;
    unsigned char* ws = a->ws;
    const i32x4* tokinfo = (const i32x4*)(ws + WS_TOKINFO); const bf16* Y = (const bf16*)(ws + WS_Y);
    bf16* xb = (bf16*)(ws + WS_XB); float* rs1 = (float*)(ws + WS_RS1);
    const f32x4* gfin = (const f32x4*)a->fin_g + lane;
    const int step = 2 * F.ngw;
    int m0 = 2 * F.gw;
    i32x4 tn0 = tokinfo[m0 < MTOK ? m0 : 0], tn1 = tokinfo[m0 + 1 < MTOK ? m0 + 1 : 0];
    for (; m0 < MTOK; m0 += step) {
        const i32x4 ti[2] = {tn0, tn1};
        const int mn = m0 + step;
        if (mn < MTOK) { tn0 = tokinfo[mn]; tn1 = tokinfo[mn + 1]; }
        f32x4 v[2][4]; u32x2 p[2][4], q[2][4];
#pragma unroll
        for (int r = 0; r < 2; ++r) {
            const int m = m0 + r;
            const int s1 = T.spref[ti[r][0]] + ti[r][1], s2 = T.spref[ti[r][2]] + ti[r][3];
            const f32x4* xr = (const f32x4*)(a->out + (size_t)m * DM) + lane;
            const u32x2* y1 = (const u32x2*)(Y + (size_t)s1 * DM) + lane; const u32x2* y2 = (const u32x2*)(Y + (size_t)s2 * DM) + lane;
#pragma unroll
            for (int j = 0; j < 4; ++j) { v[r][j] = xr[64 * j]; p[r][j] = y1[64 * j]; q[r][j] = y2[64 * j]; }
        }
#pragma unroll
        for (int r = 0; r < 2; ++r) {
            const int m = m0 + r;
            float s = 0.f;
#pragma unroll
            for (int j = 0; j < 4; ++j) {
                v[r][j][0] += bflo(p[r][j].x) + bflo(q[r][j].x); v[r][j][1] += bfhi(p[r][j].x) + bfhi(q[r][j].x);
                v[r][j][2] += bflo(p[r][j].y) + bflo(q[r][j].y); v[r][j][3] += bfhi(p[r][j].y) + bfhi(q[r][j].y);
                s += (v[r][j][0] * v[r][j][0] + v[r][j][1] * v[r][j][1]) + (v[r][j][2] * v[r][j][2] + v[r][j][3] * v[r][j][3]);
            }
            s = wave_sum(s, lane);
            const float rsv = 1.0f / sqrtf(s * (1.0f / DM) + NORM_EPS);
            f32x4* xw = (f32x4*)(a->out + (size_t)m * DM) + lane;
            if (l == DEPTH - 1) {
#pragma unroll
                for (int j = 0; j < 4; ++j) xw[64 * j] = v[r][j] * rsv * gfin[64 * j];
            } else {
                u32x2* o = (u32x2*)(xb + (size_t)m * DM) + lane;
#pragma unroll
                for (int j = 0; j < 4; ++j) { xw[64 * j] = v[r][j]; u32x2 w; w.x = cvtpk(v[r][j][0], v[r][j][1]); w.y = cvtpk(v[r][j][2], v[r][j][3]); o[64 * j] = w; }
                if (lane == 0) rs1[m] = rsv;
            }
        }
    }
}

constexpr int PH_PREP = 0, PH_GEMM1 = 1, PH_ATTN = 2, PH_COMB = 3, PH_MERGE = 4, PH_OUT = 5, PH_ROUTE = 6, PH_UP = 7, PH_DOWN = 8, PH_FIN = 9, PH_PER_LAYER = 10, NPHASE = PH_PER_LAYER * DEPTH;

__global__ void __launch_bounds__(NTHREADS, 2) fwd_kernel(Args a_by_value) {
    extern __shared__ __attribute__((aligned(16))) unsigned char lds_raw[];
    Frame F;
    F.lds = (LAS unsigned char*)lds_raw; F.misc = (volatile LAS int*)(F.lds + MISC_OFF);
    F.wave = __builtin_amdgcn_readfirstlane((int)threadIdx.x >> 6);
    F.G = gridDim.x; { const int bx = blockIdx.x; F.vcu = (F.G % 8 == 0) ? (bx % 8) * (F.G / 8) + bx / 8 : bx; }
    F.gw = blockIdx.x * NWAVES + F.wave; F.ngw = F.G * NWAVES;
    CArgs a = (CArgs)__builtin_amdgcn_kernarg_segment_ptr();
    unsigned char* ws = a->ws;
    const int ph_lo = a->ph_lo, ph_hi = a->ph_hi;
    for (int u = threadIdx.x; u < 1024; u += NTHREADS) F.misc[u] = 0;
    __syncthreads();
#if !MK_MULTI
    XcdBarrier bar = xcd_barrier_post((unsigned*)(ws + WS_CTL) + CW_BAR, (volatile LAS unsigned*)(F.misc + 8));
#define GRID_BAR() xcd_barrier(bar, F.wave)
#else
#define GRID_BAR() do { } while (0)
#endif
    for (int ph = ph_lo; ph < ph_hi; ++ph) {
        const int l = ph / PH_PER_LAYER, k = ph % PH_PER_LAYER;
        {
            int bx = blockIdx.x; asm volatile("" : "+s"(bx)); asm volatile("" : "+s"(a)); ws = a->ws;
            int wv = F.wave; asm volatile("" : "+s"(wv)); F.gw = bx * NWAVES + wv;
        }
        if (k == PH_PREP && (PHMASK & 1)) {
            prep_phase(F, a, l);
        } else if (k == PH_GEMM1 && (PHMASK & 2)) {
            DenseSched S; S.A = (const char*)(ws + WS_XB); S.Bt = (const char*)(ws + WS_WIN); S.K = DM; S.lda = DM; S.wave = F.wave; S.so.init(MTOK, DIN, F.G, (int)blockIdx.x);
            EpiProj E{(bf16*)(ws + WS_PQ), (bf16*)(ws + WS_PG), (const float*)(ws + WS_RS1), (const f32x4*)(ws + WS_ROPE)};
            pg8::gemm_phase(F.lds, S, E);
        } else if (k == PH_ATTN && (PHMASK & 4)) {
            attn_phase(F, a, l);
        } else if (k == PH_COMB && (PHMASK & 8)) {
            comb_phase(F, a);
        } else if (k == PH_MERGE && (PHMASK & 16)) {
            { DenseSched S; S.A = (const char*)(ws + WS_YA); S.Bt = (const char*)(ws + WS_WA); S.K = 512; S.lda = 512; S.wave = F.wave; S.so.init(MTOK, DM, F.G, (int)blockIdx.x);
              EpiGate<false> E{(const bf16*)(ws + WS_PG), nullptr, (bf16*)(ws + WS_M1)};
              pg8::gemm_phase(F.lds, S, E); }
            { DenseSched S; S.A = (const char*)(ws + WS_YB); S.Bt = (const char*)(ws + WS_WB); S.K = 256; S.lda = 256; S.wave = F.wave; S.so.init(MTOK, DM, F.G, (int)blockIdx.x);
              EpiGate<true> E{(const bf16*)(ws + WS_PG) + DM, (const bf16*)(ws + WS_M1), (bf16*)(ws + WS_MRG)};
              pg8::gemm_phase(F.lds, S, E); }
        } else if (k == PH_OUT && (PHMASK & 32)) {
            DenseSched S; S.A = (const char*)(ws + WS_MRG); S.Bt = (const char*)(ws + WS_WOUT); S.K = DM; S.lda = DM; S.wave = F.wave; S.so.init(MTOK, DM, F.G, (int)blockIdx.x);
            EpiResid E{l == 0 ? a->x : a->out, a->out, (bf16*)(ws + WS_XB)};
            pg8::gemm_phase(F.lds, S, E);
        } else if (k == PH_ROUTE && (PHMASK & 64)) {
            route_phase(F, a, l);
        } else if (k == PH_UP && (PHMASK & 128)) {
            const MoeTab T = moe_tables(F, a, l);
            MoeSched<true> S; S.A = (const char*)(ws + WS_XB); S.Bt = (const char*)(ws + WS_WGU); S.K = DM; S.lda = DM; S.wave = F.wave; S.ntn = 2; S.bstride_e = (size_t)512 * DM * 2; S.ltok = (const int*)(ws + WS_LTOK); S.T = T; S.G = F.G; S.c = (int)blockIdx.x;
            EpiSwiglu E{(const int*)(ws + WS_LTOK), (const float*)(ws + WS_LW), (const float*)(ws + WS_RS2), (bf16*)(ws + WS_H)};
            pg8::gemm_phase(F.lds, S, E);
        } else if (k == PH_DOWN && (PHMASK & 256)) {
            const MoeTab T = moe_tables(F, a, l);
            MoeSched<false> S; S.A = (const char*)(ws + WS_H); S.Bt = (const char*)(ws + WS_WD); S.K = DEXP; S.lda = DEXP; S.wave = F.wave; S.ntn = 4; S.bstride_e = (size_t)DM * DEXP * 2; S.ltok = nullptr; S.T = T; S.G = F.G; S.c = (int)blockIdx.x;
            EpiY E{(bf16*)(ws + WS_Y)};
            pg8::gemm_phase(F.lds, S, E);
        } else if (k == PH_FIN && (PHMASK & 512)) {
            const MoeTab T = moe_tables(F, a, l);
            fin_phase(F, a, l, T);
        }
        if (ph + 1 < ph_hi) GRID_BAR();
    }
}

extern "C" void kernel_launch(void* const* d_in, const int* in_sizes, int n_in, void* d_out, int out_size, void* d_ws, size_t ws_size, hipStream_t stream) {
    static int grid = 0;
    if (grid == 0) {
        if (n_in != 16 || out_size != MTOK * DM || ws_size < WS_END) { fprintf(stderr, "kernel_launch: unexpected shapes (n_in %d out %d ws %zu)\n", n_in, out_size, ws_size); grid = -1; return; }
        int dev = 0, cus = 0, per_cu = 0;
        if (hipGetDevice(&dev) != hipSuccess || hipDeviceGetAttribute(&cus, hipDeviceAttributeMultiprocessorCount, dev) != hipSuccess) { grid = -1; return; }
        if (hipFuncSetAttribute((const void*)fwd_kernel, hipFuncAttributeMaxDynamicSharedMemorySize, LDS_BYTES) != hipSuccess) { fprintf(stderr, "kernel_launch: hipFuncSetAttribute failed\n"); grid = -1; return; }
        if (hipOccupancyMaxActiveBlocksPerMultiprocessor(&per_cu, (const void*)fwd_kernel, NTHREADS, LDS_BYTES) != hipSuccess || per_cu < 1) { fprintf(stderr, "kernel_launch: occupancy query says %d\n", per_cu); (void)hipGetLastError(); }
        grid = cus;
    }
    if (grid < 0) return;
    (void)hipMemsetAsync((char*)d_ws + WS_CTL, 0, CTL_BYTES, stream);
    Args a{};
    a.x = (const float*)d_in[0]; a.attn_g = (const float*)d_in[1]; a.w_in = (const float*)d_in[2]; a.a_sink = (const float*)d_in[3]; a.w_a = (const float*)d_in[4]; a.w_b = (const float*)d_in[5];
    a.w_out = (const float*)d_in[6]; a.ffn_g = (const float*)d_in[7]; a.w_rg = (const float*)d_in[8]; a.b_rg = (const float*)d_in[9]; a.w_re = (const float*)d_in[10]; a.b_re = (const float*)d_in[11];
    a.w_eg = (const float*)d_in[12]; a.w_eu = (const float*)d_in[13]; a.w_ed = (const float*)d_in[14]; a.fin_g = (const float*)d_in[15];
    a.out = (float*)d_out; a.ws = (unsigned char*)d_ws;
#if MK_MULTI
    for (int ph = 0; ph < NPHASE; ++ph) { a.ph_lo = ph; a.ph_hi = ph + 1; hipLaunchKernelGGL(fwd_kernel, dim3(grid), dim3(NTHREADS), LDS_BYTES, stream, a); }
#else
    a.ph_lo = 0; a.ph_hi = NPHASE;
    void* kargs[] = {&a};
    const hipError_t le = hipLaunchCooperativeKernel((const void*)fwd_kernel, dim3(grid), dim3(NTHREADS), kargs, LDS_BYTES, stream);
    if (le != hipSuccess) fprintf(stderr, "kernel_launch: cooperative launch failed: %s (grid %d)\n", hipGetErrorString(le), grid);
#endif
}
```

```cpp
#include <hip/hip_runtime.h>
#include <hip/hip_cooperative_groups.h>
#include <cstdio>
#include <cstdint>
namespace cg = cooperative_groups;

#ifndef REP_MASK
#define REP_MASK 0
#define REP_N 2
#endif
#ifndef PHMASK
#define PHMASK 1023
#endif
#ifndef MK_MULTI
#define MK_MULTI 0
#endif

#define LAS __attribute__((address_space(3)))
#define GAS __attribute__((address_space(1)))
typedef unsigned short bf16;
typedef short bf16x8 __attribute__((ext_vector_type(8)));
typedef short s16x4 __attribute__((ext_vector_type(4)));
typedef float f32x2 __attribute__((ext_vector_type(2)));
typedef float f32x4 __attribute__((ext_vector_type(4)));
typedef float f32x16 __attribute__((ext_vector_type(16)));
typedef unsigned u32x2 __attribute__((ext_vector_type(2)));
typedef unsigned u32x4 __attribute__((ext_vector_type(4)));
typedef int i32x4 __attribute__((ext_vector_type(4)));
typedef __bf16 bf16x2_t __attribute__((ext_vector_type(2)));

constexpr int BATCH = 4, SEQ = 4096, DM = 1024, DEPTH = 2, MTOK = BATCH * SEQ;
constexpr int NQKV = 3072, NGATE = 2048, DIN = NQKV + NGATE;
constexpr int NEXP = 32, DEXP = 256;
constexpr float NORM_EPS = 1e-6f;
constexpr float LOG2E = 1.4426950408889634f, LN2 = 0.6931471805599453f;
constexpr float QSCALE = 0.125f * LOG2E;
constexpr int NWAVES = 8, NTHREADS = 512;

constexpr size_t MiB = 1u << 20;
constexpr size_t WS_CTL = 0, CTL_BYTES = 1 * MiB;
constexpr size_t WS_ROPE = 1 * MiB;
constexpr size_t WS_WR = 2 * MiB, WR_LSTRIDE = 256 * 1024;
constexpr size_t WS_RS1 = 3 * MiB, WS_RS2 = 3 * MiB + 65536;
constexpr size_t WS_TOKINFO = 5 * MiB;
constexpr size_t WS_LTOK = 6 * MiB, WS_LW = 8 * MiB;
constexpr size_t WS_LSE = 10 * MiB;
constexpr size_t WS_WIN = 12 * MiB, WS_WA = 22 * MiB, WS_WB = 23 * MiB, WS_WOUT = 24 * MiB, WNE_LSTRIDE = 14 * MiB;
constexpr size_t WS_WGU = 40 * MiB, WS_WD = 72 * MiB;
constexpr size_t WS_XB = 88 * MiB;
constexpr size_t WS_YA = 120 * MiB, WS_YB = 136 * MiB;
constexpr size_t WS_PQ = 144 * MiB;
constexpr size_t WS_M1 = 144 * MiB, WS_MRG = 176 * MiB, WS_H = 208 * MiB;
constexpr size_t WS_PG = 240 * MiB;
constexpr size_t WS_Y = 240 * MiB;
constexpr size_t WS_END = 304 * MiB;
constexpr int CW_CNT = 64, CNT_STRIDE = 64;
constexpr int CW_BAR = 8192;

constexpr int RING_BYTES = 131072;
constexpr int PREP_SCR = 16896;
constexpr int MISC_OFF = 8 * PREP_SCR;
constexpr int LDS_BYTES = 147456;

#define LDS_WAIT() asm volatile("s_waitcnt lgkmcnt(0)" ::: "memory")
#define VM_WAIT() asm volatile("s_waitcnt vmcnt(0)" ::: "memory")
__device__ __forceinline__ unsigned cvtpk(float lo, float hi) { f32x2 v = {lo, hi}; bf16x2_t b = __builtin_convertvector(v, bf16x2_t); return __builtin_bit_cast(unsigned, b); }
__device__ __forceinline__ float bf2f(unsigned short h) { return __uint_as_float(((unsigned)h) << 16); }
__device__ __forceinline__ float bflo(unsigned w) { return __uint_as_float(w << 16); }
__device__ __forceinline__ float bfhi(unsigned w) { return __uint_as_float(w & 0xffff0000u); }
__device__ __forceinline__ float fast_exp2(float x) { return __builtin_amdgcn_exp2f(x); }
__device__ __forceinline__ float fast_rcp(float x) { return __builtin_amdgcn_rcpf(x); }
__device__ __forceinline__ float sigmoidf_fast(float v) { return fast_rcp(1.0f + fast_exp2(-v * LOG2E)); }

namespace pg8 {
constexpr int BM = 256, BK = 64, HALF = 128, HTB = HALF * BK * 2, STAGE_BYTES = 8 * HTB, NXCD = 8, WGM = 8;
__host__ __device__ __forceinline__ int lds_byte(int r, int c) { const int st = (r >> 4) * 2 + (c >> 5), rr = r & 15, cc = c & 31, ob = rr * 64 + cc * 2; return st * 1024 + (ob ^ (((ob >> 9) & 1) << 5)); }
__host__ __device__ __forceinline__ void stage_rc(int b, int& R, int& C) { const int st = b / 1024, sb = b % 1024, swz = sb ^ (((sb >> 9) & 1) << 5); R = (st >> 1) * 16 + swz / 64; C = (st & 1) * 32 + (swz % 64) / 2; }
__host__ __device__ __forceinline__ int perm32(int rho) { const int n = rho >> 4, i = rho & 15; return 8 * (i >> 2) + 4 * n + (i & 3); }

struct Unit { int pm, pn, e, nvalid, slot0, lpos0; };

struct StaticOrder {
    int nM, nN, nwg, G, c;
    __device__ void init(int M, int N, int G_, int c_) { nM = M / BM; nN = N / BM; nwg = nM * nN; G = G_; c = c_; }
    __device__ bool next(int i, int& pm, int& pn) const {
        const long L = (long)i * G + c; if (L >= nwg) return false;
        int wgid = (int)L; { const int q = nwg / NXCD, r = nwg % NXCD, xcd = wgid % NXCD, off = wgid / NXCD; wgid = (xcd < r ? xcd * (q + 1) : r * (q + 1) + (xcd - r) * q) + off; }
        const int nig = WGM * nN, gid = wgid / nig, fm = gid * WGM, gsz = (nM - fm) < WGM ? (nM - fm) : WGM;
        pm = fm + ((wgid % nig) % gsz); pn = (wgid % nig) / gsz; return true;
    }
};

template <class Epi, class Sched>
__device__ __forceinline__ void gemm_phase(LAS unsigned char* lds, const Sched& S, const Epi& E) {
    unsigned z_ = 0u; asm volatile("" : "+v"(z_)); const int tid_ = (int)__builtin_amdgcn_mbcnt_hi(~0u, __builtin_amdgcn_mbcnt_lo(~0u, z_)) + S.wave * 64;
    const int tid = tid_, wid = S.wave, lane = tid & 63, wr = wid >> 2, wc = wid & 3, fr = lane & 15, fq = lane >> 4;
    const int K = S.K, nt = K / BK;
    unsigned voffA[2], voffB[2];
#pragma unroll
    for (int i = 0; i < 2; ++i) { int R, C; stage_rc(tid * 16 + i * 8192, R, C); const int Rb = Epi::PERM ? ((R & ~31) + perm32(R & 31)) : R;
        voffA[i] = (unsigned)(R * S.lda + C) * 2u; voffB[i] = (unsigned)(Rb * K + C) * 2u; }
    const size_t kstep = (size_t)(BK * 2);
    const size_t hstepB = (size_t)HALF * K * 2, hstepA = (size_t)HALF * S.lda * 2;
    const unsigned ldsw = (unsigned)wid * 1024u;
    const int aoff = lds_byte(wr * 64 + fr, fq * 8), boff = lds_byte(wc * 32 + fr, fq * 8);
#define PG8_SA(b, h) (((b) * 2 + (h)) * HTB)
#define PG8_SB(b, h) ((4 + (b) * 2 + (h)) * HTB)
#define PG8_GLDS(src, dstoff) __builtin_amdgcn_global_load_lds((const unsigned*)(src), (LAS unsigned*)(lds + (dstoff)), 16, 0, 0)
#define PG8_STAGE_A(bufoff, up, h, VO) do { if constexpr (Sched::GATHER) { _Pragma("unroll") for (int _i = 0; _i < 2; ++_i) PG8_GLDS((up) + VO[_i], (bufoff) + ldsw + _i * 8192); } \
        else { const char* _b = (up) + (size_t)(h) * hstepA; _Pragma("unroll") for (int _i = 0; _i < 2; ++_i) PG8_GLDS(_b + voffA[_i], (bufoff) + ldsw + _i * 8192); } } while (0)
#define PG8_STAGE_B(bufoff, bp) do { _Pragma("unroll") for (int _i = 0; _i < 2; ++_i) PG8_GLDS((bp) + voffB[_i], (bufoff) + ldsw + _i * 8192); } while (0)
#define PG8_LDA(dst, b, h) do { _Pragma("unroll") for (int m = 0; m < 4; ++m) _Pragma("unroll") for (int k = 0; k < 2; ++k) dst[m][k] = *(const LAS bf16x8*)(lds + PG8_SA(b, h) + aoff + m * 2048 + k * 1024); } while (0)
#define PG8_LDB(dst, b, h) do { _Pragma("unroll") for (int n = 0; n < 2; ++n) _Pragma("unroll") for (int k = 0; k < 2; ++k) dst[n][k] = *(const LAS bf16x8*)(lds + PG8_SB(b, h) + boff + n * 2048 + k * 1024); } while (0)
#define PG8_MMA(ai, bj, At, Bt) do { __builtin_amdgcn_s_setprio(1); _Pragma("unroll") for (int m = 0; m < 4; ++m) _Pragma("unroll") for (int n = 0; n < 2; ++n) _Pragma("unroll") for (int k = 0; k < 2; ++k) \
        acc[ai][bj][m][n] = __builtin_amdgcn_mfma_f32_16x16x32_bf16(Bt[n][k], At[m][k], acc[ai][bj][m][n], 0, 0, 0); __builtin_amdgcn_s_setprio(0); } while (0)
#define PG8_WAIT_V(n) asm volatile("s_waitcnt vmcnt(" #n ")" ::: "memory")
#define PG8_WAIT_L(n) asm volatile("s_waitcnt lgkmcnt(" #n ")" ::: "memory")
#define PG8_BAR __builtin_amdgcn_s_barrier()
#define PG8_SCHED __builtin_amdgcn_sched_barrier(0)
    Unit cur, nxt; int ui = 0;
    if (!S.next(0, cur)) return;
    f32x4 acc[2][2][4][2];
#pragma unroll
    for (int a = 0; a < 2; ++a)
#pragma unroll
        for (int b = 0; b < 2; ++b)
#pragma unroll
            for (int m = 0; m < 4; ++m)
#pragma unroll
                for (int n = 0; n < 2; ++n) acc[a][b][m][n] = (f32x4){0.f, 0.f, 0.f, 0.f};
    bf16x8 At[4][2], B0[2][2], B1[2][2];
    const char* Ab = S.a_base();
    const char* cA = Ab; const char* cB = S.b_base(cur);
    unsigned vF0[2], vF1[2], vK[2];
    if constexpr (Sched::GATHER) {
#pragma unroll
        for (int i = 0; i < 2; ++i) { int R, C; stage_rc(tid * 16 + i * 8192, R, C); vF0[i] = S.a_off(cur, R) + (unsigned)(C * 2); vF1[i] = S.a_off(cur, HALF + R) + (unsigned)(C * 2); vK[i] = vF1[i]; }
    } else cA = Ab + S.a_unit_off(cur);
    PG8_STAGE_B(PG8_SB(0, 0), cB); PG8_STAGE_B(PG8_SB(0, 1), cB + hstepB); PG8_STAGE_A(PG8_SA(0, 0), cA, 0, vF0); PG8_STAGE_A(PG8_SA(0, 1), cA, 1, vF1);
    if (wr == 1) PG8_BAR;
    PG8_WAIT_V(2); PG8_BAR;
    PG8_STAGE_B(PG8_SB(1, 0), cB + kstep); PG8_STAGE_A(PG8_SA(1, 0), cA + kstep, 0, vF0); PG8_STAGE_B(PG8_SB(1, 1), cB + hstepB + kstep);
    PG8_WAIT_V(6); PG8_BAR;
    for (;;) {
        const bool has_next = S.next(ui + 1, nxt);
        const char* nA = cA; const char* nB = cB;
        if (has_next) { nB = S.b_base(nxt); if constexpr (!Sched::GATHER) nA = Ab + S.a_unit_off(nxt); }
#pragma unroll 1
        for (int t = 0; t < nt; t += 2) {
            const bool last = (t == nt - 2);
            const char* a1 = cA + (size_t)(t + 1) * kstep;
            const char* a2 = last ? nA : cA + (size_t)(t + 2) * kstep; const char* b2 = last ? nB : cB + (size_t)(t + 2) * kstep;
            const char* a3 = a2 + kstep; const char* b3 = b2 + kstep;
            if constexpr (Sched::GATHER) {
                if (last && has_next) {
#pragma unroll
                    for (int i = 0; i < 2; ++i) { int R, C; stage_rc(tid * 16 + i * 8192, R, C); vF0[i] = S.a_off(nxt, R) + (unsigned)(C * 2); vF1[i] = S.a_off(nxt, HALF + R) + (unsigned)(C * 2); }
                }
            }
            PG8_LDB(B0, 0, 0); PG8_LDB(B1, 0, 1); PG8_SCHED; PG8_LDA(At, 0, 0); PG8_STAGE_A(PG8_SA(1, 1), a1, 1, vK);
            PG8_WAIT_V(8); PG8_WAIT_L(0); PG8_BAR; PG8_MMA(0, 0, At, B0); PG8_MMA(0, 1, At, B1); PG8_BAR; PG8_SCHED;
            PG8_LDA(At, 0, 1); PG8_STAGE_B(PG8_SB(0, 0), b2); PG8_STAGE_B(PG8_SB(0, 1), b2 + hstepB); PG8_STAGE_A(PG8_SA(0, 0), a2, 0, vF0);
            PG8_WAIT_V(8); PG8_WAIT_L(0); PG8_BAR; PG8_MMA(1, 0, At, B0); PG8_MMA(1, 1, At, B1); PG8_BAR; PG8_SCHED;
            PG8_LDB(B0, 1, 0); PG8_LDB(B1, 1, 1); PG8_SCHED; PG8_LDA(At, 1, 0); PG8_STAGE_A(PG8_SA(0, 1), a2, 1, vF1);
            PG8_WAIT_V(8); PG8_WAIT_L(0); PG8_BAR; PG8_MMA(0, 0, At, B0); PG8_MMA(0, 1, At, B1); PG8_BAR; PG8_SCHED;
            PG8_LDA(At, 1, 1); PG8_STAGE_B(PG8_SB(1, 0), b3); PG8_STAGE_B(PG8_SB(1, 1), b3 + hstepB); PG8_STAGE_A(PG8_SA(1, 0), a3, 0, vF0);
            PG8_WAIT_V(8); PG8_WAIT_L(0); PG8_BAR; PG8_MMA(1, 0, At, B0); PG8_MMA(1, 1, At, B1); PG8_BAR; PG8_SCHED;
        }
        if (wr == 0) PG8_BAR;
        E(acc, cur, wr, wc, fr, fq);
        if (!has_next) break;
#pragma unroll
        for (int a = 0; a < 2; ++a)
#pragma unroll
            for (int b = 0; b < 2; ++b)
#pragma unroll
                for (int m = 0; m < 4; ++m)
#pragma unroll
                    for (int n = 0; n < 2; ++n) acc[a][b][m][n] = (f32x4){0.f, 0.f, 0.f, 0.f};
        cur = nxt; cA = nA; cB = nB; ++ui;
        if constexpr (Sched::GATHER) { vK[0] = vF1[0]; vK[1] = vF1[1]; }
        if (wr == 1) PG8_BAR;
    }
    PG8_WAIT_V(0);
    PG8_BAR;
#undef PG8_SA
#undef PG8_SB
#undef PG8_GLDS
#undef PG8_STAGE_A
#undef PG8_STAGE_B
#undef PG8_LDA
#undef PG8_LDB
#undef PG8_MMA
#undef PG8_WAIT_V
#undef PG8_WAIT_L
#undef PG8_BAR
#undef PG8_SCHED
}
}
using pg8::Unit;

struct DenseSched {
    static constexpr bool GATHER = false;
    const char* A; const char* Bt; int K; int lda; int wave; pg8::StaticOrder so;
    __device__ __forceinline__ bool next(int i, Unit& u) const { int pm, pn; if (!so.next(i, pm, pn)) return false; u.pm = pm; u.pn = pn; u.e = 0; u.nvalid = 256; u.slot0 = pm * 256; u.lpos0 = 0; return true; }
    __device__ __forceinline__ const char* a_base() const { return A; }
    __device__ __forceinline__ unsigned a_off(const Unit& u, int r) const { return 0u; }
    __device__ __forceinline__ size_t a_unit_off(const Unit& u) const { return (size_t)u.pm * 256 * lda * 2; }
    __device__ __forceinline__ const char* b_base(const Unit& u) const { return Bt + (size_t)u.pn * 256 * K * 2; }
};
struct MoeTab { const volatile LAS int* cnt; const volatile LAS int* mtpref; const volatile LAS int* spref; };
template <bool GATHER_> struct MoeSched {
    static constexpr bool GATHER = GATHER_;
    const char* A; const char* Bt; int K; int lda; int wave; int ntn; size_t bstride_e; const int* ltok; MoeTab T; int G, c;
    __device__ __forceinline__ bool next(int i, Unit& u) const {
        const int L = i * G + c; const int total = T.mtpref[32] * ntn; if (L >= total) return false;
        const int tix = L / ntn; u.pn = L - tix * ntn; u.pm = tix;
        int e = 0;
#pragma unroll 1
        for (int k = 1; k < 32; ++k) if (T.mtpref[k] <= tix) e = k;
        const int mt = tix - T.mtpref[e]; u.e = e; u.slot0 = T.spref[e] + 256 * mt; const int rem = T.cnt[e] - 256 * mt; u.nvalid = rem < 256 ? rem : 256; u.lpos0 = e * MTOK + 256 * mt; return true;
    }
    __device__ __forceinline__ const char* a_base() const { return A; }
    __device__ __forceinline__ unsigned a_off(const Unit& u, int r) const { const int rr = r < u.nvalid ? r : u.nvalid - 1; return (unsigned)ltok[u.lpos0 + rr] * (unsigned)(lda * 2); }
    __device__ __forceinline__ size_t a_unit_off(const Unit& u) const { return (size_t)u.slot0 * lda * 2; }
    __device__ __forceinline__ const char* b_base(const Unit& u) const { return Bt + (size_t)u.e * bstride_e + (size_t)u.pn * 256 * K * 2; }
};

#define OPAQUE(p) asm volatile("" : "+v"(p))
struct EpiProj {
    static constexpr bool PERM = true;
    bf16* Pq; bf16* Pg; const float* rs; const f32x4* rope;
    __device__ __forceinline__ void operator()(const f32x4 (&acc)[2][2][4][2], const Unit& u, int wr, int wc, int fr, int fq) const {
        const int colh = wc * 32 + fq * 8;
        const int ib = (colh & 63) >> 2;
        const int row0 = u.pm * 256 + wr * 64 + fr;
        int mode[2]; bf16* ob[2]; size_t ostep[2];
#pragma unroll
        for (int bj = 0; bj < 2; ++bj) {
            const int h128 = 2 * u.pn + bj;
            if (h128 >= 24) mode[bj] = 3;
            else if (h128 < 6) mode[bj] = h128 < 4 ? 1 : (h128 == 4 ? 2 : 0);
            else { const int j = (h128 - 6) % 6; mode[bj] = j < 2 ? 1 : (j < 4 ? 2 : 0); }
            const int opitch = (h128 < 24) ? NQKV : NGATE;
            ob[bj] = ((h128 < 24) ? Pq + h128 * 128 + colh : Pg + (h128 - 24) * 128 + colh) + (size_t)row0 * opitch;
            ostep[bj] = (size_t)opitch * 16;
        }
        const float* rsp = rs + row0;
        const f32x4* rp = rope + (size_t)(row0 & (SEQ - 1)) * 16 + ib;
#pragma unroll
        for (int ai = 0; ai < 2; ++ai)
#pragma unroll
            for (int m = 0; m < 4; ++m) {
                OPAQUE(rsp); OPAQUE(rp); OPAQUE(ob[0]); OPAQUE(ob[1]);
                const float s = *rsp;
                f32x4 c0 = {0.f, 0.f, 0.f, 0.f}, c1 = c0;
                if (mode[0] == 1 || mode[0] == 2 || mode[1] == 1 || mode[1] == 2) { c0 = rp[0]; c1 = rp[1]; }
#pragma unroll
                for (int bj = 0; bj < 2; ++bj) {
                    f32x4 v0 = acc[ai][bj][m][0] * s, v1 = acc[ai][bj][m][1] * s;
                    if (mode[bj] == 1 || mode[bj] == 2) {
                        f32x4 o0, o1;
                        o0[0] = v0[0] * c0[0] - v0[1] * c0[1]; o0[1] = v0[1] * c0[0] + v0[0] * c0[1];
                        o0[2] = v0[2] * c0[2] - v0[3] * c0[3]; o0[3] = v0[3] * c0[2] + v0[2] * c0[3];
                        o1[0] = v1[0] * c1[0] - v1[1] * c1[1]; o1[1] = v1[1] * c1[0] + v1[0] * c1[1];
                        o1[2] = v1[2] * c1[2] - v1[3] * c1[3]; o1[3] = v1[3] * c1[2] + v1[2] * c1[3];
                        const float qs = (mode[bj] == 1) ? QSCALE : 1.0f;
                        v0 = o0 * qs; v1 = o1 * qs;
                    } else if (mode[bj] == 3) {
#pragma unroll
                        for (int j = 0; j < 4; ++j) { v0[j] = sigmoidf_fast(v0[j]); v1[j] = sigmoidf_fast(v1[j]); }
                    }
                    u32x4 w; w.x = cvtpk(v0[0], v0[1]); w.y = cvtpk(v0[2], v0[3]); w.z = cvtpk(v1[0], v1[1]); w.w = cvtpk(v1[2], v1[3]);
                    *(u32x4*)(ob[bj]) = w;
                }
                const int adv = (m == 3) ? 5 : 1;
                rsp += 16 * adv; rp += (size_t)16 * 16 * adv; ob[0] += ostep[0] * adv; ob[1] += ostep[1] * adv;
            }
    }
};
template <bool ADD> struct EpiGate {
    static constexpr bool PERM = true;
    const bf16* gate; const bf16* prev; bf16* out;
    __device__ __forceinline__ void operator()(const f32x4 (&acc)[2][2][4][2], const Unit& u, int wr, int wc, int fr, int fq) const {
        const int row0 = u.pm * 256 + wr * 64 + fr, col0 = u.pn * 256 + wc * 32 + fq * 8;
        const bf16* gp = gate + (size_t)row0 * NGATE + col0; const bf16* pp = prev + (size_t)row0 * DM + col0; bf16* op = out + (size_t)row0 * DM + col0;
#pragma unroll
        for (int ai = 0; ai < 2; ++ai)
#pragma unroll
            for (int m = 0; m < 4; ++m) {
                OPAQUE(gp); OPAQUE(op); if (ADD) OPAQUE(pp);
#pragma unroll
                for (int bj = 0; bj < 2; ++bj) {
                    const u32x4 g = *(const u32x4*)(gp + bj * 128);
                    const f32x4 a0 = acc[ai][bj][m][0], a1 = acc[ai][bj][m][1];
                    float r[8];
                    r[0] = a0[0] * bflo(g.x); r[1] = a0[1] * bfhi(g.x); r[2] = a0[2] * bflo(g.y); r[3] = a0[3] * bfhi(g.y);
                    r[4] = a1[0] * bflo(g.z); r[5] = a1[1] * bfhi(g.z); r[6] = a1[2] * bflo(g.w); r[7] = a1[3] * bfhi(g.w);
                    if (ADD) { const u32x4 p = *(const u32x4*)(pp + bj * 128);
                        r[0] += bflo(p.x); r[1] += bfhi(p.x); r[2] += bflo(p.y); r[3] += bfhi(p.y); r[4] += bflo(p.z); r[5] += bfhi(p.z); r[6] += bflo(p.w); r[7] += bfhi(p.w); }
                    u32x4 w; w.x = cvtpk(r[0], r[1]); w.y = cvtpk(r[2], r[3]); w.z = cvtpk(r[4], r[5]); w.w = cvtpk(r[6], r[7]);
                    *(u32x4*)(op + bj * 128) = w;
                }
                const int adv = (m == 3) ? 5 : 1;
                gp += (size_t)16 * NGATE * adv; pp += (size_t)16 * DM * adv; op += (size_t)16 * DM * adv;
            }
    }
};
struct EpiResid {
    static constexpr bool PERM = true, REPEAT = false;
    bf16* xb;
    __device__ __forceinline__ void operator()(const f32x4 (&acc)[2][2][4][2], const Unit& u, int wr, int wc, int fr, int fq) const {
        const int row0 = u.pm * 256 + wr * 64 + fr, col0 = u.pn * 256 + wc * 32 + fq * 8;
        bf16* xp = xb + (size_t)row0 * DM + col0;
#pragma unroll
        for (int ai = 0; ai < 2; ++ai)
#pragma unroll
            for (int m = 0; m < 4; ++m) {
                OPAQUE(xp);
#pragma unroll
                for (int bj = 0; bj < 2; ++bj) {
                    const u32x4 p = *(const u32x4*)(xp + bj * 128);
                    const f32x4 a0 = acc[ai][bj][m][0], a1 = acc[ai][bj][m][1];
                    u32x4 w;
                    w.x = cvtpk(a0[0] + bflo(p.x), a0[1] + bfhi(p.x)); w.y = cvtpk(a0[2] + bflo(p.y), a0[3] + bfhi(p.y));
                    w.z = cvtpk(a1[0] + bflo(p.z), a1[1] + bfhi(p.z)); w.w = cvtpk(a1[2] + bflo(p.w), a1[3] + bfhi(p.w));
                    *(u32x4*)(xp + bj * 128) = w;
                }
                const int adv = (m == 3) ? 5 : 1;
                xp += (size_t)16 * DM * adv;
            }
    }
};
struct EpiSwiglu {
    static constexpr bool PERM = true;
    const int* ltok; const float* lw; const float* rs; bf16* H;
    __device__ __forceinline__ void operator()(const f32x4 (&acc)[2][2][4][2], const Unit& u, int wr, int wc, int fr, int fq) const {
#pragma unroll
        for (int ai = 0; ai < 2; ++ai)
#pragma unroll
            for (int m = 0; m < 4; ++m) {
                const int rr = ai * 128 + wr * 64 + m * 16 + fr;
                if (rr < u.nvalid) {
                    const int tok = ltok[u.lpos0 + rr]; const float w = lw[u.lpos0 + rr]; const float s = rs[tok];
#pragma unroll
                    for (int bj = 0; bj < 2; ++bj) {
                        const f32x4 a0 = acc[ai][bj][m][0] * s, a1 = acc[ai][bj][m][1] * s;
                        const float h0 = a0[0] * sigmoidf_fast(a0[0]) * a0[1] * w, h1 = a0[2] * sigmoidf_fast(a0[2]) * a0[3] * w;
                        const float h2 = a1[0] * sigmoidf_fast(a1[0]) * a1[1] * w, h3 = a1[2] * sigmoidf_fast(a1[2]) * a1[3] * w;
                        u32x2 o; o.x = cvtpk(h0, h1); o.y = cvtpk(h2, h3);
                        *(u32x2*)(H + (size_t)(u.slot0 + rr) * DEXP + u.pn * 128 + bj * 64 + wc * 16 + fq * 4) = o;
                    }
                }
            }
    }
};
struct EpiY {
    static constexpr bool PERM = true;
    bf16* Y;
    __device__ __forceinline__ void operator()(const f32x4 (&acc)[2][2][4][2], const Unit& u, int wr, int wc, int fr, int fq) const {
#pragma unroll
        for (int ai = 0; ai < 2; ++ai)
#pragma unroll
            for (int m = 0; m < 4; ++m) {
                const int rr = ai * 128 + wr * 64 + m * 16 + fr;
                if (rr < u.nvalid) {
#pragma unroll
                    for (int bj = 0; bj < 2; ++bj) {
                        const f32x4 a0 = acc[ai][bj][m][0], a1 = acc[ai][bj][m][1];
                        u32x4 w; w.x = cvtpk(a0[0], a0[1]); w.y = cvtpk(a0[2], a0[3]); w.z = cvtpk(a1[0], a1[1]); w.w = cvtpk(a1[2], a1[3]);
                        *(u32x4*)(Y + (size_t)(u.slot0 + rr) * DM + u.pn * 256 + bj * 128 + wc * 32 + fq * 8) = w;
                    }
                }
            }
    }
};

#define XB_TMO      128
#define XB_XCNT(j)  (256  + 64 * (j))
#define XB_XSUB(j)  (1280 + 64 * (j))
#define XB_XGEN(j)  (2304 + 64 * (j))
#define XB_TOP      3328
#define XB_TOPGEN   3392
#define XCD_BAR_WORDS 3456
#define XB_SPIN_CAP (1u << 18)
__device__ __forceinline__ unsigned xb_ld(unsigned* p)              { return __hip_atomic_load(p, __ATOMIC_RELAXED, __HIP_MEMORY_SCOPE_AGENT); }
__device__ __forceinline__ unsigned xb_add(unsigned* p, unsigned v) { return __hip_atomic_fetch_add(p, v, __ATOMIC_RELAXED, __HIP_MEMORY_SCOPE_AGENT); }
__device__ __forceinline__ unsigned xb_xcc_id() { return (unsigned)__builtin_amdgcn_s_getreg((3 << 11) | 20) & 0xFu; }
#define XB_SPIN(cond, bar) do { unsigned _sp = 0; while (cond) { __builtin_amdgcn_s_sleep(1); \
    if ((++_sp & 255u) == 0u) { if (xb_ld(&(bar)[XB_TMO])) break; if (_sp > XB_SPIN_CAP) { atomicAdd(&(bar)[XB_TMO], 1u); break; } } } } while (0)
struct XcdBarrier { unsigned* bar; unsigned x; volatile LAS unsigned* st; };
__device__ __forceinline__ XcdBarrier xcd_barrier_post(unsigned* bar, volatile LAS unsigned* st) {
    XcdBarrier b; b.bar = bar; b.x = xb_xcc_id(); b.st = st;
    if (threadIdx.x == 0) (void)xb_add(&bar[XB_XCNT(b.x)], 1u);
    return b;
}
__device__ __forceinline__ void xcd_barrier_complete(unsigned* bar, unsigned x, unsigned& nloc, unsigned& nx) {
    const unsigned G = gridDim.x * gridDim.y * gridDim.z;
    unsigned sum, cnt, mine, sp = 0u;
    for (;;) {
        sum = 0u; cnt = 0u; mine = 0u;
#pragma unroll
        for (unsigned j = 0; j < 16; ++j) { const unsigned c = xb_ld(&bar[XB_XCNT(j)]); sum += c; cnt += (c > 0u) ? 1u : 0u; mine = (j == x) ? c : mine; }
        if (sum == G) break;
        __builtin_amdgcn_s_sleep(1);
        if ((++sp & 255u) == 0u) { if (xb_ld(&bar[XB_TMO])) break; if (sp > XB_SPIN_CAP) { atomicAdd(&bar[XB_TMO], 1u); break; } }
    }
    nloc = mine > 0u ? mine : 1u; nx = cnt > 0u ? cnt : 1u;
}
__device__ __forceinline__ void xcd_barrier(const XcdBarrier& b, int wave) {
    asm volatile("s_waitcnt vmcnt(0)" ::: "memory");
    __syncthreads();
    unsigned zb_ = 0u; asm volatile("" : "+v"(zb_));
    if (wave == 0 && __builtin_amdgcn_mbcnt_hi(~0u, __builtin_amdgcn_mbcnt_lo(~0u, zb_)) == 0u) {
        unsigned* bar = b.bar;
        __builtin_amdgcn_s_waitcnt(0);
        unsigned nloc = b.st[0], nx = b.st[1];
        if (nloc == 0u) { xcd_barrier_complete(bar, b.x, nloc, nx); b.st[0] = nloc; b.st[1] = nx; }
        const unsigned old = xb_add(&bar[XB_XSUB(b.x)], 1u);
        const unsigned gen = old / nloc;
        if (old + 1u == (gen + 1u) * nloc) {
            __builtin_amdgcn_fence(__ATOMIC_RELEASE, "agent");
            asm volatile("s_waitcnt vmcnt(0)" ::: "memory");
            const unsigned og = xb_add(&bar[XB_TOP], 1u);
            const unsigned tg = og / nx;
            if (og + 1u == (tg + 1u) * nx) xb_add(&bar[XB_TOPGEN], 1u);
            else XB_SPIN(xb_ld(&bar[XB_TOPGEN]) == tg, bar);
            __builtin_amdgcn_fence(__ATOMIC_ACQUIRE, "agent");
            xb_add(&bar[XB_XGEN(b.x)], 1u);
            asm volatile("s_waitcnt vmcnt(0)" ::: "memory");
        } else {
            XB_SPIN(xb_ld(&bar[XB_XGEN(b.x)]) == gen, bar);
            __builtin_amdgcn_fence(__ATOMIC_ACQUIRE, "agent");
            asm volatile("s_waitcnt vmcnt(0)" ::: "memory");
        }
    }
    __syncthreads();
}

struct Args {
    const float* x; const float* attn_g; const float* w_in; const float* a_sink; const float* w_a; const float* w_b; const float* w_out; const float* ffn_g;
    const float* w_rg; const float* b_rg; const float* w_re; const float* b_re; const float* w_eg; const float* w_eu; const float* w_ed; const float* fin_g;
    float* out; unsigned char* ws; int ph_lo, ph_hi;
};
typedef const __attribute__((address_space(4))) Args* CArgs;
struct Frame {
    LAS unsigned char* lds; volatile LAS int* misc;
    int wave, G, vcu, gw, ngw;
};
__device__ __forceinline__ int otid() { unsigned z = 0u; asm volatile("" : "+v"(z)); return (int)__builtin_amdgcn_mbcnt_hi(~0u, __builtin_amdgcn_mbcnt_lo(~0u, z)); }
__device__ __forceinline__ float shx(float v, int o, int lane) { return __int_as_float(__builtin_amdgcn_ds_bpermute((lane ^ o) << 2, __float_as_int(v))); }
__device__ __forceinline__ float wave_sum(float v, int lane) {
#pragma unroll
    for (int o = 1; o < 64; o <<= 1) v += shx(v, o, lane);
    return v;
}

struct MapPlain { __device__ __forceinline__ int operator()(int n) const { return n; } };
struct MapWin { __device__ __forceinline__ int operator()(int n) const {
        bool rope = false;
        if (n < 640) rope = true; else if (n >= 768 && n < NQKV) rope = ((n - 768) % 768) < 512;
        if (!rope) return n; const int d = n & 63; return (n & ~63) + 2 * (d & 31) + (d >> 5); } };
struct MapGU { int t; __device__ __forceinline__ int operator()(int n) const { return 2 * n + t; } };
template <class Map> __device__ __forceinline__ void transpose_item64(const float* W, int ldn, int k0, int n0, const float* gk, bf16* WT, int Kd, const Map& map, LAS float* scr, int lane) {
    const int kq = lane >> 4, n4 = (lane & 15) * 4;
    const float* src = W + (size_t)(k0 + kq) * ldn + n0 + n4;
    f32x4 v[16];
#pragma unroll
    for (int i = 0; i < 16; ++i) v[i] = *(const f32x4*)(src + (size_t)(4 * i) * ldn);
    if (gk) {
#pragma unroll
        for (int i = 0; i < 16; ++i) v[i] = v[i] * gk[k0 + 4 * i + kq];
    }
#pragma unroll
    for (int i = 0; i < 16; ++i) { LAS float* d = scr + (4 * i + kq) * 65 + n4; d[0] = v[i][0]; d[1] = v[i][1]; d[2] = v[i][2]; d[3] = v[i][3]; }
    LDS_WAIT(); asm volatile("" ::: "memory");
    const int c = lane & 7;
#pragma unroll
    for (int j = 0; j < 8; ++j) { const int n = (lane >> 3) + 8 * j; const LAS float* p = scr + (8 * c) * 65 + n;
        u32x4 o; o.x = cvtpk(p[0 * 65], p[1 * 65]); o.y = cvtpk(p[2 * 65], p[3 * 65]); o.z = cvtpk(p[4 * 65], p[5 * 65]); o.w = cvtpk(p[6 * 65], p[7 * 65]);
        *(u32x4*)(WT + (size_t)map(n0 + n) * Kd + k0 + 8 * c) = o; }
    LDS_WAIT(); asm volatile("" ::: "memory");
}
__device__ __forceinline__ void prep_phase(const Frame& F, CArgs a) {
    const int lane = otid(), tid = F.wave * 64 + lane; (void)tid; (void)lane;
    unsigned char* ws = a->ws;
    LAS float* scr = (LAS float*)(F.lds + F.wave * PREP_SCR);
    constexpr int I_IN = 16 * 80, I_A = 8 * 16, I_B = 4 * 16, I_O = 16 * 16, I_L = I_IN + I_A + I_B + I_O;
    for (int it = F.gw; it < DEPTH * I_L; it += F.ngw) {
        const int l = it / I_L; int r = it - l * I_L;
        unsigned char* wl = ws + (size_t)l * WNE_LSTRIDE;
        if (r < I_IN) { transpose_item64(a->w_in + (size_t)l * DM * DIN, DIN, 64 * (r / 80), 64 * (r % 80), a->attn_g + l * DM, (bf16*)(wl + WS_WIN), DM, MapWin{}, scr, lane); continue; } r -= I_IN;
        if (r < I_A) { transpose_item64(a->w_a + (size_t)l * 512 * DM, DM, 64 * (r / 16), 64 * (r % 16), nullptr, (bf16*)(wl + WS_WA), 512, MapPlain{}, scr, lane); continue; } r -= I_A;
        if (r < I_B) { transpose_item64(a->w_b + (size_t)l * 256 * DM, DM, 64 * (r / 16), 64 * (r % 16), nullptr, (bf16*)(wl + WS_WB), 256, MapPlain{}, scr, lane); continue; } r -= I_B;
        transpose_item64(a->w_out + (size_t)l * DM * DM, DM, 64 * (r / 16), 64 * (r % 16), nullptr, (bf16*)(wl + WS_WOUT), DM, MapPlain{}, scr, lane);
    }
    for (int idx = blockIdx.x * NTHREADS + tid; idx < DEPTH * 32 * 3 * 64 * 8; idx += F.G * NTHREADS) {
        const int l = idx / (32 * 3 * 64 * 8), id = idx - l * (32 * 3 * 64 * 8);
        const int j = id & 7, ln = (id >> 3) & 63, q = id >> 9, nt = q % 3, i = q / 3;
        const int k = 32 * i + 8 * (ln >> 4) + j, n = 16 * nt + (ln & 15);
        const float* wg = a->w_rg + (size_t)l * DM * 4; const float* we = a->w_re + (size_t)l * DM * NEXP;
        float v = 0.f; if (n < 4) v = wg[k * 4 + n]; else if (n < 36) v = we[k * NEXP + (n - 4)];
        ((float*)(ws + WS_WR + l * WR_LSTRIDE))[id] = v * a->ffn_g[l * DM + k];
    }
    {
        float* rt = (float*)(ws + WS_ROPE);
        for (int idx = blockIdx.x * NTHREADS + tid; idx < SEQ * 32; idx += F.G * NTHREADS) {
            const int pos = idx >> 5, i = idx & 31;
            const float inv = 1.0f / powf(10000.0f, (float)(2 * i) / 64.0f);
            const float ang = (float)pos * inv;
            const double ad = (double)ang, kd = __builtin_rint(ad * 0.15915494309189535);
            const float rf = (float)__builtin_fma(-kd, 6.283185307179586, ad);
            rt[idx * 2] = cosf(rf); rt[idx * 2 + 1] = sinf(rf);
        }
        bf16* xb = (bf16*)(ws + WS_XB); float* rs1 = (float*)(ws + WS_RS1);
        for (int m = F.gw; m < MTOK; m += F.ngw) {
            const f32x4* xr = (const f32x4*)(a->x + (size_t)m * DM) + lane;
            f32x4 v[4]; float s = 0.f;
#pragma unroll
            for (int j = 0; j < 4; ++j) { v[j] = xr[64 * j]; s += (v[j][0] * v[j][0] + v[j][1] * v[j][1]) + (v[j][2] * v[j][2] + v[j][3] * v[j][3]); }
            s = wave_sum(s, lane);
            u32x2* o = (u32x2*)(xb + (size_t)m * DM) + lane;
#pragma unroll
            for (int j = 0; j < 4; ++j) { u32x2 w; w.x = cvtpk(v[j][0], v[j][1]); w.y = cvtpk(v[j][2], v[j][3]); o[64 * j] = w; }
            if (lane == 0) rs1[m] = 1.0f / sqrtf(s * (1.0f / DM) + NORM_EPS);
        }
    }
}
__device__ __forceinline__ void prep_experts(const Frame& F, CArgs a, int l, int lane) {
    unsigned char* ws = a->ws;
    LAS float* scr = (LAS float*)(F.lds + F.wave * PREP_SCR);
    constexpr int I_G = 16 * 4, I_D = 4 * 16, I_E = 2 * I_G + I_D;
    const float* fg = a->ffn_g + l * DM;
    for (int it = F.gw; it < NEXP * I_E; it += F.ngw) {
        const int e = it / I_E; int r = it - e * I_E;
        const size_t eo = ((size_t)l * NEXP + e) * DM * DEXP;
        if (r < 2 * I_G) { const int t = r / I_G; r -= t * I_G; const float* W = (t ? a->w_eu : a->w_eg) + eo;
            transpose_item64(W, DEXP, 64 * (r / 4), 64 * (r % 4), fg, (bf16*)(ws + WS_WGU) + (size_t)e * 512 * DM, DM, MapGU{t}, scr, lane); continue; } r -= 2 * I_G;
        transpose_item64(a->w_ed + eo, DM, 64 * (r / 16), 64 * (r % 16), nullptr, (bf16*)(ws + WS_WD) + (size_t)e * DM * DEXP, DEXP, MapPlain{}, scr, lane);
    }
}

__device__ __forceinline__ int crow(int r, int hi) { return (r & 3) + 8 * (r >> 2) + 4 * hi; }
__device__ __forceinline__ void attn_task(const bf16* P, int qcol, int kcol, int vcol, int b, int d, int r, int t, int W, float m0, float l0,
                                          bf16* outp, int opitch, float* lsep, LAS unsigned char* vl, int lane) {
    const int r32 = lane & 31, hi = lane >> 5;
    const int L32 = (SEQ / d) >> 5;
    const size_t tok0 = (size_t)b * SEQ + r;
    const size_t qtok = tok0 + (size_t)(32 * t + r32) * d;
    bf16x8 qf[4];
#pragma unroll
    for (int s = 0; s < 4; ++s) qf[s] = *(const bf16x8*)(P + qtok * NQKV + qcol + 16 * s + 8 * hi);
    f32x16 o0 = {}, o1 = {};
    float mrun = m0, lrun = l0;
    const int jlo = (t - W) < 0 ? 0 : (t - W), jhi = (t + W) > (L32 - 1) ? (L32 - 1) : (t + W);
    const LAS unsigned char* vrd = vl + (4 * hi + ((lane & 15) >> 2)) * 128 + (16 * ((lane >> 4) & 1) + 4 * (lane & 3)) * 2;
    const bf16* kvbase = P + (tok0 + (size_t)(lane >> 3) * d) * NQKV + (lane & 7) * 8;
    const size_t tstride = (size_t)32 * d * NQKV, vstride = (size_t)8 * d * NQKV;
    LAS unsigned char* kl = vl + 4096;
    const int kwr = (lane >> 3) * 128 + (((lane & 7) ^ ((lane >> 3) & 7)) * 16);
    const int krd = r32 * 128;
    u32x4 kn[4], vn[4];
#pragma unroll
    for (int i = 0; i < 4; ++i) { kn[i] = *(const u32x4*)(kvbase + jlo * tstride + i * vstride + kcol); vn[i] = *(const u32x4*)(kvbase + jlo * tstride + i * vstride + vcol); }
    for (int j = jlo; j <= jhi; ++j) {
#pragma unroll
        for (int i = 0; i < 4; ++i) { *(LAS u32x4*)(kl + kwr + i * 1024) = kn[i]; *(LAS u32x4*)(vl + (lane >> 3) * 128 + (lane & 7) * 16 + i * 1024) = vn[i]; }
        if (j < jhi) {
#pragma unroll
            for (int i = 0; i < 4; ++i) { kn[i] = *(const u32x4*)(kvbase + (j + 1) * tstride + i * vstride + kcol); vn[i] = *(const u32x4*)(kvbase + (j + 1) * tstride + i * vstride + vcol); }
        }
        bf16x8 kf[4];
#pragma unroll
        for (int s = 0; s < 4; ++s) kf[s] = *(const LAS bf16x8*)(kl + krd + (((2 * s + hi) ^ (r32 & 7)) * 16));
        f32x16 sc = {};
#pragma unroll
        for (int s = 0; s < 4; ++s) sc = __builtin_amdgcn_mfma_f32_32x32x16_bf16(kf[s], qf[s], sc, 0, 0, 0);
        if (j == t - W) {
#pragma unroll
            for (int g = 0; g < 16; ++g) if (crow(g, hi) < r32) sc[g] = -INFINITY;
        }
        if (j == t + W) {
#pragma unroll
            for (int g = 0; g < 16; ++g) if (crow(g, hi) > r32) sc[g] = -INFINITY;
        }
        float mx = sc[0];
#pragma unroll
        for (int g = 1; g < 16; ++g) mx = fmaxf(mx, sc[g]);
        mx = fmaxf(mx, shx(mx, 32, lane));
        const float mnew = fmaxf(mrun, mx);
        const float alpha = fast_exp2(mrun - mnew);
        float psum = 0.f;
#pragma unroll
        for (int g = 0; g < 16; ++g) { sc[g] = fast_exp2(sc[g] - mnew); psum += sc[g]; }
        psum += shx(psum, 32, lane);
        lrun = lrun * alpha + psum; mrun = mnew;
#pragma unroll
        for (int g = 0; g < 16; ++g) { o0[g] *= alpha; o1[g] *= alpha; }
        u32x4 p0, p1;
        p0.x = cvtpk(sc[0], sc[1]); p0.y = cvtpk(sc[2], sc[3]); p0.z = cvtpk(sc[4], sc[5]); p0.w = cvtpk(sc[6], sc[7]);
        p1.x = cvtpk(sc[8], sc[9]); p1.y = cvtpk(sc[10], sc[11]); p1.z = cvtpk(sc[12], sc[13]); p1.w = cvtpk(sc[14], sc[15]);
        const bf16x8 pf0 = __builtin_bit_cast(bf16x8, p0), pf1 = __builtin_bit_cast(bf16x8, p1);
#define VTR(off) __builtin_bit_cast(s16x4, __builtin_amdgcn_ds_read_tr16_b64_v4i16((LAS s16x4*)(vrd + (off))))
#define VFRAG(s, dh) ({ const s16x4 _a = VTR((16 * (s)) * 128 + (dh) * 64), _b = VTR((16 * (s) + 8) * 128 + (dh) * 64); (bf16x8){_a[0], _a[1], _a[2], _a[3], _b[0], _b[1], _b[2], _b[3]}; })
        const bf16x8 v00 = VFRAG(0, 0), v10 = VFRAG(1, 0), v01 = VFRAG(0, 1), v11 = VFRAG(1, 1);
        o0 = __builtin_amdgcn_mfma_f32_32x32x16_bf16(v00, pf0, o0, 0, 0, 0);
        o0 = __builtin_amdgcn_mfma_f32_32x32x16_bf16(v10, pf1, o0, 0, 0, 0);
        o1 = __builtin_amdgcn_mfma_f32_32x32x16_bf16(v01, pf0, o1, 0, 0, 0);
        o1 = __builtin_amdgcn_mfma_f32_32x32x16_bf16(v11, pf1, o1, 0, 0, 0);
#undef VTR
#undef VFRAG
    }
    const float inv = 1.0f / lrun;
    bf16* orow = outp + qtok * opitch;
#pragma unroll
    for (int g4 = 0; g4 < 4; ++g4) {
        u32x2 w0, w1;
        w0.x = cvtpk(o0[4 * g4] * inv, o0[4 * g4 + 1] * inv); w0.y = cvtpk(o0[4 * g4 + 2] * inv, o0[4 * g4 + 3] * inv);
        w1.x = cvtpk(o1[4 * g4] * inv, o1[4 * g4 + 1] * inv); w1.y = cvtpk(o1[4 * g4 + 2] * inv, o1[4 * g4 + 3] * inv);
        *(u32x2*)(orow + 8 * g4 + 4 * hi) = w0;
        *(u32x2*)(orow + 32 + 8 * g4 + 4 * hi) = w1;
    }
    if (lsep && hi == 0) lsep[qtok * 12] = (mrun + log2f(lrun)) * LN2;
}
__device__ __forceinline__ void attn_phase(const Frame& F, CArgs a, int l) {
    const int lane = otid(), tid = F.wave * 64 + lane; (void)tid; (void)lane;
    unsigned char* ws = a->ws;
    const bf16* P = (const bf16*)(ws + WS_PQ);
    bf16* ya = (bf16*)(ws + WS_YA); bf16* ob = (bf16*)a->out; float* lse = (float*)(ws + WS_LSE);
    LAS unsigned char* vl = F.lds + F.wave * PREP_SCR;
    constexpr int NA = BATCH * 2 * 128 * 4, NB1 = BATCH * 4 * 128;
    constexpr int NTASK = NA + 3 * NB1;
    for (int it = F.gw; it < NTASK; it += F.ngw) {
        if (it < NA) {
            const int g = it & 3, qt = (it >> 2) & 127, kvh = (it >> 9) & 1, b = it >> 10;
            const int hq = kvh * 4 + g;
            const float sk = a->a_sink[l * 8 + hq] * LOG2E;
            attn_task(P, hq * 64, 512 + kvh * 64, 640 + kvh * 64, b, 1, 0, qt, 4, sk, 1.0f, ya + hq * 64, 512, nullptr, vl, lane);
        } else {
            int r = it - NA; const int grp = r / NB1; r -= grp * NB1;
            const int d = grp == 0 ? 1 : (grp == 1 ? 4 : 16);
            const int tpr = 128 / d;
            const int tl = r % tpr; int q = r / tpr; const int res = q % d; q /= d; const int h = q & 3, b = q >> 2;
            const int base = 768 + 768 * grp;
            attn_task(P, base + h * 64, base + 256 + h * 64, base + 512 + h * 64, b, d, res, tl, 2, -1e30f, 0.0f, ob + grp * 256 + h * 64, 768, lse + grp * 4 + h, vl, lane);
        }
    }
    LDS_WAIT();
    prep_experts(F, a, l, lane);
}
__device__ __forceinline__ void comb_phase(const Frame& F, CArgs a) {
    const int lane = otid(), tid = F.wave * 64 + lane; (void)tid; (void)lane;
    unsigned char* ws = a->ws;
    const bf16* ob = (const bf16*)a->out; const float* lse = (const float*)(ws + WS_LSE); bf16* yb = (bf16*)(ws + WS_YB);
    for (int idx = blockIdx.x * NTHREADS + tid; idx < MTOK * 32; idx += F.G * NTHREADS) {
        const int tok = idx >> 5, c = idx & 31, h = c >> 3;
        const float l0 = lse[tok * 12 + h], l1 = lse[tok * 12 + 4 + h], l2 = lse[tok * 12 + 8 + h];
        const float mx = fmaxf(l0, fmaxf(l1, l2));
        float w0 = __expf(l0 - mx), w1 = __expf(l1 - mx), w2 = __expf(l2 - mx);
        const float inv = 1.0f / (w0 + w1 + w2); w0 *= inv; w1 *= inv; w2 *= inv;
        const u32x4 a0 = *(const u32x4*)(ob + (size_t)tok * 768 + c * 8), a1 = *(const u32x4*)(ob + (size_t)tok * 768 + 256 + c * 8), a2 = *(const u32x4*)(ob + (size_t)tok * 768 + 512 + c * 8);
        u32x4 o;
#define CMB(f) o.f = cvtpk(w0 * bflo(a0.f) + w1 * bflo(a1.f) + w2 * bflo(a2.f), w0 * bfhi(a0.f) + w1 * bfhi(a1.f) + w2 * bfhi(a2.f))
        CMB(x); CMB(y); CMB(z); CMB(w);
#undef CMB
        *(u32x4*)(yb + (size_t)tok * 256 + c * 8) = o;
    }
}

__device__ __forceinline__ void route_phase(const Frame& F, CArgs a, int l) {
    const int lane = otid(), tid = F.wave * 64 + lane;
    unsigned char* ws = a->ws;
    const bf16* xbf = (const bf16*)(ws + WS_XB); const f32x4* wrp = (const f32x4*)(ws + WS_WR + l * WR_LSTRIDE);
    float* rs2 = (float*)(ws + WS_RS2); i32x4* tokinfo = (i32x4*)(ws + WS_TOKINFO); int* ltok = (int*)(ws + WS_LTOK); float* lw = (float*)(ws + WS_LW);
    int* cnt = (int*)(ws + WS_CTL) + CW_CNT + l * 32 * CNT_STRIDE;
    const float* brg = a->b_rg + l * 4; const float* bre = a->b_re + l * NEXP;
    LAS f32x4* part = (LAS f32x4*)(F.lds);
    LAS float* ssp = (LAS float*)(F.lds + 12288);
    LAS float* Lg = (LAS float*)(F.lds + 16384);
    LAS float* rsL = (LAS float*)(F.lds + 16384 + 12288);
    LAS int* lcnt = (LAS int*)(F.lds + 16384 + 12288 + 256);
    LAS int* lbase = lcnt + 32;
    const int rt = F.wave & 3, kh = F.wave >> 2;
    if (tid < 32) lcnt[tid] = 0;
    __syncthreads();
    for (int blk = blockIdx.x; blk < MTOK / 64; blk += F.G) {
        const int row0 = blk * 64 + rt * 16;
        const u32x4* xr = (const u32x4*)(xbf + (size_t)(row0 + (lane & 15)) * DM + kh * 512) + (lane >> 4);
        const f32x4* wp = wrp + (size_t)(kh * 16) * 3 * 128 + lane * 2;
        f32x4 acc0 = {0.f, 0.f, 0.f, 0.f}, acc1 = acc0, acc2 = acc0; float ss = 0.f;
#pragma unroll 4
        for (int i = 0; i < 16; ++i) {
            const u32x4 xw = xr[4 * i];
            const f32x4 w0a = wp[(i * 3 + 0) * 128], w0b = wp[(i * 3 + 0) * 128 + 1], w1a = wp[(i * 3 + 1) * 128], w1b = wp[(i * 3 + 1) * 128 + 1], w2a = wp[(i * 3 + 2) * 128], w2b = wp[(i * 3 + 2) * 128 + 1];
            const float xv[8] = {bflo(xw.x), bfhi(xw.x), bflo(xw.y), bfhi(xw.y), bflo(xw.z), bfhi(xw.z), bflo(xw.w), bfhi(xw.w)};
#pragma unroll
            for (int j = 0; j < 8; ++j) ss += xv[j] * xv[j];
#pragma unroll
            for (int s = 0; s < 4; ++s) {
                acc0 = __builtin_amdgcn_mfma_f32_16x16x4f32(xv[s], w0a[s], acc0, 0, 0, 0);
                acc1 = __builtin_amdgcn_mfma_f32_16x16x4f32(xv[s], w1a[s], acc1, 0, 0, 0);
                acc2 = __builtin_amdgcn_mfma_f32_16x16x4f32(xv[s], w2a[s], acc2, 0, 0, 0);
            }
#pragma unroll
            for (int s = 0; s < 4; ++s) {
                acc0 = __builtin_amdgcn_mfma_f32_16x16x4f32(xv[4 + s], w0b[s], acc0, 0, 0, 0);
                acc1 = __builtin_amdgcn_mfma_f32_16x16x4f32(xv[4 + s], w1b[s], acc1, 0, 0, 0);
                acc2 = __builtin_amdgcn_mfma_f32_16x16x4f32(xv[4 + s], w2b[s], acc2, 0, 0, 0);
            }
        }
        ss += shx(ss, 16, lane); ss += shx(ss, 32, lane);
        if (kh == 1) { part[(rt * 3 + 0) * 64 + lane] = acc0; part[(rt * 3 + 1) * 64 + lane] = acc1; part[(rt * 3 + 2) * 64 + lane] = acc2; if (lane < 16) ssp[rt * 16 + lane] = ss; }
        __syncthreads();
        if (kh == 0) {
            acc0 += part[(rt * 3 + 0) * 64 + lane]; acc1 += part[(rt * 3 + 1) * 64 + lane]; acc2 += part[(rt * 3 + 2) * 64 + lane];
            ss += ssp[rt * 16 + (lane & 15)];
#pragma unroll
            for (int g = 0; g < 4; ++g) { const int rw = rt * 16 + 4 * (lane >> 4) + g; Lg[rw * 48 + (lane & 15)] = acc0[g]; Lg[rw * 48 + 16 + (lane & 15)] = acc1[g]; Lg[rw * 48 + 32 + (lane & 15)] = acc2[g]; }
            if (lane < 16) rsL[rt * 16 + lane] = 1.0f / sqrtf(ss * (1.0f / DM) + NORM_EPS);
        }
        __syncthreads();
        int e1 = 0, e2 = 0, r1 = 0, r2 = 0; float w1 = 0.f, w2 = 0.f, rsv = 0.f;
        if (tid < 64) {
            const LAS float* Lr = Lg + tid * 48; rsv = rsL[tid];
            float gl[4];
#pragma unroll
            for (int g = 0; g < 4; ++g) gl[g] = Lr[g] * rsv + brg[g];
            int gi = 0; float gm = gl[0];
#pragma unroll
            for (int g = 1; g < 4; ++g) if (gl[g] > gm) { gm = gl[g]; gi = g; }
            float den = 0.f;
#pragma unroll
            for (int g = 0; g < 4; ++g) den += expf(gl[g] - gm);
            const float gw = 1.0f / den;
            float v1 = -INFINITY, v2 = -INFINITY; int i1 = 0, i2 = 0;
#pragma unroll
            for (int e = 0; e < 8; ++e) {
                const float v = Lr[4 + 8 * gi + e] * rsv + bre[8 * gi + e];
                if (v > v1) { v2 = v1; i2 = i1; v1 = v; i1 = e; } else if (v > v2) { v2 = v; i2 = e; }
            }
            const float p1 = 1.0f / (1.0f + expf(v2 - v1));
            e1 = 8 * gi + i1; e2 = 8 * gi + i2; w1 = p1 * gw; w2 = (1.0f - p1) * gw;
            r1 = __hip_atomic_fetch_add(&lcnt[e1], 1, __ATOMIC_RELAXED, __HIP_MEMORY_SCOPE_WORKGROUP); r2 = __hip_atomic_fetch_add(&lcnt[e2], 1, __ATOMIC_RELAXED, __HIP_MEMORY_SCOPE_WORKGROUP);
        }
        __syncthreads();
        if (tid < 32) { const int c = lcnt[tid]; lbase[tid] = c ? atomicAdd(&cnt[tid * CNT_STRIDE], c) : 0; lcnt[tid] = 0; }
        __syncthreads();
        if (tid < 64) {
            const int tok = blk * 64 + tid;
            const int pos1 = lbase[e1] + r1, pos2 = lbase[e2] + r2;
            ltok[e1 * MTOK + pos1] = tok; lw[e1 * MTOK + pos1] = w1;
            ltok[e2 * MTOK + pos2] = tok; lw[e2 * MTOK + pos2] = w2;
            tokinfo[tok] = (i32x4){e1, pos1, e2, pos2};
            rs2[tok] = rsv;
        }
        __syncthreads();
    }
}
__device__ __forceinline__ MoeTab moe_tables(const Frame& F, CArgs a, int l) {
    const int lane = otid(), tid = F.wave * 64 + lane; (void)tid; (void)lane;
    volatile LAS int* cntL = F.misc + 64; volatile LAS int* mtp = F.misc + 128; volatile LAS int* sp = F.misc + 192;
    const int* cnt = (const int*)(a->ws + WS_CTL) + CW_CNT + l * 32 * CNT_STRIDE;
    __syncthreads();
    if (tid < 32) cntL[tid] = __hip_atomic_load(cnt + tid * CNT_STRIDE, __ATOMIC_RELAXED, __HIP_MEMORY_SCOPE_AGENT);
    __syncthreads();
    if (tid == 0) { int mt = 0, s = 0; for (int e = 0; e < 32; ++e) { mtp[e] = mt; sp[e] = s; const int c = cntL[e]; mt += (c + 255) >> 8; s += c; } mtp[32] = mt; sp[32] = s; }
    __syncthreads();
    MoeTab T; T.cnt = cntL; T.mtpref = mtp; T.spref = sp; return T;
}
__device__ __forceinline__ void fin_phase(const Frame& F, CArgs a, int l, const MoeTab& T) {
    const int lane = otid(), tid = F.wave * 64 + lane; (void)tid;
    unsigned char* ws = a->ws;
    const i32x4* tokinfo = (const i32x4*)(ws + WS_TOKINFO); const bf16* Y = (const bf16*)(ws + WS_Y);
    bf16* xb = (bf16*)(ws + WS_XB); float* rs1 = (float*)(ws + WS_RS1);
    const int step = 2 * F.ngw;
    int m0 = 2 * F.gw;
    i32x4 tn0 = tokinfo[m0 < MTOK ? m0 : 0], tn1 = tokinfo[m0 + 1 < MTOK ? m0 + 1 : 0];
    for (; m0 < MTOK; m0 += step) {
        const i32x4 ti[2] = {tn0, tn1};
        const int mn = m0 + step;
        if (mn < MTOK) { tn0 = tokinfo[mn]; tn1 = tokinfo[mn + 1]; }
        u32x4 xv[2][2], p[2][2], q[2][2];
#pragma unroll
        for (int r = 0; r < 2; ++r) {
            const int m = m0 + r;
            const int s1 = T.spref[ti[r][0]] + ti[r][1], s2 = T.spref[ti[r][2]] + ti[r][3];
            const u32x4* xr = (const u32x4*)(xb + (size_t)m * DM) + lane;
            const u32x4* y1 = (const u32x4*)(Y + (size_t)s1 * DM) + lane; const u32x4* y2 = (const u32x4*)(Y + (size_t)s2 * DM) + lane;
#pragma unroll
            for (int j = 0; j < 2; ++j) { xv[r][j] = xr[64 * j]; p[r][j] = y1[64 * j]; q[r][j] = y2[64 * j]; }
        }
#pragma unroll
        for (int r = 0; r < 2; ++r) {
            const int m = m0 + r;
            float v[2][8]; float s = 0.f;
#pragma unroll
            for (int j = 0; j < 2; ++j) {
#define FINC(c, f) v[j][2 * c] = bflo(xv[r][j].f) + bflo(p[r][j].f) + bflo(q[r][j].f); v[j][2 * c + 1] = bfhi(xv[r][j].f) + bfhi(p[r][j].f) + bfhi(q[r][j].f);
                FINC(0, x) FINC(1, y) FINC(2, z) FINC(3, w)
#undef FINC
#pragma unroll
                for (int c = 0; c < 8; ++c) s += v[j][c] * v[j][c];
            }
            s = wave_sum(s, lane);
            const float rsv = 1.0f / sqrtf(s * (1.0f / DM) + NORM_EPS);
            if (l == DEPTH - 1) {
#pragma unroll
                for (int j = 0; j < 2; ++j) {
                    const f32x4* g = (const f32x4*)(a->fin_g + 512 * j + 8 * lane); f32x4* o = (f32x4*)(a->out + (size_t)m * DM + 512 * j + 8 * lane);
                    const f32x4 g0 = g[0], g1 = g[1];
                    o[0] = (f32x4){v[j][0] * rsv * g0[0], v[j][1] * rsv * g0[1], v[j][2] * rsv * g0[2], v[j][3] * rsv * g0[3]};
                    o[1] = (f32x4){v[j][4] * rsv * g1[0], v[j][5] * rsv * g1[1], v[j][6] * rsv * g1[2], v[j][7] * rsv * g1[3]};
                }
            } else {
                u32x4* o = (u32x4*)(xb + (size_t)m * DM) + lane;
#pragma unroll
                for (int j = 0; j < 2; ++j) { u32x4 w; w.x = cvtpk(v[j][0], v[j][1]); w.y = cvtpk(v[j][2], v[j][3]); w.z = cvtpk(v[j][4], v[j][5]); w.w = cvtpk(v[j][6], v[j][7]); o[64 * j] = w; }
                if (lane == 0) rs1[m] = rsv;
            }
        }
    }
}

constexpr int PH_PREP = 0, PH_GEMM1 = 1, PH_ATTN = 2, PH_COMB = 3, PH_MERGE = 4, PH_OUT = 5, PH_ROUTE = 6, PH_UP = 7, PH_DOWN = 8, PH_FIN = 9, PH_PER_LAYER = 10, NPHASE = PH_PER_LAYER * DEPTH - 1;

__global__ void __launch_bounds__(NTHREADS, 2) fwd_kernel(Args a_by_value) {
    extern __shared__ __attribute__((aligned(16))) unsigned char lds_raw[];
    Frame F;
    F.lds = (LAS unsigned char*)lds_raw; F.misc = (volatile LAS int*)(F.lds + MISC_OFF);
    F.wave = __builtin_amdgcn_readfirstlane((int)threadIdx.x >> 6);
    F.G = gridDim.x; { const int bx = blockIdx.x; F.vcu = (F.G % 8 == 0) ? (bx % 8) * (F.G / 8) + bx / 8 : bx; }
    F.gw = blockIdx.x * NWAVES + F.wave; F.ngw = F.G * NWAVES;
    CArgs a = (CArgs)__builtin_amdgcn_kernarg_segment_ptr();
    unsigned char* ws = a->ws;
    const int ph_lo = a->ph_lo, ph_hi = a->ph_hi;
    for (int u = threadIdx.x; u < 1024; u += NTHREADS) F.misc[u] = 0;
    __syncthreads();
#if !MK_MULTI
    XcdBarrier bar = xcd_barrier_post((unsigned*)(ws + WS_CTL) + CW_BAR, (volatile LAS unsigned*)(F.misc + 8));
#define GRID_BAR() xcd_barrier(bar, F.wave)
#else
#define GRID_BAR() do { } while (0)
#endif
    for (int ph = ph_lo, rep = 0; ph < ph_hi; ) {
        const int l = ph >= PH_PER_LAYER ? 1 : 0, k = ph >= PH_PER_LAYER ? ph - (PH_PER_LAYER - 1) : ph;
        const size_t wlo = (size_t)l * WNE_LSTRIDE;
        {
            int bx = blockIdx.x; asm volatile("" : "+s"(bx)); asm volatile("" : "+s"(a)); ws = a->ws;
            int wv = F.wave; asm volatile("" : "+s"(wv)); F.gw = bx * NWAVES + wv;
        }
        if (k == PH_PREP && (PHMASK & 1)) {
            prep_phase(F, a);
        } else if (k == PH_GEMM1 && (PHMASK & 2)) {
            DenseSched S; S.A = (const char*)(ws + WS_XB); S.Bt = (const char*)(ws + wlo + WS_WIN); S.K = DM; S.lda = DM; S.wave = F.wave; S.so.init(MTOK, DIN, F.G, (int)blockIdx.x);
            EpiProj E{(bf16*)(ws + WS_PQ), (bf16*)(ws + WS_PG), (const float*)(ws + WS_RS1), (const f32x4*)(ws + WS_ROPE)};
            pg8::gemm_phase(F.lds, S, E);
        } else if (k == PH_ATTN && (PHMASK & 4)) {
            attn_phase(F, a, l);
        } else if (k == PH_COMB && (PHMASK & 8)) {
            comb_phase(F, a);
        } else if (k == PH_MERGE && (PHMASK & 16)) {
            { DenseSched S; S.A = (const char*)(ws + WS_YA); S.Bt = (const char*)(ws + wlo + WS_WA); S.K = 512; S.lda = 512; S.wave = F.wave; S.so.init(MTOK, DM, F.G, (int)blockIdx.x);
              EpiGate<false> E{(const bf16*)(ws + WS_PG), nullptr, (bf16*)(ws + WS_M1)};
              pg8::gemm_phase(F.lds, S, E); }
            { DenseSched S; S.A = (const char*)(ws + WS_YB); S.Bt = (const char*)(ws + wlo + WS_WB); S.K = 256; S.lda = 256; S.wave = F.wave; S.so.init(MTOK, DM, F.G, (int)blockIdx.x);
              EpiGate<true> E{(const bf16*)(ws + WS_PG) + DM, (const bf16*)(ws + WS_M1), (bf16*)(ws + WS_MRG)};
              pg8::gemm_phase(F.lds, S, E); }
        } else if (k == PH_OUT && (PHMASK & 32)) {
            DenseSched S; S.A = (const char*)(ws + WS_MRG); S.Bt = (const char*)(ws + wlo + WS_WOUT); S.K = DM; S.lda = DM; S.wave = F.wave; S.so.init(MTOK, DM, F.G, (int)blockIdx.x);
            EpiResid E{(bf16*)(ws + WS_XB)};
            pg8::gemm_phase(F.lds, S, E);
        } else if (k == PH_ROUTE && (PHMASK & 64)) {
            route_phase(F, a, l);
        } else if (k == PH_UP && (PHMASK & 128)) {
            const MoeTab T = moe_tables(F, a, l);
            MoeSched<true> S; S.A = (const char*)(ws + WS_XB); S.Bt = (const char*)(ws + WS_WGU); S.K = DM; S.lda = DM; S.wave = F.wave; S.ntn = 2; S.bstride_e = (size_t)512 * DM * 2; S.ltok = (const int*)(ws + WS_LTOK); S.T = T; S.G = F.G; S.c = (int)blockIdx.x;
            EpiSwiglu E{(const int*)(ws + WS_LTOK), (const float*)(ws + WS_LW), (const float*)(ws + WS_RS2), (bf16*)(ws + WS_H)};
            pg8::gemm_phase(F.lds, S, E);
        } else if (k == PH_DOWN && (PHMASK & 256)) {
            const MoeTab T = moe_tables(F, a, l);
            MoeSched<false> S; S.A = (const char*)(ws + WS_H); S.Bt = (const char*)(ws + WS_WD); S.K = DEXP; S.lda = DEXP; S.wave = F.wave; S.ntn = 4; S.bstride_e = (size_t)DM * DEXP * 2; S.ltok = nullptr; S.T = T; S.G = F.G; S.c = (int)blockIdx.x;
            EpiY E{(bf16*)(ws + WS_Y)};
            pg8::gemm_phase(F.lds, S, E);
        } else if (k == PH_FIN && (PHMASK & 512)) {
            const MoeTab T = moe_tables(F, a, l);
            fin_phase(F, a, l, T);
        }
#if REP_MASK
        if (l == 0 && ((REP_MASK >> k) & 1) && rep < REP_N) { ++rep; GRID_BAR(); continue; }
        rep = 0;
#endif
        if (ph + 1 < ph_hi) GRID_BAR();
        ++ph;
    }
}

extern "C" void kernel_launch(void* const* d_in, const int* in_sizes, int n_in, void* d_out, int out_size, void* d_ws, size_t ws_size, hipStream_t stream) {
    static int grid = 0;
    if (grid == 0) {
        if (n_in != 16 || out_size != MTOK * DM || ws_size < WS_END) { fprintf(stderr, "kernel_launch: unexpected shapes (n_in %d out %d ws %zu)\n", n_in, out_size, ws_size); grid = -1; return; }
        int dev = 0, cus = 0, per_cu = 0;
        if (hipGetDevice(&dev) != hipSuccess || hipDeviceGetAttribute(&cus, hipDeviceAttributeMultiprocessorCount, dev) != hipSuccess) { grid = -1; return; }
        if (hipFuncSetAttribute((const void*)fwd_kernel, hipFuncAttributeMaxDynamicSharedMemorySize, LDS_BYTES) != hipSuccess) { fprintf(stderr, "kernel_launch: hipFuncSetAttribute failed\n"); grid = -1; return; }
        if (hipOccupancyMaxActiveBlocksPerMultiprocessor(&per_cu, (const void*)fwd_kernel, NTHREADS, LDS_BYTES) != hipSuccess || per_cu < 1) { fprintf(stderr, "kernel_launch: occupancy query says %d\n", per_cu); (void)hipGetLastError(); }
        grid = cus;
    }
    if (grid < 0) return;
    (void)hipMemsetAsync((char*)d_ws + WS_CTL, 0, CTL_BYTES, stream);
    Args a{};
    a.x = (const float*)d_in[0]; a.attn_g = (const float*)d_in[1]; a.w_in = (const float*)d_in[2]; a.a_sink = (const float*)d_in[3]; a.w_a = (const float*)d_in[4]; a.w_b = (const float*)d_in[5];
    a.w_out = (const float*)d_in[6]; a.ffn_g = (const float*)d_in[7]; a.w_rg = (const float*)d_in[8]; a.b_rg = (const float*)d_in[9]; a.w_re = (const float*)d_in[10]; a.b_re = (const float*)d_in[11];
    a.w_eg = (const float*)d_in[12]; a.w_eu = (const float*)d_in[13]; a.w_ed = (const float*)d_in[14]; a.fin_g = (const float*)d_in[15];
    a.out = (float*)d_out; a.ws = (unsigned char*)d_ws;
#if MK_MULTI
    for (int ph = 0; ph < NPHASE; ++ph) { a.ph_lo = ph; a.ph_hi = ph + 1; hipLaunchKernelGGL(fwd_kernel, dim3(grid), dim3(NTHREADS), LDS_BYTES, stream, a); }
#else
    a.ph_lo = 0; a.ph_hi = NPHASE;
    void* kargs[] = {&a};
    const hipError_t le = hipLaunchCooperativeKernel((const void*)fwd_kernel, dim3(grid), dim3(NTHREADS), kargs, LDS_BYTES, stream);
    if (le != hipSuccess) fprintf(stderr, "kernel_launch: cooperative launch failed: %s (grid %d)\n", hipGetErrorString(le), grid);
#endif
}
```

```cpp
#include <hip/hip_runtime.h>
#include <hip/hip_cooperative_groups.h>
#include <cstdio>
#include <cstdint>
namespace cg = cooperative_groups;

#ifndef REP_MASK
#define REP_MASK 0
#define REP_N 2
#endif
#ifndef PHMASK
#define PHMASK 1023
#endif
#ifndef MK_MULTI
#define MK_MULTI 0
#endif

#define LAS __attribute__((address_space(3)))
#define GAS __attribute__((address_space(1)))
typedef unsigned short bf16;
typedef short bf16x8 __attribute__((ext_vector_type(8)));
typedef short s16x4 __attribute__((ext_vector_type(4)));
typedef float f32x2 __attribute__((ext_vector_type(2)));
typedef float f32x4 __attribute__((ext_vector_type(4)));
typedef float f32x16 __attribute__((ext_vector_type(16)));
typedef unsigned u32x2 __attribute__((ext_vector_type(2)));
typedef unsigned u32x4 __attribute__((ext_vector_type(4)));
typedef int i32x4 __attribute__((ext_vector_type(4)));
typedef __bf16 bf16x2_t __attribute__((ext_vector_type(2)));

constexpr int BATCH = 4, SEQ = 4096, DM = 1024, DEPTH = 2, MTOK = BATCH * SEQ;
constexpr int NQKV = 3072, NGATE = 2048, DIN = NQKV + NGATE;
constexpr int NEXP = 32, DEXP = 256;
constexpr float NORM_EPS = 1e-6f;
constexpr float LOG2E = 1.4426950408889634f, LN2 = 0.6931471805599453f;
constexpr float QSCALE = 0.125f * LOG2E;
constexpr int NWAVES = 8, NTHREADS = 512;

constexpr size_t MiB = 1u << 20;
constexpr size_t WS_CTL = 0, CTL_BYTES = 1 * MiB;
constexpr size_t WS_ROPE = 1 * MiB;
constexpr size_t WS_WR = 2 * MiB, WR_LSTRIDE = 256 * 1024;
constexpr size_t WS_RS1 = 3 * MiB, WS_RS2 = 3 * MiB + 65536;
constexpr size_t WS_TOKINFO = 5 * MiB;
constexpr size_t WS_LTOK = 6 * MiB, WS_LW = 8 * MiB;
constexpr size_t WS_LSE = 10 * MiB;
constexpr size_t WS_WIN = 12 * MiB, WS_WA = 22 * MiB, WS_WB = 23 * MiB, WS_WOUT = 24 * MiB, WNE_LSTRIDE = 14 * MiB;
constexpr size_t WS_WGU = 40 * MiB, WS_WD = 72 * MiB;
constexpr size_t WS_XB = 88 * MiB;
constexpr size_t WS_YA = 120 * MiB, WS_YB = 136 * MiB;
constexpr size_t WS_PQ = 144 * MiB;
constexpr size_t WS_M1 = 144 * MiB, WS_MRG = 176 * MiB, WS_H = 208 * MiB;
constexpr size_t WS_PG = 240 * MiB;
constexpr size_t WS_Y = 240 * MiB;
constexpr size_t WS_END = 304 * MiB;
constexpr int CW_CNT = 64, CNT_STRIDE = 64;
constexpr int CW_BAR = 8192;

constexpr int RING_BYTES = 131072;
constexpr int PREP_SCR = 16896;
constexpr int MISC_OFF = 8 * PREP_SCR;
constexpr int LDS_BYTES = 147456;

#define LDS_WAIT() asm volatile("s_waitcnt lgkmcnt(0)" ::: "memory")
#define VM_WAIT() asm volatile("s_waitcnt vmcnt(0)" ::: "memory")
__device__ __forceinline__ unsigned cvtpk(float lo, float hi) { f32x2 v = {lo, hi}; bf16x2_t b = __builtin_convertvector(v, bf16x2_t); return __builtin_bit_cast(unsigned, b); }
__device__ __forceinline__ float bf2f(unsigned short h) { return __uint_as_float(((unsigned)h) << 16); }
__device__ __forceinline__ float bflo(unsigned w) { return __uint_as_float(w << 16); }
__device__ __forceinline__ float bfhi(unsigned w) { return __uint_as_float(w & 0xffff0000u); }
__device__ __forceinline__ float fast_exp2(float x) { return __builtin_amdgcn_exp2f(x); }
__device__ __forceinline__ float fast_rcp(float x) { return __builtin_amdgcn_rcpf(x); }
__device__ __forceinline__ float sigmoidf_fast(float v) { return fast_rcp(1.0f + fast_exp2(-v * LOG2E)); }

namespace pg8 {
constexpr int BM = 256, BK = 64, HALF = 128, HTB = HALF * BK * 2, STAGE_BYTES = 8 * HTB, NXCD = 8, WGM = 4;
__host__ __device__ __forceinline__ int lds_byte(int r, int c) { const int st = (r >> 4) * 2 + (c >> 5), rr = r & 15, cc = c & 31, ob = rr * 64 + cc * 2; return st * 1024 + (ob ^ (((ob >> 9) & 1) << 5)); }
__host__ __device__ __forceinline__ void stage_rc(int b, int& R, int& C) { const int st = b / 1024, sb = b % 1024, swz = sb ^ (((sb >> 9) & 1) << 5); R = (st >> 1) * 16 + swz / 64; C = (st & 1) * 32 + (swz % 64) / 2; }
__host__ __device__ __forceinline__ int perm32(int rho) { const int n = rho >> 4, i = rho & 15; return 8 * (i >> 2) + 4 * n + (i & 3); }

struct Unit { int pm, pn, e, nvalid, slot0, lpos0; };

struct StaticOrder {
    int nM, nN, nwg, G, c;
    __device__ void init(int M, int N, int G_, int c_) { nM = M / BM; nN = N / BM; nwg = nM * nN; G = G_; c = c_; }
    __device__ bool next(int i, int& pm, int& pn) const {
        const long L = (long)i * G + c; if (L >= nwg) return false;
        int wgid = (int)L; { const int q = nwg / NXCD, r = nwg % NXCD, xcd = wgid % NXCD, off = wgid / NXCD; wgid = (xcd < r ? xcd * (q + 1) : r * (q + 1) + (xcd - r) * q) + off; }
        const int nig = WGM * nN, gid = wgid / nig, fm = gid * WGM, gsz = (nM - fm) < WGM ? (nM - fm) : WGM;
        pm = fm + ((wgid % nig) % gsz); pn = (wgid % nig) / gsz; return true;
    }
};

template <class Epi, class Sched>
__device__ __forceinline__ void gemm_phase(LAS unsigned char* lds, const Sched& S, const Epi& E) {
    unsigned z_ = 0u; asm volatile("" : "+v"(z_)); const int tid_ = (int)__builtin_amdgcn_mbcnt_hi(~0u, __builtin_amdgcn_mbcnt_lo(~0u, z_)) + S.wave * 64;
    const int tid = tid_, wid = S.wave, lane = tid & 63, wr = wid >> 2, wc = wid & 3, fr = lane & 15, fq = lane >> 4;
    const int K = S.K, nt = K / BK;
    unsigned voffA[2], voffB[2];
#pragma unroll
    for (int i = 0; i < 2; ++i) { int R, C; stage_rc(tid * 16 + i * 8192, R, C); const int Rb = Epi::PERM ? ((R & ~31) + perm32(R & 31)) : R;
        voffA[i] = (unsigned)(R * S.lda + C) * 2u; voffB[i] = (unsigned)(Rb * K + C) * 2u; }
    const size_t kstep = (size_t)(BK * 2);
    const size_t hstepB = (size_t)HALF * K * 2, hstepA = (size_t)HALF * S.lda * 2;
    const unsigned ldsw = (unsigned)wid * 1024u;
    const int aoff = lds_byte(wr * 64 + fr, fq * 8), boff = lds_byte(wc * 32 + fr, fq * 8);
#define PG8_SA(b, h) (((b) * 2 + (h)) * HTB)
#define PG8_SB(b, h) ((4 + (b) * 2 + (h)) * HTB)
#define PG8_GLDS(src, dstoff) __builtin_amdgcn_global_load_lds((const unsigned*)(src), (LAS unsigned*)(lds + (dstoff)), 16, 0, 0)
#define PG8_STAGE_A(bufoff, up, h, VO) do { if constexpr (Sched::GATHER) { _Pragma("unroll") for (int _i = 0; _i < 2; ++_i) PG8_GLDS((up) + VO[_i], (bufoff) + ldsw + _i * 8192); } \
        else { const char* _b = (up) + (size_t)(h) * hstepA; _Pragma("unroll") for (int _i = 0; _i < 2; ++_i) PG8_GLDS(_b + voffA[_i], (bufoff) + ldsw + _i * 8192); } } while (0)
#define PG8_STAGE_B(bufoff, bp) do { _Pragma("unroll") for (int _i = 0; _i < 2; ++_i) PG8_GLDS((bp) + voffB[_i], (bufoff) + ldsw + _i * 8192); } while (0)
#define PG8_LDA(dst, b, h) do { _Pragma("unroll") for (int m = 0; m < 4; ++m) _Pragma("unroll") for (int k = 0; k < 2; ++k) dst[m][k] = *(const LAS bf16x8*)(lds + PG8_SA(b, h) + aoff + m * 2048 + k * 1024); } while (0)
#define PG8_LDB(dst, b, h) do { _Pragma("unroll") for (int n = 0; n < 2; ++n) _Pragma("unroll") for (int k = 0; k < 2; ++k) dst[n][k] = *(const LAS bf16x8*)(lds + PG8_SB(b, h) + boff + n * 2048 + k * 1024); } while (0)
#define PG8_MMA(ai, bj, At, Bt) do { __builtin_amdgcn_s_setprio(1); _Pragma("unroll") for (int m = 0; m < 4; ++m) _Pragma("unroll") for (int n = 0; n < 2; ++n) _Pragma("unroll") for (int k = 0; k < 2; ++k) \
        acc[ai][bj][m][n] = __builtin_amdgcn_mfma_f32_16x16x32_bf16(Bt[n][k], At[m][k], acc[ai][bj][m][n], 0, 0, 0); __builtin_amdgcn_s_setprio(0); } while (0)
#define PG8_WAIT_V(n) asm volatile("s_waitcnt vmcnt(" #n ")" ::: "memory")
#define PG8_WAIT_L(n) asm volatile("s_waitcnt lgkmcnt(" #n ")" ::: "memory")
#define PG8_BAR __builtin_amdgcn_s_barrier()
#define PG8_SCHED __builtin_amdgcn_sched_barrier(0)
    Unit cur, nxt; int ui = 0;
    if (!S.next(0, cur)) return;
    f32x4 acc[2][2][4][2];
#pragma unroll
    for (int a = 0; a < 2; ++a)
#pragma unroll
        for (int b = 0; b < 2; ++b)
#pragma unroll
            for (int m = 0; m < 4; ++m)
#pragma unroll
                for (int n = 0; n < 2; ++n) acc[a][b][m][n] = (f32x4){0.f, 0.f, 0.f, 0.f};
    bf16x8 At[4][2], B0[2][2], B1[2][2];
    const char* Ab = S.a_base();
    const char* cA = Ab; const char* cB = S.b_base(cur);
    unsigned vF0[2], vF1[2], vK[2];
    if constexpr (Sched::GATHER) {
#pragma unroll
        for (int i = 0; i < 2; ++i) { int R, C; stage_rc(tid * 16 + i * 8192, R, C); vF0[i] = S.a_off(cur, R) + (unsigned)(C * 2); vF1[i] = S.a_off(cur, HALF + R) + (unsigned)(C * 2); vK[i] = vF1[i]; }
    } else cA = Ab + S.a_unit_off(cur);
    PG8_STAGE_B(PG8_SB(0, 0), cB); PG8_STAGE_B(PG8_SB(0, 1), cB + hstepB); PG8_STAGE_A(PG8_SA(0, 0), cA, 0, vF0); PG8_STAGE_A(PG8_SA(0, 1), cA, 1, vF1);
    if (wr == 1) PG8_BAR;
    PG8_WAIT_V(2); PG8_BAR;
    PG8_STAGE_B(PG8_SB(1, 0), cB + kstep); PG8_STAGE_A(PG8_SA(1, 0), cA + kstep, 0, vF0); PG8_STAGE_B(PG8_SB(1, 1), cB + hstepB + kstep);
    PG8_WAIT_V(6); PG8_BAR;
    for (;;) {
        const bool has_next = S.next(ui + 1, nxt);
        const char* nA = cA; const char* nB = cB;
        if (has_next) { nB = S.b_base(nxt); if constexpr (!Sched::GATHER) nA = Ab + S.a_unit_off(nxt); }
#pragma unroll 1
        for (int t = 0; t < nt; t += 2) {
            const bool last = (t == nt - 2);
            const char* a1 = cA + (size_t)(t + 1) * kstep;
            const char* a2 = last ? nA : cA + (size_t)(t + 2) * kstep; const char* b2 = last ? nB : cB + (size_t)(t + 2) * kstep;
            const char* a3 = a2 + kstep; const char* b3 = b2 + kstep;
            if constexpr (Sched::GATHER) {
                if (last && has_next) {
#pragma unroll
                    for (int i = 0; i < 2; ++i) { int R, C; stage_rc(tid * 16 + i * 8192, R, C); vF0[i] = S.a_off(nxt, R) + (unsigned)(C * 2); vF1[i] = S.a_off(nxt, HALF + R) + (unsigned)(C * 2); }
                }
            }
            PG8_LDB(B0, 0, 0); PG8_LDB(B1, 0, 1); PG8_SCHED; PG8_LDA(At, 0, 0); PG8_STAGE_A(PG8_SA(1, 1), a1, 1, vK);
            PG8_WAIT_V(8); PG8_WAIT_L(0); PG8_BAR; PG8_MMA(0, 0, At, B0); PG8_MMA(0, 1, At, B1); PG8_BAR; PG8_SCHED;
            PG8_LDA(At, 0, 1); PG8_STAGE_B(PG8_SB(0, 0), b2); PG8_STAGE_B(PG8_SB(0, 1), b2 + hstepB); PG8_STAGE_A(PG8_SA(0, 0), a2, 0, vF0);
            PG8_WAIT_V(8); PG8_WAIT_L(0); PG8_BAR; PG8_MMA(1, 0, At, B0); PG8_MMA(1, 1, At, B1); PG8_BAR; PG8_SCHED;
            PG8_LDB(B0, 1, 0); PG8_LDB(B1, 1, 1); PG8_SCHED; PG8_LDA(At, 1, 0); PG8_STAGE_A(PG8_SA(0, 1), a2, 1, vF1);
            PG8_WAIT_V(8); PG8_WAIT_L(0); PG8_BAR; PG8_MMA(0, 0, At, B0); PG8_MMA(0, 1, At, B1); PG8_BAR; PG8_SCHED;
            PG8_LDA(At, 1, 1); PG8_STAGE_B(PG8_SB(1, 0), b3); PG8_STAGE_B(PG8_SB(1, 1), b3 + hstepB); PG8_STAGE_A(PG8_SA(1, 0), a3, 0, vF0);
            PG8_WAIT_V(8); PG8_WAIT_L(0); PG8_BAR; PG8_MMA(1, 0, At, B0); PG8_MMA(1, 1, At, B1); PG8_BAR; PG8_SCHED;
        }
        if (wr == 0) PG8_BAR;
        E(acc, cur, wr, wc, fr, fq);
        if (!has_next) break;
#pragma unroll
        for (int a = 0; a < 2; ++a)
#pragma unroll
            for (int b = 0; b < 2; ++b)
#pragma unroll
                for (int m = 0; m < 4; ++m)
#pragma unroll
                    for (int n = 0; n < 2; ++n) acc[a][b][m][n] = (f32x4){0.f, 0.f, 0.f, 0.f};
        cur = nxt; cA = nA; cB = nB; ++ui;
        if constexpr (Sched::GATHER) { vK[0] = vF1[0]; vK[1] = vF1[1]; }
        if (wr == 1) PG8_BAR;
    }
    PG8_WAIT_V(0);
    PG8_BAR;
#undef PG8_SA
#undef PG8_SB
#undef PG8_GLDS
#undef PG8_STAGE_A
#undef PG8_STAGE_B
#undef PG8_LDA
#undef PG8_LDB
#undef PG8_MMA
#undef PG8_WAIT_V
#undef PG8_WAIT_L
#undef PG8_BAR
#undef PG8_SCHED
}
}
using pg8::Unit;

struct DenseSched {
    static constexpr bool GATHER = false;
    const char* A; const char* Bt; int K; int lda; int wave; pg8::StaticOrder so;
    __device__ __forceinline__ bool next(int i, Unit& u) const { int pm, pn; if (!so.next(i, pm, pn)) return false; u.pm = pm; u.pn = pn; u.e = 0; u.nvalid = 256; u.slot0 = pm * 256; u.lpos0 = 0; return true; }
    __device__ __forceinline__ const char* a_base() const { return A; }
    __device__ __forceinline__ unsigned a_off(const Unit& u, int r) const { return 0u; }
    __device__ __forceinline__ size_t a_unit_off(const Unit& u) const { return (size_t)u.pm * 256 * lda * 2; }
    __device__ __forceinline__ const char* b_base(const Unit& u) const { return Bt + (size_t)u.pn * 256 * K * 2; }
};
struct MoeTab { const volatile LAS int* cnt; const volatile LAS int* mtpref; const volatile LAS int* spref; };
template <bool GATHER_> struct MoeSched {
    static constexpr bool GATHER = GATHER_;
    const char* A; const char* Bt; int K; int lda; int wave; int ntn; size_t bstride_e; const int* ltok; MoeTab T; int G, c, lo, hi;
    __device__ __forceinline__ bool next(int i, Unit& u) const {
        const int L = lo + i * G + c; if (c < 0 || L >= hi) return false;
        const int tix = L / ntn; u.pn = L - tix * ntn; u.pm = tix;
        int e = 0;
#pragma unroll 1
        for (int k = 1; k < 32; ++k) if (T.mtpref[k] <= tix) e = k;
        const int mt = tix - T.mtpref[e]; u.e = e; u.slot0 = T.spref[e] + 256 * mt; const int rem = T.cnt[e] - 256 * mt; u.nvalid = rem < 256 ? rem : 256; u.lpos0 = e * MTOK + 256 * mt; return true;
    }
    __device__ __forceinline__ const char* a_base() const { return A; }
    __device__ __forceinline__ unsigned a_off(const Unit& u, int r) const { const int rr = r < u.nvalid ? r : u.nvalid - 1; return (unsigned)ltok[u.lpos0 + rr] * (unsigned)(lda * 2); }
    __device__ __forceinline__ size_t a_unit_off(const Unit& u) const { return (size_t)u.slot0 * lda * 2; }
    __device__ __forceinline__ const char* b_base(const Unit& u) const { return Bt + (size_t)u.e * bstride_e + (size_t)u.pn * 256 * K * 2; }
};

#define OPAQUE(p) asm volatile("" : "+v"(p))
struct EpiProj {
    static constexpr bool PERM = true, REPEAT = true;
    bf16* Pq; bf16* Pg; const float* rs; const f32x4* rope;
    __device__ __forceinline__ static void rot(f32x4& c, const f32x4& st) {
        const f32x4 o = c;
        c[0] = o[0] * st[0] - o[1] * st[1]; c[1] = o[1] * st[0] + o[0] * st[1];
        c[2] = o[2] * st[2] - o[3] * st[3]; c[3] = o[3] * st[2] + o[2] * st[3];
    }
    __device__ __forceinline__ void operator()(const f32x4 (&acc)[2][2][4][2], const Unit& u, int wr, int wc, int fr, int fq) const {
        const int colh = wc * 32 + fq * 8;
        const int ib = (colh & 63) >> 2;
        const int row0 = u.pm * 256 + wr * 64 + fr;
        int mode[2]; bf16* ob[2]; size_t ostep[2];
#pragma unroll
        for (int bj = 0; bj < 2; ++bj) {
            const int h128 = 2 * u.pn + bj;
            if (h128 >= 24) mode[bj] = 3;
            else if (h128 < 6) mode[bj] = h128 < 4 ? 1 : (h128 == 4 ? 2 : 0);
            else { const int j = (h128 - 6) % 6; mode[bj] = j < 2 ? 1 : (j < 4 ? 2 : 0); }
            const int opitch = (h128 < 24) ? NQKV : NGATE;
            ob[bj] = ((h128 < 24) ? Pq + h128 * 128 + colh : Pg + (h128 - 24) * 128 + colh) + (size_t)row0 * opitch;
            ostep[bj] = (size_t)opitch * 16;
        }
        float rsv[8];
#pragma unroll
        for (int i = 0; i < 8; ++i) rsv[i] = rs[row0 + (i >> 2) * 128 + (i & 3) * 16];
        const f32x4* rp = rope + (size_t)(row0 & (SEQ - 1)) * 16 + ib;
        f32x4 c0 = rp[0], c1 = rp[1];
        const f32x4 s16a = rope[16 * 16 + ib], s16b = rope[16 * 16 + ib + 1], s80a = rope[80 * 16 + ib], s80b = rope[80 * 16 + ib + 1];
#pragma unroll
        for (int ai = 0; ai < 2; ++ai)
#pragma unroll
            for (int m = 0; m < 4; ++m) {
                OPAQUE(ob[0]); OPAQUE(ob[1]);
                const float s = rsv[ai * 4 + m];
#pragma unroll
                for (int bj = 0; bj < 2; ++bj) {
                    f32x4 v0 = acc[ai][bj][m][0] * s, v1 = acc[ai][bj][m][1] * s;
                    if (mode[bj] == 1 || mode[bj] == 2) {
                        f32x4 o0, o1;
                        o0[0] = v0[0] * c0[0] - v0[1] * c0[1]; o0[1] = v0[1] * c0[0] + v0[0] * c0[1];
                        o0[2] = v0[2] * c0[2] - v0[3] * c0[3]; o0[3] = v0[3] * c0[2] + v0[2] * c0[3];
                        o1[0] = v1[0] * c1[0] - v1[1] * c1[1]; o1[1] = v1[1] * c1[0] + v1[0] * c1[1];
                        o1[2] = v1[2] * c1[2] - v1[3] * c1[3]; o1[3] = v1[3] * c1[2] + v1[2] * c1[3];
                        const float qs = (mode[bj] == 1) ? QSCALE : 1.0f;
                        v0 = o0 * qs; v1 = o1 * qs;
                    } else if (mode[bj] == 3) {
#pragma unroll
                        for (int j = 0; j < 4; ++j) { v0[j] = sigmoidf_fast(v0[j]); v1[j] = sigmoidf_fast(v1[j]); }
                    }
                    u32x4 w; w.x = cvtpk(v0[0], v0[1]); w.y = cvtpk(v0[2], v0[3]); w.z = cvtpk(v1[0], v1[1]); w.w = cvtpk(v1[2], v1[3]);
                    *(u32x4*)(ob[bj]) = w;
                }
                if (m == 3) { rot(c0, s80a); rot(c1, s80b); } else { rot(c0, s16a); rot(c1, s16b); }
                const int adv = (m == 3) ? 5 : 1;
                ob[0] += ostep[0] * adv; ob[1] += ostep[1] * adv;
            }
    }
};
template <bool ADD> struct EpiGate {
    static constexpr bool PERM = true, REPEAT = false;
    const bf16* gate; const bf16* prev; bf16* out;
    __device__ __forceinline__ void operator()(const f32x4 (&acc)[2][2][4][2], const Unit& u, int wr, int wc, int fr, int fq) const {
        const int row0 = u.pm * 256 + wr * 64 + fr, col0 = u.pn * 256 + wc * 32 + fq * 8;
        const bf16* gp = gate + (size_t)row0 * NGATE + col0; const bf16* pp = prev + (size_t)row0 * DM + col0; bf16* op = out + (size_t)row0 * DM + col0;
        u32x4 g[2][2], p[2][2];
#define EG_LOAD(slot, i) do { const size_t ro = (size_t)(16 * (i) + 64 * ((i) >> 2)); g[slot][0] = *(const u32x4*)(gp + ro * NGATE); g[slot][1] = *(const u32x4*)(gp + ro * NGATE + 128); \
        if (ADD) { p[slot][0] = *(const u32x4*)(pp + ro * DM); p[slot][1] = *(const u32x4*)(pp + ro * DM + 128); } } while (0)
        EG_LOAD(0, 0);
#pragma unroll
        for (int i = 0; i < 8; ++i) {
            const int ai = i >> 2, m = i & 3, sl = i & 1;
            if (i + 1 < 8) { if (sl == 0) EG_LOAD(1, i + 1); else EG_LOAD(0, i + 1); }
            bf16* orow = op + (size_t)(16 * i + 64 * (i >> 2)) * DM;
#pragma unroll
            for (int bj = 0; bj < 2; ++bj) {
                const u32x4 gg = g[sl][bj];
                const f32x4 a0 = acc[ai][bj][m][0], a1 = acc[ai][bj][m][1];
                float r[8];
                r[0] = a0[0] * bflo(gg.x); r[1] = a0[1] * bfhi(gg.x); r[2] = a0[2] * bflo(gg.y); r[3] = a0[3] * bfhi(gg.y);
                r[4] = a1[0] * bflo(gg.z); r[5] = a1[1] * bfhi(gg.z); r[6] = a1[2] * bflo(gg.w); r[7] = a1[3] * bfhi(gg.w);
                if (ADD) { const u32x4 q = p[sl][bj];
                    r[0] += bflo(q.x); r[1] += bfhi(q.x); r[2] += bflo(q.y); r[3] += bfhi(q.y); r[4] += bflo(q.z); r[5] += bfhi(q.z); r[6] += bflo(q.w); r[7] += bfhi(q.w); }
                u32x4 w; w.x = cvtpk(r[0], r[1]); w.y = cvtpk(r[2], r[3]); w.z = cvtpk(r[4], r[5]); w.w = cvtpk(r[6], r[7]);
                *(u32x4*)(orow + bj * 128) = w;
            }
            asm volatile("" ::: "memory");
        }
#undef EG_LOAD
    }
};
struct EpiResid {
    static constexpr bool PERM = true, REPEAT = false;
    bf16* xb;
    __device__ __forceinline__ void operator()(const f32x4 (&acc)[2][2][4][2], const Unit& u, int wr, int wc, int fr, int fq) const {
        const int row0 = u.pm * 256 + wr * 64 + fr, col0 = u.pn * 256 + wc * 32 + fq * 8;
        bf16* xp = xb + (size_t)row0 * DM + col0;
        u32x4 p[2][2];
#define ER_LOAD(slot, i) do { const size_t ro = (size_t)(16 * (i) + 64 * ((i) >> 2)); p[slot][0] = *(const u32x4*)(xp + ro * DM); p[slot][1] = *(const u32x4*)(xp + ro * DM + 128); } while (0)
        ER_LOAD(0, 0);
#pragma unroll
        for (int i = 0; i < 8; ++i) {
            const int ai = i >> 2, m = i & 3, sl = i & 1;
            if (i + 1 < 8) { if (sl == 0) ER_LOAD(1, i + 1); else ER_LOAD(0, i + 1); }
            bf16* orow = xp + (size_t)(16 * i + 64 * (i >> 2)) * DM;
#pragma unroll
            for (int bj = 0; bj < 2; ++bj) {
                const u32x4 q = p[sl][bj];
                const f32x4 a0 = acc[ai][bj][m][0], a1 = acc[ai][bj][m][1];
                u32x4 w;
                w.x = cvtpk(a0[0] + bflo(q.x), a0[1] + bfhi(q.x)); w.y = cvtpk(a0[2] + bflo(q.y), a0[3] + bfhi(q.y));
                w.z = cvtpk(a1[0] + bflo(q.z), a1[1] + bfhi(q.z)); w.w = cvtpk(a1[2] + bflo(q.w), a1[3] + bfhi(q.w));
                *(u32x4*)(orow + bj * 128) = w;
            }
            asm volatile("" ::: "memory");
        }
#undef ER_LOAD
    }
};
struct EpiSwiglu {
    static constexpr bool PERM = true, REPEAT = false;
    const int* ltok; const float* lw; const float* rs; bf16* H;
    __device__ __forceinline__ void operator()(const f32x4 (&acc)[2][2][4][2], const Unit& u, int wr, int wc, int fr, int fq) const {
        int tok[8]; float w8[8], s8[8];
#pragma unroll
        for (int i = 0; i < 8; ++i) { const int rr = (i >> 2) * 128 + wr * 64 + (i & 3) * 16 + fr; const int rc = rr < u.nvalid ? rr : u.nvalid - 1; tok[i] = ltok[u.lpos0 + rc]; w8[i] = lw[u.lpos0 + rc]; }
#pragma unroll
        for (int i = 0; i < 8; ++i) s8[i] = rs[tok[i]];
#pragma unroll
        for (int ai = 0; ai < 2; ++ai)
#pragma unroll
            for (int m = 0; m < 4; ++m) {
                const int rr = ai * 128 + wr * 64 + m * 16 + fr;
                if (rr < u.nvalid) {
                    const float w = w8[ai * 4 + m], s = s8[ai * 4 + m];
#pragma unroll
                    for (int bj = 0; bj < 2; ++bj) {
                        const f32x4 a0 = acc[ai][bj][m][0] * s, a1 = acc[ai][bj][m][1] * s;
                        const float h0 = a0[0] * sigmoidf_fast(a0[0]) * a0[1] * w, h1 = a0[2] * sigmoidf_fast(a0[2]) * a0[3] * w;
                        const float h2 = a1[0] * sigmoidf_fast(a1[0]) * a1[1] * w, h3 = a1[2] * sigmoidf_fast(a1[2]) * a1[3] * w;
                        u32x2 o; o.x = cvtpk(h0, h1); o.y = cvtpk(h2, h3);
                        *(u32x2*)(H + (size_t)(u.slot0 + rr) * DEXP + u.pn * 128 + bj * 64 + wc * 16 + fq * 4) = o;
                    }
                }
            }
    }
};
struct EpiY {
    static constexpr bool PERM = true;
    bf16* Y;
    __device__ __forceinline__ void operator()(const f32x4 (&acc)[2][2][4][2], const Unit& u, int wr, int wc, int fr, int fq) const {
#pragma unroll
        for (int ai = 0; ai < 2; ++ai)
#pragma unroll
            for (int m = 0; m < 4; ++m) {
                const int rr = ai * 128 + wr * 64 + m * 16 + fr;
                if (rr < u.nvalid) {
#pragma unroll
                    for (int bj = 0; bj < 2; ++bj) {
                        const f32x4 a0 = acc[ai][bj][m][0], a1 = acc[ai][bj][m][1];
                        u32x4 w; w.x = cvtpk(a0[0], a0[1]); w.y = cvtpk(a0[2], a0[3]); w.z = cvtpk(a1[0], a1[1]); w.w = cvtpk(a1[2], a1[3]);
                        *(u32x4*)(Y + (size_t)(u.slot0 + rr) * DM + u.pn * 256 + bj * 128 + wc * 32 + fq * 8) = w;
                    }
                }
            }
    }
};

#define XB_TMO      128
#define XB_XCNT(j)  (256  + 64 * (j))
#define XB_XSUB(j)  (1280 + 64 * (j))
#define XB_XGEN(j)  (2304 + 64 * (j))
#define XB_TOP      3328
#define XB_TOPGEN   3392
#define XCD_BAR_WORDS 3456
#define XB_SPIN_CAP (1u << 18)
__device__ __forceinline__ unsigned xb_ld(unsigned* p)              { return __hip_atomic_load(p, __ATOMIC_RELAXED, __HIP_MEMORY_SCOPE_AGENT); }
__device__ __forceinline__ unsigned xb_add(unsigned* p, unsigned v) { return __hip_atomic_fetch_add(p, v, __ATOMIC_RELAXED, __HIP_MEMORY_SCOPE_AGENT); }
__device__ __forceinline__ unsigned xb_xcc_id() { return (unsigned)__builtin_amdgcn_s_getreg((3 << 11) | 20) & 0xFu; }
#define XB_SPIN(cond, bar) do { unsigned _sp = 0; while (cond) { __builtin_amdgcn_s_sleep(1); \
    if ((++_sp & 255u) == 0u) { if (xb_ld(&(bar)[XB_TMO])) break; if (_sp > XB_SPIN_CAP) { atomicAdd(&(bar)[XB_TMO], 1u); break; } } } } while (0)
struct XcdBarrier { unsigned* bar; unsigned x; volatile LAS unsigned* st; };
__device__ __forceinline__ XcdBarrier xcd_barrier_post(unsigned* bar, volatile LAS unsigned* st) {
    XcdBarrier b; b.bar = bar; b.x = xb_xcc_id(); b.st = st;
    if (threadIdx.x == 0) (void)xb_add(&bar[XB_XCNT(b.x)], 1u);
    return b;
}
__device__ __forceinline__ void xcd_barrier_complete(unsigned* bar, unsigned x, unsigned& nloc, unsigned& nx) {
    const unsigned G = gridDim.x * gridDim.y * gridDim.z;
    unsigned sum, cnt, mine, sp = 0u;
    for (;;) {
        sum = 0u; cnt = 0u; mine = 0u;
#pragma unroll
        for (unsigned j = 0; j < 16; ++j) { const unsigned c = xb_ld(&bar[XB_XCNT(j)]); sum += c; cnt += (c > 0u) ? 1u : 0u; mine = (j == x) ? c : mine; }
        if (sum == G) break;
        __builtin_amdgcn_s_sleep(1);
        if ((++sp & 255u) == 0u) { if (xb_ld(&bar[XB_TMO])) break; if (sp > XB_SPIN_CAP) { atomicAdd(&bar[XB_TMO], 1u); break; } }
    }
    nloc = mine > 0u ? mine : 1u; nx = cnt > 0u ? cnt : 1u;
}
__device__ __forceinline__ void xcd_barrier(const XcdBarrier& b, int wave) {
    asm volatile("s_waitcnt vmcnt(0)" ::: "memory");
    __syncthreads();
    unsigned zb_ = 0u; asm volatile("" : "+v"(zb_));
    if (wave == 0 && __builtin_amdgcn_mbcnt_hi(~0u, __builtin_amdgcn_mbcnt_lo(~0u, zb_)) == 0u) {
        unsigned* bar = b.bar;
        __builtin_amdgcn_s_waitcnt(0);
        unsigned nloc = b.st[0], nx = b.st[1];
        if (nloc == 0u) { xcd_barrier_complete(bar, b.x, nloc, nx); b.st[0] = nloc; b.st[1] = nx; }
        const unsigned old = xb_add(&bar[XB_XSUB(b.x)], 1u);
        const unsigned gen = old / nloc;
        if (old + 1u == (gen + 1u) * nloc) {
            __builtin_amdgcn_fence(__ATOMIC_RELEASE, "agent");
            asm volatile("s_waitcnt vmcnt(0)" ::: "memory");
            const unsigned og = xb_add(&bar[XB_TOP], 1u);
            const unsigned tg = og / nx;
            if (og + 1u == (tg + 1u) * nx) xb_add(&bar[XB_TOPGEN], 1u);
            else XB_SPIN(xb_ld(&bar[XB_TOPGEN]) == tg, bar);
            __builtin_amdgcn_fence(__ATOMIC_ACQUIRE, "agent");
            xb_add(&bar[XB_XGEN(b.x)], 1u);
            asm volatile("s_waitcnt vmcnt(0)" ::: "memory");
        } else {
            XB_SPIN(xb_ld(&bar[XB_XGEN(b.x)]) == gen, bar);
            __builtin_amdgcn_fence(__ATOMIC_ACQUIRE, "agent");
            asm volatile("s_waitcnt vmcnt(0)" ::: "memory");
        }
    }
    __syncthreads();
}

struct Args {
    const float* x; const float* attn_g; const float* w_in; const float* a_sink; const float* w_a; const float* w_b; const float* w_out; const float* ffn_g;
    const float* w_rg; const float* b_rg; const float* w_re; const float* b_re; const float* w_eg; const float* w_eu; const float* w_ed; const float* fin_g;
    float* out; unsigned char* ws; int ph_lo, ph_hi;
};
typedef const __attribute__((address_space(4))) Args* CArgs;
struct Frame {
    LAS unsigned char* lds; volatile LAS int* misc;
    int wave, G, vcu, gw, ngw, bx;
};
__device__ __forceinline__ int otid() { unsigned z = 0u; asm volatile("" : "+v"(z)); return (int)__builtin_amdgcn_mbcnt_hi(~0u, __builtin_amdgcn_mbcnt_lo(~0u, z)); }
__device__ __forceinline__ float shx(float v, int o, int lane) { return __int_as_float(__builtin_amdgcn_ds_bpermute((lane ^ o) << 2, __float_as_int(v))); }
__device__ __forceinline__ float wave_sum(float v, int lane) {
#pragma unroll
    for (int o = 1; o < 64; o <<= 1) v += shx(v, o, lane);
    return v;
}

struct MapPlain { __device__ __forceinline__ int operator()(int n) const { return n; } };
struct MapWin { __device__ __forceinline__ int operator()(int n) const {
        bool rope = false;
        if (n < 640) rope = true; else if (n >= 768 && n < NQKV) rope = ((n - 768) % 768) < 512;
        if (!rope) return n; const int d = n & 63; return (n & ~63) + 2 * (d & 31) + (d >> 5); } };
struct MapGU { int t; __device__ __forceinline__ int operator()(int n) const { return 2 * n + t; } };
template <class Map> __device__ __forceinline__ void transpose_item64(const float* W, int ldn, int k0, int n0, const float* gk, bf16* WT, int Kd, const Map& map, LAS float* scr, int lane) {
    const int kq = lane >> 4, n4 = (lane & 15) * 4;
    const float* src = W + (size_t)(k0 + kq) * ldn + n0 + n4;
    f32x4 v[16];
#pragma unroll
    for (int i = 0; i < 16; ++i) v[i] = *(const f32x4*)(src + (size_t)(4 * i) * ldn);
    if (gk) {
#pragma unroll
        for (int i = 0; i < 16; ++i) v[i] = v[i] * gk[k0 + 4 * i + kq];
    }
#pragma unroll
    for (int i = 0; i < 16; ++i) { LAS float* d = scr + (4 * i + kq) * 65 + n4; d[0] = v[i][0]; d[1] = v[i][1]; d[2] = v[i][2]; d[3] = v[i][3]; }
    LDS_WAIT(); asm volatile("" ::: "memory");
    const int c = lane & 7;
#pragma unroll
    for (int j = 0; j < 8; ++j) { const int n = (lane >> 3) + 8 * j; const LAS float* p = scr + (8 * c) * 65 + n;
        u32x4 o; o.x = cvtpk(p[0 * 65], p[1 * 65]); o.y = cvtpk(p[2 * 65], p[3 * 65]); o.z = cvtpk(p[4 * 65], p[5 * 65]); o.w = cvtpk(p[6 * 65], p[7 * 65]);
        *(u32x4*)(WT + (size_t)map(n0 + n) * Kd + k0 + 8 * c) = o; }
    LDS_WAIT(); asm volatile("" ::: "memory");
}
__device__ __forceinline__ void prep_phase(const Frame& F, CArgs a) {
    const int lane = otid(), tid = F.wave * 64 + lane; (void)tid; (void)lane;
    unsigned char* ws = a->ws;
    LAS float* scr = (LAS float*)(F.lds + F.wave * PREP_SCR);
    constexpr int I_IN = 16 * 80, I_A = 8 * 16, I_B = 4 * 16, I_O = 16 * 16, I_L = I_IN + I_A + I_B + I_O;
    for (int it = F.gw; it < DEPTH * I_L; it += F.ngw) {
        const int l = it / I_L; int r = it - l * I_L;
        unsigned char* wl = ws + (size_t)l * WNE_LSTRIDE;
        if (r < I_IN) { transpose_item64(a->w_in + (size_t)l * DM * DIN, DIN, 64 * (r / 80), 64 * (r % 80), a->attn_g + l * DM, (bf16*)(wl + WS_WIN), DM, MapWin{}, scr, lane); continue; } r -= I_IN;
        if (r < I_A) { transpose_item64(a->w_a + (size_t)l * 512 * DM, DM, 64 * (r / 16), 64 * (r % 16), nullptr, (bf16*)(wl + WS_WA), 512, MapPlain{}, scr, lane); continue; } r -= I_A;
        if (r < I_B) { transpose_item64(a->w_b + (size_t)l * 256 * DM, DM, 64 * (r / 16), 64 * (r % 16), nullptr, (bf16*)(wl + WS_WB), 256, MapPlain{}, scr, lane); continue; } r -= I_B;
        transpose_item64(a->w_out + (size_t)l * DM * DM, DM, 64 * (r / 16), 64 * (r % 16), nullptr, (bf16*)(wl + WS_WOUT), DM, MapPlain{}, scr, lane);
    }
    for (int idx = F.bx * NTHREADS + tid; idx < DEPTH * 32 * 3 * 64 * 8; idx += F.G * NTHREADS) {
        const int l = idx / (32 * 3 * 64 * 8), id = idx - l * (32 * 3 * 64 * 8);
        const int j = id & 7, ln = (id >> 3) & 63, q = id >> 9, nt = q % 3, i = q / 3;
        const int k = 32 * i + 8 * (ln >> 4) + j, n = 16 * nt + (ln & 15);
        const float* wg = a->w_rg + (size_t)l * DM * 4; const float* we = a->w_re + (size_t)l * DM * NEXP;
        float v = 0.f; if (n < 4) v = wg[k * 4 + n]; else if (n < 36) v = we[k * NEXP + (n - 4)];
        ((float*)(ws + WS_WR + l * WR_LSTRIDE))[id] = v * a->ffn_g[l * DM + k];
    }
    {
        float* rt = (float*)(ws + WS_ROPE);
        for (int idx = F.bx * NTHREADS + tid; idx < SEQ * 32; idx += F.G * NTHREADS) {
            const int pos = idx >> 5, i = idx & 31;
            const float inv = 1.0f / powf(10000.0f, (float)(2 * i) / 64.0f);
            const float ang = (float)pos * inv;
            const double ad = (double)ang, kd = __builtin_rint(ad * 0.15915494309189535);
            const float rf = (float)__builtin_fma(-kd, 6.283185307179586, ad);
            rt[idx * 2] = cosf(rf); rt[idx * 2 + 1] = sinf(rf);
        }
        bf16* xb = (bf16*)(ws + WS_XB); float* rs1 = (float*)(ws + WS_RS1);
        for (int m = F.gw; m < MTOK; m += F.ngw) {
            const f32x4* xr = (const f32x4*)(a->x + (size_t)m * DM) + lane;
            f32x4 v[4]; float s = 0.f;
#pragma unroll
            for (int j = 0; j < 4; ++j) { v[j] = xr[64 * j]; s += (v[j][0] * v[j][0] + v[j][1] * v[j][1]) + (v[j][2] * v[j][2] + v[j][3] * v[j][3]); }
            s = wave_sum(s, lane);
            u32x2* o = (u32x2*)(xb + (size_t)m * DM) + lane;
#pragma unroll
            for (int j = 0; j < 4; ++j) { u32x2 w; w.x = cvtpk(v[j][0], v[j][1]); w.y = cvtpk(v[j][2], v[j][3]); o[64 * j] = w; }
            if (lane == 0) rs1[m] = 1.0f / sqrtf(s * (1.0f / DM) + NORM_EPS);
        }
    }
}
__device__ __forceinline__ void prep_experts(const Frame& F, CArgs a, int l, int lane) {
    unsigned char* ws = a->ws;
    LAS float* scr = (LAS float*)(F.lds + F.wave * PREP_SCR);
    constexpr int I_G = 16 * 4, I_D = 4 * 16, I_E = 2 * I_G + I_D;
    const float* fg = a->ffn_g + l * DM;
    for (int it = F.gw; it < NEXP * I_E; it += F.ngw) {
        const int e = it / I_E; int r = it - e * I_E;
        const size_t eo = ((size_t)l * NEXP + e) * DM * DEXP;
        if (r < 2 * I_G) { const int t = r / I_G; r -= t * I_G; const float* W = (t ? a->w_eu : a->w_eg) + eo;
            transpose_item64(W, DEXP, 64 * (r / 4), 64 * (r % 4), fg, (bf16*)(ws + WS_WGU) + (size_t)e * 512 * DM, DM, MapGU{t}, scr, lane); continue; } r -= 2 * I_G;
        transpose_item64(a->w_ed + eo, DM, 64 * (r / 16), 64 * (r % 16), nullptr, (bf16*)(ws + WS_WD) + (size_t)e * DM * DEXP, DEXP, MapPlain{}, scr, lane);
    }
}

__device__ __forceinline__ int crow(int r, int hi) { return (r & 3) + 8 * (r >> 2) + 4 * hi; }
struct AttnUnit { int kcol, vcol, b, d, r, t0, span, W, qcol, tq; float m0, l0; bf16* outp; int opitch; float* lsep; bool valid; };
__device__ __forceinline__ AttnUnit attn_decode(int idx, int G, int bx, int wave, int l, CArgs a, bf16* ya, bf16* ob, float* lse) {
    AttnUnit U; U.valid = false;
    const int nA = (BATCH * 2 * 64 - bx + G - 1) / G;
    if (idx < nA) {
        const int u = bx + idx * G; const int qb = u & 63, kvh = (u >> 6) & 1, b = u >> 7; const int g = wave >> 1, hq = kvh * 4 + g;
        U.kcol = 512 + kvh * 64; U.vcol = 640 + kvh * 64; U.b = b; U.d = 1; U.r = 0; U.t0 = 2 * qb; U.span = 2; U.W = 4; U.qcol = hq * 64; U.tq = 2 * qb + (wave & 1);
        U.m0 = a->a_sink[l * 8 + hq] * LOG2E; U.l0 = 1.0f; U.outp = ya + hq * 64; U.opitch = 512; U.lsep = nullptr; U.valid = true; return U;
    }
    const int u = bx + (idx - nA) * G;
    if (u < 3 * 256) {
        const int grp = u >> 8; int q = u & 255;
        const int d = grp == 0 ? 1 : (grp == 1 ? 4 : 16), bpr = 16 / d;
        const int blk = q % bpr; q /= bpr; const int res = q % d; q /= d; const int h = q & 3, b = q >> 2;
        const int base = 768 + 768 * grp;
        U.kcol = base + 256 + h * 64; U.vcol = base + 512 + h * 64; U.b = b; U.d = d; U.r = res; U.t0 = 8 * blk; U.span = 8; U.W = 2; U.qcol = base + h * 64; U.tq = 8 * blk + wave;
        U.m0 = -1e30f; U.l0 = 0.0f; U.outp = ob + grp * 256 + h * 64; U.opitch = 768; U.lsep = lse + grp * 4 + h; U.valid = true;
    }
    return U;
}
__device__ __forceinline__ void attn_fetch(const bf16* P, const AttnUnit& U, int tid, u32x4 (&buf)[12]) {
    const int L32 = (SEQ / U.d) >> 5, jbase = U.t0 - U.W, ntile = U.span + 2 * U.W, nch = ntile * 512;
    const size_t tok0 = (size_t)U.b * SEQ + U.r;
#pragma unroll
    for (int i = 0; i < 12; ++i) {
        const int c = tid + 512 * i;
        if (c < nch) {
            const int kv = c >= ntile * 256, cc = kv ? c - ntile * 256 : c, row = cc >> 3, ch = cc & 7, tile = row >> 5, rr = row & 31, j = jbase + tile;
            if (j >= 0 && j < L32) buf[i] = *(const u32x4*)(P + (tok0 + (size_t)(32 * j + rr) * U.d) * NQKV + (kv ? U.vcol : U.kcol) + ch * 8);
        }
    }
}
__device__ __forceinline__ void attn_stage(const AttnUnit& U, int tid, const u32x4 (&buf)[12], LAS unsigned char* lds) {
    const int L32 = (SEQ / U.d) >> 5, jbase = U.t0 - U.W, ntile = U.span + 2 * U.W, nch = ntile * 512;
    LAS unsigned char* kimg = lds; LAS unsigned char* vimg = lds + ntile * 4096;
#pragma unroll
    for (int i = 0; i < 12; ++i) {
        const int c = tid + 512 * i;
        if (c < nch) {
            const int kv = c >= ntile * 256, cc = kv ? c - ntile * 256 : c, row = cc >> 3, ch = cc & 7, tile = row >> 5, rr = row & 31, j = jbase + tile;
            if (j >= 0 && j < L32) *(LAS u32x4*)((kv ? vimg : kimg) + tile * 4096 + rr * 128 + (kv ? ch : (ch ^ (rr & 7))) * 16) = buf[i];
        }
    }
}
__device__ __forceinline__ void attn_compute(const bf16* P, const AttnUnit& U, const bf16x8 (&qf)[4], LAS unsigned char* lds, int lane) {
    const int r32 = lane & 31, hi = lane >> 5;
    const int d = U.d, W = U.W, tq = U.tq;
    const int L32 = (SEQ / d) >> 5;
    const size_t tok0 = (size_t)U.b * SEQ + U.r;
    const int jbase = U.t0 - W, ntile = U.span + 2 * W;
    LAS unsigned char* kimg = lds; LAS unsigned char* vimg = lds + ntile * 4096;
    const size_t qtok = tok0 + (size_t)(32 * tq + r32) * d;
    f32x16 o0 = {}, o1 = {};
    float mrun = U.m0, lrun = U.l0;
    const int jlo = (tq - W) < 0 ? 0 : (tq - W), jhi = (tq + W) > (L32 - 1) ? (L32 - 1) : (tq + W);
    const int vrd = (4 * hi + ((lane & 15) >> 2)) * 128 + (16 * ((lane >> 4) & 1) + 4 * (lane & 3)) * 2;
    const int krd = r32 * 128;
#define VTR(p, off) __builtin_bit_cast(s16x4, __builtin_amdgcn_ds_read_tr16_b64_v4i16((LAS s16x4*)((p) + (off))))
    bf16x8 kn[4];
    { const LAS unsigned char* kl = kimg + (jlo - jbase) * 4096 + krd;
#pragma unroll
      for (int s = 0; s < 4; ++s) kn[s] = *(const LAS bf16x8*)(kl + (((2 * s + hi) ^ (r32 & 7)) * 16)); }
    for (int j = jlo; j <= jhi; ++j) {
        const LAS unsigned char* vl = vimg + (j - jbase) * 4096 + vrd;
        bf16x8 kf[4];
#pragma unroll
        for (int s = 0; s < 4; ++s) kf[s] = kn[s];
        s16x4 va[4], vb[4];
#pragma unroll
        for (int q = 0; q < 4; ++q) { va[q] = VTR(vl, (16 * (q & 1)) * 128 + (q >> 1) * 64); vb[q] = VTR(vl, (16 * (q & 1) + 8) * 128 + (q >> 1) * 64); }
        if (j < jhi) { const LAS unsigned char* kl = kimg + (j + 1 - jbase) * 4096 + krd;
#pragma unroll
            for (int s = 0; s < 4; ++s) kn[s] = *(const LAS bf16x8*)(kl + (((2 * s + hi) ^ (r32 & 7)) * 16)); }
        __builtin_amdgcn_sched_barrier(0);
        f32x16 sc = {};
#pragma unroll
        for (int s = 0; s < 4; ++s) sc = __builtin_amdgcn_mfma_f32_32x32x16_bf16(kf[s], qf[s], sc, 0, 0, 0);
        if (j == tq - W) {
#pragma unroll
            for (int g = 0; g < 16; ++g) if (crow(g, hi) < r32) sc[g] = -INFINITY;
        }
        if (j == tq + W) {
#pragma unroll
            for (int g = 0; g < 16; ++g) if (crow(g, hi) > r32) sc[g] = -INFINITY;
        }
        float mx = fmaxf(fmaxf(sc[0], sc[1]), fmaxf(sc[2], sc[3]));
#pragma unroll
        for (int g = 4; g < 16; g += 4) mx = fmaxf(mx, fmaxf(fmaxf(sc[g], sc[g + 1]), fmaxf(sc[g + 2], sc[g + 3])));
        { const auto rr = __builtin_amdgcn_permlane32_swap(__float_as_uint(mx), __float_as_uint(mx), false, false); mx = fmaxf(__uint_as_float(rr[0]), __uint_as_float(rr[1])); }
        if (__any(mx > mrun + 8.0f)) {
            const float mnew = fmaxf(mrun, mx);
            const float alpha = fast_exp2(mrun - mnew);
            lrun *= alpha; mrun = mnew;
#pragma unroll
            for (int g = 0; g < 16; ++g) { o0[g] *= alpha; o1[g] *= alpha; }
        }
        float psum = 0.f;
#pragma unroll
        for (int g = 0; g < 16; ++g) { sc[g] = fast_exp2(sc[g] - mrun); psum += sc[g]; }
        { const auto rr = __builtin_amdgcn_permlane32_swap(__float_as_uint(psum), __float_as_uint(psum), false, false); psum = __uint_as_float(rr[0]) + __uint_as_float(rr[1]); }
        lrun += psum;
        u32x4 p0, p1;
        p0.x = cvtpk(sc[0], sc[1]); p0.y = cvtpk(sc[2], sc[3]); p0.z = cvtpk(sc[4], sc[5]); p0.w = cvtpk(sc[6], sc[7]);
        p1.x = cvtpk(sc[8], sc[9]); p1.y = cvtpk(sc[10], sc[11]); p1.z = cvtpk(sc[12], sc[13]); p1.w = cvtpk(sc[14], sc[15]);
        const bf16x8 pf0 = __builtin_bit_cast(bf16x8, p0), pf1 = __builtin_bit_cast(bf16x8, p1);
#define VFR(q) ((bf16x8){va[q][0], va[q][1], va[q][2], va[q][3], vb[q][0], vb[q][1], vb[q][2], vb[q][3]})
        o0 = __builtin_amdgcn_mfma_f32_32x32x16_bf16(VFR(0), pf0, o0, 0, 0, 0);
        o0 = __builtin_amdgcn_mfma_f32_32x32x16_bf16(VFR(1), pf1, o0, 0, 0, 0);
        o1 = __builtin_amdgcn_mfma_f32_32x32x16_bf16(VFR(2), pf0, o1, 0, 0, 0);
        o1 = __builtin_amdgcn_mfma_f32_32x32x16_bf16(VFR(3), pf1, o1, 0, 0, 0);
#undef VFR
    }
#undef VTR
    const float inv = 1.0f / lrun;
    bf16* orow = U.outp + qtok * U.opitch;
#pragma unroll
    for (int g4 = 0; g4 < 4; ++g4) {
        u32x2 w0, w1;
        w0.x = cvtpk(o0[4 * g4] * inv, o0[4 * g4 + 1] * inv); w0.y = cvtpk(o0[4 * g4 + 2] * inv, o0[4 * g4 + 3] * inv);
        w1.x = cvtpk(o1[4 * g4] * inv, o1[4 * g4 + 1] * inv); w1.y = cvtpk(o1[4 * g4 + 2] * inv, o1[4 * g4 + 3] * inv);
        *(u32x2*)(orow + 8 * g4 + 4 * hi) = w0;
        *(u32x2*)(orow + 32 + 8 * g4 + 4 * hi) = w1;
    }
    if (U.lsep && hi == 0) U.lsep[qtok * 12] = (mrun + log2f(lrun)) * LN2;
}
__device__ __forceinline__ void attn_phase(const Frame& F, CArgs a, int l) {
    const int lane = otid(), tid = F.wave * 64 + lane; (void)tid; (void)lane;
    unsigned char* ws = a->ws;
    const bf16* P = (const bf16*)(ws + WS_PQ);
    bf16* ya = (bf16*)(ws + WS_YA); bf16* ob = (bf16*)a->out; float* lse = (float*)(ws + WS_LSE);
    const int r32 = lane & 31, hi = lane >> 5;
    u32x4 buf[12];
    AttnUnit U = attn_decode(0, F.G, F.bx, F.wave, l, a, ya, ob, lse);
    if (U.valid) attn_fetch(P, U, tid, buf);
    for (int idx = 0; U.valid; ++idx) {
        attn_stage(U, tid, buf, F.lds);
        bf16x8 qf[4];
        { const size_t qtok = (size_t)U.b * SEQ + U.r + (size_t)(32 * U.tq + r32) * U.d;
#pragma unroll
          for (int s = 0; s < 4; ++s) qf[s] = *(const bf16x8*)(P + qtok * NQKV + U.qcol + 16 * s + 8 * hi); }
        const AttnUnit Un = attn_decode(idx + 1, F.G, F.bx, F.wave, l, a, ya, ob, lse);
        __syncthreads();
        if (Un.valid) attn_fetch(P, Un, tid, buf);
        attn_compute(P, U, qf, F.lds, lane);
        __syncthreads();
        U = Un;
    }
    prep_experts(F, a, l, lane);
}
__device__ __forceinline__ void comb_phase(const Frame& F, CArgs a) {
    const int lane = otid(), tid = F.wave * 64 + lane; (void)tid; (void)lane;
    unsigned char* ws = a->ws;
    const bf16* ob = (const bf16*)a->out; const float* lse = (const float*)(ws + WS_LSE); bf16* yb = (bf16*)(ws + WS_YB);
    for (int idx = F.bx * NTHREADS + tid; idx < MTOK * 32; idx += F.G * NTHREADS) {
        const int tok = idx >> 5, c = idx & 31, h = c >> 3;
        const float l0 = lse[tok * 12 + h], l1 = lse[tok * 12 + 4 + h], l2 = lse[tok * 12 + 8 + h];
        const float mx = fmaxf(l0, fmaxf(l1, l2));
        float w0 = __expf(l0 - mx), w1 = __expf(l1 - mx), w2 = __expf(l2 - mx);
        const float inv = 1.0f / (w0 + w1 + w2); w0 *= inv; w1 *= inv; w2 *= inv;
        const u32x4 a0 = *(const u32x4*)(ob + (size_t)tok * 768 + c * 8), a1 = *(const u32x4*)(ob + (size_t)tok * 768 + 256 + c * 8), a2 = *(const u32x4*)(ob + (size_t)tok * 768 + 512 + c * 8);
        u32x4 o;
#define CMB(f) o.f = cvtpk(w0 * bflo(a0.f) + w1 * bflo(a1.f) + w2 * bflo(a2.f), w0 * bfhi(a0.f) + w1 * bfhi(a1.f) + w2 * bfhi(a2.f))
        CMB(x); CMB(y); CMB(z); CMB(w);
#undef CMB
        *(u32x4*)(yb + (size_t)tok * 256 + c * 8) = o;
    }
}

__device__ __forceinline__ void route_phase(const Frame& F, CArgs a, int l) {
    const int lane = otid(), tid = F.wave * 64 + lane;
    unsigned char* ws = a->ws;
    const bf16* xbf = (const bf16*)(ws + WS_XB); const f32x4* wrp = (const f32x4*)(ws + WS_WR + l * WR_LSTRIDE);
    float* rs2 = (float*)(ws + WS_RS2); i32x4* tokinfo = (i32x4*)(ws + WS_TOKINFO); int* ltok = (int*)(ws + WS_LTOK); float* lw = (float*)(ws + WS_LW);
    int* cnt = (int*)(ws + WS_CTL) + CW_CNT + l * 32 * CNT_STRIDE;
    const float* brg = a->b_rg + l * 4; const float* bre = a->b_re + l * NEXP;
    LAS f32x4* part = (LAS f32x4*)(F.lds);
    LAS float* ssp = (LAS float*)(F.lds + 12288);
    LAS float* Lg = (LAS float*)(F.lds + 16384);
    LAS float* rsL = (LAS float*)(F.lds + 16384 + 12288);
    LAS int* lcnt = (LAS int*)(F.lds + 16384 + 12288 + 256);
    LAS int* lbase = lcnt + 32;
    const int rt = F.wave & 3, kh = F.wave >> 2;
    if (tid < 32) lcnt[tid] = 0;
    __syncthreads();
    for (int blk = F.bx; blk < MTOK / 64; blk += F.G) {
        const int row0 = blk * 64 + rt * 16;
        const u32x4* xr = (const u32x4*)(xbf + (size_t)(row0 + (lane & 15)) * DM + kh * 512) + (lane >> 4);
        const f32x4* wp = wrp + (size_t)(kh * 16) * 3 * 128 + lane * 2;
        f32x4 acc0 = {0.f, 0.f, 0.f, 0.f}, acc1 = acc0, acc2 = acc0; float ss = 0.f;
#pragma unroll 4
        for (int i = 0; i < 16; ++i) {
            const u32x4 xw = xr[4 * i];
            const f32x4 w0a = wp[(i * 3 + 0) * 128], w0b = wp[(i * 3 + 0) * 128 + 1], w1a = wp[(i * 3 + 1) * 128], w1b = wp[(i * 3 + 1) * 128 + 1], w2a = wp[(i * 3 + 2) * 128], w2b = wp[(i * 3 + 2) * 128 + 1];
            const float xv[8] = {bflo(xw.x), bfhi(xw.x), bflo(xw.y), bfhi(xw.y), bflo(xw.z), bfhi(xw.z), bflo(xw.w), bfhi(xw.w)};
#pragma unroll
            for (int j = 0; j < 8; ++j) ss += xv[j] * xv[j];
#pragma unroll
            for (int s = 0; s < 4; ++s) {
                acc0 = __builtin_amdgcn_mfma_f32_16x16x4f32(xv[s], w0a[s], acc0, 0, 0, 0);
                acc1 = __builtin_amdgcn_mfma_f32_16x16x4f32(xv[s], w1a[s], acc1, 0, 0, 0);
                acc2 = __builtin_amdgcn_mfma_f32_16x16x4f32(xv[s], w2a[s], acc2, 0, 0, 0);
            }
#pragma unroll
            for (int s = 0; s < 4; ++s) {
                acc0 = __builtin_amdgcn_mfma_f32_16x16x4f32(xv[4 + s], w0b[s], acc0, 0, 0, 0);
                acc1 = __builtin_amdgcn_mfma_f32_16x16x4f32(xv[4 + s], w1b[s], acc1, 0, 0, 0);
                acc2 = __builtin_amdgcn_mfma_f32_16x16x4f32(xv[4 + s], w2b[s], acc2, 0, 0, 0);
            }
        }
        ss += shx(ss, 16, lane); ss += shx(ss, 32, lane);
        if (kh == 1) { part[(rt * 3 + 0) * 64 + lane] = acc0; part[(rt * 3 + 1) * 64 + lane] = acc1; part[(rt * 3 + 2) * 64 + lane] = acc2; if (lane < 16) ssp[rt * 16 + lane] = ss; }
        __syncthreads();
        if (kh == 0) {
            acc0 += part[(rt * 3 + 0) * 64 + lane]; acc1 += part[(rt * 3 + 1) * 64 + lane]; acc2 += part[(rt * 3 + 2) * 64 + lane];
            ss += ssp[rt * 16 + (lane & 15)];
#pragma unroll
            for (int g = 0; g < 4; ++g) { const int rw = rt * 16 + 4 * (lane >> 4) + g; Lg[rw * 48 + (lane & 15)] = acc0[g]; Lg[rw * 48 + 16 + (lane & 15)] = acc1[g]; Lg[rw * 48 + 32 + (lane & 15)] = acc2[g]; }
            if (lane < 16) rsL[rt * 16 + lane] = 1.0f / sqrtf(ss * (1.0f / DM) + NORM_EPS);
        }
        __syncthreads();
        int e1 = 0, e2 = 0, r1 = 0, r2 = 0; float w1 = 0.f, w2 = 0.f, rsv = 0.f;
        if (tid < 64) {
            const LAS float* Lr = Lg + tid * 48; rsv = rsL[tid];
            float gl[4];
#pragma unroll
            for (int g = 0; g < 4; ++g) gl[g] = Lr[g] * rsv + brg[g];
            int gi = 0; float gm = gl[0];
#pragma unroll
            for (int g = 1; g < 4; ++g) if (gl[g] > gm) { gm = gl[g]; gi = g; }
            float den = 0.f;
#pragma unroll
            for (int g = 0; g < 4; ++g) den += expf(gl[g] - gm);
            const float gw = 1.0f / den;
            float v1 = -INFINITY, v2 = -INFINITY; int i1 = 0, i2 = 0;
#pragma unroll
            for (int e = 0; e < 8; ++e) {
                const float v = Lr[4 + 8 * gi + e] * rsv + bre[8 * gi + e];
                if (v > v1) { v2 = v1; i2 = i1; v1 = v; i1 = e; } else if (v > v2) { v2 = v; i2 = e; }
            }
            const float p1 = 1.0f / (1.0f + expf(v2 - v1));
            e1 = 8 * gi + i1; e2 = 8 * gi + i2; w1 = p1 * gw; w2 = (1.0f - p1) * gw;
            r1 = __hip_atomic_fetch_add(&lcnt[e1], 1, __ATOMIC_RELAXED, __HIP_MEMORY_SCOPE_WORKGROUP); r2 = __hip_atomic_fetch_add(&lcnt[e2], 1, __ATOMIC_RELAXED, __HIP_MEMORY_SCOPE_WORKGROUP);
        }
        __syncthreads();
        if (tid < 32) { const int c = lcnt[tid]; lbase[tid] = c ? atomicAdd(&cnt[tid * CNT_STRIDE], c) : 0; lcnt[tid] = 0; }
        __syncthreads();
        if (tid < 64) {
            const int tok = blk * 64 + tid;
            const int pos1 = lbase[e1] + r1, pos2 = lbase[e2] + r2;
            ltok[e1 * MTOK + pos1] = tok; lw[e1 * MTOK + pos1] = w1;
            ltok[e2 * MTOK + pos2] = tok; lw[e2 * MTOK + pos2] = w2;
            tokinfo[tok] = (i32x4){e1, pos1, e2, pos2};
            rs2[tok] = rsv;
        }
        __syncthreads();
    }
}
__device__ __forceinline__ MoeTab moe_tables(const Frame& F, CArgs a, int l) {
    const int lane = otid(), tid = F.wave * 64 + lane; (void)tid; (void)lane;
    volatile LAS int* cntL = F.misc + 64; volatile LAS int* mtp = F.misc + 128; volatile LAS int* sp = F.misc + 192;
    const int* cnt = (const int*)(a->ws + WS_CTL) + CW_CNT + l * 32 * CNT_STRIDE;
    __syncthreads();
    if (tid < 32) cntL[tid] = __hip_atomic_load(cnt + tid * CNT_STRIDE, __ATOMIC_RELAXED, __HIP_MEMORY_SCOPE_AGENT);
    __syncthreads();
    if (tid == 0) { int mt = 0, s = 0; for (int e = 0; e < 32; ++e) { mtp[e] = mt; sp[e] = s; const int c = cntL[e]; mt += (c + 255) >> 8; s += c; } mtp[32] = mt; sp[32] = s; }
    __syncthreads();
    MoeTab T; T.cnt = cntL; T.mtpref = mtp; T.spref = sp; return T;
}
__device__ __forceinline__ void fin_phase(const Frame& F, CArgs a, int l, const MoeTab& T) {
    const int lane = otid(), tid = F.wave * 64 + lane; (void)tid;
    unsigned char* ws = a->ws;
    const i32x4* tokinfo = (const i32x4*)(ws + WS_TOKINFO); const bf16* Y = (const bf16*)(ws + WS_Y);
    bf16* xb = (bf16*)(ws + WS_XB); float* rs1 = (float*)(ws + WS_RS1);
    const int step = 2 * F.ngw;
    int m0 = 2 * F.gw;
    i32x4 tn0 = tokinfo[m0 < MTOK ? m0 : 0], tn1 = tokinfo[m0 + 1 < MTOK ? m0 + 1 : 0];
    for (; m0 < MTOK; m0 += step) {
        const i32x4 ti[2] = {tn0, tn1};
        const int mn = m0 + step;
        if (mn < MTOK) { tn0 = tokinfo[mn]; tn1 = tokinfo[mn + 1]; }
        u32x4 xv[2][2], p[2][2], q[2][2];
#pragma unroll
        for (int r = 0; r < 2; ++r) {
            const int m = m0 + r;
            const int s1 = T.spref[ti[r][0]] + ti[r][1], s2 = T.spref[ti[r][2]] + ti[r][3];
            const u32x4* xr = (const u32x4*)(xb + (size_t)m * DM) + lane;
            const u32x4* y1 = (const u32x4*)(Y + (size_t)s1 * DM) + lane; const u32x4* y2 = (const u32x4*)(Y + (size_t)s2 * DM) + lane;
#pragma unroll
            for (int j = 0; j < 2; ++j) { xv[r][j] = xr[64 * j]; p[r][j] = y1[64 * j]; q[r][j] = y2[64 * j]; }
        }
#pragma unroll
        for (int r = 0; r < 2; ++r) {
            const int m = m0 + r;
            float v[2][8]; float s = 0.f;
#pragma unroll
            for (int j = 0; j < 2; ++j) {
#define FINC(c, f) v[j][2 * c] = bflo(xv[r][j].f) + bflo(p[r][j].f) + bflo(q[r][j].f); v[j][2 * c + 1] = bfhi(xv[r][j].f) + bfhi(p[r][j].f) + bfhi(q[r][j].f);
                FINC(0, x) FINC(1, y) FINC(2, z) FINC(3, w)
#undef FINC
#pragma unroll
                for (int c = 0; c < 8; ++c) s += v[j][c] * v[j][c];
            }
            s = wave_sum(s, lane);
            const float rsv = 1.0f / sqrtf(s * (1.0f / DM) + NORM_EPS);
            if (l == DEPTH - 1) {
#pragma unroll
                for (int j = 0; j < 2; ++j) {
                    const f32x4* g = (const f32x4*)(a->fin_g + 512 * j + 8 * lane); f32x4* o = (f32x4*)(a->out + (size_t)m * DM + 512 * j + 8 * lane);
                    const f32x4 g0 = g[0], g1 = g[1];
                    o[0] = (f32x4){v[j][0] * rsv * g0[0], v[j][1] * rsv * g0[1], v[j][2] * rsv * g0[2], v[j][3] * rsv * g0[3]};
                    o[1] = (f32x4){v[j][4] * rsv * g1[0], v[j][5] * rsv * g1[1], v[j][6] * rsv * g1[2], v[j][7] * rsv * g1[3]};
                }
            } else {
                u32x4* o = (u32x4*)(xb + (size_t)m * DM) + lane;
#pragma unroll
                for (int j = 0; j < 2; ++j) { u32x4 w; w.x = cvtpk(v[j][0], v[j][1]); w.y = cvtpk(v[j][2], v[j][3]); w.z = cvtpk(v[j][4], v[j][5]); w.w = cvtpk(v[j][6], v[j][7]); o[64 * j] = w; }
                if (lane == 0) rs1[m] = rsv;
            }
        }
    }
}

constexpr int PH_PREP = 0, PH_GEMM1 = 1, PH_ATTN = 2, PH_COMB = 3, PH_MERGE = 4, PH_OUT = 5, PH_ROUTE = 6, PH_UP = 7, PH_DOWN = 8, PH_DOWN2 = 9, PH_FIN = 10, PH_PER_LAYER = 11, NPHASE = PH_PER_LAYER * DEPTH - 1;

__global__ void __launch_bounds__(NTHREADS, 2) fwd_kernel(Args a_by_value) {
    extern __shared__ __attribute__((aligned(16))) unsigned char lds_raw[];
    Frame F;
    F.lds = (LAS unsigned char*)lds_raw; F.misc = (volatile LAS int*)(F.lds + MISC_OFF);
    F.wave = __builtin_amdgcn_readfirstlane((int)threadIdx.x >> 6);
    F.G = gridDim.x; { const int bx = blockIdx.x; F.vcu = (F.G % 8 == 0) ? (bx % 8) * (F.G / 8) + bx / 8 : bx; }
    F.gw = blockIdx.x * NWAVES + F.wave; F.ngw = F.G * NWAVES;
    CArgs a = (CArgs)__builtin_amdgcn_kernarg_segment_ptr();
    unsigned char* ws = a->ws;
    const int ph_lo = a->ph_lo, ph_hi = a->ph_hi;
    for (int u = threadIdx.x; u < 1024; u += NTHREADS) F.misc[u] = 0;
    __syncthreads();
#if !MK_MULTI
    XcdBarrier bar = xcd_barrier_post((unsigned*)(ws + WS_CTL) + CW_BAR, (volatile LAS unsigned*)(F.misc + 8));
#define GRID_BAR() xcd_barrier(bar, F.wave)
#else
#define GRID_BAR() do { } while (0)
#endif
    for (int ph = ph_lo, rep = 0; ph < ph_hi; ) {
        const int l = ph >= PH_PER_LAYER ? 1 : 0, k = ph >= PH_PER_LAYER ? ph - (PH_PER_LAYER - 1) : ph;
        const size_t wlo = (size_t)l * WNE_LSTRIDE;
        {
            int bx = blockIdx.x; asm volatile("" : "+s"(bx)); asm volatile("" : "+s"(a)); ws = a->ws;
            int wv = F.wave; asm volatile("" : "+s"(wv)); F.gw = bx * NWAVES + wv; F.bx = bx;
        }
        if (k == PH_PREP && (PHMASK & 1)) {
            prep_phase(F, a);
        } else if (k == PH_GEMM1 && (PHMASK & 2)) {
            DenseSched S; S.A = (const char*)(ws + WS_XB); S.Bt = (const char*)(ws + wlo + WS_WIN); S.K = DM; S.lda = DM; S.wave = F.wave; S.so.init(MTOK, DIN, F.G, F.bx);
            EpiProj E{(bf16*)(ws + WS_PQ), (bf16*)(ws + WS_PG), (const float*)(ws + WS_RS1), (const f32x4*)(ws + WS_ROPE)};
            pg8::gemm_phase(F.lds, S, E);
        } else if (k == PH_ATTN && (PHMASK & 4)) {
            attn_phase(F, a, l);
        } else if (k == PH_COMB && (PHMASK & 8)) {
            comb_phase(F, a);
        } else if (k == PH_MERGE && (PHMASK & 16)) {
            { DenseSched S; S.A = (const char*)(ws + WS_YA); S.Bt = (const char*)(ws + wlo + WS_WA); S.K = 512; S.lda = 512; S.wave = F.wave; S.so.init(MTOK, DM, F.G, F.bx);
              EpiGate<false> E{(const bf16*)(ws + WS_PG), nullptr, (bf16*)(ws + WS_M1)};
              pg8::gemm_phase(F.lds, S, E); }
            { DenseSched S; S.A = (const char*)(ws + WS_YB); S.Bt = (const char*)(ws + wlo + WS_WB); S.K = 256; S.lda = 256; S.wave = F.wave; S.so.init(MTOK, DM, F.G, F.bx);
              EpiGate<true> E{(const bf16*)(ws + WS_PG) + DM, (const bf16*)(ws + WS_M1), (bf16*)(ws + WS_MRG)};
              pg8::gemm_phase(F.lds, S, E); }
        } else if (k == PH_OUT && (PHMASK & 32)) {
            DenseSched S; S.A = (const char*)(ws + WS_MRG); S.Bt = (const char*)(ws + wlo + WS_WOUT); S.K = DM; S.lda = DM; S.wave = F.wave; S.so.init(MTOK, DM, F.G, F.bx);
            EpiResid E{(bf16*)(ws + WS_XB)};
            pg8::gemm_phase(F.lds, S, E);
        } else if (k == PH_ROUTE && (PHMASK & 64)) {
            route_phase(F, a, l);
        } else if (k == PH_UP || k == PH_DOWN || k == PH_DOWN2) {
            const MoeTab T = moe_tables(F, a, l);
            const int mtT = T.mtpref[32], nU = 2 * mtT, nU1 = nU < F.G ? nU : F.G, nU2 = nU - nU1, tready = nU1 >> 1;
            const int bx = F.vcu;
            MoeSched<true> SU; SU.A = (const char*)(ws + WS_XB); SU.Bt = (const char*)(ws + WS_WGU); SU.K = DM; SU.lda = DM; SU.wave = F.wave; SU.ntn = 2; SU.bstride_e = (size_t)512 * DM * 2; SU.ltok = (const int*)(ws + WS_LTOK); SU.T = T;
            MoeSched<false> SD; SD.A = (const char*)(ws + WS_H); SD.Bt = (const char*)(ws + WS_WD); SD.K = DEXP; SD.lda = DEXP; SD.wave = F.wave; SD.ntn = 4; SD.bstride_e = (size_t)DM * DEXP * 2; SD.ltok = nullptr; SD.T = T;
            EpiSwiglu EU{(const int*)(ws + WS_LTOK), (const float*)(ws + WS_LW), (const float*)(ws + WS_RS2), (bf16*)(ws + WS_H)};
            EpiY ED{(bf16*)(ws + WS_Y)};
            if (k == PH_UP) { SU.G = F.G; SU.c = bx; SU.lo = 0; SU.hi = nU1; pg8::gemm_phase(F.lds, SU, EU); }
            else if (k == PH_DOWN) {
                if (bx < nU2) { SU.G = nU2; SU.c = bx; SU.lo = nU1; SU.hi = nU; pg8::gemm_phase(F.lds, SU, EU); }
                else { SD.G = F.G - nU2; SD.c = bx - nU2; SD.lo = 0; SD.hi = 4 * tready; pg8::gemm_phase(F.lds, SD, ED); }
            } else { SD.G = F.G; SD.c = bx; SD.lo = 4 * tready; SD.hi = 4 * mtT; pg8::gemm_phase(F.lds, SD, ED); }
        } else if (k == PH_FIN && (PHMASK & 512)) {
            const MoeTab T = moe_tables(F, a, l);
            fin_phase(F, a, l, T);
        }
#if REP_MASK
        if (l == 0 && ((REP_MASK >> k) & 1) && rep < REP_N) { ++rep; GRID_BAR(); continue; }
        rep = 0;
#endif
        if (ph + 1 < ph_hi) GRID_BAR();
        ++ph;
    }
}

extern "C" void kernel_launch(void* const* d_in, const int* in_sizes, int n_in, void* d_out, int out_size, void* d_ws, size_t ws_size, hipStream_t stream) {
    static int grid = 0;
    if (grid == 0) {
        if (n_in != 16 || out_size != MTOK * DM || ws_size < WS_END) { fprintf(stderr, "kernel_launch: unexpected shapes (n_in %d out %d ws %zu)\n", n_in, out_size, ws_size); grid = -1; return; }
        int dev = 0, cus = 0, per_cu = 0;
        if (hipGetDevice(&dev) != hipSuccess || hipDeviceGetAttribute(&cus, hipDeviceAttributeMultiprocessorCount, dev) != hipSuccess) { grid = -1; return; }
        if (hipFuncSetAttribute((const void*)fwd_kernel, hipFuncAttributeMaxDynamicSharedMemorySize, LDS_BYTES) != hipSuccess) { fprintf(stderr, "kernel_launch: hipFuncSetAttribute failed\n"); grid = -1; return; }
        if (hipOccupancyMaxActiveBlocksPerMultiprocessor(&per_cu, (const void*)fwd_kernel, NTHREADS, LDS_BYTES) != hipSuccess || per_cu < 1) { fprintf(stderr, "kernel_launch: occupancy query says %d\n", per_cu); (void)hipGetLastError(); }
        grid = cus;
    }
    if (grid < 0) return;
    (void)hipMemsetAsync((char*)d_ws + WS_CTL, 0, CTL_BYTES, stream);
    Args a{};
    a.x = (const float*)d_in[0]; a.attn_g = (const float*)d_in[1]; a.w_in = (const float*)d_in[2]; a.a_sink = (const float*)d_in[3]; a.w_a = (const float*)d_in[4]; a.w_b = (const float*)d_in[5];
    a.w_out = (const float*)d_in[6]; a.ffn_g = (const float*)d_in[7]; a.w_rg = (const float*)d_in[8]; a.b_rg = (const float*)d_in[9]; a.w_re = (const float*)d_in[10]; a.b_re = (const float*)d_in[11];
    a.w_eg = (const float*)d_in[12]; a.w_eu = (const float*)d_in[13]; a.w_ed = (const float*)d_in[14]; a.fin_g = (const float*)d_in[15];
    a.out = (float*)d_out; a.ws = (unsigned char*)d_ws;
#if MK_MULTI
    for (int ph = 0; ph < NPHASE; ++ph) { a.ph_lo = ph; a.ph_hi = ph + 1; hipLaunchKernelGGL(fwd_kernel, dim3(grid), dim3(NTHREADS), LDS_BYTES, stream, a); }
#else
    a.ph_lo = 0; a.ph_hi = NPHASE;
    void* kargs[] = {&a};
    const hipError_t le = hipLaunchCooperativeKernel((const void*)fwd_kernel, dim3(grid), dim3(NTHREADS), kargs, LDS_BYTES, stream);
    if (le != hipSuccess) fprintf(stderr, "kernel_launch: cooperative launch failed: %s (grid %d)\n", hipGetErrorString(le), grid);
#endif
}
```

```cpp
#include <hip/hip_runtime.h>
#include <hip/hip_cooperative_groups.h>
#include <cstdio>
#include <cstdint>
namespace cg = cooperative_groups;

#ifndef REP_MASK
#define REP_MASK 0
#define REP_N 2
#endif
#ifndef PHMASK
#define PHMASK 1023
#endif
#ifndef MK_MULTI
#define MK_MULTI 0
#endif

#define LAS __attribute__((address_space(3)))
#define GAS __attribute__((address_space(1)))
typedef unsigned short bf16;
typedef short bf16x8 __attribute__((ext_vector_type(8)));
typedef short s16x4 __attribute__((ext_vector_type(4)));
typedef float f32x2 __attribute__((ext_vector_type(2)));
typedef float f32x4 __attribute__((ext_vector_type(4)));
typedef float f32x16 __attribute__((ext_vector_type(16)));
typedef unsigned u32x2 __attribute__((ext_vector_type(2)));
typedef unsigned u32x4 __attribute__((ext_vector_type(4)));
typedef int i32x4 __attribute__((ext_vector_type(4)));
typedef __bf16 bf16x2_t __attribute__((ext_vector_type(2)));

constexpr int BATCH = 4, SEQ = 4096, DM = 1024, DEPTH = 2, MTOK = BATCH * SEQ;
constexpr int NQKV = 3072, NGATE = 2048, DIN = NQKV + NGATE;
constexpr int NEXP = 32, DEXP = 256;
constexpr float NORM_EPS = 1e-6f;
constexpr float LOG2E = 1.4426950408889634f, LN2 = 0.6931471805599453f;
constexpr float QSCALE = 0.125f * LOG2E;
constexpr int NWAVES = 8, NTHREADS = 512;

constexpr size_t MiB = 1u << 20;
constexpr size_t WS_CTL = 0, CTL_BYTES = 1 * MiB;
constexpr size_t WS_ROPE = 1 * MiB;
constexpr size_t WS_WR = 2 * MiB, WR_LSTRIDE = 256 * 1024;
constexpr size_t WS_RS1 = 3 * MiB, WS_RS2 = 3 * MiB + 65536;
constexpr size_t WS_TOKINFO = 5 * MiB;
constexpr size_t WS_LTOK = 6 * MiB, WS_LW = 8 * MiB;
constexpr size_t WS_LSE = 10 * MiB;
constexpr size_t WS_WIN = 12 * MiB, WS_WAB = 22 * MiB, WS_WOUT = 24 * MiB, WNE_LSTRIDE = 14 * MiB;
constexpr size_t WS_WGU = 40 * MiB, WS_WD = 72 * MiB;
constexpr size_t WS_XB = 88 * MiB;
constexpr size_t WS_YAB = 120 * MiB;
constexpr size_t WS_PQ = 144 * MiB;
constexpr size_t WS_MRG = 176 * MiB, WS_H = 208 * MiB;
constexpr size_t WS_PG = 240 * MiB;
constexpr size_t WS_Y = 240 * MiB;
constexpr size_t WS_END = 304 * MiB;
constexpr int CW_CNT = 64, CNT_STRIDE = 64;
constexpr int CW_BAR = 8192;

constexpr int RING_BYTES = 131072;
constexpr int PREP_SCR = 16896;
constexpr int MISC_OFF = 8 * PREP_SCR;
constexpr int LDS_BYTES = 147456;

#define LDS_WAIT() asm volatile("s_waitcnt lgkmcnt(0)" ::: "memory")
#define VM_WAIT() asm volatile("s_waitcnt vmcnt(0)" ::: "memory")
__device__ __forceinline__ unsigned cvtpk(float lo, float hi) { f32x2 v = {lo, hi}; bf16x2_t b = __builtin_convertvector(v, bf16x2_t); return __builtin_bit_cast(unsigned, b); }
__device__ __forceinline__ float bf2f(unsigned short h) { return __uint_as_float(((unsigned)h) << 16); }
__device__ __forceinline__ float bflo(unsigned w) { return __uint_as_float(w << 16); }
__device__ __forceinline__ float bfhi(unsigned w) { return __uint_as_float(w & 0xffff0000u); }
__device__ __forceinline__ float fast_exp2(float x) { return __builtin_amdgcn_exp2f(x); }
__device__ __forceinline__ float fast_rcp(float x) { return __builtin_amdgcn_rcpf(x); }
__device__ __forceinline__ float sigmoidf_fast(float v) { return fast_rcp(1.0f + fast_exp2(-v * LOG2E)); }

namespace pg8 {
constexpr int BM = 256, BK = 64, HALF = 128, HTB = HALF * BK * 2, STAGE_BYTES = 8 * HTB, NXCD = 8, WGM = 4;
__host__ __device__ __forceinline__ int lds_byte(int r, int c) { const int st = (r >> 4) * 2 + (c >> 5), rr = r & 15, cc = c & 31, ob = rr * 64 + cc * 2; return st * 1024 + (ob ^ (((ob >> 9) & 1) << 5)); }
__host__ __device__ __forceinline__ void stage_rc(int b, int& R, int& C) { const int st = b / 1024, sb = b % 1024, swz = sb ^ (((sb >> 9) & 1) << 5); R = (st >> 1) * 16 + swz / 64; C = (st & 1) * 32 + (swz % 64) / 2; }
__host__ __device__ __forceinline__ int perm32(int rho) { const int n = rho >> 4, i = rho & 15; return 8 * (i >> 2) + 4 * n + (i & 3); }

struct Unit { int pm, pn, e, nvalid, slot0, lpos0, nt, kofs, sub; };

struct StaticOrder {
    int nM, nN, nwg, G, c;
    __device__ void init(int M, int N, int G_, int c_) { nM = M / BM; nN = N / BM; nwg = nM * nN; G = G_; c = c_; }
    __device__ bool next(int i, int& pm, int& pn) const {
        const long L = (long)i * G + c; if (L >= nwg) return false;
        int wgid = (int)L; { const int q = nwg / NXCD, r = nwg % NXCD, xcd = wgid % NXCD, off = wgid / NXCD; wgid = (xcd < r ? xcd * (q + 1) : r * (q + 1) + (xcd - r) * q) + off; }
        const int nig = WGM * nN, gid = wgid / nig, fm = gid * WGM, gsz = (nM - fm) < WGM ? (nM - fm) : WGM;
        pm = fm + ((wgid % nig) % gsz); pn = (wgid % nig) / gsz; return true;
    }
};

template <class Epi, class Sched>
__device__ __forceinline__ void gemm_phase(LAS unsigned char* lds, const Sched& S, const Epi& E) {
    unsigned z_ = 0u; asm volatile("" : "+v"(z_)); const int tid_ = (int)__builtin_amdgcn_mbcnt_hi(~0u, __builtin_amdgcn_mbcnt_lo(~0u, z_)) + S.wave * 64;
    const int tid = tid_, wid = S.wave, lane = tid & 63, wr = wid >> 2, wc = wid & 3, fr = lane & 15, fq = lane >> 4;
    const int K = S.ldb;
    unsigned voffA[2], voffB[2];
#pragma unroll
    for (int i = 0; i < 2; ++i) { int R, C; stage_rc(tid * 16 + i * 8192, R, C); const int Rb = Epi::PERM ? ((R & ~31) + perm32(R & 31)) : R;
        voffA[i] = (unsigned)(R * S.lda + C) * 2u; voffB[i] = (unsigned)(Rb * K + C) * 2u; }
    const size_t kstep = (size_t)(BK * 2);
    const size_t hstepB = (size_t)HALF * K * 2, hstepA = (size_t)HALF * S.lda * 2;
    const unsigned ldsw = (unsigned)wid * 1024u;
    const int aoff = lds_byte(wr * 64 + fr, fq * 8), boff = lds_byte(wc * 32 + fr, fq * 8);
#define PG8_SA(b, h) (((b) * 2 + (h)) * HTB)
#define PG8_SB(b, h) ((4 + (b) * 2 + (h)) * HTB)
#define PG8_GLDS(src, dstoff) __builtin_amdgcn_global_load_lds((const unsigned*)(src), (LAS unsigned*)(lds + (dstoff)), 16, 0, 0)
#define PG8_STAGE_A(bufoff, up, h, VO) do { if constexpr (Sched::GATHER) { _Pragma("unroll") for (int _i = 0; _i < 2; ++_i) PG8_GLDS((up) + VO[_i], (bufoff) + ldsw + _i * 8192); } \
        else { const char* _b = (up) + (size_t)(h) * hstepA; _Pragma("unroll") for (int _i = 0; _i < 2; ++_i) PG8_GLDS(_b + voffA[_i], (bufoff) + ldsw + _i * 8192); } } while (0)
#define PG8_STAGE_B(bufoff, bp) do { _Pragma("unroll") for (int _i = 0; _i < 2; ++_i) PG8_GLDS((bp) + voffB[_i], (bufoff) + ldsw + _i * 8192); } while (0)
#define PG8_LDA(dst, b, h) do { _Pragma("unroll") for (int m = 0; m < 4; ++m) _Pragma("unroll") for (int k = 0; k < 2; ++k) dst[m][k] = *(const LAS bf16x8*)(lds + PG8_SA(b, h) + aoff + m * 2048 + k * 1024); } while (0)
#define PG8_LDB(dst, b, h) do { _Pragma("unroll") for (int n = 0; n < 2; ++n) _Pragma("unroll") for (int k = 0; k < 2; ++k) dst[n][k] = *(const LAS bf16x8*)(lds + PG8_SB(b, h) + boff + n * 2048 + k * 1024); } while (0)
#define PG8_MMA(ai, bj, At, Bt) do { __builtin_amdgcn_s_setprio(1); _Pragma("unroll") for (int m = 0; m < 4; ++m) _Pragma("unroll") for (int n = 0; n < 2; ++n) _Pragma("unroll") for (int k = 0; k < 2; ++k) \
        acc[ai][bj][m][n] = __builtin_amdgcn_mfma_f32_16x16x32_bf16(Bt[n][k], At[m][k], acc[ai][bj][m][n], 0, 0, 0); __builtin_amdgcn_s_setprio(0); } while (0)
#define PG8_WAIT_V(n) asm volatile("s_waitcnt vmcnt(" #n ")" ::: "memory")
#define PG8_WAIT_L(n) asm volatile("s_waitcnt lgkmcnt(" #n ")" ::: "memory")
#define PG8_BAR __builtin_amdgcn_s_barrier()
#define PG8_SCHED __builtin_amdgcn_sched_barrier(0)
    Unit cur, nxt; int ui = 0;
    if (!S.next(0, cur)) return;
    f32x4 acc[2][2][4][2];
#pragma unroll
    for (int a = 0; a < 2; ++a)
#pragma unroll
        for (int b = 0; b < 2; ++b)
#pragma unroll
            for (int m = 0; m < 4; ++m)
#pragma unroll
                for (int n = 0; n < 2; ++n) acc[a][b][m][n] = (f32x4){0.f, 0.f, 0.f, 0.f};
    bf16x8 At[4][2], B0[2][2], B1[2][2];
    const char* Ab = S.a_base();
    const char* cA = Ab; const char* cB = S.b_base(cur);
    unsigned vF0[2], vF1[2], vK[2];
    if constexpr (Sched::GATHER) {
#pragma unroll
        for (int i = 0; i < 2; ++i) { int R, C; stage_rc(tid * 16 + i * 8192, R, C); vF0[i] = S.a_off(cur, R) + (unsigned)(C * 2); vF1[i] = S.a_off(cur, HALF + R) + (unsigned)(C * 2); vK[i] = vF1[i]; }
    } else cA = Ab + S.a_unit_off(cur);
    PG8_STAGE_B(PG8_SB(0, 0), cB); PG8_STAGE_B(PG8_SB(0, 1), cB + hstepB); PG8_STAGE_A(PG8_SA(0, 0), cA, 0, vF0); PG8_STAGE_A(PG8_SA(0, 1), cA, 1, vF1);
    if (wr == 1) PG8_BAR;
    PG8_WAIT_V(2); PG8_BAR;
    PG8_STAGE_B(PG8_SB(1, 0), cB + kstep); PG8_STAGE_A(PG8_SA(1, 0), cA + kstep, 0, vF0); PG8_STAGE_B(PG8_SB(1, 1), cB + hstepB + kstep);
    PG8_WAIT_V(6); PG8_BAR;
    for (;;) {
        const bool has_next = S.next(ui + 1, nxt);
        const char* nA = cA; const char* nB = cB;
        if (has_next) { nB = S.b_base(nxt); if constexpr (!Sched::GATHER) nA = Ab + S.a_unit_off(nxt); }
        const int nt = cur.nt;
#pragma unroll 1
        for (int t = 0; t < nt; t += 2) {
            const bool last = (t == nt - 2);
            const char* a1 = cA + (size_t)(t + 1) * kstep;
            const char* a2 = last ? nA : cA + (size_t)(t + 2) * kstep; const char* b2 = last ? nB : cB + (size_t)(t + 2) * kstep;
            const char* a3 = a2 + kstep; const char* b3 = b2 + kstep;
            if constexpr (Sched::GATHER) {
                if (last && has_next) {
#pragma unroll
                    for (int i = 0; i < 2; ++i) { int R, C; stage_rc(tid * 16 + i * 8192, R, C); vF0[i] = S.a_off(nxt, R) + (unsigned)(C * 2); vF1[i] = S.a_off(nxt, HALF + R) + (unsigned)(C * 2); }
                }
            }
            PG8_LDB(B0, 0, 0); PG8_LDB(B1, 0, 1); PG8_SCHED; PG8_LDA(At, 0, 0); PG8_STAGE_A(PG8_SA(1, 1), a1, 1, vK);
            PG8_WAIT_V(8); PG8_WAIT_L(0); PG8_BAR; PG8_MMA(0, 0, At, B0); PG8_MMA(0, 1, At, B1); PG8_BAR; PG8_SCHED;
            PG8_LDA(At, 0, 1); PG8_STAGE_B(PG8_SB(0, 0), b2); PG8_STAGE_B(PG8_SB(0, 1), b2 + hstepB); PG8_STAGE_A(PG8_SA(0, 0), a2, 0, vF0);
            PG8_WAIT_V(8); PG8_WAIT_L(0); PG8_BAR; PG8_MMA(1, 0, At, B0); PG8_MMA(1, 1, At, B1); PG8_BAR; PG8_SCHED;
            PG8_LDB(B0, 1, 0); PG8_LDB(B1, 1, 1); PG8_SCHED; PG8_LDA(At, 1, 0); PG8_STAGE_A(PG8_SA(0, 1), a2, 1, vF1);
            PG8_WAIT_V(8); PG8_WAIT_L(0); PG8_BAR; PG8_MMA(0, 0, At, B0); PG8_MMA(0, 1, At, B1); PG8_BAR; PG8_SCHED;
            PG8_LDA(At, 1, 1); PG8_STAGE_B(PG8_SB(1, 0), b3); PG8_STAGE_B(PG8_SB(1, 1), b3 + hstepB); PG8_STAGE_A(PG8_SA(1, 0), a3, 0, vF0);
            PG8_WAIT_V(8); PG8_WAIT_L(0); PG8_BAR; PG8_MMA(1, 0, At, B0); PG8_MMA(1, 1, At, B1); PG8_BAR; PG8_SCHED;
        }
        if (wr == 0) PG8_BAR;
        bool keep = false;
        if constexpr (Epi::HAS_MID) { if (cur.sub == 0) { E.mid(acc, cur, wr, wc, fr, fq); keep = true; } else E(acc, cur, wr, wc, fr, fq); }
        else E(acc, cur, wr, wc, fr, fq);
        if (!has_next) break;
        if (!keep) {
#pragma unroll
        for (int a = 0; a < 2; ++a)
#pragma unroll
            for (int b = 0; b < 2; ++b)
#pragma unroll
                for (int m = 0; m < 4; ++m)
#pragma unroll
                    for (int n = 0; n < 2; ++n) acc[a][b][m][n] = (f32x4){0.f, 0.f, 0.f, 0.f};
        }
        cur = nxt; cA = nA; cB = nB; ++ui;
        if constexpr (Sched::GATHER) { vK[0] = vF1[0]; vK[1] = vF1[1]; }
        if (wr == 1) PG8_BAR;
    }
    PG8_WAIT_V(0);
    PG8_BAR;
#undef PG8_SA
#undef PG8_SB
#undef PG8_GLDS
#undef PG8_STAGE_A
#undef PG8_STAGE_B
#undef PG8_LDA
#undef PG8_LDB
#undef PG8_MMA
#undef PG8_WAIT_V
#undef PG8_WAIT_L
#undef PG8_BAR
#undef PG8_SCHED
}
}
using pg8::Unit;

struct DenseSched {
    static constexpr bool GATHER = false;
    const char* A; const char* Bt; int K; int lda; int ldb; int wave; int ksplit; pg8::StaticOrder so;
    __device__ __forceinline__ bool next(int i, Unit& u) const {
        int pm, pn; const int ti = ksplit ? (i >> 1) : i; if (!so.next(ti, pm, pn)) return false;
        u.pm = pm; u.pn = pn; u.e = 0; u.nvalid = 256; u.slot0 = pm * 256; u.lpos0 = 0;
        if (ksplit) { u.sub = i & 1; u.kofs = u.sub ? ksplit : 0; u.nt = (u.sub ? K - ksplit : ksplit) / 64; } else { u.sub = 1; u.kofs = 0; u.nt = K / 64; }
        return true; }
    __device__ __forceinline__ const char* a_base() const { return A; }
    __device__ __forceinline__ unsigned a_off(const Unit& u, int r) const { return 0u; }
    __device__ __forceinline__ size_t a_unit_off(const Unit& u) const { return ((size_t)u.pm * 256 * lda + u.kofs) * 2; }
    __device__ __forceinline__ const char* b_base(const Unit& u) const { return Bt + ((size_t)u.pn * 256 * ldb + u.kofs) * 2; }
};
struct MoeTab { const volatile LAS int* cnt; const volatile LAS int* mtpref; const volatile LAS int* spref; };
template <bool GATHER_> struct MoeSched {
    static constexpr bool GATHER = GATHER_;
    const char* A; const char* Bt; int K; int lda; int ldb; int wave; int ntn; size_t bstride_e; const int* ltok; MoeTab T; int G, c, lo, hi;
    __device__ __forceinline__ bool next(int i, Unit& u) const {
        const int L = lo + i * G + c; if (c < 0 || L >= hi) return false;
        const int tix = L / ntn; u.pn = L - tix * ntn; u.pm = tix;
        int e = 0;
#pragma unroll 1
        for (int k = 1; k < 32; ++k) if (T.mtpref[k] <= tix) e = k;
        const int mt = tix - T.mtpref[e]; u.e = e; u.slot0 = T.spref[e] + 256 * mt; const int rem = T.cnt[e] - 256 * mt; u.nvalid = rem < 256 ? rem : 256; u.lpos0 = e * MTOK + 256 * mt; u.nt = K / 64; u.kofs = 0; u.sub = 1; return true;
    }
    __device__ __forceinline__ const char* a_base() const { return A; }
    __device__ __forceinline__ unsigned a_off(const Unit& u, int r) const { const int rr = r < u.nvalid ? r : u.nvalid - 1; return (unsigned)ltok[u.lpos0 + rr] * (unsigned)(lda * 2); }
    __device__ __forceinline__ size_t a_unit_off(const Unit& u) const { return (size_t)u.slot0 * lda * 2; }
    __device__ __forceinline__ const char* b_base(const Unit& u) const { return Bt + (size_t)u.e * bstride_e + (size_t)u.pn * 256 * K * 2; }
};

#define OPAQUE(p) asm volatile("" : "+v"(p))
struct EpiProj {
    static constexpr bool PERM = true, REPEAT = true, HAS_MID = false;
    bf16* Pq; bf16* Pg; const float* rs; const f32x4* rope;
    __device__ __forceinline__ static void rot(f32x4& c, const f32x4& st) {
        const f32x4 o = c;
        c[0] = o[0] * st[0] - o[1] * st[1]; c[1] = o[1] * st[0] + o[0] * st[1];
        c[2] = o[2] * st[2] - o[3] * st[3]; c[3] = o[3] * st[2] + o[2] * st[3];
    }
    __device__ __forceinline__ void operator()(const f32x4 (&acc)[2][2][4][2], const Unit& u, int wr, int wc, int fr, int fq) const {
        const int colh = wc * 32 + fq * 8;
        const int ib = (colh & 63) >> 2;
        const int row0 = u.pm * 256 + wr * 64 + fr;
        int mode[2]; bf16* ob[2]; size_t ostep[2];
#pragma unroll
        for (int bj = 0; bj < 2; ++bj) {
            const int h128 = 2 * u.pn + bj;
            if (h128 >= 24) mode[bj] = 3;
            else if (h128 < 6) mode[bj] = h128 < 4 ? 1 : (h128 == 4 ? 2 : 0);
            else { const int j = (h128 - 6) % 6; mode[bj] = j < 2 ? 1 : (j < 4 ? 2 : 0); }
            if (h128 < 24) { ob[bj] = Pq + h128 * 128 + colh + (size_t)row0 * NQKV; ostep[bj] = (size_t)NQKV * 16; }
            else { ob[bj] = Pg + (((h128 - 24) * 128 + colh) >> 1) + (size_t)row0 * (NGATE / 2); ostep[bj] = (size_t)(NGATE / 2) * 16; }
        }
        float rsv[8];
#pragma unroll
        for (int i = 0; i < 8; ++i) rsv[i] = rs[row0 + (i >> 2) * 128 + (i & 3) * 16];
        const f32x4* rp = rope + (size_t)(row0 & (SEQ - 1)) * 16 + ib;
        f32x4 c0 = rp[0], c1 = rp[1];
        const f32x4 s16a = rope[16 * 16 + ib], s16b = rope[16 * 16 + ib + 1], s80a = rope[80 * 16 + ib], s80b = rope[80 * 16 + ib + 1];
#pragma unroll
        for (int ai = 0; ai < 2; ++ai)
#pragma unroll
            for (int m = 0; m < 4; ++m) {
                OPAQUE(ob[0]); OPAQUE(ob[1]);
                const float s = rsv[ai * 4 + m];
#pragma unroll
                for (int bj = 0; bj < 2; ++bj) {
                    f32x4 v0 = acc[ai][bj][m][0] * s, v1 = acc[ai][bj][m][1] * s;
                    if (mode[bj] == 1 || mode[bj] == 2) {
                        f32x4 o0, o1;
                        o0[0] = v0[0] * c0[0] - v0[1] * c0[1]; o0[1] = v0[1] * c0[0] + v0[0] * c0[1];
                        o0[2] = v0[2] * c0[2] - v0[3] * c0[3]; o0[3] = v0[3] * c0[2] + v0[2] * c0[3];
                        o1[0] = v1[0] * c1[0] - v1[1] * c1[1]; o1[1] = v1[1] * c1[0] + v1[0] * c1[1];
                        o1[2] = v1[2] * c1[2] - v1[3] * c1[3]; o1[3] = v1[3] * c1[2] + v1[2] * c1[3];
                        const float qs = (mode[bj] == 1) ? QSCALE : 1.0f;
                        v0 = o0 * qs; v1 = o1 * qs;
                    } else if (mode[bj] == 3) {
#pragma unroll
                        for (int j = 0; j < 4; ++j) { v0[j] = sigmoidf_fast(v0[j]); v1[j] = sigmoidf_fast(v1[j]); }
                    }
                    if (mode[bj] == 3) {
                        unsigned q[8];
#pragma unroll
                        for (int j = 0; j < 4; ++j) { q[j] = (unsigned)fminf(v0[j] * 256.0f, 255.0f); q[4 + j] = (unsigned)fminf(v1[j] * 256.0f, 255.0f); }
                        u32x2 w; w.x = q[0] | (q[1] << 8) | (q[2] << 16) | (q[3] << 24); w.y = q[4] | (q[5] << 8) | (q[6] << 16) | (q[7] << 24);
                        *(u32x2*)(ob[bj]) = w;
                    } else {
                        u32x4 w; w.x = cvtpk(v0[0], v0[1]); w.y = cvtpk(v0[2], v0[3]); w.z = cvtpk(v1[0], v1[1]); w.w = cvtpk(v1[2], v1[3]);
                        *(u32x4*)(ob[bj]) = w;
                    }
                }
                if (m == 3) { rot(c0, s80a); rot(c1, s80b); } else { rot(c0, s16a); rot(c1, s16b); }
                const int adv = (m == 3) ? 5 : 1;
                ob[0] += ostep[0] * adv; ob[1] += ostep[1] * adv;
            }
    }
};
struct EpiMerge {
    static constexpr bool PERM = true, REPEAT = false, HAS_MID = true;
    const unsigned char* gate; bf16* out;
    __device__ __forceinline__ static float dq(unsigned w, int k) { return ((float)((w >> (8 * k)) & 255u) + 0.5f) * (1.0f / 256.0f); }
    __device__ __forceinline__ void mid(f32x4 (&acc)[2][2][4][2], const Unit& u, int wr, int wc, int fr, int fq) const {
        const int row0 = u.pm * 256 + wr * 64 + fr, col0 = u.pn * 256 + wc * 32 + fq * 8;
        const unsigned char* gp = gate + (size_t)row0 * NGATE + col0;
        u32x2 ga[2][2], gb[2][2];
#define EM_LOAD(slot, i) do { const size_t ro = (size_t)(16 * (i) + 64 * ((i) >> 2)) * NGATE; ga[slot][0] = *(const u32x2*)(gp + ro); ga[slot][1] = *(const u32x2*)(gp + ro + 128); \
        gb[slot][0] = *(const u32x2*)(gp + ro + 1024); gb[slot][1] = *(const u32x2*)(gp + ro + 1024 + 128); } while (0)
        EM_LOAD(0, 0);
#pragma unroll
        for (int i = 0; i < 8; ++i) {
            const int ai = i >> 2, m = i & 3, sl = i & 1;
            if (i + 1 < 8) { if (sl == 0) EM_LOAD(1, i + 1); else EM_LOAD(0, i + 1); }
#pragma unroll
            for (int bj = 0; bj < 2; ++bj) {
                const u32x2 A = ga[sl][bj], B = gb[sl][bj];
#pragma unroll
                for (int j = 0; j < 4; ++j) {
                    acc[ai][bj][m][0][j] *= dq(B.x, j) * fast_rcp(dq(A.x, j));
                    acc[ai][bj][m][1][j] *= dq(B.y, j) * fast_rcp(dq(A.y, j));
                }
            }
        }
#undef EM_LOAD
    }
    __device__ __forceinline__ void operator()(const f32x4 (&acc)[2][2][4][2], const Unit& u, int wr, int wc, int fr, int fq) const {
        const int row0 = u.pm * 256 + wr * 64 + fr, col0 = u.pn * 256 + wc * 32 + fq * 8;
        const unsigned char* gp = gate + (size_t)row0 * NGATE + col0; bf16* op = out + (size_t)row0 * DM + col0;
        u32x2 ga[2][2];
#define EF_LOAD(slot, i) do { const size_t ro = (size_t)(16 * (i) + 64 * ((i) >> 2)) * NGATE; ga[slot][0] = *(const u32x2*)(gp + ro); ga[slot][1] = *(const u32x2*)(gp + ro + 128); } while (0)
        EF_LOAD(0, 0);
#pragma unroll
        for (int i = 0; i < 8; ++i) {
            const int ai = i >> 2, m = i & 3, sl = i & 1;
            if (i + 1 < 8) { if (sl == 0) EF_LOAD(1, i + 1); else EF_LOAD(0, i + 1); }
            bf16* orow = op + (size_t)(16 * i + 64 * (i >> 2)) * DM;
#pragma unroll
            for (int bj = 0; bj < 2; ++bj) {
                const u32x2 A = ga[sl][bj];
                const f32x4 a0 = acc[ai][bj][m][0], a1 = acc[ai][bj][m][1];
                u32x4 w;
                w.x = cvtpk(a0[0] * dq(A.x, 0), a0[1] * dq(A.x, 1)); w.y = cvtpk(a0[2] * dq(A.x, 2), a0[3] * dq(A.x, 3));
                w.z = cvtpk(a1[0] * dq(A.y, 0), a1[1] * dq(A.y, 1)); w.w = cvtpk(a1[2] * dq(A.y, 2), a1[3] * dq(A.y, 3));
                *(u32x4*)(orow + bj * 128) = w;
            }
            asm volatile("" ::: "memory");
        }
#undef EF_LOAD
    }
};
struct EpiResid {
    static constexpr bool PERM = true, REPEAT = false, HAS_MID = false;
    bf16* xb;
    __device__ __forceinline__ void operator()(const f32x4 (&acc)[2][2][4][2], const Unit& u, int wr, int wc, int fr, int fq) const {
        const int row0 = u.pm * 256 + wr * 64 + fr, col0 = u.pn * 256 + wc * 32 + fq * 8;
        bf16* xp = xb + (size_t)row0 * DM + col0;
        u32x4 p[2][2];
#define ER_LOAD(slot, i) do { const size_t ro = (size_t)(16 * (i) + 64 * ((i) >> 2)); p[slot][0] = *(const u32x4*)(xp + ro * DM); p[slot][1] = *(const u32x4*)(xp + ro * DM + 128); } while (0)
        ER_LOAD(0, 0);
#pragma unroll
        for (int i = 0; i < 8; ++i) {
            const int ai = i >> 2, m = i & 3, sl = i & 1;
            if (i + 1 < 8) { if (sl == 0) ER_LOAD(1, i + 1); else ER_LOAD(0, i + 1); }
            bf16* orow = xp + (size_t)(16 * i + 64 * (i >> 2)) * DM;
#pragma unroll
            for (int bj = 0; bj < 2; ++bj) {
                const u32x4 q = p[sl][bj];
                const f32x4 a0 = acc[ai][bj][m][0], a1 = acc[ai][bj][m][1];
                u32x4 w;
                w.x = cvtpk(a0[0] + bflo(q.x), a0[1] + bfhi(q.x)); w.y = cvtpk(a0[2] + bflo(q.y), a0[3] + bfhi(q.y));
                w.z = cvtpk(a1[0] + bflo(q.z), a1[1] + bfhi(q.z)); w.w = cvtpk(a1[2] + bflo(q.w), a1[3] + bfhi(q.w));
                *(u32x4*)(orow + bj * 128) = w;
            }
            asm volatile("" ::: "memory");
        }
#undef ER_LOAD
    }
};
struct EpiSwiglu {
    static constexpr bool PERM = true, REPEAT = false, HAS_MID = false;
    const int* ltok; const float* lw; const float* rs; bf16* H;
    __device__ __forceinline__ void operator()(const f32x4 (&acc)[2][2][4][2], const Unit& u, int wr, int wc, int fr, int fq) const {
        int tok[8]; float w8[8], s8[8];
#pragma unroll
        for (int i = 0; i < 8; ++i) { const int rr = (i >> 2) * 128 + wr * 64 + (i & 3) * 16 + fr; const int rc = rr < u.nvalid ? rr : u.nvalid - 1; tok[i] = ltok[u.lpos0 + rc]; w8[i] = lw[u.lpos0 + rc]; }
#pragma unroll
        for (int i = 0; i < 8; ++i) s8[i] = rs[tok[i]];
#pragma unroll
        for (int ai = 0; ai < 2; ++ai)
#pragma unroll
            for (int m = 0; m < 4; ++m) {
                const int rr = ai * 128 + wr * 64 + m * 16 + fr;
                if (rr < u.nvalid) {
                    const float w = w8[ai * 4 + m], s = s8[ai * 4 + m];
#pragma unroll
                    for (int bj = 0; bj < 2; ++bj) {
                        const f32x4 a0 = acc[ai][bj][m][0] * s, a1 = acc[ai][bj][m][1] * s;
                        const float h0 = a0[0] * sigmoidf_fast(a0[0]) * a0[1] * w, h1 = a0[2] * sigmoidf_fast(a0[2]) * a0[3] * w;
                        const float h2 = a1[0] * sigmoidf_fast(a1[0]) * a1[1] * w, h3 = a1[2] * sigmoidf_fast(a1[2]) * a1[3] * w;
                        u32x2 o; o.x = cvtpk(h0, h1); o.y = cvtpk(h2, h3);
                        *(u32x2*)(H + (size_t)(u.slot0 + rr) * DEXP + u.pn * 128 + bj * 64 + wc * 16 + fq * 4) = o;
                    }
                }
            }
    }
};
struct EpiY {
    static constexpr bool PERM = true, REPEAT = false, HAS_MID = false;
    bf16* Y;
    __device__ __forceinline__ void operator()(const f32x4 (&acc)[2][2][4][2], const Unit& u, int wr, int wc, int fr, int fq) const {
#pragma unroll
        for (int ai = 0; ai < 2; ++ai)
#pragma unroll
            for (int m = 0; m < 4; ++m) {
                const int rr = ai * 128 + wr * 64 + m * 16 + fr;
                if (rr < u.nvalid) {
#pragma unroll
                    for (int bj = 0; bj < 2; ++bj) {
                        const f32x4 a0 = acc[ai][bj][m][0], a1 = acc[ai][bj][m][1];
                        u32x4 w; w.x = cvtpk(a0[0], a0[1]); w.y = cvtpk(a0[2], a0[3]); w.z = cvtpk(a1[0], a1[1]); w.w = cvtpk(a1[2], a1[3]);
                        *(u32x4*)(Y + (size_t)(u.slot0 + rr) * DM + u.pn * 256 + bj * 128 + wc * 32 + fq * 8) = w;
                    }
                }
            }
    }
};

#define XB_TMO      128
#define XB_XCNT(j)  (256  + 64 * (j))
#define XB_XSUB(j)  (1280 + 64 * (j))
#define XB_XGEN(j)  (2304 + 64 * (j))
#define XB_TOP      3328
#define XB_TOPGEN   3392
#define XCD_BAR_WORDS 3456
#define XB_SPIN_CAP (1u << 18)
__device__ __forceinline__ unsigned xb_ld(unsigned* p)              { return __hip_atomic_load(p, __ATOMIC_RELAXED, __HIP_MEMORY_SCOPE_AGENT); }
__device__ __forceinline__ unsigned xb_add(unsigned* p, unsigned v) { return __hip_atomic_fetch_add(p, v, __ATOMIC_RELAXED, __HIP_MEMORY_SCOPE_AGENT); }
__device__ __forceinline__ unsigned xb_xcc_id() { return (unsigned)__builtin_amdgcn_s_getreg((3 << 11) | 20) & 0xFu; }
#define XB_SPIN(cond, bar) do { unsigned _sp = 0; while (cond) { __builtin_amdgcn_s_sleep(1); \
    if ((++_sp & 255u) == 0u) { if (xb_ld(&(bar)[XB_TMO])) break; if (_sp > XB_SPIN_CAP) { atomicAdd(&(bar)[XB_TMO], 1u); break; } } } } while (0)
struct XcdBarrier { unsigned* bar; unsigned x; volatile LAS unsigned* st; };
__device__ __forceinline__ XcdBarrier xcd_barrier_post(unsigned* bar, volatile LAS unsigned* st) {
    XcdBarrier b; b.bar = bar; b.x = xb_xcc_id(); b.st = st;
    if (threadIdx.x == 0) (void)xb_add(&bar[XB_XCNT(b.x)], 1u);
    return b;
}
__device__ __forceinline__ void xcd_barrier_complete(unsigned* bar, unsigned x, unsigned& nloc, unsigned& nx) {
    const unsigned G = gridDim.x * gridDim.y * gridDim.z;
    unsigned sum, cnt, mine, sp = 0u;
    for (;;) {
        sum = 0u; cnt = 0u; mine = 0u;
#pragma unroll
        for (unsigned j = 0; j < 16; ++j) { const unsigned c = xb_ld(&bar[XB_XCNT(j)]); sum += c; cnt += (c > 0u) ? 1u : 0u; mine = (j == x) ? c : mine; }
        if (sum == G) break;
        __builtin_amdgcn_s_sleep(1);
        if ((++sp & 255u) == 0u) { if (xb_ld(&bar[XB_TMO])) break; if (sp > XB_SPIN_CAP) { atomicAdd(&bar[XB_TMO], 1u); break; } }
    }
    nloc = mine > 0u ? mine : 1u; nx = cnt > 0u ? cnt : 1u;
}
__device__ __forceinline__ void xcd_barrier(const XcdBarrier& b, int wave) {
    asm volatile("s_waitcnt vmcnt(0)" ::: "memory");
    __syncthreads();
    unsigned zb_ = 0u; asm volatile("" : "+v"(zb_));
    if (wave == 0 && __builtin_amdgcn_mbcnt_hi(~0u, __builtin_amdgcn_mbcnt_lo(~0u, zb_)) == 0u) {
        unsigned* bar = b.bar;
        __builtin_amdgcn_s_waitcnt(0);
        unsigned nloc = b.st[0], nx = b.st[1];
        if (nloc == 0u) { xcd_barrier_complete(bar, b.x, nloc, nx); b.st[0] = nloc; b.st[1] = nx; }
        const unsigned old = xb_add(&bar[XB_XSUB(b.x)], 1u);
        const unsigned gen = old / nloc;
        if (old + 1u == (gen + 1u) * nloc) {
            __builtin_amdgcn_fence(__ATOMIC_RELEASE, "agent");
            asm volatile("s_waitcnt vmcnt(0)" ::: "memory");
            const unsigned og = xb_add(&bar[XB_TOP], 1u);
            const unsigned tg = og / nx;
            if (og + 1u == (tg + 1u) * nx) xb_add(&bar[XB_TOPGEN], 1u);
            else XB_SPIN(xb_ld(&bar[XB_TOPGEN]) == tg, bar);
            __builtin_amdgcn_fence(__ATOMIC_ACQUIRE, "agent");
            xb_add(&bar[XB_XGEN(b.x)], 1u);
            asm volatile("s_waitcnt vmcnt(0)" ::: "memory");
        } else {
            XB_SPIN(xb_ld(&bar[XB_XGEN(b.x)]) == gen, bar);
            __builtin_amdgcn_fence(__ATOMIC_ACQUIRE, "agent");
            asm volatile("s_waitcnt vmcnt(0)" ::: "memory");
        }
    }
    __syncthreads();
}

struct Args {
    const float* x; const float* attn_g; const float* w_in; const float* a_sink; const float* w_a; const float* w_b; const float* w_out; const float* ffn_g;
    const float* w_rg; const float* b_rg; const float* w_re; const float* b_re; const float* w_eg; const float* w_eu; const float* w_ed; const float* fin_g;
    float* out; unsigned char* ws; int ph_lo, ph_hi;
};
typedef const __attribute__((address_space(4))) Args* CArgs;
struct Frame {
    LAS unsigned char* lds; volatile LAS int* misc;
    int wave, G, vcu, gw, ngw, bx;
};
__device__ __forceinline__ int otid() { unsigned z = 0u; asm volatile("" : "+v"(z)); return (int)__builtin_amdgcn_mbcnt_hi(~0u, __builtin_amdgcn_mbcnt_lo(~0u, z)); }
__device__ __forceinline__ float shx(float v, int o, int lane) { return __int_as_float(__builtin_amdgcn_ds_bpermute((lane ^ o) << 2, __float_as_int(v))); }
__device__ __forceinline__ float wave_sum(float v, int lane) {
#pragma unroll
    for (int o = 1; o < 64; o <<= 1) v += shx(v, o, lane);
    return v;
}

struct MapPlain { __device__ __forceinline__ int operator()(int n) const { return n; } };
struct MapWin { __device__ __forceinline__ int operator()(int n) const {
        bool rope = false;
        if (n < 640) rope = true; else if (n >= 768 && n < NQKV) rope = ((n - 768) % 768) < 512;
        if (!rope) return n; const int d = n & 63; return (n & ~63) + 2 * (d & 31) + (d >> 5); } };
struct MapGU { int t; __device__ __forceinline__ int operator()(int n) const { return 2 * n + t; } };
template <class Map> __device__ __forceinline__ void transpose_item64(const float* W, int ldn, int k0, int n0, const float* gk, bf16* WT, int Kd, const Map& map, LAS float* scr, int lane) {
    const int kq = lane >> 4, n4 = (lane & 15) * 4;
    const float* src = W + (size_t)(k0 + kq) * ldn + n0 + n4;
    f32x4 v[16];
#pragma unroll
    for (int i = 0; i < 16; ++i) v[i] = *(const f32x4*)(src + (size_t)(4 * i) * ldn);
    if (gk) {
#pragma unroll
        for (int i = 0; i < 16; ++i) v[i] = v[i] * gk[k0 + 4 * i + kq];
    }
#pragma unroll
    for (int i = 0; i < 16; ++i) { LAS float* d = scr + (4 * i + kq) * 65 + n4; d[0] = v[i][0]; d[1] = v[i][1]; d[2] = v[i][2]; d[3] = v[i][3]; }
    LDS_WAIT(); asm volatile("" ::: "memory");
    const int c = lane & 7;
#pragma unroll
    for (int j = 0; j < 8; ++j) { const int n = (lane >> 3) + 8 * j; const LAS float* p = scr + (8 * c) * 65 + n;
        u32x4 o; o.x = cvtpk(p[0 * 65], p[1 * 65]); o.y = cvtpk(p[2 * 65], p[3 * 65]); o.z = cvtpk(p[4 * 65], p[5 * 65]); o.w = cvtpk(p[6 * 65], p[7 * 65]);
        *(u32x4*)(WT + (size_t)map(n0 + n) * Kd + k0 + 8 * c) = o; }
    LDS_WAIT(); asm volatile("" ::: "memory");
}
__device__ __forceinline__ void prep_phase(const Frame& F, CArgs a) {
    const int lane = otid(), tid = F.wave * 64 + lane; (void)tid; (void)lane;
    unsigned char* ws = a->ws;
    LAS float* scr = (LAS float*)(F.lds + F.wave * PREP_SCR);
    constexpr int I_IN = 16 * 80, I_A = 8 * 16, I_B = 4 * 16, I_O = 16 * 16, I_L = I_IN + I_A + I_B + I_O;
    for (int it = F.gw; it < DEPTH * I_L; it += F.ngw) {
        const int l = it / I_L; int r = it - l * I_L;
        unsigned char* wl = ws + (size_t)l * WNE_LSTRIDE;
        if (r < I_IN) { transpose_item64(a->w_in + (size_t)l * DM * DIN, DIN, 64 * (r / 80), 64 * (r % 80), a->attn_g + l * DM, (bf16*)(wl + WS_WIN), DM, MapWin{}, scr, lane); continue; } r -= I_IN;
        if (r < I_A) { transpose_item64(a->w_a + (size_t)l * 512 * DM, DM, 64 * (r / 16), 64 * (r % 16), nullptr, (bf16*)(wl + WS_WAB) + 256, 768, MapPlain{}, scr, lane); continue; } r -= I_A;
        if (r < I_B) { transpose_item64(a->w_b + (size_t)l * 256 * DM, DM, 64 * (r / 16), 64 * (r % 16), nullptr, (bf16*)(wl + WS_WAB), 768, MapPlain{}, scr, lane); continue; } r -= I_B;
        transpose_item64(a->w_out + (size_t)l * DM * DM, DM, 64 * (r / 16), 64 * (r % 16), nullptr, (bf16*)(wl + WS_WOUT), DM, MapPlain{}, scr, lane);
    }
    for (int idx = F.bx * NTHREADS + tid; idx < DEPTH * 32 * 3 * 64 * 8; idx += F.G * NTHREADS) {
        const int l = idx / (32 * 3 * 64 * 8), id = idx - l * (32 * 3 * 64 * 8);
        const int j = id & 7, ln = (id >> 3) & 63, q = id >> 9, nt = q % 3, i = q / 3;
        const int k = 32 * i + 8 * (ln >> 4) + j, n = 16 * nt + (ln & 15);
        const float* wg = a->w_rg + (size_t)l * DM * 4; const float* we = a->w_re + (size_t)l * DM * NEXP;
        float v = 0.f; if (n < 4) v = wg[k * 4 + n]; else if (n < 36) v = we[k * NEXP + (n - 4)];
        ((float*)(ws + WS_WR + l * WR_LSTRIDE))[id] = v * a->ffn_g[l * DM + k];
    }
    {
        float* rt = (float*)(ws + WS_ROPE);
        for (int idx = F.bx * NTHREADS + tid; idx < SEQ * 32; idx += F.G * NTHREADS) {
            const int pos = idx >> 5, i = idx & 31;
            const float inv = 1.0f / powf(10000.0f, (float)(2 * i) / 64.0f);
            const float ang = (float)pos * inv;
            const double ad = (double)ang, kd = __builtin_rint(ad * 0.15915494309189535);
            const float rf = (float)__builtin_fma(-kd, 6.283185307179586, ad);
            rt[idx * 2] = cosf(rf); rt[idx * 2 + 1] = sinf(rf);
        }
        bf16* xb = (bf16*)(ws + WS_XB); float* rs1 = (float*)(ws + WS_RS1);
        for (int m = F.gw; m < MTOK; m += F.ngw) {
            const f32x4* xr = (const f32x4*)(a->x + (size_t)m * DM) + lane;
            f32x4 v[4]; float s = 0.f;
#pragma unroll
            for (int j = 0; j < 4; ++j) { v[j] = xr[64 * j]; s += (v[j][0] * v[j][0] + v[j][1] * v[j][1]) + (v[j][2] * v[j][2] + v[j][3] * v[j][3]); }
            s = wave_sum(s, lane);
            u32x2* o = (u32x2*)(xb + (size_t)m * DM) + lane;
#pragma unroll
            for (int j = 0; j < 4; ++j) { u32x2 w; w.x = cvtpk(v[j][0], v[j][1]); w.y = cvtpk(v[j][2], v[j][3]); o[64 * j] = w; }
            if (lane == 0) rs1[m] = 1.0f / sqrtf(s * (1.0f / DM) + NORM_EPS);
        }
    }
}
__device__ __forceinline__ void prep_experts(const Frame& F, CArgs a, int l, int lane) {
    unsigned char* ws = a->ws;
    LAS float* scr = (LAS float*)(F.lds + F.wave * PREP_SCR);
    constexpr int I_G = 16 * 4, I_D = 4 * 16, I_E = 2 * I_G + I_D;
    const float* fg = a->ffn_g + l * DM;
    for (int it = F.gw; it < NEXP * I_E; it += F.ngw) {
        const int e = it / I_E; int r = it - e * I_E;
        const size_t eo = ((size_t)l * NEXP + e) * DM * DEXP;
        if (r < 2 * I_G) { const int t = r / I_G; r -= t * I_G; const float* W = (t ? a->w_eu : a->w_eg) + eo;
            transpose_item64(W, DEXP, 64 * (r / 4), 64 * (r % 4), fg, (bf16*)(ws + WS_WGU) + (size_t)e * 512 * DM, DM, MapGU{t}, scr, lane); continue; } r -= 2 * I_G;
        transpose_item64(a->w_ed + eo, DM, 64 * (r / 16), 64 * (r % 16), nullptr, (bf16*)(ws + WS_WD) + (size_t)e * DM * DEXP, DEXP, MapPlain{}, scr, lane);
    }
}

__device__ __forceinline__ int crow(int r, int hi) { return (r & 3) + 8 * (r >> 2) + 4 * hi; }
struct AttnUnit { int kcol, vcol, b, d, r, t0, span, W, qcol, tq; float m0, l0; bf16* outp; int opitch; float* lsep; bool valid; };
__device__ __forceinline__ AttnUnit attn_decode(int idx, int G, int bx, int wave, int l, CArgs a, bf16* ya, bf16* ob, float* lse) {
    AttnUnit U; U.valid = false;
    const int nA = (BATCH * 2 * 64 - bx + G - 1) / G;
    if (idx < nA) {
        const int u = bx + idx * G; const int qb = u & 63, kvh = (u >> 6) & 1, b = u >> 7; const int g = wave >> 1, hq = kvh * 4 + g;
        U.kcol = 512 + kvh * 64; U.vcol = 640 + kvh * 64; U.b = b; U.d = 1; U.r = 0; U.t0 = 2 * qb; U.span = 2; U.W = 4; U.qcol = hq * 64; U.tq = 2 * qb + (wave & 1);
        U.m0 = a->a_sink[l * 8 + hq] * LOG2E; U.l0 = 1.0f; U.outp = ya + hq * 64; U.opitch = 768; U.lsep = nullptr; U.valid = true; return U;
    }
    const int u = bx + (idx - nA) * G;
    if (u < 3 * 256) {
        const int grp = u >> 8; int q = u & 255;
        const int d = grp == 0 ? 1 : (grp == 1 ? 4 : 16), bpr = 16 / d;
        const int blk = q % bpr; q /= bpr; const int res = q % d; q /= d; const int h = q & 3, b = q >> 2;
        const int base = 768 + 768 * grp;
        U.kcol = base + 256 + h * 64; U.vcol = base + 512 + h * 64; U.b = b; U.d = d; U.r = res; U.t0 = 8 * blk; U.span = 8; U.W = 2; U.qcol = base + h * 64; U.tq = 8 * blk + wave;
        U.m0 = -1e30f; U.l0 = 0.0f; U.outp = ob + grp * 256 + h * 64; U.opitch = 768; U.lsep = lse + grp * 4 + h; U.valid = true;
    }
    return U;
}
__device__ __forceinline__ void attn_fetch(const bf16* P, const AttnUnit& U, int tid, u32x4 (&buf)[12]) {
    const int L32 = (SEQ / U.d) >> 5, jbase = U.t0 - U.W, ntile = U.span + 2 * U.W, nch = ntile * 512;
    const size_t tok0 = (size_t)U.b * SEQ + U.r;
#pragma unroll
    for (int i = 0; i < 12; ++i) {
        const int c = tid + 512 * i;
        if (c < nch) {
            const int kv = c >= ntile * 256, cc = kv ? c - ntile * 256 : c, row = cc >> 3, ch = cc & 7, tile = row >> 5, rr = row & 31, j = jbase + tile;
            if (j >= 0 && j < L32) buf[i] = *(const u32x4*)(P + (tok0 + (size_t)(32 * j + rr) * U.d) * NQKV + (kv ? U.vcol : U.kcol) + ch * 8);
        }
    }
}
__device__ __forceinline__ void attn_stage(const AttnUnit& U, int tid, const u32x4 (&buf)[12], LAS unsigned char* lds) {
    const int L32 = (SEQ / U.d) >> 5, jbase = U.t0 - U.W, ntile = U.span + 2 * U.W, nch = ntile * 512;
    LAS unsigned char* kimg = lds; LAS unsigned char* vimg = lds + ntile * 4096;
#pragma unroll
    for (int i = 0; i < 12; ++i) {
        const int c = tid + 512 * i;
        if (c < nch) {
            const int kv = c >= ntile * 256, cc = kv ? c - ntile * 256 : c, row = cc >> 3, ch = cc & 7, tile = row >> 5, rr = row & 31, j = jbase + tile;
            if (j >= 0 && j < L32) *(LAS u32x4*)((kv ? vimg : kimg) + tile * 4096 + rr * 128 + (kv ? ch : (ch ^ (rr & 7))) * 16) = buf[i];
        }
    }
}
__device__ __forceinline__ void attn_compute(const bf16* P, const AttnUnit& U, const bf16x8 (&qf)[4], LAS unsigned char* lds, int lane) {
    const int r32 = lane & 31, hi = lane >> 5;
    const int d = U.d, W = U.W, tq = U.tq;
    const int L32 = (SEQ / d) >> 5;
    const size_t tok0 = (size_t)U.b * SEQ + U.r;
    const int jbase = U.t0 - W, ntile = U.span + 2 * W;
    LAS unsigned char* kimg = lds; LAS unsigned char* vimg = lds + ntile * 4096;
    const size_t qtok = tok0 + (size_t)(32 * tq + r32) * d;
    f32x16 o0 = {}, o1 = {};
    float mrun = U.m0, lrun = U.l0;
    const int jlo = (tq - W) < 0 ? 0 : (tq - W), jhi = (tq + W) > (L32 - 1) ? (L32 - 1) : (tq + W);
    const int vrd = (4 * hi + ((lane & 15) >> 2)) * 128 + (16 * ((lane >> 4) & 1) + 4 * (lane & 3)) * 2;
    const int krd = r32 * 128;
#define VTR(p, off) __builtin_bit_cast(s16x4, __builtin_amdgcn_ds_read_tr16_b64_v4i16((LAS s16x4*)((p) + (off))))
    bf16x8 kn[4];
    { const LAS unsigned char* kl = kimg + (jlo - jbase) * 4096 + krd;
#pragma unroll
      for (int s = 0; s < 4; ++s) kn[s] = *(const LAS bf16x8*)(kl + (((2 * s + hi) ^ (r32 & 7)) * 16)); }
    for (int j = jlo; j <= jhi; ++j) {
        const LAS unsigned char* vl = vimg + (j - jbase) * 4096 + vrd;
        bf16x8 kf[4];
#pragma unroll
        for (int s = 0; s < 4; ++s) kf[s] = kn[s];
        s16x4 va[4], vb[4];
#pragma unroll
        for (int q = 0; q < 4; ++q) { va[q] = VTR(vl, (16 * (q & 1)) * 128 + (q >> 1) * 64); vb[q] = VTR(vl, (16 * (q & 1) + 8) * 128 + (q >> 1) * 64); }
        if (j < jhi) { const LAS unsigned char* kl = kimg + (j + 1 - jbase) * 4096 + krd;
#pragma unroll
            for (int s = 0; s < 4; ++s) kn[s] = *(const LAS bf16x8*)(kl + (((2 * s + hi) ^ (r32 & 7)) * 16)); }
        __builtin_amdgcn_sched_barrier(0);
        f32x16 sc = {};
#pragma unroll
        for (int s = 0; s < 4; ++s) sc = __builtin_amdgcn_mfma_f32_32x32x16_bf16(kf[s], qf[s], sc, 0, 0, 0);
        if (j == tq - W) {
#pragma unroll
            for (int g = 0; g < 16; ++g) if (crow(g, hi) < r32) sc[g] = -INFINITY;
        }
        if (j == tq + W) {
#pragma unroll
            for (int g = 0; g < 16; ++g) if (crow(g, hi) > r32) sc[g] = -INFINITY;
        }
        float mx = fmaxf(fmaxf(sc[0], sc[1]), fmaxf(sc[2], sc[3]));
#pragma unroll
        for (int g = 4; g < 16; g += 4) mx = fmaxf(mx, fmaxf(fmaxf(sc[g], sc[g + 1]), fmaxf(sc[g + 2], sc[g + 3])));
        { const auto rr = __builtin_amdgcn_permlane32_swap(__float_as_uint(mx), __float_as_uint(mx), false, false); mx = fmaxf(__uint_as_float(rr[0]), __uint_as_float(rr[1])); }
        if (__any(mx > mrun + 8.0f)) {
            const float mnew = fmaxf(mrun, mx);
            const float alpha = fast_exp2(mrun - mnew);
            lrun *= alpha; mrun = mnew;
#pragma unroll
            for (int g = 0; g < 16; ++g) { o0[g] *= alpha; o1[g] *= alpha; }
        }
        float psum = 0.f;
#pragma unroll
        for (int g = 0; g < 16; ++g) { sc[g] = fast_exp2(sc[g] - mrun); psum += sc[g]; }
        { const auto rr = __builtin_amdgcn_permlane32_swap(__float_as_uint(psum), __float_as_uint(psum), false, false); psum = __uint_as_float(rr[0]) + __uint_as_float(rr[1]); }
        lrun += psum;
        u32x4 p0, p1;
        p0.x = cvtpk(sc[0], sc[1]); p0.y = cvtpk(sc[2], sc[3]); p0.z = cvtpk(sc[4], sc[5]); p0.w = cvtpk(sc[6], sc[7]);
        p1.x = cvtpk(sc[8], sc[9]); p1.y = cvtpk(sc[10], sc[11]); p1.z = cvtpk(sc[12], sc[13]); p1.w = cvtpk(sc[14], sc[15]);
        const bf16x8 pf0 = __builtin_bit_cast(bf16x8, p0), pf1 = __builtin_bit_cast(bf16x8, p1);
#define VFR(q) ((bf16x8){va[q][0], va[q][1], va[q][2], va[q][3], vb[q][0], vb[q][1], vb[q][2], vb[q][3]})
        o0 = __builtin_amdgcn_mfma_f32_32x32x16_bf16(VFR(0), pf0, o0, 0, 0, 0);
        o0 = __builtin_amdgcn_mfma_f32_32x32x16_bf16(VFR(1), pf1, o0, 0, 0, 0);
        o1 = __builtin_amdgcn_mfma_f32_32x32x16_bf16(VFR(2), pf0, o1, 0, 0, 0);
        o1 = __builtin_amdgcn_mfma_f32_32x32x16_bf16(VFR(3), pf1, o1, 0, 0, 0);
#undef VFR
    }
#undef VTR
    const float inv = 1.0f / lrun;
    bf16* orow = U.outp + qtok * U.opitch;
#pragma unroll
    for (int g4 = 0; g4 < 4; ++g4) {
        u32x2 w0, w1;
        w0.x = cvtpk(o0[4 * g4] * inv, o0[4 * g4 + 1] * inv); w0.y = cvtpk(o0[4 * g4 + 2] * inv, o0[4 * g4 + 3] * inv);
        w1.x = cvtpk(o1[4 * g4] * inv, o1[4 * g4 + 1] * inv); w1.y = cvtpk(o1[4 * g4 + 2] * inv, o1[4 * g4 + 3] * inv);
        *(u32x2*)(orow + 8 * g4 + 4 * hi) = w0;
        *(u32x2*)(orow + 32 + 8 * g4 + 4 * hi) = w1;
    }
    if (U.lsep && hi == 0) U.lsep[qtok * 12] = (mrun + log2f(lrun)) * LN2;
}
__device__ __forceinline__ void attn_phase(const Frame& F, CArgs a, int l) {
    const int lane = otid(), tid = F.wave * 64 + lane; (void)tid; (void)lane;
    unsigned char* ws = a->ws;
    const bf16* P = (const bf16*)(ws + WS_PQ);
    bf16* ya = (bf16*)(ws + WS_YAB) + 256; bf16* ob = (bf16*)a->out; float* lse = (float*)(ws + WS_LSE);
    const int r32 = lane & 31, hi = lane >> 5;
    u32x4 buf[12];
    AttnUnit U = attn_decode(0, F.G, F.bx, F.wave, l, a, ya, ob, lse);
    if (U.valid) attn_fetch(P, U, tid, buf);
    for (int idx = 0; U.valid; ++idx) {
        attn_stage(U, tid, buf, F.lds);
        bf16x8 qf[4];
        { const size_t qtok = (size_t)U.b * SEQ + U.r + (size_t)(32 * U.tq + r32) * U.d;
#pragma unroll
          for (int s = 0; s < 4; ++s) qf[s] = *(const bf16x8*)(P + qtok * NQKV + U.qcol + 16 * s + 8 * hi); }
        const AttnUnit Un = attn_decode(idx + 1, F.G, F.bx, F.wave, l, a, ya, ob, lse);
        __syncthreads();
        if (Un.valid) attn_fetch(P, Un, tid, buf);
        attn_compute(P, U, qf, F.lds, lane);
        __syncthreads();
        U = Un;
    }
    prep_experts(F, a, l, lane);
}
__device__ __forceinline__ void comb_phase(const Frame& F, CArgs a) {
    const int lane = otid(), tid = F.wave * 64 + lane; (void)tid; (void)lane;
    unsigned char* ws = a->ws;
    const bf16* ob = (const bf16*)a->out; const float* lse = (const float*)(ws + WS_LSE); bf16* yb = (bf16*)(ws + WS_YAB);
    for (int idx = F.bx * NTHREADS + tid; idx < MTOK * 32; idx += F.G * NTHREADS) {
        const int tok = idx >> 5, c = idx & 31, h = c >> 3;
        const float l0 = lse[tok * 12 + h], l1 = lse[tok * 12 + 4 + h], l2 = lse[tok * 12 + 8 + h];
        const float mx = fmaxf(l0, fmaxf(l1, l2));
        float w0 = __expf(l0 - mx), w1 = __expf(l1 - mx), w2 = __expf(l2 - mx);
        const float inv = 1.0f / (w0 + w1 + w2); w0 *= inv; w1 *= inv; w2 *= inv;
        const u32x4 a0 = *(const u32x4*)(ob + (size_t)tok * 768 + c * 8), a1 = *(const u32x4*)(ob + (size_t)tok * 768 + 256 + c * 8), a2 = *(const u32x4*)(ob + (size_t)tok * 768 + 512 + c * 8);
        u32x4 o;
#define CMB(f) o.f = cvtpk(w0 * bflo(a0.f) + w1 * bflo(a1.f) + w2 * bflo(a2.f), w0 * bfhi(a0.f) + w1 * bfhi(a1.f) + w2 * bfhi(a2.f))
        CMB(x); CMB(y); CMB(z); CMB(w);
#undef CMB
        *(u32x4*)(yb + (size_t)tok * 768 + c * 8) = o;
    }
}

__device__ __forceinline__ void route_phase(const Frame& F, CArgs a, int l) {
    const int lane = otid(), tid = F.wave * 64 + lane;
    unsigned char* ws = a->ws;
    const bf16* xbf = (const bf16*)(ws + WS_XB); const f32x4* wrp = (const f32x4*)(ws + WS_WR + l * WR_LSTRIDE);
    float* rs2 = (float*)(ws + WS_RS2); i32x4* tokinfo = (i32x4*)(ws + WS_TOKINFO); int* ltok = (int*)(ws + WS_LTOK); float* lw = (float*)(ws + WS_LW);
    int* cnt = (int*)(ws + WS_CTL) + CW_CNT + l * 32 * CNT_STRIDE;
    const float* brg = a->b_rg + l * 4; const float* bre = a->b_re + l * NEXP;
    LAS f32x4* part = (LAS f32x4*)(F.lds);
    LAS float* ssp = (LAS float*)(F.lds + 12288);
    LAS float* Lg = (LAS float*)(F.lds + 16384);
    LAS float* rsL = (LAS float*)(F.lds + 16384 + 12288);
    LAS int* lcnt = (LAS int*)(F.lds + 16384 + 12288 + 256);
    LAS int* lbase = lcnt + 32;
    const int rt = F.wave & 3, kh = F.wave >> 2;
    if (tid < 32) lcnt[tid] = 0;
    __syncthreads();
    for (int blk = F.bx; blk < MTOK / 64; blk += F.G) {
        const int row0 = blk * 64 + rt * 16;
        const u32x4* xr = (const u32x4*)(xbf + (size_t)(row0 + (lane & 15)) * DM + kh * 512) + (lane >> 4);
        const f32x4* wp = wrp + (size_t)(kh * 16) * 3 * 128 + lane * 2;
        f32x4 acc0 = {0.f, 0.f, 0.f, 0.f}, acc1 = acc0, acc2 = acc0; float ss = 0.f;
#pragma unroll 4
        for (int i = 0; i < 16; ++i) {
            const u32x4 xw = xr[4 * i];
            const f32x4 w0a = wp[(i * 3 + 0) * 128], w0b = wp[(i * 3 + 0) * 128 + 1], w1a = wp[(i * 3 + 1) * 128], w1b = wp[(i * 3 + 1) * 128 + 1], w2a = wp[(i * 3 + 2) * 128], w2b = wp[(i * 3 + 2) * 128 + 1];
            const float xv[8] = {bflo(xw.x), bfhi(xw.x), bflo(xw.y), bfhi(xw.y), bflo(xw.z), bfhi(xw.z), bflo(xw.w), bfhi(xw.w)};
#pragma unroll
            for (int j = 0; j < 8; ++j) ss += xv[j] * xv[j];
#pragma unroll
            for (int s = 0; s < 4; ++s) {
                acc0 = __builtin_amdgcn_mfma_f32_16x16x4f32(xv[s], w0a[s], acc0, 0, 0, 0);
                acc1 = __builtin_amdgcn_mfma_f32_16x16x4f32(xv[s], w1a[s], acc1, 0, 0, 0);
                acc2 = __builtin_amdgcn_mfma_f32_16x16x4f32(xv[s], w2a[s], acc2, 0, 0, 0);
            }
#pragma unroll
            for (int s = 0; s < 4; ++s) {
                acc0 = __builtin_amdgcn_mfma_f32_16x16x4f32(xv[4 + s], w0b[s], acc0, 0, 0, 0);
                acc1 = __builtin_amdgcn_mfma_f32_16x16x4f32(xv[4 + s], w1b[s], acc1, 0, 0, 0);
                acc2 = __builtin_amdgcn_mfma_f32_16x16x4f32(xv[4 + s], w2b[s], acc2, 0, 0, 0);
            }
        }
        ss += shx(ss, 16, lane); ss += shx(ss, 32, lane);
        if (kh == 1) { part[(rt * 3 + 0) * 64 + lane] = acc0; part[(rt * 3 + 1) * 64 + lane] = acc1; part[(rt * 3 + 2) * 64 + lane] = acc2; if (lane < 16) ssp[rt * 16 + lane] = ss; }
        __syncthreads();
        if (kh == 0) {
            acc0 += part[(rt * 3 + 0) * 64 + lane]; acc1 += part[(rt * 3 + 1) * 64 + lane]; acc2 += part[(rt * 3 + 2) * 64 + lane];
            ss += ssp[rt * 16 + (lane & 15)];
#pragma unroll
            for (int g = 0; g < 4; ++g) { const int rw = rt * 16 + 4 * (lane >> 4) + g; Lg[rw * 48 + (lane & 15)] = acc0[g]; Lg[rw * 48 + 16 + (lane & 15)] = acc1[g]; Lg[rw * 48 + 32 + (lane & 15)] = acc2[g]; }
            if (lane < 16) rsL[rt * 16 + lane] = 1.0f / sqrtf(ss * (1.0f / DM) + NORM_EPS);
        }
        __syncthreads();
        int e1 = 0, e2 = 0, r1 = 0, r2 = 0; float w1 = 0.f, w2 = 0.f, rsv = 0.f;
        if (tid < 64) {
            const LAS float* Lr = Lg + tid * 48; rsv = rsL[tid];
            float gl[4];
#pragma unroll
            for (int g = 0; g < 4; ++g) gl[g] = Lr[g] * rsv + brg[g];
            int gi = 0; float gm = gl[0];
#pragma unroll
            for (int g = 1; g < 4; ++g) if (gl[g] > gm) { gm = gl[g]; gi = g; }
            float den = 0.f;
#pragma unroll
            for (int g = 0; g < 4; ++g) den += expf(gl[g] - gm);
            const float gw = 1.0f / den;
            float v1 = -INFINITY, v2 = -INFINITY; int i1 = 0, i2 = 0;
#pragma unroll
            for (int e = 0; e < 8; ++e) {
                const float v = Lr[4 + 8 * gi + e] * rsv + bre[8 * gi + e];
                if (v > v1) { v2 = v1; i2 = i1; v1 = v; i1 = e; } else if (v > v2) { v2 = v; i2 = e; }
            }
            const float p1 = 1.0f / (1.0f + expf(v2 - v1));
            e1 = 8 * gi + i1; e2 = 8 * gi + i2; w1 = p1 * gw; w2 = (1.0f - p1) * gw;
            r1 = __hip_atomic_fetch_add(&lcnt[e1], 1, __ATOMIC_RELAXED, __HIP_MEMORY_SCOPE_WORKGROUP); r2 = __hip_atomic_fetch_add(&lcnt[e2], 1, __ATOMIC_RELAXED, __HIP_MEMORY_SCOPE_WORKGROUP);
        }
        __syncthreads();
        if (tid < 32) { const int c = lcnt[tid]; lbase[tid] = c ? atomicAdd(&cnt[tid * CNT_STRIDE], c) : 0; lcnt[tid] = 0; }
        __syncthreads();
        if (tid < 64) {
            const int tok = blk * 64 + tid;
            const int pos1 = lbase[e1] + r1, pos2 = lbase[e2] + r2;
            ltok[e1 * MTOK + pos1] = tok; lw[e1 * MTOK + pos1] = w1;
            ltok[e2 * MTOK + pos2] = tok; lw[e2 * MTOK + pos2] = w2;
            tokinfo[tok] = (i32x4){e1, pos1, e2, pos2};
            rs2[tok] = rsv;
        }
        __syncthreads();
    }
}
__device__ __forceinline__ MoeTab moe_tables(const Frame& F, CArgs a, int l) {
    const int lane = otid(), tid = F.wave * 64 + lane; (void)tid; (void)lane;
    volatile LAS int* cntL = F.misc + 64; volatile LAS int* mtp = F.misc + 128; volatile LAS int* sp = F.misc + 192;
    const int* cnt = (const int*)(a->ws + WS_CTL) + CW_CNT + l * 32 * CNT_STRIDE;
    __syncthreads();
    if (tid < 32) cntL[tid] = __hip_atomic_load(cnt + tid * CNT_STRIDE, __ATOMIC_RELAXED, __HIP_MEMORY_SCOPE_AGENT);
    __syncthreads();
    if (tid == 0) { int mt = 0, s = 0; for (int e = 0; e < 32; ++e) { mtp[e] = mt; sp[e] = s; const int c = cntL[e]; mt += (c + 255) >> 8; s += c; } mtp[32] = mt; sp[32] = s; }
    __syncthreads();
    MoeTab T; T.cnt = cntL; T.mtpref = mtp; T.spref = sp; return T;
}
__device__ __forceinline__ void fin_phase(const Frame& F, CArgs a, int l, const MoeTab& T) {
    const int lane = otid(), tid = F.wave * 64 + lane; (void)tid;
    unsigned char* ws = a->ws;
    const i32x4* tokinfo = (const i32x4*)(ws + WS_TOKINFO); const bf16* Y = (const bf16*)(ws + WS_Y);
    bf16* xb = (bf16*)(ws + WS_XB); float* rs1 = (float*)(ws + WS_RS1);
    const int step = 2 * F.ngw;
    int m0 = 2 * F.gw;
    i32x4 tn0 = tokinfo[m0 < MTOK ? m0 : 0], tn1 = tokinfo[m0 + 1 < MTOK ? m0 + 1 : 0];
    for (; m0 < MTOK; m0 += step) {
        const i32x4 ti[2] = {tn0, tn1};
        const int mn = m0 + step;
        if (mn < MTOK) { tn0 = tokinfo[mn]; tn1 = tokinfo[mn + 1]; }
        u32x4 xv[2][2], p[2][2], q[2][2];
#pragma unroll
        for (int r = 0; r < 2; ++r) {
            const int m = m0 + r;
            const int s1 = T.spref[ti[r][0]] + ti[r][1], s2 = T.spref[ti[r][2]] + ti[r][3];
            const u32x4* xr = (const u32x4*)(xb + (size_t)m * DM) + lane;
            const u32x4* y1 = (const u32x4*)(Y + (size_t)s1 * DM) + lane; const u32x4* y2 = (const u32x4*)(Y + (size_t)s2 * DM) + lane;
#pragma unroll
            for (int j = 0; j < 2; ++j) { xv[r][j] = xr[64 * j]; p[r][j] = y1[64 * j]; q[r][j] = y2[64 * j]; }
        }
#pragma unroll
        for (int r = 0; r < 2; ++r) {
            const int m = m0 + r;
            float v[2][8]; float s = 0.f;
#pragma unroll
            for (int j = 0; j < 2; ++j) {
#define FINC(c, f) v[j][2 * c] = bflo(xv[r][j].f) + bflo(p[r][j].f) + bflo(q[r][j].f); v[j][2 * c + 1] = bfhi(xv[r][j].f) + bfhi(p[r][j].f) + bfhi(q[r][j].f);
                FINC(0, x) FINC(1, y) FINC(2, z) FINC(3, w)
#undef FINC
#pragma unroll
                for (int c = 0; c < 8; ++c) s += v[j][c] * v[j][c];
            }
            s = wave_sum(s, lane);
            const float rsv = 1.0f / sqrtf(s * (1.0f / DM) + NORM_EPS);
            if (l == DEPTH - 1) {
#pragma unroll
                for (int j = 0; j < 2; ++j) {
                    const f32x4* g = (const f32x4*)(a->fin_g + 512 * j + 8 * lane); f32x4* o = (f32x4*)(a->out + (size_t)m * DM + 512 * j + 8 * lane);
                    const f32x4 g0 = g[0], g1 = g[1];
                    o[0] = (f32x4){v[j][0] * rsv * g0[0], v[j][1] * rsv * g0[1], v[j][2] * rsv * g0[2], v[j][3] * rsv * g0[3]};
                    o[1] = (f32x4){v[j][4] * rsv * g1[0], v[j][5] * rsv * g1[1], v[j][6] * rsv * g1[2], v[j][7] * rsv * g1[3]};
                }
            } else {
                u32x4* o = (u32x4*)(xb + (size_t)m * DM) + lane;
#pragma unroll
                for (int j = 0; j < 2; ++j) { u32x4 w; w.x = cvtpk(v[j][0], v[j][1]); w.y = cvtpk(v[j][2], v[j][3]); w.z = cvtpk(v[j][4], v[j][5]); w.w = cvtpk(v[j][6], v[j][7]); o[64 * j] = w; }
                if (lane == 0) rs1[m] = rsv;
            }
        }
    }
}

constexpr int PH_PREP = 0, PH_GEMM1 = 1, PH_ATTN = 2, PH_COMB = 3, PH_MERGE = 4, PH_OUT = 5, PH_ROUTE = 6, PH_UP = 7, PH_DOWN = 8, PH_DOWN2 = 9, PH_FIN = 10, PH_PER_LAYER = 11, NPHASE = PH_PER_LAYER * DEPTH - 1;

__global__ void __launch_bounds__(NTHREADS, 2) fwd_kernel(Args a_by_value) {
    extern __shared__ __attribute__((aligned(16))) unsigned char lds_raw[];
    Frame F;
    F.lds = (LAS unsigned char*)lds_raw; F.misc = (volatile LAS int*)(F.lds + MISC_OFF);
    F.wave = __builtin_amdgcn_readfirstlane((int)threadIdx.x >> 6);
    F.G = gridDim.x; { const int bx = blockIdx.x; F.vcu = (F.G % 8 == 0) ? (bx % 8) * (F.G / 8) + bx / 8 : bx; }
    F.gw = blockIdx.x * NWAVES + F.wave; F.ngw = F.G * NWAVES;
    CArgs a = (CArgs)__builtin_amdgcn_kernarg_segment_ptr();
    unsigned char* ws = a->ws;
    const int ph_lo = a->ph_lo, ph_hi = a->ph_hi;
    for (int u = threadIdx.x; u < 1024; u += NTHREADS) F.misc[u] = 0;
    __syncthreads();
#if !MK_MULTI
    XcdBarrier bar = xcd_barrier_post((unsigned*)(ws + WS_CTL) + CW_BAR, (volatile LAS unsigned*)(F.misc + 8));
#define GRID_BAR() xcd_barrier(bar, F.wave)
#else
#define GRID_BAR() do { } while (0)
#endif
    for (int ph = ph_lo, rep = 0; ph < ph_hi; ) {
        const int l = ph >= PH_PER_LAYER ? 1 : 0, k = ph >= PH_PER_LAYER ? ph - (PH_PER_LAYER - 1) : ph;
        const size_t wlo = (size_t)l * WNE_LSTRIDE;
        {
            int bx = blockIdx.x; asm volatile("" : "+s"(bx)); asm volatile("" : "+s"(a)); ws = a->ws;
            int wv = F.wave; asm volatile("" : "+s"(wv)); F.gw = bx * NWAVES + wv; F.bx = bx;
        }
        if (k == PH_PREP && (PHMASK & 1)) {
            prep_phase(F, a);
        } else if (k == PH_GEMM1 && (PHMASK & 2)) {
            DenseSched S; S.A = (const char*)(ws + WS_XB); S.Bt = (const char*)(ws + wlo + WS_WIN); S.K = DM; S.lda = DM; S.ldb = DM; S.ksplit = 0; S.wave = F.wave; S.so.init(MTOK, DIN, F.G, F.bx);
            EpiProj E{(bf16*)(ws + WS_PQ), (bf16*)(ws + WS_PG), (const float*)(ws + WS_RS1), (const f32x4*)(ws + WS_ROPE)};
            pg8::gemm_phase(F.lds, S, E);
        } else if (k == PH_ATTN && (PHMASK & 4)) {
            attn_phase(F, a, l);
        } else if (k == PH_COMB && (PHMASK & 8)) {
            comb_phase(F, a);
        } else if (k == PH_MERGE && (PHMASK & 16)) {
            DenseSched S; S.A = (const char*)(ws + WS_YAB); S.Bt = (const char*)(ws + wlo + WS_WAB); S.K = 768; S.lda = 768; S.ldb = 768; S.ksplit = 256; S.wave = F.wave; S.so.init(MTOK, DM, F.G, F.bx);
            EpiMerge E{(const unsigned char*)(ws + WS_PG), (bf16*)(ws + WS_MRG)};
            pg8::gemm_phase(F.lds, S, E);
        } else if (k == PH_OUT && (PHMASK & 32)) {
            DenseSched S; S.A = (const char*)(ws + WS_MRG); S.Bt = (const char*)(ws + wlo + WS_WOUT); S.K = DM; S.lda = DM; S.ldb = DM; S.ksplit = 0; S.wave = F.wave; S.so.init(MTOK, DM, F.G, F.bx);
            EpiResid E{(bf16*)(ws + WS_XB)};
            pg8::gemm_phase(F.lds, S, E);
        } else if (k == PH_ROUTE && (PHMASK & 64)) {
            route_phase(F, a, l);
        } else if (k == PH_UP || k == PH_DOWN || k == PH_DOWN2) {
            const MoeTab T = moe_tables(F, a, l);
            const int mtT = T.mtpref[32], nU = 2 * mtT, nU1 = nU < F.G ? nU : F.G, nU2 = nU - nU1, tready = nU1 >> 1;
            const int bx = F.vcu;
            MoeSched<true> SU; SU.A = (const char*)(ws + WS_XB); SU.Bt = (const char*)(ws + WS_WGU); SU.K = DM; SU.lda = DM; SU.ldb = DM; SU.wave = F.wave; SU.ntn = 2; SU.bstride_e = (size_t)512 * DM * 2; SU.ltok = (const int*)(ws + WS_LTOK); SU.T = T;
            MoeSched<false> SD; SD.A = (const char*)(ws + WS_H); SD.Bt = (const char*)(ws + WS_WD); SD.K = DEXP; SD.lda = DEXP; SD.ldb = DEXP; SD.wave = F.wave; SD.ntn = 4; SD.bstride_e = (size_t)DM * DEXP * 2; SD.ltok = nullptr; SD.T = T;
            EpiSwiglu EU{(const int*)(ws + WS_LTOK), (const float*)(ws + WS_LW), (const float*)(ws + WS_RS2), (bf16*)(ws + WS_H)};
            EpiY ED{(bf16*)(ws + WS_Y)};
            if (k == PH_UP) { SU.G = F.G; SU.c = bx; SU.lo = 0; SU.hi = nU1; pg8::gemm_phase(F.lds, SU, EU); }
            else if (k == PH_DOWN) {
                if (bx < nU2) { SU.G = nU2; SU.c = bx; SU.lo = nU1; SU.hi = nU; pg8::gemm_phase(F.lds, SU, EU); }
                else { SD.G = F.G - nU2; SD.c = bx - nU2; SD.lo = 0; SD.hi = 4 * tready; pg8::gemm_phase(F.lds, SD, ED); }
            } else { SD.G = F.G; SD.c = bx; SD.lo = 4 * tready; SD.hi = 4 * mtT; pg8::gemm_phase(F.lds, SD, ED); }
        } else if (k == PH_FIN && (PHMASK & 512)) {
            const MoeTab T = moe_tables(F, a, l);
            fin_phase(F, a, l, T);
        }
#if REP_MASK
        if (l == 0 && ((REP_MASK >> k) & 1) && rep < REP_N) { ++rep; GRID_BAR(); continue; }
        rep = 0;
#endif
        if (ph + 1 < ph_hi) GRID_BAR();
        ++ph;
    }
}

extern "C" void kernel_launch(void* const* d_in, const int* in_sizes, int n_in, void* d_out, int out_size, void* d_ws, size_t ws_size, hipStream_t stream) {
    static int grid = 0;
    if (grid == 0) {
        if (n_in != 16 || out_size != MTOK * DM || ws_size < WS_END) { fprintf(stderr, "kernel_launch: unexpected shapes (n_in %d out %d ws %zu)\n", n_in, out_size, ws_size); grid = -1; return; }
        int dev = 0, cus = 0, per_cu = 0;
        if (hipGetDevice(&dev) != hipSuccess || hipDeviceGetAttribute(&cus, hipDeviceAttributeMultiprocessorCount, dev) != hipSuccess) { grid = -1; return; }
        if (hipFuncSetAttribute((const void*)fwd_kernel, hipFuncAttributeMaxDynamicSharedMemorySize, LDS_BYTES) != hipSuccess) { fprintf(stderr, "kernel_launch: hipFuncSetAttribute failed\n"); grid = -1; return; }
        if (hipOccupancyMaxActiveBlocksPerMultiprocessor(&per_cu, (const void*)fwd_kernel, NTHREADS, LDS_BYTES) != hipSuccess || per_cu < 1) { fprintf(stderr, "kernel_launch: occupancy query says %d\n", per_cu); (void)hipGetLastError(); }
        grid = cus;
    }
    if (grid < 0) return;
    (void)hipMemsetAsync((char*)d_ws + WS_CTL, 0, CTL_BYTES, stream);
    Args a{};
    a.x = (const float*)d_in[0]; a.attn_g = (const float*)d_in[1]; a.w_in = (const float*)d_in[2]; a.a_sink = (const float*)d_in[3]; a.w_a = (const float*)d_in[4]; a.w_b = (const float*)d_in[5];
    a.w_out = (const float*)d_in[6]; a.ffn_g = (const float*)d_in[7]; a.w_rg = (const float*)d_in[8]; a.b_rg = (const float*)d_in[9]; a.w_re = (const float*)d_in[10]; a.b_re = (const float*)d_in[11];
    a.w_eg = (const float*)d_in[12]; a.w_eu = (const float*)d_in[13]; a.w_ed = (const float*)d_in[14]; a.fin_g = (const float*)d_in[15];
    a.out = (float*)d_out; a.ws = (unsigned char*)d_ws;
#if MK_MULTI
    for (int ph = 0; ph < NPHASE; ++ph) { a.ph_lo = ph; a.ph_hi = ph + 1; hipLaunchKernelGGL(fwd_kernel, dim3(grid), dim3(NTHREADS), LDS_BYTES, stream, a); }
#else
    a.ph_lo = 0; a.ph_hi = NPHASE;
    void* kargs[] = {&a};
    const hipError_t le = hipLaunchCooperativeKernel((const void*)fwd_kernel, dim3(grid), dim3(NTHREADS), kargs, LDS_BYTES, stream);
    if (le != hipSuccess) fprintf(stderr, "kernel_launch: cooperative launch failed: %s (grid %d)\n", hipGetErrorString(le), grid);
#endif
}
```

```cpp
#include <hip/hip_runtime.h>
#include <hip/hip_cooperative_groups.h>
#include <cstdio>
#include <cstdint>
namespace cg = cooperative_groups;

#ifndef REP_MASK
#define REP_MASK 0
#define REP_N 2
#endif
#ifndef PHMASK
#define PHMASK 1023
#endif
#ifndef MK_MULTI
#define MK_MULTI 0
#endif

#define LAS __attribute__((address_space(3)))
#define GAS __attribute__((address_space(1)))
typedef unsigned short bf16;
typedef short bf16x8 __attribute__((ext_vector_type(8)));
typedef short s16x4 __attribute__((ext_vector_type(4)));
typedef float f32x2 __attribute__((ext_vector_type(2)));
typedef float f32x4 __attribute__((ext_vector_type(4)));
typedef float f32x16 __attribute__((ext_vector_type(16)));
typedef unsigned u32x2 __attribute__((ext_vector_type(2)));
typedef unsigned u32x4 __attribute__((ext_vector_type(4)));
typedef int i32x4 __attribute__((ext_vector_type(4)));
typedef __bf16 bf16x2_t __attribute__((ext_vector_type(2)));

constexpr int BATCH = 4, SEQ = 4096, DM = 1024, DEPTH = 2, MTOK = BATCH * SEQ;
constexpr int NQKV = 3072, NGATE = 2048, DIN = NQKV + NGATE;
constexpr int NEXP = 32, DEXP = 256;
constexpr float NORM_EPS = 1e-6f;
constexpr float LOG2E = 1.4426950408889634f, LN2 = 0.6931471805599453f;
constexpr float QSCALE = 0.125f * LOG2E;
constexpr int NWAVES = 8, NTHREADS = 512;

constexpr size_t MiB = 1u << 20;
constexpr size_t WS_CTL = 0, CTL_BYTES = 1 * MiB;
constexpr size_t WS_ROPE = 1 * MiB;
constexpr size_t WS_WR = 2 * MiB, WR_LSTRIDE = 512 * 1024, WR_LO = 256 * 1024;
constexpr size_t WS_RS1 = 3 * MiB, WS_RS2 = 3 * MiB + 65536;
constexpr size_t WS_TOKINFO = 5 * MiB;
constexpr size_t WS_LTOK = 6 * MiB, WS_LW = 8 * MiB;
constexpr size_t WS_LSE = 10 * MiB;
constexpr size_t WS_WIN = 12 * MiB, WS_WAB = 22 * MiB, WS_WOUT = 24 * MiB, WNE_LSTRIDE = 14 * MiB;
constexpr size_t WS_WGU = 40 * MiB, WS_WD = 72 * MiB;
constexpr size_t WS_XB = 88 * MiB;
constexpr size_t WS_YAB = 120 * MiB;
constexpr size_t WS_PQ = 144 * MiB;
constexpr size_t WS_MRG = 176 * MiB, WS_H = 208 * MiB;
constexpr size_t WS_PG = 240 * MiB;
constexpr size_t WS_Y = 240 * MiB;
constexpr size_t WS_END = 304 * MiB;
constexpr int CW_CNT = 64, CNT_STRIDE = 64;
constexpr int CW_BAR = 8192;

constexpr int RING_BYTES = 131072;
constexpr int PREP_SCR = 16896;
constexpr int MISC_OFF = 8 * PREP_SCR;
constexpr int LDS_BYTES = 147456;

#define LDS_WAIT() asm volatile("s_waitcnt lgkmcnt(0)" ::: "memory")
#define VM_WAIT() asm volatile("s_waitcnt vmcnt(0)" ::: "memory")
__device__ __forceinline__ unsigned cvtpk(float lo, float hi) { f32x2 v = {lo, hi}; bf16x2_t b = __builtin_convertvector(v, bf16x2_t); return __builtin_bit_cast(unsigned, b); }
__device__ __forceinline__ float bf2f(unsigned short h) { return __uint_as_float(((unsigned)h) << 16); }
__device__ __forceinline__ float bflo(unsigned w) { return __uint_as_float(w << 16); }
__device__ __forceinline__ float bfhi(unsigned w) { return __uint_as_float(w & 0xffff0000u); }
__device__ __forceinline__ float fast_exp2(float x) { return __builtin_amdgcn_exp2f(x); }
__device__ __forceinline__ float fast_rcp(float x) { return __builtin_amdgcn_rcpf(x); }
__device__ __forceinline__ float sigmoidf_fast(float v) { return fast_rcp(1.0f + fast_exp2(-v * LOG2E)); }

namespace pg8 {
constexpr int BM = 256, BK = 64, HALF = 128, HTB = HALF * BK * 2, STAGE_BYTES = 8 * HTB, NXCD = 8, WGM = 4;
__host__ __device__ __forceinline__ int lds_byte(int r, int c) { const int st = (r >> 4) * 2 + (c >> 5), rr = r & 15, cc = c & 31, ob = rr * 64 + cc * 2; return st * 1024 + (ob ^ (((ob >> 9) & 1) << 5)); }
__host__ __device__ __forceinline__ void stage_rc(int b, int& R, int& C) { const int st = b / 1024, sb = b % 1024, swz = sb ^ (((sb >> 9) & 1) << 5); R = (st >> 1) * 16 + swz / 64; C = (st & 1) * 32 + (swz % 64) / 2; }
__host__ __device__ __forceinline__ int perm32(int rho) { const int n = rho >> 4, i = rho & 15; return 8 * (i >> 2) + 4 * n + (i & 3); }

struct Unit { int pm, pn, e, nvalid, slot0, lpos0, nt, kofs, sub; };

struct StaticOrder {
    int nM, nN, nwg, G, c;
    __device__ void init(int M, int N, int G_, int c_) { nM = M / BM; nN = N / BM; nwg = nM * nN; G = G_; c = c_; }
    __device__ bool next(int i, int& pm, int& pn) const {
        const long L = (long)i * G + c; if (L >= nwg) return false;
        int wgid = (int)L; { const int q = nwg / NXCD, r = nwg % NXCD, xcd = wgid % NXCD, off = wgid / NXCD; wgid = (xcd < r ? xcd * (q + 1) : r * (q + 1) + (xcd - r) * q) + off; }
        const int nig = WGM * nN, gid = wgid / nig, fm = gid * WGM, gsz = (nM - fm) < WGM ? (nM - fm) : WGM;
        pm = fm + ((wgid % nig) % gsz); pn = (wgid % nig) / gsz; return true;
    }
};

template <class Epi, class Sched>
__device__ __forceinline__ void gemm_phase(LAS unsigned char* lds, const Sched& S, const Epi& E) {
    unsigned z_ = 0u; asm volatile("" : "+v"(z_)); const int tid_ = (int)__builtin_amdgcn_mbcnt_hi(~0u, __builtin_amdgcn_mbcnt_lo(~0u, z_)) + S.wave * 64;
    const int tid = tid_, wid = S.wave, lane = tid & 63, wr = wid >> 2, wc = wid & 3, fr = lane & 15, fq = lane >> 4;
    const int K = S.ldb;
    unsigned voffA[2], voffB[2];
#pragma unroll
    for (int i = 0; i < 2; ++i) { int R, C; stage_rc(tid * 16 + i * 8192, R, C); const int Rb = Epi::PERM ? ((R & ~31) + perm32(R & 31)) : R;
        voffA[i] = (unsigned)(R * S.lda + C) * 2u; voffB[i] = (unsigned)(Rb * K + C) * 2u; }
    const size_t kstep = (size_t)(BK * 2);
    const size_t hstepB = (size_t)HALF * K * 2, hstepA = (size_t)HALF * S.lda * 2;
    const unsigned ldsw = (unsigned)wid * 1024u;
    const int aoff = lds_byte(wr * 64 + fr, fq * 8), boff = lds_byte(wc * 32 + fr, fq * 8);
#define PG8_SA(b, h) (((b) * 2 + (h)) * HTB)
#define PG8_SB(b, h) ((4 + (b) * 2 + (h)) * HTB)
#define PG8_GLDS(src, dstoff) __builtin_amdgcn_global_load_lds((const unsigned*)(src), (LAS unsigned*)(lds + (dstoff)), 16, 0, 0)
#define PG8_STAGE_A(bufoff, up, h, VO) do { if constexpr (Sched::GATHER) { _Pragma("unroll") for (int _i = 0; _i < 2; ++_i) PG8_GLDS((up) + VO[_i], (bufoff) + ldsw + _i * 8192); } \
        else { const char* _b = (up) + (size_t)(h) * hstepA; _Pragma("unroll") for (int _i = 0; _i < 2; ++_i) PG8_GLDS(_b + voffA[_i], (bufoff) + ldsw + _i * 8192); } } while (0)
#define PG8_STAGE_B(bufoff, bp) do { _Pragma("unroll") for (int _i = 0; _i < 2; ++_i) PG8_GLDS((bp) + voffB[_i], (bufoff) + ldsw + _i * 8192); } while (0)
#define PG8_LDA(dst, b, h) do { _Pragma("unroll") for (int m = 0; m < 4; ++m) _Pragma("unroll") for (int k = 0; k < 2; ++k) dst[m][k] = *(const LAS bf16x8*)(lds + PG8_SA(b, h) + aoff + m * 2048 + k * 1024); } while (0)
#define PG8_LDB(dst, b, h) do { _Pragma("unroll") for (int n = 0; n < 2; ++n) _Pragma("unroll") for (int k = 0; k < 2; ++k) dst[n][k] = *(const LAS bf16x8*)(lds + PG8_SB(b, h) + boff + n * 2048 + k * 1024); } while (0)
#define PG8_MMA(ai, bj, At, Bt) do { __builtin_amdgcn_s_setprio(1); _Pragma("unroll") for (int m = 0; m < 4; ++m) _Pragma("unroll") for (int n = 0; n < 2; ++n) _Pragma("unroll") for (int k = 0; k < 2; ++k) \
        acc[ai][bj][m][n] = __builtin_amdgcn_mfma_f32_16x16x32_bf16(Bt[n][k], At[m][k], acc[ai][bj][m][n], 0, 0, 0); __builtin_amdgcn_s_setprio(0); } while (0)
#define PG8_WAIT_V(n) asm volatile("s_waitcnt vmcnt(" #n ")" ::: "memory")
#define PG8_WAIT_L(n) asm volatile("s_waitcnt lgkmcnt(" #n ")" ::: "memory")
#define PG8_BAR __builtin_amdgcn_s_barrier()
#define PG8_SCHED __builtin_amdgcn_sched_barrier(0)
    Unit cur, nxt; int ui = 0;
    if (!S.next(0, cur)) return;
    f32x4 acc[2][2][4][2];
#pragma unroll
    for (int a = 0; a < 2; ++a)
#pragma unroll
        for (int b = 0; b < 2; ++b)
#pragma unroll
            for (int m = 0; m < 4; ++m)
#pragma unroll
                for (int n = 0; n < 2; ++n) acc[a][b][m][n] = (f32x4){0.f, 0.f, 0.f, 0.f};
    bf16x8 At[4][2], B0[2][2], B1[2][2];
    const char* Ab = S.a_base();
    const char* cA = Ab; const char* cB = S.b_base(cur);
    unsigned vF0[2], vF1[2], vK[2];
    if constexpr (Sched::GATHER) {
#pragma unroll
        for (int i = 0; i < 2; ++i) { int R, C; stage_rc(tid * 16 + i * 8192, R, C); vF0[i] = S.a_off(cur, R) + (unsigned)(C * 2); vF1[i] = S.a_off(cur, HALF + R) + (unsigned)(C * 2); vK[i] = vF1[i]; }
    } else cA = Ab + S.a_unit_off(cur);
    PG8_STAGE_B(PG8_SB(0, 0), cB); PG8_STAGE_B(PG8_SB(0, 1), cB + hstepB); PG8_STAGE_A(PG8_SA(0, 0), cA, 0, vF0); PG8_STAGE_A(PG8_SA(0, 1), cA, 1, vF1);
    if (wr == 1) PG8_BAR;
    PG8_WAIT_V(2); PG8_BAR;
    PG8_STAGE_B(PG8_SB(1, 0), cB + kstep); PG8_STAGE_A(PG8_SA(1, 0), cA + kstep, 0, vF0); PG8_STAGE_B(PG8_SB(1, 1), cB + hstepB + kstep);
    PG8_WAIT_V(6); PG8_BAR;
    for (;;) {
        const bool has_next = S.next(ui + 1, nxt);
        const char* nA = cA; const char* nB = cB;
        if (has_next) { nB = S.b_base(nxt); if constexpr (!Sched::GATHER) nA = Ab + S.a_unit_off(nxt); }
        const int nt = cur.nt;
#pragma unroll 1
        for (int t = 0; t < nt; t += 2) {
            const bool last = (t == nt - 2);
            const char* a1 = cA + (size_t)(t + 1) * kstep;
            const char* a2 = last ? nA : cA + (size_t)(t + 2) * kstep; const char* b2 = last ? nB : cB + (size_t)(t + 2) * kstep;
            const char* a3 = a2 + kstep; const char* b3 = b2 + kstep;
            if constexpr (Sched::GATHER) {
                if (last && has_next) {
#pragma unroll
                    for (int i = 0; i < 2; ++i) { int R, C; stage_rc(tid * 16 + i * 8192, R, C); vF0[i] = S.a_off(nxt, R) + (unsigned)(C * 2); vF1[i] = S.a_off(nxt, HALF + R) + (unsigned)(C * 2); }
                }
            }
            PG8_LDB(B0, 0, 0); PG8_LDB(B1, 0, 1); PG8_SCHED; PG8_LDA(At, 0, 0); PG8_STAGE_A(PG8_SA(1, 1), a1, 1, vK);
            PG8_WAIT_V(8); PG8_WAIT_L(0); PG8_BAR; PG8_MMA(0, 0, At, B0); PG8_MMA(0, 1, At, B1); PG8_BAR; PG8_SCHED;
            PG8_LDA(At, 0, 1); PG8_STAGE_B(PG8_SB(0, 0), b2); PG8_STAGE_B(PG8_SB(0, 1), b2 + hstepB); PG8_STAGE_A(PG8_SA(0, 0), a2, 0, vF0);
            PG8_WAIT_V(8); PG8_WAIT_L(0); PG8_BAR; PG8_MMA(1, 0, At, B0); PG8_MMA(1, 1, At, B1); PG8_BAR; PG8_SCHED;
            PG8_LDB(B0, 1, 0); PG8_LDB(B1, 1, 1); PG8_SCHED; PG8_LDA(At, 1, 0); PG8_STAGE_A(PG8_SA(0, 1), a2, 1, vF1);
            PG8_WAIT_V(8); PG8_WAIT_L(0); PG8_BAR; PG8_MMA(0, 0, At, B0); PG8_MMA(0, 1, At, B1); PG8_BAR; PG8_SCHED;
            PG8_LDA(At, 1, 1); PG8_STAGE_B(PG8_SB(1, 0), b3); PG8_STAGE_B(PG8_SB(1, 1), b3 + hstepB); PG8_STAGE_A(PG8_SA(1, 0), a3, 0, vF0);
            PG8_WAIT_V(8); PG8_WAIT_L(0); PG8_BAR; PG8_MMA(1, 0, At, B0); PG8_MMA(1, 1, At, B1); PG8_BAR; PG8_SCHED;
        }
        if (wr == 0) PG8_BAR;
        bool keep = false;
        if constexpr (Epi::HAS_MID) { if (cur.sub == 0) { E.mid(acc, cur, wr, wc, fr, fq); keep = true; } else E(acc, cur, wr, wc, fr, fq); }
        else E(acc, cur, wr, wc, fr, fq);
        if (!has_next) break;
        if (!keep) {
#pragma unroll
        for (int a = 0; a < 2; ++a)
#pragma unroll
            for (int b = 0; b < 2; ++b)
#pragma unroll
                for (int m = 0; m < 4; ++m)
#pragma unroll
                    for (int n = 0; n < 2; ++n) acc[a][b][m][n] = (f32x4){0.f, 0.f, 0.f, 0.f};
        }
        cur = nxt; cA = nA; cB = nB; ++ui;
        if constexpr (Sched::GATHER) { vK[0] = vF1[0]; vK[1] = vF1[1]; }
        if (wr == 1) PG8_BAR;
    }
    PG8_WAIT_V(0);
    PG8_BAR;
#undef PG8_SA
#undef PG8_SB
#undef PG8_GLDS
#undef PG8_STAGE_A
#undef PG8_STAGE_B
#undef PG8_LDA
#undef PG8_LDB
#undef PG8_MMA
#undef PG8_WAIT_V
#undef PG8_WAIT_L
#undef PG8_BAR
#undef PG8_SCHED
}
}
using pg8::Unit;

struct DenseSched {
    static constexpr bool GATHER = false;
    const char* A; const char* Bt; int K; int lda; int ldb; int wave; int ksplit; pg8::StaticOrder so;
    __device__ __forceinline__ bool next(int i, Unit& u) const {
        int pm, pn; const int ti = ksplit ? (i >> 1) : i; if (!so.next(ti, pm, pn)) return false;
        u.pm = pm; u.pn = pn; u.e = 0; u.nvalid = 256; u.slot0 = pm * 256; u.lpos0 = 0;
        if (ksplit) { u.sub = i & 1; u.kofs = u.sub ? ksplit : 0; u.nt = (u.sub ? K - ksplit : ksplit) / 64; } else { u.sub = 1; u.kofs = 0; u.nt = K / 64; }
        return true; }
    __device__ __forceinline__ const char* a_base() const { return A; }
    __device__ __forceinline__ unsigned a_off(const Unit& u, int r) const { return 0u; }
    __device__ __forceinline__ size_t a_unit_off(const Unit& u) const { return ((size_t)u.pm * 256 * lda + u.kofs) * 2; }
    __device__ __forceinline__ const char* b_base(const Unit& u) const { return Bt + ((size_t)u.pn * 256 * ldb + u.kofs) * 2; }
};
struct MoeTab { const volatile LAS int* cnt; const volatile LAS int* mtpref; const volatile LAS int* spref; };
template <bool GATHER_> struct MoeSched {
    static constexpr bool GATHER = GATHER_;
    const char* A; const char* Bt; int K; int lda; int ldb; int wave; int ntn; size_t bstride_e; const int* ltok; MoeTab T; int G, c, lo, hi;
    __device__ __forceinline__ bool next(int i, Unit& u) const {
        const int L = lo + i * G + c; if (c < 0 || L >= hi) return false;
        const int tix = L / ntn; u.pn = L - tix * ntn; u.pm = tix;
        int e = 0;
#pragma unroll 1
        for (int k = 1; k < 32; ++k) if (T.mtpref[k] <= tix) e = k;
        const int mt = tix - T.mtpref[e]; u.e = e; u.slot0 = T.spref[e] + 256 * mt; const int rem = T.cnt[e] - 256 * mt; u.nvalid = rem < 256 ? rem : 256; u.lpos0 = e * MTOK + 256 * mt; u.nt = K / 64; u.kofs = 0; u.sub = 1; return true;
    }
    __device__ __forceinline__ const char* a_base() const { return A; }
    __device__ __forceinline__ unsigned a_off(const Unit& u, int r) const { const int rr = r < u.nvalid ? r : u.nvalid - 1; return (unsigned)ltok[u.lpos0 + rr] * (unsigned)(lda * 2); }
    __device__ __forceinline__ size_t a_unit_off(const Unit& u) const { return (size_t)u.slot0 * lda * 2; }
    __device__ __forceinline__ const char* b_base(const Unit& u) const { return Bt + (size_t)u.e * bstride_e + (size_t)u.pn * 256 * K * 2; }
};

#define OPAQUE(p) asm volatile("" : "+v"(p))
struct EpiProj {
    static constexpr bool PERM = true, REPEAT = true, HAS_MID = false;
    bf16* Pq; bf16* Pg; const float* rs; const f32x4* rope;
    __device__ __forceinline__ static void rot(f32x4& c, const f32x4& st) {
        const f32x4 o = c;
        c[0] = o[0] * st[0] - o[1] * st[1]; c[1] = o[1] * st[0] + o[0] * st[1];
        c[2] = o[2] * st[2] - o[3] * st[3]; c[3] = o[3] * st[2] + o[2] * st[3];
    }
    __device__ __forceinline__ void operator()(const f32x4 (&acc)[2][2][4][2], const Unit& u, int wr, int wc, int fr, int fq) const {
        const int colh = wc * 32 + fq * 8;
        const int ib = (colh & 63) >> 2;
        const int row0 = u.pm * 256 + wr * 64 + fr;
        int mode[2]; bf16* ob[2]; size_t ostep[2];
#pragma unroll
        for (int bj = 0; bj < 2; ++bj) {
            const int h128 = 2 * u.pn + bj;
            if (h128 >= 24) mode[bj] = 3;
            else if (h128 < 6) mode[bj] = h128 < 4 ? 1 : (h128 == 4 ? 2 : 0);
            else { const int j = (h128 - 6) % 6; mode[bj] = j < 2 ? 1 : (j < 4 ? 2 : 0); }
            if (h128 < 24) { ob[bj] = Pq + h128 * 128 + colh + (size_t)row0 * NQKV; ostep[bj] = (size_t)NQKV * 16; }
            else { ob[bj] = Pg + (((h128 - 24) * 128 + colh) >> 1) + (size_t)row0 * (NGATE / 2); ostep[bj] = (size_t)(NGATE / 2) * 16; }
        }
        float rsv[8];
#pragma unroll
        for (int i = 0; i < 8; ++i) rsv[i] = rs[row0 + (i >> 2) * 128 + (i & 3) * 16];
        const f32x4* rp = rope + (size_t)(row0 & (SEQ - 1)) * 16 + ib;
        f32x4 c0 = rp[0], c1 = rp[1];
        const f32x4 s16a = rope[16 * 16 + ib], s16b = rope[16 * 16 + ib + 1], s80a = rope[80 * 16 + ib], s80b = rope[80 * 16 + ib + 1];
#pragma unroll
        for (int ai = 0; ai < 2; ++ai)
#pragma unroll
            for (int m = 0; m < 4; ++m) {
                OPAQUE(ob[0]); OPAQUE(ob[1]);
                const float s = rsv[ai * 4 + m];
#pragma unroll
                for (int bj = 0; bj < 2; ++bj) {
                    f32x4 v0 = acc[ai][bj][m][0] * s, v1 = acc[ai][bj][m][1] * s;
                    if (mode[bj] == 1 || mode[bj] == 2) {
                        f32x4 o0, o1;
                        o0[0] = v0[0] * c0[0] - v0[1] * c0[1]; o0[1] = v0[1] * c0[0] + v0[0] * c0[1];
                        o0[2] = v0[2] * c0[2] - v0[3] * c0[3]; o0[3] = v0[3] * c0[2] + v0[2] * c0[3];
                        o1[0] = v1[0] * c1[0] - v1[1] * c1[1]; o1[1] = v1[1] * c1[0] + v1[0] * c1[1];
                        o1[2] = v1[2] * c1[2] - v1[3] * c1[3]; o1[3] = v1[3] * c1[2] + v1[2] * c1[3];
                        const float qs = (mode[bj] == 1) ? QSCALE : 1.0f;
                        v0 = o0 * qs; v1 = o1 * qs;
                    } else if (mode[bj] == 3) {
#pragma unroll
                        for (int j = 0; j < 4; ++j) { v0[j] = sigmoidf_fast(v0[j]); v1[j] = sigmoidf_fast(v1[j]); }
                    }
                    if (mode[bj] == 3) {
                        unsigned q[8];
#pragma unroll
                        for (int j = 0; j < 4; ++j) { q[j] = (unsigned)fminf(v0[j] * 256.0f, 255.0f); q[4 + j] = (unsigned)fminf(v1[j] * 256.0f, 255.0f); }
                        u32x2 w; w.x = q[0] | (q[1] << 8) | (q[2] << 16) | (q[3] << 24); w.y = q[4] | (q[5] << 8) | (q[6] << 16) | (q[7] << 24);
                        *(u32x2*)(ob[bj]) = w;
                    } else {
                        u32x4 w; w.x = cvtpk(v0[0], v0[1]); w.y = cvtpk(v0[2], v0[3]); w.z = cvtpk(v1[0], v1[1]); w.w = cvtpk(v1[2], v1[3]);
                        *(u32x4*)(ob[bj]) = w;
                    }
                }
                if (m == 3) { rot(c0, s80a); rot(c1, s80b); } else { rot(c0, s16a); rot(c1, s16b); }
                const int adv = (m == 3) ? 5 : 1;
                ob[0] += ostep[0] * adv; ob[1] += ostep[1] * adv;
            }
    }
};
struct EpiMerge {
    static constexpr bool PERM = true, REPEAT = false, HAS_MID = true;
    const unsigned char* gate; bf16* out;
    __device__ __forceinline__ static float dq(unsigned w, int k) { return ((float)((w >> (8 * k)) & 255u) + 0.5f) * (1.0f / 256.0f); }
    __device__ __forceinline__ void mid(f32x4 (&acc)[2][2][4][2], const Unit& u, int wr, int wc, int fr, int fq) const {
        const int row0 = u.pm * 256 + wr * 64 + fr, col0 = u.pn * 256 + wc * 32 + fq * 8;
        const unsigned char* gp = gate + (size_t)row0 * NGATE + col0;
        u32x2 ga[2][2], gb[2][2];
#define EM_LOAD(slot, i) do { const size_t ro = (size_t)(16 * (i) + 64 * ((i) >> 2)) * NGATE; ga[slot][0] = *(const u32x2*)(gp + ro); ga[slot][1] = *(const u32x2*)(gp + ro + 128); \
        gb[slot][0] = *(const u32x2*)(gp + ro + 1024); gb[slot][1] = *(const u32x2*)(gp + ro + 1024 + 128); } while (0)
        EM_LOAD(0, 0);
#pragma unroll
        for (int i = 0; i < 8; ++i) {
            const int ai = i >> 2, m = i & 3, sl = i & 1;
            if (i + 1 < 8) { if (sl == 0) EM_LOAD(1, i + 1); else EM_LOAD(0, i + 1); }
#pragma unroll
            for (int bj = 0; bj < 2; ++bj) {
                const u32x2 A = ga[sl][bj], B = gb[sl][bj];
#pragma unroll
                for (int j = 0; j < 4; ++j) {
                    acc[ai][bj][m][0][j] *= dq(B.x, j) * fast_rcp(dq(A.x, j));
                    acc[ai][bj][m][1][j] *= dq(B.y, j) * fast_rcp(dq(A.y, j));
                }
            }
        }
#undef EM_LOAD
    }
    __device__ __forceinline__ void operator()(const f32x4 (&acc)[2][2][4][2], const Unit& u, int wr, int wc, int fr, int fq) const {
        const int row0 = u.pm * 256 + wr * 64 + fr, col0 = u.pn * 256 + wc * 32 + fq * 8;
        const unsigned char* gp = gate + (size_t)row0 * NGATE + col0; bf16* op = out + (size_t)row0 * DM + col0;
        u32x2 ga[2][2];
#define EF_LOAD(slot, i) do { const size_t ro = (size_t)(16 * (i) + 64 * ((i) >> 2)) * NGATE; ga[slot][0] = *(const u32x2*)(gp + ro); ga[slot][1] = *(const u32x2*)(gp + ro + 128); } while (0)
        EF_LOAD(0, 0);
#pragma unroll
        for (int i = 0; i < 8; ++i) {
            const int ai = i >> 2, m = i & 3, sl = i & 1;
            if (i + 1 < 8) { if (sl == 0) EF_LOAD(1, i + 1); else EF_LOAD(0, i + 1); }
            bf16* orow = op + (size_t)(16 * i + 64 * (i >> 2)) * DM;
#pragma unroll
            for (int bj = 0; bj < 2; ++bj) {
                const u32x2 A = ga[sl][bj];
                const f32x4 a0 = acc[ai][bj][m][0], a1 = acc[ai][bj][m][1];
                u32x4 w;
                w.x = cvtpk(a0[0] * dq(A.x, 0), a0[1] * dq(A.x, 1)); w.y = cvtpk(a0[2] * dq(A.x, 2), a0[3] * dq(A.x, 3));
                w.z = cvtpk(a1[0] * dq(A.y, 0), a1[1] * dq(A.y, 1)); w.w = cvtpk(a1[2] * dq(A.y, 2), a1[3] * dq(A.y, 3));
                *(u32x4*)(orow + bj * 128) = w;
            }
            asm volatile("" ::: "memory");
        }
#undef EF_LOAD
    }
};
struct EpiResid {
    static constexpr bool PERM = true, REPEAT = false, HAS_MID = false;
    bf16* xb;
    __device__ __forceinline__ void operator()(const f32x4 (&acc)[2][2][4][2], const Unit& u, int wr, int wc, int fr, int fq) const {
        const int row0 = u.pm * 256 + wr * 64 + fr, col0 = u.pn * 256 + wc * 32 + fq * 8;
        bf16* xp = xb + (size_t)row0 * DM + col0;
        u32x4 p[2][2];
#define ER_LOAD(slot, i) do { const size_t ro = (size_t)(16 * (i) + 64 * ((i) >> 2)); p[slot][0] = *(const u32x4*)(xp + ro * DM); p[slot][1] = *(const u32x4*)(xp + ro * DM + 128); } while (0)
        ER_LOAD(0, 0);
#pragma unroll
        for (int i = 0; i < 8; ++i) {
            const int ai = i >> 2, m = i & 3, sl = i & 1;
            if (i + 1 < 8) { if (sl == 0) ER_LOAD(1, i + 1); else ER_LOAD(0, i + 1); }
            bf16* orow = xp + (size_t)(16 * i + 64 * (i >> 2)) * DM;
#pragma unroll
            for (int bj = 0; bj < 2; ++bj) {
                const u32x4 q = p[sl][bj];
                const f32x4 a0 = acc[ai][bj][m][0], a1 = acc[ai][bj][m][1];
                u32x4 w;
                w.x = cvtpk(a0[0] + bflo(q.x), a0[1] + bfhi(q.x)); w.y = cvtpk(a0[2] + bflo(q.y), a0[3] + bfhi(q.y));
                w.z = cvtpk(a1[0] + bflo(q.z), a1[1] + bfhi(q.z)); w.w = cvtpk(a1[2] + bflo(q.w), a1[3] + bfhi(q.w));
                *(u32x4*)(orow + bj * 128) = w;
            }
            asm volatile("" ::: "memory");
        }
#undef ER_LOAD
    }
};
struct EpiSwiglu {
    static constexpr bool PERM = true, REPEAT = false, HAS_MID = false;
    const int* ltok; const float* lw; const float* rs; bf16* H;
    __device__ __forceinline__ void operator()(const f32x4 (&acc)[2][2][4][2], const Unit& u, int wr, int wc, int fr, int fq) const {
        int tok[8]; float w8[8], s8[8];
#pragma unroll
        for (int i = 0; i < 8; ++i) { const int rr = (i >> 2) * 128 + wr * 64 + (i & 3) * 16 + fr; const int rc = rr < u.nvalid ? rr : u.nvalid - 1; tok[i] = ltok[u.lpos0 + rc]; w8[i] = lw[u.lpos0 + rc]; }
#pragma unroll
        for (int i = 0; i < 8; ++i) s8[i] = rs[tok[i]];
#pragma unroll
        for (int ai = 0; ai < 2; ++ai)
#pragma unroll
            for (int m = 0; m < 4; ++m) {
                const int rr = ai * 128 + wr * 64 + m * 16 + fr;
                if (rr < u.nvalid) {
                    const float w = w8[ai * 4 + m], s = s8[ai * 4 + m];
#pragma unroll
                    for (int bj = 0; bj < 2; ++bj) {
                        const f32x4 a0 = acc[ai][bj][m][0] * s, a1 = acc[ai][bj][m][1] * s;
                        const float h0 = a0[0] * sigmoidf_fast(a0[0]) * a0[1] * w, h1 = a0[2] * sigmoidf_fast(a0[2]) * a0[3] * w;
                        const float h2 = a1[0] * sigmoidf_fast(a1[0]) * a1[1] * w, h3 = a1[2] * sigmoidf_fast(a1[2]) * a1[3] * w;
                        u32x2 o; o.x = cvtpk(h0, h1); o.y = cvtpk(h2, h3);
                        *(u32x2*)(H + (size_t)(u.slot0 + rr) * DEXP + u.pn * 128 + bj * 64 + wc * 16 + fq * 4) = o;
                    }
                }
            }
    }
};
struct EpiY {
    static constexpr bool PERM = true, REPEAT = false, HAS_MID = false;
    bf16* Y;
    __device__ __forceinline__ void operator()(const f32x4 (&acc)[2][2][4][2], const Unit& u, int wr, int wc, int fr, int fq) const {
#pragma unroll
        for (int ai = 0; ai < 2; ++ai)
#pragma unroll
            for (int m = 0; m < 4; ++m) {
                const int rr = ai * 128 + wr * 64 + m * 16 + fr;
                if (rr < u.nvalid) {
#pragma unroll
                    for (int bj = 0; bj < 2; ++bj) {
                        const f32x4 a0 = acc[ai][bj][m][0], a1 = acc[ai][bj][m][1];
                        u32x4 w; w.x = cvtpk(a0[0], a0[1]); w.y = cvtpk(a0[2], a0[3]); w.z = cvtpk(a1[0], a1[1]); w.w = cvtpk(a1[2], a1[3]);
                        *(u32x4*)(Y + (size_t)(u.slot0 + rr) * DM + u.pn * 256 + bj * 128 + wc * 32 + fq * 8) = w;
                    }
                }
            }
    }
};

#define XB_TMO      128
#define XB_XCNT(j)  (256  + 64 * (j))
#define XB_XSUB(j)  (1280 + 64 * (j))
#define XB_XGEN(j)  (2304 + 64 * (j))
#define XB_TOP      3328
#define XB_TOPGEN   3392
#define XCD_BAR_WORDS 3456
#define XB_SPIN_CAP (1u << 18)
__device__ __forceinline__ unsigned xb_ld(unsigned* p)              { return __hip_atomic_load(p, __ATOMIC_RELAXED, __HIP_MEMORY_SCOPE_AGENT); }
__device__ __forceinline__ unsigned xb_add(unsigned* p, unsigned v) { return __hip_atomic_fetch_add(p, v, __ATOMIC_RELAXED, __HIP_MEMORY_SCOPE_AGENT); }
__device__ __forceinline__ unsigned xb_xcc_id() { return (unsigned)__builtin_amdgcn_s_getreg((3 << 11) | 20) & 0xFu; }
#define XB_SPIN(cond, bar) do { unsigned _sp = 0; while (cond) { __builtin_amdgcn_s_sleep(1); \
    if ((++_sp & 255u) == 0u) { if (xb_ld(&(bar)[XB_TMO])) break; if (_sp > XB_SPIN_CAP) { atomicAdd(&(bar)[XB_TMO], 1u); break; } } } } while (0)
struct XcdBarrier { unsigned* bar; unsigned x; volatile LAS unsigned* st; };
__device__ __forceinline__ XcdBarrier xcd_barrier_post(unsigned* bar, volatile LAS unsigned* st) {
    XcdBarrier b; b.bar = bar; b.x = xb_xcc_id(); b.st = st;
    if (threadIdx.x == 0) (void)xb_add(&bar[XB_XCNT(b.x)], 1u);
    return b;
}
__device__ __forceinline__ void xcd_barrier_complete(unsigned* bar, unsigned x, unsigned& nloc, unsigned& nx) {
    const unsigned G = gridDim.x * gridDim.y * gridDim.z;
    unsigned sum, cnt, mine, sp = 0u;
    for (;;) {
        sum = 0u; cnt = 0u; mine = 0u;
#pragma unroll
        for (unsigned j = 0; j < 16; ++j) { const unsigned c = xb_ld(&bar[XB_XCNT(j)]); sum += c; cnt += (c > 0u) ? 1u : 0u; mine = (j == x) ? c : mine; }
        if (sum == G) break;
        __builtin_amdgcn_s_sleep(1);
        if ((++sp & 255u) == 0u) { if (xb_ld(&bar[XB_TMO])) break; if (sp > XB_SPIN_CAP) { atomicAdd(&bar[XB_TMO], 1u); break; } }
    }
    nloc = mine > 0u ? mine : 1u; nx = cnt > 0u ? cnt : 1u;
}
__device__ __forceinline__ void xcd_barrier(const XcdBarrier& b, int wave) {
    asm volatile("s_waitcnt vmcnt(0)" ::: "memory");
    __syncthreads();
    unsigned zb_ = 0u; asm volatile("" : "+v"(zb_));
    if (wave == 0 && __builtin_amdgcn_mbcnt_hi(~0u, __builtin_amdgcn_mbcnt_lo(~0u, zb_)) == 0u) {
        unsigned* bar = b.bar;
        __builtin_amdgcn_s_waitcnt(0);
        unsigned nloc = b.st[0], nx = b.st[1];
        if (nloc == 0u) { xcd_barrier_complete(bar, b.x, nloc, nx); b.st[0] = nloc; b.st[1] = nx; }
        const unsigned old = xb_add(&bar[XB_XSUB(b.x)], 1u);
        const unsigned gen = old / nloc;
        if (old + 1u == (gen + 1u) * nloc) {
            __builtin_amdgcn_fence(__ATOMIC_RELEASE, "agent");
            asm volatile("s_waitcnt vmcnt(0)" ::: "memory");
            const unsigned og = xb_add(&bar[XB_TOP], 1u);
            const unsigned tg = og / nx;
            if (og + 1u == (tg + 1u) * nx) xb_add(&bar[XB_TOPGEN], 1u);
            else XB_SPIN(xb_ld(&bar[XB_TOPGEN]) == tg, bar);
            __builtin_amdgcn_fence(__ATOMIC_ACQUIRE, "agent");
            xb_add(&bar[XB_XGEN(b.x)], 1u);
            asm volatile("s_waitcnt vmcnt(0)" ::: "memory");
        } else {
            XB_SPIN(xb_ld(&bar[XB_XGEN(b.x)]) == gen, bar);
            __builtin_amdgcn_fence(__ATOMIC_ACQUIRE, "agent");
            asm volatile("s_waitcnt vmcnt(0)" ::: "memory");
        }
    }
    __syncthreads();
}

struct Args {
    const float* x; const float* attn_g; const float* w_in; const float* a_sink; const float* w_a; const float* w_b; const float* w_out; const float* ffn_g;
    const float* w_rg; const float* b_rg; const float* w_re; const float* b_re; const float* w_eg; const float* w_eu; const float* w_ed; const float* fin_g;
    float* out; unsigned char* ws; int ph_lo, ph_hi;
};
typedef const __attribute__((address_space(4))) Args* CArgs;
struct Frame {
    LAS unsigned char* lds; volatile LAS int* misc;
    int wave, G, vcu, gw, ngw, bx;
};
__device__ __forceinline__ int otid() { unsigned z = 0u; asm volatile("" : "+v"(z)); return (int)__builtin_amdgcn_mbcnt_hi(~0u, __builtin_amdgcn_mbcnt_lo(~0u, z)); }
__device__ __forceinline__ float shx(float v, int o, int lane) { return __int_as_float(__builtin_amdgcn_ds_bpermute((lane ^ o) << 2, __float_as_int(v))); }
__device__ __forceinline__ float wave_sum(float v, int lane) {
#pragma unroll
    for (int o = 1; o < 64; o <<= 1) v += shx(v, o, lane);
    return v;
}

struct MapPlain { __device__ __forceinline__ int operator()(int n) const { return n; } };
struct MapWin { __device__ __forceinline__ int operator()(int n) const {
        bool rope = false;
        if (n < 640) rope = true; else if (n >= 768 && n < NQKV) rope = ((n - 768) % 768) < 512;
        if (!rope) return n; const int d = n & 63; return (n & ~63) + 2 * (d & 31) + (d >> 5); } };
struct MapGU { int t; __device__ __forceinline__ int operator()(int n) const { return 2 * n + t; } };
template <class Map> __device__ __forceinline__ void transpose_item64(const float* W, int ldn, int k0, int n0, const float* gk, bf16* WT, int Kd, const Map& map, LAS float* scr, int lane) {
    const int kq = lane >> 4, n4 = (lane & 15) * 4;
    const float* src = W + (size_t)(k0 + kq) * ldn + n0 + n4;
    f32x4 v[16];
#pragma unroll
    for (int i = 0; i < 16; ++i) v[i] = *(const f32x4*)(src + (size_t)(4 * i) * ldn);
    if (gk) {
#pragma unroll
        for (int i = 0; i < 16; ++i) v[i] = v[i] * gk[k0 + 4 * i + kq];
    }
#pragma unroll
    for (int i = 0; i < 16; ++i) { LAS float* d = scr + (4 * i + kq) * 65 + n4; d[0] = v[i][0]; d[1] = v[i][1]; d[2] = v[i][2]; d[3] = v[i][3]; }
    LDS_WAIT(); asm volatile("" ::: "memory");
    const int c = lane & 7;
#pragma unroll
    for (int j = 0; j < 8; ++j) { const int n = (lane >> 3) + 8 * j; const LAS float* p = scr + (8 * c) * 65 + n;
        u32x4 o; o.x = cvtpk(p[0 * 65], p[1 * 65]); o.y = cvtpk(p[2 * 65], p[3 * 65]); o.z = cvtpk(p[4 * 65], p[5 * 65]); o.w = cvtpk(p[6 * 65], p[7 * 65]);
        *(u32x4*)(WT + (size_t)map(n0 + n) * Kd + k0 + 8 * c) = o; }
    LDS_WAIT(); asm volatile("" ::: "memory");
}
__device__ __forceinline__ void prep_phase(const Frame& F, CArgs a) {
    const int lane = otid(), tid = F.wave * 64 + lane; (void)tid; (void)lane;
    unsigned char* ws = a->ws;
    LAS float* scr = (LAS float*)(F.lds + F.wave * PREP_SCR);
    constexpr int I_IN = 16 * 80, I_A = 8 * 16, I_B = 4 * 16, I_O = 16 * 16, I_L = I_IN + I_A + I_B + I_O;
    for (int it = F.gw; it < DEPTH * I_L; it += F.ngw) {
        const int l = it / I_L; int r = it - l * I_L;
        unsigned char* wl = ws + (size_t)l * WNE_LSTRIDE;
        if (r < I_IN) { transpose_item64(a->w_in + (size_t)l * DM * DIN, DIN, 64 * (r / 80), 64 * (r % 80), a->attn_g + l * DM, (bf16*)(wl + WS_WIN), DM, MapWin{}, scr, lane); continue; } r -= I_IN;
        if (r < I_A) { transpose_item64(a->w_a + (size_t)l * 512 * DM, DM, 64 * (r / 16), 64 * (r % 16), nullptr, (bf16*)(wl + WS_WAB) + 256, 768, MapPlain{}, scr, lane); continue; } r -= I_A;
        if (r < I_B) { transpose_item64(a->w_b + (size_t)l * 256 * DM, DM, 64 * (r / 16), 64 * (r % 16), nullptr, (bf16*)(wl + WS_WAB), 768, MapPlain{}, scr, lane); continue; } r -= I_B;
        transpose_item64(a->w_out + (size_t)l * DM * DM, DM, 64 * (r / 16), 64 * (r % 16), nullptr, (bf16*)(wl + WS_WOUT), DM, MapPlain{}, scr, lane);
    }
    for (int idx = F.bx * NTHREADS + tid; idx < DEPTH * 32 * 3 * 64 * 8; idx += F.G * NTHREADS) {
        const int l = idx / (32 * 3 * 64 * 8), id = idx - l * (32 * 3 * 64 * 8);
        const int j = id & 7, ln = (id >> 3) & 63, q = id >> 9, nt = q % 3, i = q / 3;
        const int k = 32 * i + 8 * (ln >> 4) + j, n = 16 * nt + (ln & 15);
        const float* wg = a->w_rg + (size_t)l * DM * 4; const float* we = a->w_re + (size_t)l * DM * NEXP;
        float v = 0.f; if (n < 4) v = wg[k * 4 + n]; else if (n < 36) v = we[k * NEXP + (n - 4)];
        v *= a->ffn_g[l * DM + k];
        const unsigned hb = cvtpk(v, 0.f) & 0xffffu; const float hf = __uint_as_float(hb << 16);
        const unsigned lb = cvtpk(v - hf, 0.f) & 0xffffu;
        ((bf16*)(ws + WS_WR + l * WR_LSTRIDE))[id] = (bf16)hb; ((bf16*)(ws + WS_WR + l * WR_LSTRIDE + WR_LO))[id] = (bf16)lb;
    }
    {
        float* rt = (float*)(ws + WS_ROPE);
        for (int idx = F.bx * NTHREADS + tid; idx < SEQ * 32; idx += F.G * NTHREADS) {
            const int pos = idx >> 5, i = idx & 31;
            const float inv = 1.0f / powf(10000.0f, (float)(2 * i) / 64.0f);
            const float ang = (float)pos * inv;
            const double ad = (double)ang, kd = __builtin_rint(ad * 0.15915494309189535);
            const float rf = (float)__builtin_fma(-kd, 6.283185307179586, ad);
            rt[idx * 2] = cosf(rf); rt[idx * 2 + 1] = sinf(rf);
        }
        bf16* xb = (bf16*)(ws + WS_XB); float* rs1 = (float*)(ws + WS_RS1);
        for (int m = F.gw; m < MTOK; m += F.ngw) {
            const f32x4* xr = (const f32x4*)(a->x + (size_t)m * DM) + lane;
            f32x4 v[4]; float s = 0.f;
#pragma unroll
            for (int j = 0; j < 4; ++j) { v[j] = xr[64 * j]; s += (v[j][0] * v[j][0] + v[j][1] * v[j][1]) + (v[j][2] * v[j][2] + v[j][3] * v[j][3]); }
            s = wave_sum(s, lane);
            u32x2* o = (u32x2*)(xb + (size_t)m * DM) + lane;
#pragma unroll
            for (int j = 0; j < 4; ++j) { u32x2 w; w.x = cvtpk(v[j][0], v[j][1]); w.y = cvtpk(v[j][2], v[j][3]); o[64 * j] = w; }
            if (lane == 0) rs1[m] = 1.0f / sqrtf(s * (1.0f / DM) + NORM_EPS);
        }
    }
}
__device__ __forceinline__ void prep_experts(const Frame& F, CArgs a, int l, int lane, int part, int w, int nw) {
    unsigned char* ws = a->ws;
    LAS float* scr = (LAS float*)(F.lds + F.wave * PREP_SCR);
    constexpr int I_G = 16 * 4, I_D = 4 * 16;
    const float* fg = a->ffn_g + l * DM;
    if (part == 0) {
        for (int it = w; it < NEXP * 2 * I_G; it += nw) {
            const int e = it / (2 * I_G); int r = it - e * (2 * I_G); const int t = r / I_G; r -= t * I_G;
            const size_t eo = ((size_t)l * NEXP + e) * DM * DEXP; const float* W = (t ? a->w_eu : a->w_eg) + eo;
            transpose_item64(W, DEXP, 64 * (r / 4), 64 * (r % 4), fg, (bf16*)(ws + WS_WGU) + (size_t)e * 512 * DM, DM, MapGU{t}, scr, lane);
        }
    } else {
        for (int it = w; it < NEXP * I_D; it += nw) {
            const int e = it / I_D, r = it - e * I_D;
            const size_t eo = ((size_t)l * NEXP + e) * DM * DEXP;
            transpose_item64(a->w_ed + eo, DM, 64 * (r / 16), 64 * (r % 16), nullptr, (bf16*)(ws + WS_WD) + (size_t)e * DM * DEXP, DEXP, MapPlain{}, scr, lane);
        }
    }
}

__device__ __forceinline__ int crow(int r, int hi) { return (r & 3) + 8 * (r >> 2) + 4 * hi; }
struct AttnUnit { int kcol, vcol, b, d, r, t0, span, W, qcol, tq; float m0, l0; bf16* outp; int opitch; float* lsep; bool valid; };
__device__ __forceinline__ AttnUnit attn_decode(int idx, int G, int bx, int wave, int l, CArgs a, bf16* ya, bf16* ob, float* lse) {
    AttnUnit U; U.valid = false;
    const int nA = (BATCH * 2 * 64 - bx + G - 1) / G;
    if (idx < nA) {
        const int u = bx + idx * G; const int qb = u & 63, kvh = (u >> 6) & 1, b = u >> 7; const int g = wave >> 1, hq = kvh * 4 + g;
        U.kcol = 512 + kvh * 64; U.vcol = 640 + kvh * 64; U.b = b; U.d = 1; U.r = 0; U.t0 = 2 * qb; U.span = 2; U.W = 4; U.qcol = hq * 64; U.tq = 2 * qb + (wave & 1);
        U.m0 = a->a_sink[l * 8 + hq] * LOG2E; U.l0 = 1.0f; U.outp = ya + hq * 64; U.opitch = 768; U.lsep = nullptr; U.valid = true; return U;
    }
    const int u = bx + (idx - nA) * G;
    if (u < 3 * 256) {
        const int grp = u >> 8; int q = u & 255;
        const int d = grp == 0 ? 1 : (grp == 1 ? 4 : 16), bpr = 16 / d;
        const int blk = q % bpr; q /= bpr; const int res = q % d; q /= d; const int h = q & 3, b = q >> 2;
        const int base = 768 + 768 * grp;
        U.kcol = base + 256 + h * 64; U.vcol = base + 512 + h * 64; U.b = b; U.d = d; U.r = res; U.t0 = 8 * blk; U.span = 8; U.W = 2; U.qcol = base + h * 64; U.tq = 8 * blk + wave;
        U.m0 = -1e30f; U.l0 = 0.0f; U.outp = ob + grp * 256 + h * 64; U.opitch = 768; U.lsep = lse + grp * 4 + h; U.valid = true;
    }
    return U;
}
__device__ __forceinline__ void attn_fetch(const bf16* P, const AttnUnit& U, int tid, u32x4 (&buf)[12]) {
    const int L32 = (SEQ / U.d) >> 5, jbase = U.t0 - U.W, ntile = U.span + 2 * U.W, nch = ntile * 512;
    const size_t tok0 = (size_t)U.b * SEQ + U.r;
#pragma unroll
    for (int i = 0; i < 12; ++i) {
        const int c = tid + 512 * i;
        if (c < nch) {
            const int kv = c >= ntile * 256, cc = kv ? c - ntile * 256 : c, row = cc >> 3, ch = cc & 7, tile = row >> 5, rr = row & 31, j = jbase + tile;
            if (j >= 0 && j < L32) buf[i] = *(const u32x4*)(P + (tok0 + (size_t)(32 * j + rr) * U.d) * NQKV + (kv ? U.vcol : U.kcol) + ch * 8);
        }
    }
}
__device__ __forceinline__ void attn_stage(const AttnUnit& U, int tid, const u32x4 (&buf)[12], LAS unsigned char* lds) {
    const int L32 = (SEQ / U.d) >> 5, jbase = U.t0 - U.W, ntile = U.span + 2 * U.W, nch = ntile * 512;
    LAS unsigned char* kimg = lds; LAS unsigned char* vimg = lds + ntile * 4096;
#pragma unroll
    for (int i = 0; i < 12; ++i) {
        const int c = tid + 512 * i;
        if (c < nch) {
            const int kv = c >= ntile * 256, cc = kv ? c - ntile * 256 : c, row = cc >> 3, ch = cc & 7, tile = row >> 5, rr = row & 31, j = jbase + tile;
            if (j >= 0 && j < L32) *(LAS u32x4*)((kv ? vimg : kimg) + tile * 4096 + rr * 128 + (kv ? ch : (ch ^ (rr & 7))) * 16) = buf[i];
        }
    }
}
template <int NT> __device__ __forceinline__ void attn_step(int j, int jbase, int tq, int W, const LAS unsigned char* kimg, const LAS unsigned char* vimg, int krd, int vrd, int r32, int hi,
                                                          const bf16x8 (&qf)[4], f32x16& o0, f32x16& o1, float& mrun, float& lrun) {
#define VTR(p, off) __builtin_bit_cast(s16x4, __builtin_amdgcn_ds_read_tr16_b64_v4i16((LAS s16x4*)((p) + (off))))
    bf16x8 kf[NT][4]; s16x4 va[NT][4], vb[NT][4];
#pragma unroll
    for (int t = 0; t < NT; ++t) {
        const LAS unsigned char* kl = kimg + (j + t - jbase) * 4096 + krd;
#pragma unroll
        for (int s = 0; s < 4; ++s) kf[t][s] = *(const LAS bf16x8*)(kl + (((2 * s + hi) ^ (r32 & 7)) * 16));
    }
#pragma unroll
    for (int t = 0; t < NT; ++t) {
        const LAS unsigned char* vl = vimg + (j + t - jbase) * 4096 + vrd;
#pragma unroll
        for (int q = 0; q < 4; ++q) { va[t][q] = VTR(vl, (16 * (q & 1)) * 128 + (q >> 1) * 64); vb[t][q] = VTR(vl, (16 * (q & 1) + 8) * 128 + (q >> 1) * 64); }
    }
    __builtin_amdgcn_sched_barrier(0);
    f32x16 sc[NT];
#pragma unroll
    for (int t = 0; t < NT; ++t) sc[t] = f32x16{};
#pragma unroll
    for (int s = 0; s < 4; ++s)
#pragma unroll
        for (int t = 0; t < NT; ++t) sc[t] = __builtin_amdgcn_mfma_f32_32x32x16_bf16(kf[t][s], qf[s], sc[t], 0, 0, 0);
#pragma unroll
    for (int t = 0; t < NT; ++t) {
        if (j + t == tq - W) {
#pragma unroll
            for (int g = 0; g < 16; ++g) if (crow(g, hi) < r32) sc[t][g] = -INFINITY;
        }
        if (j + t == tq + W) {
#pragma unroll
            for (int g = 0; g < 16; ++g) if (crow(g, hi) > r32) sc[t][g] = -INFINITY;
        }
    }
    float mx = -INFINITY;
#pragma unroll
    for (int t = 0; t < NT; ++t)
#pragma unroll
        for (int g = 0; g < 16; g += 4) mx = fmaxf(mx, fmaxf(fmaxf(sc[t][g], sc[t][g + 1]), fmaxf(sc[t][g + 2], sc[t][g + 3])));
    { const auto rr = __builtin_amdgcn_permlane32_swap(__float_as_uint(mx), __float_as_uint(mx), false, false); mx = fmaxf(__uint_as_float(rr[0]), __uint_as_float(rr[1])); }
    if (__any(mx > mrun + 8.0f)) {
        const float mnew = fmaxf(mrun, mx);
        const float alpha = fast_exp2(mrun - mnew);
        lrun *= alpha; mrun = mnew;
#pragma unroll
        for (int g = 0; g < 16; ++g) { o0[g] *= alpha; o1[g] *= alpha; }
    }
    float ps[4] = {0.f, 0.f, 0.f, 0.f};
#pragma unroll
    for (int t = 0; t < NT; ++t)
#pragma unroll
        for (int g = 0; g < 16; ++g) { sc[t][g] = fast_exp2(sc[t][g] - mrun); ps[g & 3] += sc[t][g]; }
    float psum = (ps[0] + ps[1]) + (ps[2] + ps[3]);
    { const auto rr = __builtin_amdgcn_permlane32_swap(__float_as_uint(psum), __float_as_uint(psum), false, false); psum = __uint_as_float(rr[0]) + __uint_as_float(rr[1]); }
    lrun += psum;
#define VFR(t, q) ((bf16x8){va[t][q][0], va[t][q][1], va[t][q][2], va[t][q][3], vb[t][q][0], vb[t][q][1], vb[t][q][2], vb[t][q][3]})
#pragma unroll
    for (int t = 0; t < NT; ++t) {
        u32x4 p0, p1;
        p0.x = cvtpk(sc[t][0], sc[t][1]); p0.y = cvtpk(sc[t][2], sc[t][3]); p0.z = cvtpk(sc[t][4], sc[t][5]); p0.w = cvtpk(sc[t][6], sc[t][7]);
        p1.x = cvtpk(sc[t][8], sc[t][9]); p1.y = cvtpk(sc[t][10], sc[t][11]); p1.z = cvtpk(sc[t][12], sc[t][13]); p1.w = cvtpk(sc[t][14], sc[t][15]);
        const bf16x8 pf0 = __builtin_bit_cast(bf16x8, p0), pf1 = __builtin_bit_cast(bf16x8, p1);
        o0 = __builtin_amdgcn_mfma_f32_32x32x16_bf16(VFR(t, 0), pf0, o0, 0, 0, 0);
        o1 = __builtin_amdgcn_mfma_f32_32x32x16_bf16(VFR(t, 2), pf0, o1, 0, 0, 0);
        o0 = __builtin_amdgcn_mfma_f32_32x32x16_bf16(VFR(t, 1), pf1, o0, 0, 0, 0);
        o1 = __builtin_amdgcn_mfma_f32_32x32x16_bf16(VFR(t, 3), pf1, o1, 0, 0, 0);
    }
#undef VFR
#undef VTR
}
__device__ __forceinline__ void attn_compute(const bf16* P, const AttnUnit& U, const bf16x8 (&qf)[4], LAS unsigned char* lds, LAS unsigned char* stg, int lane) {
    const int r32 = lane & 31, hi = lane >> 5;
    const int d = U.d, W = U.W, tq = U.tq;
    const int L32 = (SEQ / d) >> 5;
    const size_t tok0 = (size_t)U.b * SEQ + U.r;
    const int jbase = U.t0 - W, ntile = U.span + 2 * W;
    LAS unsigned char* kimg = lds; LAS unsigned char* vimg = lds + ntile * 4096;
    const size_t qtok = tok0 + (size_t)(32 * tq + r32) * d;
    f32x16 o0 = {}, o1 = {};
    float mrun = U.m0, lrun = U.l0;
    const int jlo = (tq - W) < 0 ? 0 : (tq - W), jhi = (tq + W) > (L32 - 1) ? (L32 - 1) : (tq + W);
    const int vrd = (4 * hi + ((lane & 15) >> 2)) * 128 + (16 * ((lane >> 4) & 1) + 4 * (lane & 3)) * 2;
    const int krd = r32 * 128;
    int j = jlo;
    for (; j + 1 <= jhi; j += 2) attn_step<2>(j, jbase, tq, W, kimg, vimg, krd, vrd, r32, hi, qf, o0, o1, mrun, lrun);
    if (j <= jhi) attn_step<1>(j, jbase, tq, W, kimg, vimg, krd, vrd, r32, hi, qf, o0, o1, mrun, lrun);
    const float inv = 1.0f / lrun;
#pragma unroll
    for (int g4 = 0; g4 < 4; ++g4) {
        u32x2 w0, w1;
        w0.x = cvtpk(o0[4 * g4] * inv, o0[4 * g4 + 1] * inv); w0.y = cvtpk(o0[4 * g4 + 2] * inv, o0[4 * g4 + 3] * inv);
        w1.x = cvtpk(o1[4 * g4] * inv, o1[4 * g4 + 1] * inv); w1.y = cvtpk(o1[4 * g4 + 2] * inv, o1[4 * g4 + 3] * inv);
        *(LAS u32x2*)(stg + r32 * 144 + (8 * g4 + 4 * hi) * 2) = w0;
        *(LAS u32x2*)(stg + r32 * 144 + 64 + (8 * g4 + 4 * hi) * 2) = w1;
    }
#pragma unroll
    for (int i = 0; i < 4; ++i) {
        const int row = i * 8 + (lane >> 3), ch = lane & 7;
        const u32x4 v = *(const LAS u32x4*)(stg + row * 144 + ch * 16);
        *(u32x4*)(U.outp + (tok0 + (size_t)(32 * tq + row) * d) * U.opitch + ch * 8) = v;
    }
    if (U.lsep && hi == 0) U.lsep[qtok * 12] = (mrun + log2f(lrun)) * LN2;
}
__device__ __forceinline__ void attn_phase(const Frame& F, CArgs a, int l) {
    const int lane = otid(), tid = F.wave * 64 + lane; (void)tid; (void)lane;
    unsigned char* ws = a->ws;
    const bf16* P = (const bf16*)(ws + WS_PQ);
    bf16* ya = (bf16*)(ws + WS_YAB) + 256; bf16* ob = (bf16*)a->out; float* lse = (float*)(ws + WS_LSE);
    const int r32 = lane & 31, hi = lane >> 5;
    u32x4 buf[12];
    LAS unsigned char* stg = F.lds + 98304 + F.wave * 4608;
    AttnUnit U = attn_decode(0, F.G, F.bx, F.wave, l, a, ya, ob, lse);
    if (U.valid) attn_fetch(P, U, tid, buf);
    for (int idx = 0; U.valid; ++idx) {
        attn_stage(U, tid, buf, F.lds);
        u32x4 qv[4];
#pragma unroll
        for (int i = 0; i < 4; ++i) { const int row = i * 8 + (lane >> 3), ch = lane & 7;
            qv[i] = *(const u32x4*)(P + ((size_t)U.b * SEQ + U.r + (size_t)(32 * U.tq + row) * U.d) * NQKV + U.qcol + ch * 8); }
        const AttnUnit Un = attn_decode(idx + 1, F.G, F.bx, F.wave, l, a, ya, ob, lse);
#pragma unroll
        for (int i = 0; i < 4; ++i) { const int row = i * 8 + (lane >> 3), ch = lane & 7; *(LAS u32x4*)(stg + row * 144 + ch * 16) = qv[i]; }
        bf16x8 qf[4];
#pragma unroll
        for (int s = 0; s < 4; ++s) qf[s] = *(const LAS bf16x8*)(stg + r32 * 144 + (2 * s + hi) * 16);
        __syncthreads();
        if (Un.valid) attn_fetch(P, Un, tid, buf);
        attn_compute(P, U, qf, F.lds, stg, lane);
        __syncthreads();
        U = Un;
    }
    prep_experts(F, a, l, lane, 0, F.gw, F.ngw);
    prep_experts(F, a, l, lane, 1, F.gw, F.ngw);
}
__device__ __forceinline__ void comb_rows(const Frame& F, CArgs a, int row0, int tid) {
    unsigned char* ws = a->ws;
    const bf16* ob = (const bf16*)a->out; const float* lse = (const float*)(ws + WS_LSE); bf16* yb = (bf16*)(ws + WS_YAB);
#pragma unroll 4
    for (int it = 0; it < 16; ++it) {
        const int idx = tid + it * NTHREADS;
        const int tok = row0 + (idx >> 5), c = idx & 31, h = c >> 3;
        const float l0 = lse[tok * 12 + h], l1 = lse[tok * 12 + 4 + h], l2 = lse[tok * 12 + 8 + h];
        const u32x4 a0 = *(const u32x4*)(ob + (size_t)tok * 768 + c * 8), a1 = *(const u32x4*)(ob + (size_t)tok * 768 + 256 + c * 8), a2 = *(const u32x4*)(ob + (size_t)tok * 768 + 512 + c * 8);
        const float mx = fmaxf(l0, fmaxf(l1, l2));
        float w0 = __expf(l0 - mx), w1 = __expf(l1 - mx), w2 = __expf(l2 - mx);
        const float inv = 1.0f / (w0 + w1 + w2); w0 *= inv; w1 *= inv; w2 *= inv;
        u32x4 o;
#define CMB(f) o.f = cvtpk(w0 * bflo(a0.f) + w1 * bflo(a1.f) + w2 * bflo(a2.f), w0 * bfhi(a0.f) + w1 * bfhi(a1.f) + w2 * bfhi(a2.f))
        CMB(x); CMB(y); CMB(z); CMB(w);
#undef CMB
        *(u32x4*)(yb + (size_t)tok * 768 + c * 8) = o;
    }
}

__device__ __forceinline__ void route_phase(const Frame& F, CArgs a, int l) {
    const int lane = otid(), tid = F.wave * 64 + lane;
    unsigned char* ws = a->ws;
    const bf16* xbf = (const bf16*)(ws + WS_XB); const u32x4* wrh = (const u32x4*)(ws + WS_WR + l * WR_LSTRIDE); const u32x4* wrl = (const u32x4*)(ws + WS_WR + l * WR_LSTRIDE + WR_LO);
    float* rs2 = (float*)(ws + WS_RS2); i32x4* tokinfo = (i32x4*)(ws + WS_TOKINFO); int* ltok = (int*)(ws + WS_LTOK); float* lw = (float*)(ws + WS_LW);
    int* cnt = (int*)(ws + WS_CTL) + CW_CNT + l * 32 * CNT_STRIDE;
    const float* brg = a->b_rg + l * 4; const float* bre = a->b_re + l * NEXP;
    LAS f32x4* part = (LAS f32x4*)(F.lds);
    LAS float* ssp = (LAS float*)(F.lds + 12288);
    LAS float* Lg = (LAS float*)(F.lds + 16384);
    LAS float* rsL = (LAS float*)(F.lds + 16384 + 12288);
    LAS int* lcnt = (LAS int*)(F.lds + 16384 + 12288 + 256);
    LAS int* lbase = lcnt + 32;
    const int rt = F.wave & 3, kh = F.wave >> 2;
    if (tid < 32) lcnt[tid] = 0;
    __syncthreads();
    for (int blk = F.bx; blk < MTOK / 64; blk += F.G) {
        const int row0 = blk * 64 + rt * 16;
        const u32x4* xr = (const u32x4*)(xbf + (size_t)(row0 + (lane & 15)) * DM + kh * 512) + (lane >> 4);
        const u32x4* wh = wrh + (size_t)(kh * 16) * 3 * 64 + lane; const u32x4* wl = wrl + (size_t)(kh * 16) * 3 * 64 + lane;
        f32x4 acc0 = {0.f, 0.f, 0.f, 0.f}, acc1 = acc0, acc2 = acc0; float ss = 0.f;
#pragma unroll 4
        for (int i = 0; i < 16; ++i) {
            const u32x4 xw = xr[4 * i];
            const u32x4 h0 = wh[(i * 3 + 0) * 64], h1 = wh[(i * 3 + 1) * 64], h2 = wh[(i * 3 + 2) * 64], l0 = wl[(i * 3 + 0) * 64], l1 = wl[(i * 3 + 1) * 64], l2 = wl[(i * 3 + 2) * 64];
            const float xv[8] = {bflo(xw.x), bfhi(xw.x), bflo(xw.y), bfhi(xw.y), bflo(xw.z), bfhi(xw.z), bflo(xw.w), bfhi(xw.w)};
#pragma unroll
            for (int j = 0; j < 8; ++j) ss += xv[j] * xv[j];
            const bf16x8 xf = __builtin_bit_cast(bf16x8, xw);
            acc0 = __builtin_amdgcn_mfma_f32_16x16x32_bf16(xf, __builtin_bit_cast(bf16x8, l0), acc0, 0, 0, 0);
            acc1 = __builtin_amdgcn_mfma_f32_16x16x32_bf16(xf, __builtin_bit_cast(bf16x8, l1), acc1, 0, 0, 0);
            acc2 = __builtin_amdgcn_mfma_f32_16x16x32_bf16(xf, __builtin_bit_cast(bf16x8, l2), acc2, 0, 0, 0);
            acc0 = __builtin_amdgcn_mfma_f32_16x16x32_bf16(xf, __builtin_bit_cast(bf16x8, h0), acc0, 0, 0, 0);
            acc1 = __builtin_amdgcn_mfma_f32_16x16x32_bf16(xf, __builtin_bit_cast(bf16x8, h1), acc1, 0, 0, 0);
            acc2 = __builtin_amdgcn_mfma_f32_16x16x32_bf16(xf, __builtin_bit_cast(bf16x8, h2), acc2, 0, 0, 0);
        }
        ss += shx(ss, 16, lane); ss += shx(ss, 32, lane);
        if (kh == 1) { part[(rt * 3 + 0) * 64 + lane] = acc0; part[(rt * 3 + 1) * 64 + lane] = acc1; part[(rt * 3 + 2) * 64 + lane] = acc2; if (lane < 16) ssp[rt * 16 + lane] = ss; }
        __syncthreads();
        if (kh == 0) {
            acc0 += part[(rt * 3 + 0) * 64 + lane]; acc1 += part[(rt * 3 + 1) * 64 + lane]; acc2 += part[(rt * 3 + 2) * 64 + lane];
            ss += ssp[rt * 16 + (lane & 15)];
#pragma unroll
            for (int g = 0; g < 4; ++g) { const int rw = rt * 16 + 4 * (lane >> 4) + g; Lg[rw * 48 + (lane & 15)] = acc0[g]; Lg[rw * 48 + 16 + (lane & 15)] = acc1[g]; Lg[rw * 48 + 32 + (lane & 15)] = acc2[g]; }
            if (lane < 16) rsL[rt * 16 + lane] = 1.0f / sqrtf(ss * (1.0f / DM) + NORM_EPS);
        }
        __syncthreads();
        int e1 = 0, e2 = 0, r1 = 0, r2 = 0; float w1 = 0.f, w2 = 0.f, rsv = 0.f;
        if (tid < 64) {
            const LAS float* Lr = Lg + tid * 48; rsv = rsL[tid];
            float gl[4];
#pragma unroll
            for (int g = 0; g < 4; ++g) gl[g] = Lr[g] * rsv + brg[g];
            int gi = 0; float gm = gl[0];
#pragma unroll
            for (int g = 1; g < 4; ++g) if (gl[g] > gm) { gm = gl[g]; gi = g; }
            float den = 0.f;
#pragma unroll
            for (int g = 0; g < 4; ++g) den += expf(gl[g] - gm);
            const float gw = 1.0f / den;
            float v1 = -INFINITY, v2 = -INFINITY; int i1 = 0, i2 = 0;
#pragma unroll
            for (int e = 0; e < 8; ++e) {
                const float v = Lr[4 + 8 * gi + e] * rsv + bre[8 * gi + e];
                if (v > v1) { v2 = v1; i2 = i1; v1 = v; i1 = e; } else if (v > v2) { v2 = v; i2 = e; }
            }
            const float p1 = 1.0f / (1.0f + expf(v2 - v1));
            e1 = 8 * gi + i1; e2 = 8 * gi + i2; w1 = p1 * gw; w2 = (1.0f - p1) * gw;
            r1 = __hip_atomic_fetch_add(&lcnt[e1], 1, __ATOMIC_RELAXED, __HIP_MEMORY_SCOPE_WORKGROUP); r2 = __hip_atomic_fetch_add(&lcnt[e2], 1, __ATOMIC_RELAXED, __HIP_MEMORY_SCOPE_WORKGROUP);
        }
        __syncthreads();
        if (tid < 32) { const int c = lcnt[tid]; lbase[tid] = c ? atomicAdd(&cnt[tid * CNT_STRIDE], c) : 0; lcnt[tid] = 0; }
        __syncthreads();
        if (tid < 64) {
            const int tok = blk * 64 + tid;
            const int pos1 = lbase[e1] + r1, pos2 = lbase[e2] + r2;
            ltok[e1 * MTOK + pos1] = tok; lw[e1 * MTOK + pos1] = w1;
            ltok[e2 * MTOK + pos2] = tok; lw[e2 * MTOK + pos2] = w2;
            tokinfo[tok] = (i32x4){e1, pos1, e2, pos2};
            rs2[tok] = rsv;
        }
        __syncthreads();
    }
}
__device__ __forceinline__ MoeTab moe_tables(const Frame& F, CArgs a, int l) {
    const int lane = otid(), tid = F.wave * 64 + lane; (void)tid; (void)lane;
    volatile LAS int* cntL = F.misc + 64; volatile LAS int* mtp = F.misc + 128; volatile LAS int* sp = F.misc + 192;
    const int* cnt = (const int*)(a->ws + WS_CTL) + CW_CNT + l * 32 * CNT_STRIDE;
    __syncthreads();
    if (tid < 32) cntL[tid] = __hip_atomic_load(cnt + tid * CNT_STRIDE, __ATOMIC_RELAXED, __HIP_MEMORY_SCOPE_AGENT);
    __syncthreads();
    if (tid == 0) { int mt = 0, s = 0; for (int e = 0; e < 32; ++e) { mtp[e] = mt; sp[e] = s; const int c = cntL[e]; mt += (c + 255) >> 8; s += c; } mtp[32] = mt; sp[32] = s; }
    __syncthreads();
    MoeTab T; T.cnt = cntL; T.mtpref = mtp; T.spref = sp; return T;
}
__device__ __forceinline__ void fin_phase(const Frame& F, CArgs a, int l, const MoeTab& T) {
    const int lane = otid(), tid = F.wave * 64 + lane; (void)tid;
    unsigned char* ws = a->ws;
    const i32x4* tokinfo = (const i32x4*)(ws + WS_TOKINFO); const bf16* Y = (const bf16*)(ws + WS_Y);
    bf16* xb = (bf16*)(ws + WS_XB); float* rs1 = (float*)(ws + WS_RS1);
    const int step = 2 * F.ngw;
    int m0 = 2 * F.gw;
    i32x4 tn0 = tokinfo[m0 < MTOK ? m0 : 0], tn1 = tokinfo[m0 + 1 < MTOK ? m0 + 1 : 0];
    for (; m0 < MTOK; m0 += step) {
        const i32x4 ti[2] = {tn0, tn1};
        const int mn = m0 + step;
        if (mn < MTOK) { tn0 = tokinfo[mn]; tn1 = tokinfo[mn + 1]; }
        u32x4 xv[2][2], p[2][2], q[2][2];
#pragma unroll
        for (int r = 0; r < 2; ++r) {
            const int m = m0 + r;
            const int s1 = T.spref[ti[r][0]] + ti[r][1], s2 = T.spref[ti[r][2]] + ti[r][3];
            const u32x4* xr = (const u32x4*)(xb + (size_t)m * DM) + lane;
            const u32x4* y1 = (const u32x4*)(Y + (size_t)s1 * DM) + lane; const u32x4* y2 = (const u32x4*)(Y + (size_t)s2 * DM) + lane;
#pragma unroll
            for (int j = 0; j < 2; ++j) { xv[r][j] = xr[64 * j]; p[r][j] = y1[64 * j]; q[r][j] = y2[64 * j]; }
        }
#pragma unroll
        for (int r = 0; r < 2; ++r) {
            const int m = m0 + r;
            float v[2][8]; float s = 0.f;
#pragma unroll
            for (int j = 0; j < 2; ++j) {
#define FINC(c, f) v[j][2 * c] = bflo(xv[r][j].f) + bflo(p[r][j].f) + bflo(q[r][j].f); v[j][2 * c + 1] = bfhi(xv[r][j].f) + bfhi(p[r][j].f) + bfhi(q[r][j].f);
                FINC(0, x) FINC(1, y) FINC(2, z) FINC(3, w)
#undef FINC
#pragma unroll
                for (int c = 0; c < 8; ++c) s += v[j][c] * v[j][c];
            }
            s = wave_sum(s, lane);
            const float rsv = 1.0f / sqrtf(s * (1.0f / DM) + NORM_EPS);
            if (l == DEPTH - 1) {
#pragma unroll
                for (int j = 0; j < 2; ++j) {
                    const f32x4* g = (const f32x4*)(a->fin_g + 512 * j + 8 * lane); f32x4* o = (f32x4*)(a->out + (size_t)m * DM + 512 * j + 8 * lane);
                    const f32x4 g0 = g[0], g1 = g[1];
                    o[0] = (f32x4){v[j][0] * rsv * g0[0], v[j][1] * rsv * g0[1], v[j][2] * rsv * g0[2], v[j][3] * rsv * g0[3]};
                    o[1] = (f32x4){v[j][4] * rsv * g1[0], v[j][5] * rsv * g1[1], v[j][6] * rsv * g1[2], v[j][7] * rsv * g1[3]};
                }
            } else {
                u32x4* o = (u32x4*)(xb + (size_t)m * DM) + lane;
#pragma unroll
                for (int j = 0; j < 2; ++j) { u32x4 w; w.x = cvtpk(v[j][0], v[j][1]); w.y = cvtpk(v[j][2], v[j][3]); w.z = cvtpk(v[j][4], v[j][5]); w.w = cvtpk(v[j][6], v[j][7]); o[64 * j] = w; }
                if (lane == 0) rs1[m] = rsv;
            }
        }
    }
}

constexpr int PH_PREP = 0, PH_GEMM1 = 1, PH_ATTN = 2, PH_MERGE = 3, PH_OUT = 4, PH_ROUTE = 5, PH_UP = 6, PH_DOWN = 7, PH_DOWN2 = 8, PH_FIN = 9, PH_PER_LAYER = 10, NPHASE = PH_PER_LAYER * DEPTH - 1;

__global__ void __launch_bounds__(NTHREADS, 2) fwd_kernel(Args a_by_value) {
    extern __shared__ __attribute__((aligned(16))) unsigned char lds_raw[];
    Frame F;
    F.lds = (LAS unsigned char*)lds_raw; F.misc = (volatile LAS int*)(F.lds + MISC_OFF);
    F.wave = __builtin_amdgcn_readfirstlane((int)threadIdx.x >> 6);
    F.G = gridDim.x; { const int bx = blockIdx.x; F.vcu = (F.G % 8 == 0) ? (bx % 8) * (F.G / 8) + bx / 8 : bx; }
    F.gw = blockIdx.x * NWAVES + F.wave; F.ngw = F.G * NWAVES;
    CArgs a = (CArgs)__builtin_amdgcn_kernarg_segment_ptr();
    unsigned char* ws = a->ws;
    const int ph_lo = a->ph_lo, ph_hi = a->ph_hi;
    for (int u = threadIdx.x; u < 1024; u += NTHREADS) F.misc[u] = 0;
    __syncthreads();
#if !MK_MULTI
    XcdBarrier bar = xcd_barrier_post((unsigned*)(ws + WS_CTL) + CW_BAR, (volatile LAS unsigned*)(F.misc + 8));
#define GRID_BAR() xcd_barrier(bar, F.wave)
#else
#define GRID_BAR() do { } while (0)
#endif
    for (int ph = ph_lo, rep = 0; ph < ph_hi; ) {
        const int l = ph >= PH_PER_LAYER ? 1 : 0, k = ph >= PH_PER_LAYER ? ph - (PH_PER_LAYER - 1) : ph;
        const size_t wlo = (size_t)l * WNE_LSTRIDE;
        {
            int bx = blockIdx.x; asm volatile("" : "+s"(bx)); asm volatile("" : "+s"(a)); ws = a->ws;
            int wv = F.wave; asm volatile("" : "+s"(wv)); F.gw = bx * NWAVES + wv; F.bx = bx;
        }
        if (k == PH_PREP && (PHMASK & 1)) {
            prep_phase(F, a);
        } else if (k == PH_GEMM1 && (PHMASK & 2)) {
            DenseSched S; S.A = (const char*)(ws + WS_XB); S.Bt = (const char*)(ws + wlo + WS_WIN); S.K = DM; S.lda = DM; S.ldb = DM; S.ksplit = 0; S.wave = F.wave; S.so.init(MTOK, DIN, F.G, F.bx);
            EpiProj E{(bf16*)(ws + WS_PQ), (bf16*)(ws + WS_PG), (const float*)(ws + WS_RS1), (const f32x4*)(ws + WS_ROPE)};
            pg8::gemm_phase(F.lds, S, E);
        } else if (k == PH_ATTN && (PHMASK & 4)) {
            attn_phase(F, a, l);
        } else if (k == PH_MERGE && (PHMASK & 16)) {
            { pg8::StaticOrder so; so.init(MTOK, DM, F.G, F.bx); const int tid_ = F.wave * 64 + otid();
              for (int i = 0, pm, pn; so.next(i, pm, pn); ++i) comb_rows(F, a, pm * 256, tid_);
              VM_WAIT(); __syncthreads(); }
            DenseSched S; S.A = (const char*)(ws + WS_YAB); S.Bt = (const char*)(ws + wlo + WS_WAB); S.K = 768; S.lda = 768; S.ldb = 768; S.ksplit = 256; S.wave = F.wave; S.so.init(MTOK, DM, F.G, F.bx);
            EpiMerge E{(const unsigned char*)(ws + WS_PG), (bf16*)(ws + WS_MRG)};
            pg8::gemm_phase(F.lds, S, E);
        } else if (k == PH_OUT && (PHMASK & 32)) {
            DenseSched S; S.A = (const char*)(ws + WS_MRG); S.Bt = (const char*)(ws + wlo + WS_WOUT); S.K = DM; S.lda = DM; S.ldb = DM; S.ksplit = 0; S.wave = F.wave; S.so.init(MTOK, DM, F.G, F.bx);
            EpiResid E{(bf16*)(ws + WS_XB)};
            pg8::gemm_phase(F.lds, S, E);
        } else if (k == PH_ROUTE && (PHMASK & 64)) {
            route_phase(F, a, l);
        } else if (k == PH_UP || k == PH_DOWN || k == PH_DOWN2) {
            const MoeTab T = moe_tables(F, a, l);
            const int mtT = T.mtpref[32], nU = 2 * mtT, nU1 = nU < F.G ? nU : F.G, nU2 = nU - nU1, tready = nU1 >> 1;
            const int bx = F.vcu;
            MoeSched<true> SU; SU.A = (const char*)(ws + WS_XB); SU.Bt = (const char*)(ws + WS_WGU); SU.K = DM; SU.lda = DM; SU.ldb = DM; SU.wave = F.wave; SU.ntn = 2; SU.bstride_e = (size_t)512 * DM * 2; SU.ltok = (const int*)(ws + WS_LTOK); SU.T = T;
            MoeSched<false> SD; SD.A = (const char*)(ws + WS_H); SD.Bt = (const char*)(ws + WS_WD); SD.K = DEXP; SD.lda = DEXP; SD.ldb = DEXP; SD.wave = F.wave; SD.ntn = 4; SD.bstride_e = (size_t)DM * DEXP * 2; SD.ltok = nullptr; SD.T = T;
            EpiSwiglu EU{(const int*)(ws + WS_LTOK), (const float*)(ws + WS_LW), (const float*)(ws + WS_RS2), (bf16*)(ws + WS_H)};
            EpiY ED{(bf16*)(ws + WS_Y)};
            if (k == PH_UP) { SU.G = F.G; SU.c = bx; SU.lo = 0; SU.hi = nU1; pg8::gemm_phase(F.lds, SU, EU); }
            else if (k == PH_DOWN) {
                if (bx < nU2) { SU.G = nU2; SU.c = bx; SU.lo = nU1; SU.hi = nU; pg8::gemm_phase(F.lds, SU, EU); }
                else { SD.G = F.G - nU2; SD.c = bx - nU2; SD.lo = 0; SD.hi = 4 * tready; pg8::gemm_phase(F.lds, SD, ED); }
            } else {
                const int nX3 = 4 * (mtT - tready);
                SD.G = F.G; SD.c = bx; SD.lo = 4 * tready; SD.hi = 4 * mtT; pg8::gemm_phase(F.lds, SD, ED);
                if (false) {
                    const int nidle = F.G - nX3;
                    if (nidle >= 32) { if (bx >= nX3) prep_experts(F, a, l + 1, otid(), 0, (bx - nX3) * NWAVES + F.wave, nidle * NWAVES); }
                    else prep_experts(F, a, l + 1, otid(), 0, bx * NWAVES + F.wave, F.ngw);
                }
            }
        } else if (k == PH_FIN && (PHMASK & 512)) {
            const MoeTab T = moe_tables(F, a, l);
            fin_phase(F, a, l, T);
        }
#if REP_MASK
        if (l == 0 && ((REP_MASK >> k) & 1) && rep < REP_N) { ++rep; GRID_BAR(); continue; }
        rep = 0;
#endif
        if (ph + 1 < ph_hi) { GRID_BAR();
#ifdef EXTRA_BAR
            for (int eb = 0; eb < EXTRA_BAR; ++eb) GRID_BAR();
#endif
        }
        ++ph;
    }
}

extern "C" void kernel_launch(void* const* d_in, const int* in_sizes, int n_in, void* d_out, int out_size, void* d_ws, size_t ws_size, hipStream_t stream) {
    static int grid = 0;
    if (grid == 0) {
        if (n_in != 16 || out_size != MTOK * DM || ws_size < WS_END) { fprintf(stderr, "kernel_launch: unexpected shapes (n_in %d out %d ws %zu)\n", n_in, out_size, ws_size); grid = -1; return; }
        int dev = 0, cus = 0, per_cu = 0;
        if (hipGetDevice(&dev) != hipSuccess || hipDeviceGetAttribute(&cus, hipDeviceAttributeMultiprocessorCount, dev) != hipSuccess) { grid = -1; return; }
        if (hipFuncSetAttribute((const void*)fwd_kernel, hipFuncAttributeMaxDynamicSharedMemorySize, LDS_BYTES) != hipSuccess) { fprintf(stderr, "kernel_launch: hipFuncSetAttribute failed\n"); grid = -1; return; }
        if (hipOccupancyMaxActiveBlocksPerMultiprocessor(&per_cu, (const void*)fwd_kernel, NTHREADS, LDS_BYTES) != hipSuccess || per_cu < 1) { fprintf(stderr, "kernel_launch: occupancy query says %d\n", per_cu); (void)hipGetLastError(); }
        grid = cus;
    }
    if (grid < 0) return;
    (void)hipMemsetAsync((char*)d_ws + WS_CTL, 0, CTL_BYTES, stream);
    Args a{};
    a.x = (const float*)d_in[0]; a.attn_g = (const float*)d_in[1]; a.w_in = (const float*)d_in[2]; a.a_sink = (const float*)d_in[3]; a.w_a = (const float*)d_in[4]; a.w_b = (const float*)d_in[5];
    a.w_out = (const float*)d_in[6]; a.ffn_g = (const float*)d_in[7]; a.w_rg = (const float*)d_in[8]; a.b_rg = (const float*)d_in[9]; a.w_re = (const float*)d_in[10]; a.b_re = (const float*)d_in[11];
    a.w_eg = (const float*)d_in[12]; a.w_eu = (const float*)d_in[13]; a.w_ed = (const float*)d_in[14]; a.fin_g = (const float*)d_in[15];
    a.out = (float*)d_out; a.ws = (unsigned char*)d_ws;
#if MK_MULTI
    for (int ph = 0; ph < NPHASE; ++ph) { a.ph_lo = ph; a.ph_hi = ph + 1; hipLaunchKernelGGL(fwd_kernel, dim3(grid), dim3(NTHREADS), LDS_BYTES, stream, a); }
#else
    a.ph_lo = 0; a.ph_hi = NPHASE;
    void* kargs[] = {&a};
    const hipError_t le = hipLaunchCooperativeKernel((const void*)fwd_kernel, dim3(grid), dim3(NTHREADS), kargs, LDS_BYTES, stream);
    if (le != hipSuccess) fprintf(stderr, "kernel_launch: cooperative launch failed: %s (grid %d)\n", hipGetErrorString(le), grid);
#endif
}
```

```cpp
#include <hip/hip_runtime.h>
#include <hip/hip_cooperative_groups.h>
#include <cstdio>
#include <cstdint>
namespace cg = cooperative_groups;

#ifndef REP_MASK
#define REP_MASK 0
#define REP_N 2
#endif
#ifndef PHMASK
#define PHMASK 1023
#endif
#ifndef MK_MULTI
#define MK_MULTI 0
#endif

#define LAS __attribute__((address_space(3)))
#define GAS __attribute__((address_space(1)))
typedef unsigned short bf16;
typedef short bf16x8 __attribute__((ext_vector_type(8)));
typedef short s16x4 __attribute__((ext_vector_type(4)));
typedef float f32x2 __attribute__((ext_vector_type(2)));
typedef float f32x4 __attribute__((ext_vector_type(4)));
typedef float f32x16 __attribute__((ext_vector_type(16)));
typedef unsigned u32x2 __attribute__((ext_vector_type(2)));
typedef unsigned u32x4 __attribute__((ext_vector_type(4)));
typedef int i32x4 __attribute__((ext_vector_type(4)));
typedef __bf16 bf16x2_t __attribute__((ext_vector_type(2)));

constexpr int BATCH = 4, SEQ = 4096, DM = 1024, DEPTH = 2, MTOK = BATCH * SEQ;
constexpr int NQKV = 3072, NGATE = 2048, DIN = NQKV + NGATE;
constexpr int NEXP = 32, DEXP = 256;
constexpr float NORM_EPS = 1e-6f;
constexpr float LOG2E = 1.4426950408889634f, LN2 = 0.6931471805599453f;
constexpr float QSCALE = 0.125f * LOG2E;
constexpr int NWAVES = 8, NTHREADS = 512;

constexpr size_t MiB = 1u << 20;
constexpr size_t WS_CTL = 0, CTL_BYTES = 1 * MiB;
constexpr size_t WS_ROPE = 1 * MiB;
constexpr size_t WS_WR = 2 * MiB, WR_LSTRIDE = 512 * 1024, WR_LO = 256 * 1024;
constexpr size_t WS_RS1 = 3 * MiB, WS_RS2 = 3 * MiB + 65536;
constexpr size_t WS_TOKINFO = 5 * MiB;
constexpr size_t WS_LTOK = 6 * MiB, WS_LW = 8 * MiB;
constexpr size_t WS_LSE = 10 * MiB;
constexpr size_t WS_WIN = 12 * MiB, WS_WAB = 22 * MiB, WS_WOUT = 24 * MiB, WNE_LSTRIDE = 14 * MiB;
constexpr size_t WS_WGU = 40 * MiB, WS_WD = 72 * MiB;
constexpr size_t WS_XB = 88 * MiB;
constexpr size_t WS_YAB = 120 * MiB;
constexpr size_t WS_PQ = 144 * MiB;
constexpr size_t WS_MRG = 176 * MiB, WS_H = 208 * MiB;
constexpr size_t WS_PG = 240 * MiB;
constexpr size_t WS_Y = 240 * MiB;
constexpr size_t WS_END = 304 * MiB;
constexpr int CW_CNT = 64, CNT_STRIDE = 64;
constexpr int CW_BAR = 8192;
constexpr int CW_UPD = 32768, UPD_STRIDE = 64;
constexpr int CW_ERR = 32;

constexpr int RING_BYTES = 131072;
constexpr int PREP_SCR = 16896;
constexpr int MISC_OFF = 8 * PREP_SCR;
constexpr int LDS_BYTES = 147456;

#define LDS_WAIT() asm volatile("s_waitcnt lgkmcnt(0)" ::: "memory")
#define VM_WAIT() asm volatile("s_waitcnt vmcnt(0)" ::: "memory")
__device__ __forceinline__ unsigned cvtpk(float lo, float hi) { f32x2 v = {lo, hi}; bf16x2_t b = __builtin_convertvector(v, bf16x2_t); return __builtin_bit_cast(unsigned, b); }
__device__ __forceinline__ float bf2f(unsigned short h) { return __uint_as_float(((unsigned)h) << 16); }
__device__ __forceinline__ float bflo(unsigned w) { return __uint_as_float(w << 16); }
__device__ __forceinline__ float bfhi(unsigned w) { return __uint_as_float(w & 0xffff0000u); }
__device__ __forceinline__ float fast_exp2(float x) { return __builtin_amdgcn_exp2f(x); }
__device__ __forceinline__ float fast_rcp(float x) { return __builtin_amdgcn_rcpf(x); }
__device__ __forceinline__ int olane() { unsigned z = 0u; asm volatile("" : "+v"(z)); return (int)__builtin_amdgcn_mbcnt_hi(~0u, __builtin_amdgcn_mbcnt_lo(~0u, z)); }
__device__ __forceinline__ float sigmoidf_fast(float v) { return fast_rcp(1.0f + fast_exp2(-v * LOG2E)); }

namespace pg8 {
constexpr int BM = 256, BK = 64, HALF = 128, HTB = HALF * BK * 2, STAGE_BYTES = 8 * HTB, NXCD = 8, WGM = 4;
__host__ __device__ __forceinline__ int lds_byte(int r, int c) { const int st = (r >> 4) * 2 + (c >> 5), rr = r & 15, cc = c & 31, ob = rr * 64 + cc * 2; return st * 1024 + (ob ^ (((ob >> 9) & 1) << 5)); }
__host__ __device__ __forceinline__ void stage_rc(int b, int& R, int& C) { const int st = b / 1024, sb = b % 1024, swz = sb ^ (((sb >> 9) & 1) << 5); R = (st >> 1) * 16 + swz / 64; C = (st & 1) * 32 + (swz % 64) / 2; }
__host__ __device__ __forceinline__ int perm32(int rho) { const int n = rho >> 4, i = rho & 15; return 8 * (i >> 2) + 4 * n + (i & 3); }

struct Unit { int pm, pn, e, nvalid, slot0, lpos0, nt, kofs, sub; };

struct StaticOrder {
    int nM, nN, nwg, G, c;
    __device__ void init(int M, int N, int G_, int c_) { nM = M / BM; nN = N / BM; nwg = nM * nN; G = G_; c = c_; }
    __device__ bool next(int i, int& pm, int& pn) const {
        const long L = (long)i * G + c; if (L >= nwg) return false;
        int wgid = (int)L; { const int q = nwg / NXCD, r = nwg % NXCD, xcd = wgid % NXCD, off = wgid / NXCD; wgid = (xcd < r ? xcd * (q + 1) : r * (q + 1) + (xcd - r) * q) + off; }
        const int nig = WGM * nN, gid = wgid / nig, fm = gid * WGM, gsz = (nM - fm) < WGM ? (nM - fm) : WGM;
        pm = fm + ((wgid % nig) % gsz); pn = (wgid % nig) / gsz; return true;
    }
};

template <class Epi, class Sched>
__device__ __forceinline__ void gemm_phase(LAS unsigned char* lds, const Sched& S, const Epi& E) {
    unsigned z_ = 0u; asm volatile("" : "+v"(z_)); const int tid_ = (int)__builtin_amdgcn_mbcnt_hi(~0u, __builtin_amdgcn_mbcnt_lo(~0u, z_)) + S.wave * 64;
    const int tid = tid_, wid = S.wave, lane = tid & 63, wr = wid >> 2, wc = wid & 3, fr = lane & 15, fq = lane >> 4;
    const int K = S.ldb;
    unsigned voffA[2], voffB[2];
#pragma unroll
    for (int i = 0; i < 2; ++i) { int R, C; stage_rc(tid * 16 + i * 8192, R, C); const int Rb = Epi::PERM ? ((R & ~31) + perm32(R & 31)) : R;
        voffA[i] = (unsigned)(R * S.lda + C) * 2u; voffB[i] = (unsigned)(Rb * K + C) * 2u; }
    const size_t kstep = (size_t)(BK * 2);
    const size_t hstepB = (size_t)HALF * K * 2, hstepA = (size_t)HALF * S.lda * 2;
    const unsigned ldsw = (unsigned)wid * 1024u;
    const int aoff = lds_byte(wr * 64 + fr, fq * 8), boff = lds_byte(wc * 32 + fr, fq * 8);
#define PG8_SA(b, h) (((b) * 2 + (h)) * HTB)
#define PG8_SB(b, h) ((4 + (b) * 2 + (h)) * HTB)
#define PG8_GLDS(src, dstoff) __builtin_amdgcn_global_load_lds((const unsigned*)(src), (LAS unsigned*)(lds + (dstoff)), 16, 0, 0)
#define PG8_STAGE_A(bufoff, up, h, VO) do { if constexpr (Sched::GATHER) { _Pragma("unroll") for (int _i = 0; _i < 2; ++_i) PG8_GLDS((up) + VO[_i], (bufoff) + ldsw + _i * 8192); } \
        else { const char* _b = (up) + (size_t)(h) * hstepA; _Pragma("unroll") for (int _i = 0; _i < 2; ++_i) PG8_GLDS(_b + voffA[_i], (bufoff) + ldsw + _i * 8192); } } while (0)
#define PG8_STAGE_B(bufoff, bp) do { _Pragma("unroll") for (int _i = 0; _i < 2; ++_i) PG8_GLDS((bp) + voffB[_i], (bufoff) + ldsw + _i * 8192); } while (0)
#define PG8_LDA(dst, b, h) do { _Pragma("unroll") for (int m = 0; m < 4; ++m) _Pragma("unroll") for (int k = 0; k < 2; ++k) dst[m][k] = *(const LAS bf16x8*)(lds + PG8_SA(b, h) + aoff + m * 2048 + k * 1024); } while (0)
#define PG8_LDB(dst, b, h) do { _Pragma("unroll") for (int n = 0; n < 2; ++n) _Pragma("unroll") for (int k = 0; k < 2; ++k) dst[n][k] = *(const LAS bf16x8*)(lds + PG8_SB(b, h) + boff + n * 2048 + k * 1024); } while (0)
#define PG8_MMA(ai, bj, At, Bt) do { __builtin_amdgcn_s_setprio(1); _Pragma("unroll") for (int m = 0; m < 4; ++m) _Pragma("unroll") for (int n = 0; n < 2; ++n) _Pragma("unroll") for (int k = 0; k < 2; ++k) \
        acc[ai][bj][m][n] = __builtin_amdgcn_mfma_f32_16x16x32_bf16(Bt[n][k], At[m][k], acc[ai][bj][m][n], 0, 0, 0); __builtin_amdgcn_s_setprio(0); } while (0)
#define PG8_WAIT_V(n) asm volatile("s_waitcnt vmcnt(" #n ")" ::: "memory")
#define PG8_WAIT_L(n) asm volatile("s_waitcnt lgkmcnt(" #n ")" ::: "memory")
#define PG8_BAR __builtin_amdgcn_s_barrier()
#define PG8_SCHED __builtin_amdgcn_sched_barrier(0)
    Unit cur, nxt; int ui = 0;
    if (!S.next(0, cur)) return;
    f32x4 acc[2][2][4][2];
#pragma unroll
    for (int a = 0; a < 2; ++a)
#pragma unroll
        for (int b = 0; b < 2; ++b)
#pragma unroll
            for (int m = 0; m < 4; ++m)
#pragma unroll
                for (int n = 0; n < 2; ++n) acc[a][b][m][n] = (f32x4){0.f, 0.f, 0.f, 0.f};
    bf16x8 At[4][2], B0[2][2], B1[2][2];
    const char* Ab = S.a_base();
    const char* cA = Ab; const char* cB = S.b_base(cur);
    unsigned vF0[2], vF1[2], vK[2];
    if constexpr (Sched::GATHER) {
#pragma unroll
        for (int i = 0; i < 2; ++i) { int R, C; stage_rc(tid * 16 + i * 8192, R, C); vF0[i] = S.a_off(cur, R) + (unsigned)(C * 2); vF1[i] = S.a_off(cur, HALF + R) + (unsigned)(C * 2); vK[i] = vF1[i]; }
    } else cA = Ab + S.a_unit_off(cur);
    S.a_ready(cur);
    PG8_STAGE_B(PG8_SB(0, 0), cB); PG8_STAGE_B(PG8_SB(0, 1), cB + hstepB); PG8_STAGE_A(PG8_SA(0, 0), cA, 0, vF0); PG8_STAGE_A(PG8_SA(0, 1), cA, 1, vF1);
    if (wr == 1) PG8_BAR;
    PG8_WAIT_V(2); PG8_BAR;
    PG8_STAGE_B(PG8_SB(1, 0), cB + kstep); PG8_STAGE_A(PG8_SA(1, 0), cA + kstep, 0, vF0); PG8_STAGE_B(PG8_SB(1, 1), cB + hstepB + kstep);
    PG8_WAIT_V(6); PG8_BAR;
    for (;;) {
        const bool has_next = S.next(ui + 1, nxt);
        const char* nA = cA; const char* nB = cB;
        if (has_next) { nB = S.b_base(nxt); if constexpr (!Sched::GATHER) nA = Ab + S.a_unit_off(nxt); }
        const int nt = cur.nt;
#pragma unroll 1
        for (int t = 0; t < nt; t += 2) {
            const bool last = (t == nt - 2);
            if (last && has_next) S.a_ready(nxt);
            const char* a1 = cA + (size_t)(t + 1) * kstep;
            const char* a2 = last ? nA : cA + (size_t)(t + 2) * kstep; const char* b2 = last ? nB : cB + (size_t)(t + 2) * kstep;
            const char* a3 = a2 + kstep; const char* b3 = b2 + kstep;
            if constexpr (Sched::GATHER) {
                if (last && has_next) {
#pragma unroll
                    for (int i = 0; i < 2; ++i) { int R, C; stage_rc(tid * 16 + i * 8192, R, C); vF0[i] = S.a_off(nxt, R) + (unsigned)(C * 2); vF1[i] = S.a_off(nxt, HALF + R) + (unsigned)(C * 2); }
                }
            }
            PG8_LDB(B0, 0, 0); PG8_LDB(B1, 0, 1); PG8_SCHED; PG8_LDA(At, 0, 0); PG8_STAGE_A(PG8_SA(1, 1), a1, 1, vK);
            PG8_WAIT_V(8); PG8_WAIT_L(0); PG8_BAR; PG8_MMA(0, 0, At, B0); PG8_MMA(0, 1, At, B1); PG8_BAR; PG8_SCHED;
            PG8_LDA(At, 0, 1); PG8_STAGE_B(PG8_SB(0, 0), b2); PG8_STAGE_B(PG8_SB(0, 1), b2 + hstepB); PG8_STAGE_A(PG8_SA(0, 0), a2, 0, vF0);
            PG8_WAIT_V(8); PG8_WAIT_L(0); PG8_BAR; PG8_MMA(1, 0, At, B0); PG8_MMA(1, 1, At, B1); PG8_BAR; PG8_SCHED;
            PG8_LDB(B0, 1, 0); PG8_LDB(B1, 1, 1); PG8_SCHED; PG8_LDA(At, 1, 0); PG8_STAGE_A(PG8_SA(0, 1), a2, 1, vF1);
            PG8_WAIT_V(8); PG8_WAIT_L(0); PG8_BAR; PG8_MMA(0, 0, At, B0); PG8_MMA(0, 1, At, B1); PG8_BAR; PG8_SCHED;
            PG8_LDA(At, 1, 1); PG8_STAGE_B(PG8_SB(1, 0), b3); PG8_STAGE_B(PG8_SB(1, 1), b3 + hstepB); PG8_STAGE_A(PG8_SA(1, 0), a3, 0, vF0);
            PG8_WAIT_V(8); PG8_WAIT_L(0); PG8_BAR; PG8_MMA(1, 0, At, B0); PG8_MMA(1, 1, At, B1); PG8_BAR; PG8_SCHED;
        }
        if (wr == 0) PG8_BAR;
        bool keep = false;
        if constexpr (Epi::HAS_MID) { if (cur.sub == 0) { E.mid(acc, cur, wr, wc, fr, fq); keep = true; } else E(acc, cur, wr, wc, fr, fq); }
        else E(acc, cur, wr, wc, fr, fq);
        S.done(cur);
        if (!has_next) break;
        if (!keep) {
#pragma unroll
        for (int a = 0; a < 2; ++a)
#pragma unroll
            for (int b = 0; b < 2; ++b)
#pragma unroll
                for (int m = 0; m < 4; ++m)
#pragma unroll
                    for (int n = 0; n < 2; ++n) acc[a][b][m][n] = (f32x4){0.f, 0.f, 0.f, 0.f};
        }
        cur = nxt; cA = nA; cB = nB; ++ui;
        if constexpr (Sched::GATHER) { vK[0] = vF1[0]; vK[1] = vF1[1]; }
        if (wr == 1) PG8_BAR;
    }
    PG8_WAIT_V(0);
    PG8_BAR;
#undef PG8_SA
#undef PG8_SB
#undef PG8_GLDS
#undef PG8_STAGE_A
#undef PG8_STAGE_B
#undef PG8_LDA
#undef PG8_LDB
#undef PG8_MMA
#undef PG8_WAIT_V
#undef PG8_WAIT_L
#undef PG8_BAR
#undef PG8_SCHED
}
}
using pg8::Unit;

struct DenseSched {
    static constexpr bool GATHER = false;
    const char* A; const char* Bt; int K; int lda; int ldb; int wave; int ksplit; pg8::StaticOrder so;
    __device__ __forceinline__ bool next(int i, Unit& u) const {
        int pm, pn; const int ti = ksplit ? (i >> 1) : i; if (!so.next(ti, pm, pn)) return false;
        u.pm = pm; u.pn = pn; u.e = 0; u.nvalid = 256; u.slot0 = pm * 256; u.lpos0 = 0;
        if (ksplit) { u.sub = i & 1; u.kofs = u.sub ? ksplit : 0; u.nt = (u.sub ? K - ksplit : ksplit) / 64; } else { u.sub = 1; u.kofs = 0; u.nt = K / 64; }
        return true; }
    __device__ __forceinline__ const char* a_base() const { return A; }
    __device__ __forceinline__ unsigned a_off(const Unit& u, int r) const { return 0u; }
    __device__ __forceinline__ size_t a_unit_off(const Unit& u) const { return ((size_t)u.pm * 256 * lda + u.kofs) * 2; }
    __device__ __forceinline__ const char* b_base(const Unit& u) const { return Bt + ((size_t)u.pn * 256 * ldb + u.kofs) * 2; }
    __device__ __forceinline__ void a_ready(const Unit&) const {}
    __device__ __forceinline__ void done(const Unit&) const {}
};
struct MoeTab { const volatile LAS int* cnt; const volatile LAS int* mtpref; const volatile LAS int* spref; };
template <bool GATHER_> struct MoeSched {
    static constexpr bool GATHER = GATHER_;
    const char* A; const char* Bt; int K; int lda; int ldb; int wave; int ntn; size_t bstride_e; const int* ltok; MoeTab T;
    int G1, c1, lo1, hi1, G2, c2, lo2, hi2; unsigned* upd; unsigned* err;
    __device__ __forceinline__ bool next(int i, Unit& u) const {
        int L;
        const int n1 = (c1 >= 0 && lo1 + c1 < hi1) ? (hi1 - lo1 - c1 + G1 - 1) / G1 : 0;
        if (i < n1) L = lo1 + c1 + i * G1;
        else { L = lo2 + c2 + (i - n1) * G2; if (c2 < 0 || L >= hi2) return false; }
        const int tix = L / ntn; u.pn = L - tix * ntn; u.pm = tix;
        int e = 0;
#pragma unroll 1
        for (int k = 1; k < 32; ++k) if (T.mtpref[k] <= tix) e = k;
        const int mt = tix - T.mtpref[e]; u.e = e; u.slot0 = T.spref[e] + 256 * mt; const int rem = T.cnt[e] - 256 * mt; u.nvalid = rem < 256 ? rem : 256; u.lpos0 = e * MTOK + 256 * mt; u.nt = K / 64; u.kofs = 0; u.sub = 1; return true;
    }
    __device__ __forceinline__ const char* a_base() const { return A; }
    __device__ __forceinline__ unsigned a_off(const Unit& u, int r) const { const int rr = r < u.nvalid ? r : u.nvalid - 1; return (unsigned)ltok[u.lpos0 + rr] * (unsigned)(lda * 2); }
    __device__ __forceinline__ size_t a_unit_off(const Unit& u) const { return (size_t)u.slot0 * lda * 2; }
    __device__ __forceinline__ const char* b_base(const Unit& u) const { return Bt + (size_t)u.e * bstride_e + (size_t)u.pn * 256 * K * 2; }
    __device__ __forceinline__ void a_ready(const Unit& u) const {
        if constexpr (!GATHER_) {
            if (wave == 0) {
                unsigned* p = upd + u.pm * UPD_STRIDE; unsigned spins = 0;
                while ((unsigned)__builtin_amdgcn_readfirstlane(__hip_atomic_load(p, __ATOMIC_RELAXED, __HIP_MEMORY_SCOPE_AGENT)) < 16u) {
                    __builtin_amdgcn_s_sleep(2);
                    if (++spins > (1u << 22)) { __hip_atomic_store(err, 1u, __ATOMIC_RELAXED, __HIP_MEMORY_SCOPE_AGENT); break; }
                }
                __builtin_amdgcn_fence(__ATOMIC_ACQUIRE, "agent");
                asm volatile("s_waitcnt vmcnt(0)" ::: "memory");
            }
            asm volatile("" ::: "memory"); __builtin_amdgcn_s_barrier(); asm volatile("" ::: "memory");
        }
    }
    __device__ __forceinline__ void done(const Unit& u) const {
        if constexpr (GATHER_) {
            asm volatile("s_waitcnt vmcnt(0)" ::: "memory");
            if (olane() == 0) __hip_atomic_fetch_add(upd + u.pm * UPD_STRIDE, 1u, __ATOMIC_RELAXED, __HIP_MEMORY_SCOPE_AGENT);
        }
    }
};

#define OPAQUE(p) asm volatile("" : "+v"(p))
struct EpiProj {
    static constexpr bool PERM = true, REPEAT = true, HAS_MID = false;
    bf16* Pq; bf16* Pg; const float* rs; const f32x4* rope;
    __device__ __forceinline__ static void rot(f32x4& c, const f32x4& st) {
        const f32x4 o = c;
        c[0] = o[0] * st[0] - o[1] * st[1]; c[1] = o[1] * st[0] + o[0] * st[1];
        c[2] = o[2] * st[2] - o[3] * st[3]; c[3] = o[3] * st[2] + o[2] * st[3];
    }
    __device__ __forceinline__ void operator()(const f32x4 (&acc)[2][2][4][2], const Unit& u, int wr, int wc, int fr, int fq) const {
        const int colh = wc * 32 + fq * 8;
        const int ib = (colh & 63) >> 2;
        const int row0 = u.pm * 256 + wr * 64 + fr;
        int mode[2]; bf16* ob[2]; size_t ostep[2];
#pragma unroll
        for (int bj = 0; bj < 2; ++bj) {
            const int h128 = 2 * u.pn + bj;
            if (h128 >= 24) mode[bj] = 3;
            else if (h128 < 6) mode[bj] = h128 < 4 ? 1 : (h128 == 4 ? 2 : 0);
            else { const int j = (h128 - 6) % 6; mode[bj] = j < 2 ? 1 : (j < 4 ? 2 : 0); }
            if (h128 < 24) { ob[bj] = Pq + h128 * 128 + colh + (size_t)row0 * NQKV; ostep[bj] = (size_t)NQKV * 16; }
            else { ob[bj] = Pg + (((h128 - 24) * 128 + colh) >> 1) + (size_t)row0 * (NGATE / 2); ostep[bj] = (size_t)(NGATE / 2) * 16; }
        }
        float rsv[8];
#pragma unroll
        for (int i = 0; i < 8; ++i) rsv[i] = rs[row0 + (i >> 2) * 128 + (i & 3) * 16];
        const f32x4* rp = rope + (size_t)(row0 & (SEQ - 1)) * 16 + ib;
        f32x4 c0 = rp[0], c1 = rp[1];
        const f32x4 s16a = rope[16 * 16 + ib], s16b = rope[16 * 16 + ib + 1], s80a = rope[80 * 16 + ib], s80b = rope[80 * 16 + ib + 1];
#pragma unroll
        for (int ai = 0; ai < 2; ++ai)
#pragma unroll
            for (int m = 0; m < 4; ++m) {
                OPAQUE(ob[0]); OPAQUE(ob[1]);
                const float s = rsv[ai * 4 + m];
#pragma unroll
                for (int bj = 0; bj < 2; ++bj) {
                    f32x4 v0 = acc[ai][bj][m][0] * s, v1 = acc[ai][bj][m][1] * s;
                    if (mode[bj] == 1 || mode[bj] == 2) {
                        f32x4 o0, o1;
                        o0[0] = v0[0] * c0[0] - v0[1] * c0[1]; o0[1] = v0[1] * c0[0] + v0[0] * c0[1];
                        o0[2] = v0[2] * c0[2] - v0[3] * c0[3]; o0[3] = v0[3] * c0[2] + v0[2] * c0[3];
                        o1[0] = v1[0] * c1[0] - v1[1] * c1[1]; o1[1] = v1[1] * c1[0] + v1[0] * c1[1];
                        o1[2] = v1[2] * c1[2] - v1[3] * c1[3]; o1[3] = v1[3] * c1[2] + v1[2] * c1[3];
                        const float qs = (mode[bj] == 1) ? QSCALE : 1.0f;
                        v0 = o0 * qs; v1 = o1 * qs;
                    } else if (mode[bj] == 3) {
#pragma unroll
                        for (int j = 0; j < 4; ++j) { v0[j] = sigmoidf_fast(v0[j]); v1[j] = sigmoidf_fast(v1[j]); }
                    }
                    if (mode[bj] == 3) {
                        unsigned q[8];
#pragma unroll
                        for (int j = 0; j < 4; ++j) { q[j] = (unsigned)fminf(v0[j] * 256.0f, 255.0f); q[4 + j] = (unsigned)fminf(v1[j] * 256.0f, 255.0f); }
                        u32x2 w; w.x = q[0] | (q[1] << 8) | (q[2] << 16) | (q[3] << 24); w.y = q[4] | (q[5] << 8) | (q[6] << 16) | (q[7] << 24);
                        *(u32x2*)(ob[bj]) = w;
                    } else {
                        u32x4 w; w.x = cvtpk(v0[0], v0[1]); w.y = cvtpk(v0[2], v0[3]); w.z = cvtpk(v1[0], v1[1]); w.w = cvtpk(v1[2], v1[3]);
                        *(u32x4*)(ob[bj]) = w;
                    }
                }
                if (m == 3) { rot(c0, s80a); rot(c1, s80b); } else { rot(c0, s16a); rot(c1, s16b); }
                const int adv = (m == 3) ? 5 : 1;
                ob[0] += ostep[0] * adv; ob[1] += ostep[1] * adv;
            }
    }
};
struct EpiMerge {
    static constexpr bool PERM = true, REPEAT = false, HAS_MID = true;
    const unsigned char* gate; bf16* out;
    __device__ __forceinline__ static float dq(unsigned w, int k) { return ((float)((w >> (8 * k)) & 255u) + 0.5f) * (1.0f / 256.0f); }
    __device__ __forceinline__ void mid(f32x4 (&acc)[2][2][4][2], const Unit& u, int wr, int wc, int fr, int fq) const {
        const int row0 = u.pm * 256 + wr * 64 + fr, col0 = u.pn * 256 + wc * 32 + fq * 8;
        const unsigned char* gp = gate + (size_t)row0 * NGATE + col0;
        u32x2 ga[2][2], gb[2][2];
#define EM_LOAD(slot, i) do { const size_t ro = (size_t)(16 * (i) + 64 * ((i) >> 2)) * NGATE; ga[slot][0] = *(const u32x2*)(gp + ro); ga[slot][1] = *(const u32x2*)(gp + ro + 128); \
        gb[slot][0] = *(const u32x2*)(gp + ro + 1024); gb[slot][1] = *(const u32x2*)(gp + ro + 1024 + 128); } while (0)
        EM_LOAD(0, 0);
#pragma unroll
        for (int i = 0; i < 8; ++i) {
            const int ai = i >> 2, m = i & 3, sl = i & 1;
            if (i + 1 < 8) { if (sl == 0) EM_LOAD(1, i + 1); else EM_LOAD(0, i + 1); }
#pragma unroll
            for (int bj = 0; bj < 2; ++bj) {
                const u32x2 A = ga[sl][bj], B = gb[sl][bj];
#pragma unroll
                for (int j = 0; j < 4; ++j) {
                    acc[ai][bj][m][0][j] *= dq(B.x, j) * fast_rcp(dq(A.x, j));
                    acc[ai][bj][m][1][j] *= dq(B.y, j) * fast_rcp(dq(A.y, j));
                }
            }
        }
#undef EM_LOAD
    }
    __device__ __forceinline__ void operator()(const f32x4 (&acc)[2][2][4][2], const Unit& u, int wr, int wc, int fr, int fq) const {
        const int row0 = u.pm * 256 + wr * 64 + fr, col0 = u.pn * 256 + wc * 32 + fq * 8;
        const unsigned char* gp = gate + (size_t)row0 * NGATE + col0; bf16* op = out + (size_t)row0 * DM + col0;
        u32x2 ga[2][2];
#define EF_LOAD(slot, i) do { const size_t ro = (size_t)(16 * (i) + 64 * ((i) >> 2)) * NGATE; ga[slot][0] = *(const u32x2*)(gp + ro); ga[slot][1] = *(const u32x2*)(gp + ro + 128); } while (0)
        EF_LOAD(0, 0);
#pragma unroll
        for (int i = 0; i < 8; ++i) {
            const int ai = i >> 2, m = i & 3, sl = i & 1;
            if (i + 1 < 8) { if (sl == 0) EF_LOAD(1, i + 1); else EF_LOAD(0, i + 1); }
            bf16* orow = op + (size_t)(16 * i + 64 * (i >> 2)) * DM;
#pragma unroll
            for (int bj = 0; bj < 2; ++bj) {
                const u32x2 A = ga[sl][bj];
                const f32x4 a0 = acc[ai][bj][m][0], a1 = acc[ai][bj][m][1];
                u32x4 w;
                w.x = cvtpk(a0[0] * dq(A.x, 0), a0[1] * dq(A.x, 1)); w.y = cvtpk(a0[2] * dq(A.x, 2), a0[3] * dq(A.x, 3));
                w.z = cvtpk(a1[0] * dq(A.y, 0), a1[1] * dq(A.y, 1)); w.w = cvtpk(a1[2] * dq(A.y, 2), a1[3] * dq(A.y, 3));
                *(u32x4*)(orow + bj * 128) = w;
            }
            asm volatile("" ::: "memory");
        }
#undef EF_LOAD
    }
};
struct EpiResid {
    static constexpr bool PERM = true, REPEAT = false, HAS_MID = false;
    bf16* xb;
    __device__ __forceinline__ void operator()(const f32x4 (&acc)[2][2][4][2], const Unit& u, int wr, int wc, int fr, int fq) const {
        const int row0 = u.pm * 256 + wr * 64 + fr, col0 = u.pn * 256 + wc * 32 + fq * 8;
        bf16* xp = xb + (size_t)row0 * DM + col0;
        u32x4 p[2][2];
#define ER_LOAD(slot, i) do { const size_t ro = (size_t)(16 * (i) + 64 * ((i) >> 2)); p[slot][0] = *(const u32x4*)(xp + ro * DM); p[slot][1] = *(const u32x4*)(xp + ro * DM + 128); } while (0)
        ER_LOAD(0, 0);
#pragma unroll
        for (int i = 0; i < 8; ++i) {
            const int ai = i >> 2, m = i & 3, sl = i & 1;
            if (i + 1 < 8) { if (sl == 0) ER_LOAD(1, i + 1); else ER_LOAD(0, i + 1); }
            bf16* orow = xp + (size_t)(16 * i + 64 * (i >> 2)) * DM;
#pragma unroll
            for (int bj = 0; bj < 2; ++bj) {
                const u32x4 q = p[sl][bj];
                const f32x4 a0 = acc[ai][bj][m][0], a1 = acc[ai][bj][m][1];
                u32x4 w;
                w.x = cvtpk(a0[0] + bflo(q.x), a0[1] + bfhi(q.x)); w.y = cvtpk(a0[2] + bflo(q.y), a0[3] + bfhi(q.y));
                w.z = cvtpk(a1[0] + bflo(q.z), a1[1] + bfhi(q.z)); w.w = cvtpk(a1[2] + bflo(q.w), a1[3] + bfhi(q.w));
                *(u32x4*)(orow + bj * 128) = w;
            }
            asm volatile("" ::: "memory");
        }
#undef ER_LOAD
    }
};
struct EpiSwiglu {
    static constexpr bool PERM = true, REPEAT = false, HAS_MID = false;
    const int* ltok; const float* lw; const float* rs; bf16* H;
    __device__ __forceinline__ void operator()(const f32x4 (&acc)[2][2][4][2], const Unit& u, int wr, int wc, int fr, int fq) const {
        int tok[8]; float w8[8], s8[8];
#pragma unroll
        for (int i = 0; i < 8; ++i) { const int rr = (i >> 2) * 128 + wr * 64 + (i & 3) * 16 + fr; const int rc = rr < u.nvalid ? rr : u.nvalid - 1; tok[i] = ltok[u.lpos0 + rc]; w8[i] = lw[u.lpos0 + rc]; }
#pragma unroll
        for (int i = 0; i < 8; ++i) s8[i] = rs[tok[i]];
#pragma unroll
        for (int ai = 0; ai < 2; ++ai)
#pragma unroll
            for (int m = 0; m < 4; ++m) {
                const int rr = ai * 128 + wr * 64 + m * 16 + fr;
                if (rr < u.nvalid) {
                    const float w = w8[ai * 4 + m], s = s8[ai * 4 + m];
#pragma unroll
                    for (int bj = 0; bj < 2; ++bj) {
                        const f32x4 a0 = acc[ai][bj][m][0] * s, a1 = acc[ai][bj][m][1] * s;
                        const float h0 = a0[0] * sigmoidf_fast(a0[0]) * a0[1] * w, h1 = a0[2] * sigmoidf_fast(a0[2]) * a0[3] * w;
                        const float h2 = a1[0] * sigmoidf_fast(a1[0]) * a1[1] * w, h3 = a1[2] * sigmoidf_fast(a1[2]) * a1[3] * w;
                        u32x2 o; o.x = cvtpk(h0, h1); o.y = cvtpk(h2, h3);
                        __hip_atomic_store((unsigned long long*)(H + (size_t)(u.slot0 + rr) * DEXP + u.pn * 128 + bj * 64 + wc * 16 + fq * 4), (unsigned long long)o.x | ((unsigned long long)o.y << 32), __ATOMIC_RELAXED, __HIP_MEMORY_SCOPE_AGENT);
                    }
                }
            }
    }
};
struct EpiY {
    static constexpr bool PERM = true, REPEAT = false, HAS_MID = false;
    bf16* Y;
    __device__ __forceinline__ void operator()(const f32x4 (&acc)[2][2][4][2], const Unit& u, int wr, int wc, int fr, int fq) const {
#pragma unroll
        for (int ai = 0; ai < 2; ++ai)
#pragma unroll
            for (int m = 0; m < 4; ++m) {
                const int rr = ai * 128 + wr * 64 + m * 16 + fr;
                if (rr < u.nvalid) {
#pragma unroll
                    for (int bj = 0; bj < 2; ++bj) {
                        const f32x4 a0 = acc[ai][bj][m][0], a1 = acc[ai][bj][m][1];
                        u32x4 w; w.x = cvtpk(a0[0], a0[1]); w.y = cvtpk(a0[2], a0[3]); w.z = cvtpk(a1[0], a1[1]); w.w = cvtpk(a1[2], a1[3]);
                        *(u32x4*)(Y + (size_t)(u.slot0 + rr) * DM + u.pn * 256 + bj * 128 + wc * 32 + fq * 8) = w;
                    }
                }
            }
    }
};

#define XB_TMO      128
#define XB_XCNT(j)  (256  + 64 * (j))
#define XB_XSUB(j)  (1280 + 64 * (j))
#define XB_XGEN(j)  (2304 + 64 * (j))
#define XB_TOP      3328
#define XB_TOPGEN   3392
#define XCD_BAR_WORDS 3456
#define XB_SPIN_CAP (1u << 18)
__device__ __forceinline__ unsigned xb_ld(unsigned* p)              { return __hip_atomic_load(p, __ATOMIC_RELAXED, __HIP_MEMORY_SCOPE_AGENT); }
__device__ __forceinline__ unsigned xb_add(unsigned* p, unsigned v) { return __hip_atomic_fetch_add(p, v, __ATOMIC_RELAXED, __HIP_MEMORY_SCOPE_AGENT); }
__device__ __forceinline__ unsigned xb_xcc_id() { return (unsigned)__builtin_amdgcn_s_getreg((3 << 11) | 20) & 0xFu; }
#define XB_SPIN(cond, bar) do { unsigned _sp = 0; while (cond) { __builtin_amdgcn_s_sleep(1); \
    if ((++_sp & 255u) == 0u) { if (xb_ld(&(bar)[XB_TMO])) break; if (_sp > XB_SPIN_CAP) { atomicAdd(&(bar)[XB_TMO], 1u); break; } } } } while (0)
struct XcdBarrier { unsigned* bar; unsigned x; volatile LAS unsigned* st; };
__device__ __forceinline__ XcdBarrier xcd_barrier_post(unsigned* bar, volatile LAS unsigned* st) {
    XcdBarrier b; b.bar = bar; b.x = xb_xcc_id(); b.st = st;
    if (threadIdx.x == 0) (void)xb_add(&bar[XB_XCNT(b.x)], 1u);
    return b;
}
__device__ __forceinline__ void xcd_barrier_complete(unsigned* bar, unsigned x, unsigned& nloc, unsigned& nx) {
    const unsigned G = gridDim.x * gridDim.y * gridDim.z;
    unsigned sum, cnt, mine, sp = 0u;
    for (;;) {
        sum = 0u; cnt = 0u; mine = 0u;
#pragma unroll
        for (unsigned j = 0; j < 16; ++j) { const unsigned c = xb_ld(&bar[XB_XCNT(j)]); sum += c; cnt += (c > 0u) ? 1u : 0u; mine = (j == x) ? c : mine; }
        if (sum == G) break;
        __builtin_amdgcn_s_sleep(1);
        if ((++sp & 255u) == 0u) { if (xb_ld(&bar[XB_TMO])) break; if (sp > XB_SPIN_CAP) { atomicAdd(&bar[XB_TMO], 1u); break; } }
    }
    nloc = mine > 0u ? mine : 1u; nx = cnt > 0u ? cnt : 1u;
}
__device__ __forceinline__ void xcd_barrier(const XcdBarrier& b, int wave) {
    asm volatile("s_waitcnt vmcnt(0)" ::: "memory");
    __syncthreads();
    unsigned zb_ = 0u; asm volatile("" : "+v"(zb_));
    if (wave == 0 && __builtin_amdgcn_mbcnt_hi(~0u, __builtin_amdgcn_mbcnt_lo(~0u, zb_)) == 0u) {
        unsigned* bar = b.bar;
        __builtin_amdgcn_s_waitcnt(0);
        unsigned nloc = b.st[0], nx = b.st[1];
        if (nloc == 0u) { xcd_barrier_complete(bar, b.x, nloc, nx); b.st[0] = nloc; b.st[1] = nx; }
        const unsigned old = xb_add(&bar[XB_XSUB(b.x)], 1u);
        const unsigned gen = old / nloc;
        if (old + 1u == (gen + 1u) * nloc) {
            __builtin_amdgcn_fence(__ATOMIC_RELEASE, "agent");
            asm volatile("s_waitcnt vmcnt(0)" ::: "memory");
            const unsigned og = xb_add(&bar[XB_TOP], 1u);
            const unsigned tg = og / nx;
            if (og + 1u == (tg + 1u) * nx) xb_add(&bar[XB_TOPGEN], 1u);
            else XB_SPIN(xb_ld(&bar[XB_TOPGEN]) == tg, bar);
            __builtin_amdgcn_fence(__ATOMIC_ACQUIRE, "agent");
            xb_add(&bar[XB_XGEN(b.x)], 1u);
            asm volatile("s_waitcnt vmcnt(0)" ::: "memory");
        } else {
            XB_SPIN(xb_ld(&bar[XB_XGEN(b.x)]) == gen, bar);
            __builtin_amdgcn_fence(__ATOMIC_ACQUIRE, "agent");
            asm volatile("s_waitcnt vmcnt(0)" ::: "memory");
        }
    }
    __syncthreads();
}

struct Args {
    const float* x; const float* attn_g; const float* w_in; const float* a_sink; const float* w_a; const float* w_b; const float* w_out; const float* ffn_g;
    const float* w_rg; const float* b_rg; const float* w_re; const float* b_re; const float* w_eg; const float* w_eu; const float* w_ed; const float* fin_g;
    float* out; unsigned char* ws; int ph_lo, ph_hi;
};
typedef const __attribute__((address_space(4))) Args* CArgs;
struct Frame {
    LAS unsigned char* lds; volatile LAS int* misc;
    int wave, G, vcu, gw, ngw, bx;
};
__device__ __forceinline__ int otid() { unsigned z = 0u; asm volatile("" : "+v"(z)); return (int)__builtin_amdgcn_mbcnt_hi(~0u, __builtin_amdgcn_mbcnt_lo(~0u, z)); }
__device__ __forceinline__ float shx(float v, int o, int lane) { return __int_as_float(__builtin_amdgcn_ds_bpermute((lane ^ o) << 2, __float_as_int(v))); }
__device__ __forceinline__ float wave_sum(float v, int lane) {
#pragma unroll
    for (int o = 1; o < 64; o <<= 1) v += shx(v, o, lane);
    return v;
}

struct MapPlain { __device__ __forceinline__ int operator()(int n) const { return n; } };
struct MapWin { __device__ __forceinline__ int operator()(int n) const {
        bool rope = false;
        if (n < 640) rope = true; else if (n >= 768 && n < NQKV) rope = ((n - 768) % 768) < 512;
        if (!rope) return n; const int d = n & 63; return (n & ~63) + 2 * (d & 31) + (d >> 5); } };
struct MapGU { int t; __device__ __forceinline__ int operator()(int n) const { return 2 * n + t; } };
template <class Map> __device__ __forceinline__ void transpose_item64(const float* W, int ldn, int k0, int n0, const float* gk, bf16* WT, int Kd, const Map& map, LAS float* scr, int lane) {
    const int kq = lane >> 4, n4 = (lane & 15) * 4;
    const float* src = W + (size_t)(k0 + kq) * ldn + n0 + n4;
    f32x4 v[16];
#pragma unroll
    for (int i = 0; i < 16; ++i) v[i] = *(const f32x4*)(src + (size_t)(4 * i) * ldn);
    if (gk) {
#pragma unroll
        for (int i = 0; i < 16; ++i) v[i] = v[i] * gk[k0 + 4 * i + kq];
    }
#pragma unroll
    for (int i = 0; i < 16; ++i) { LAS float* d = scr + (4 * i + kq) * 65 + n4; d[0] = v[i][0]; d[1] = v[i][1]; d[2] = v[i][2]; d[3] = v[i][3]; }
    LDS_WAIT(); asm volatile("" ::: "memory");
    const int c = lane & 7;
#pragma unroll
    for (int j = 0; j < 8; ++j) { const int n = (lane >> 3) + 8 * j; const LAS float* p = scr + (8 * c) * 65 + n;
        u32x4 o; o.x = cvtpk(p[0 * 65], p[1 * 65]); o.y = cvtpk(p[2 * 65], p[3 * 65]); o.z = cvtpk(p[4 * 65], p[5 * 65]); o.w = cvtpk(p[6 * 65], p[7 * 65]);
        *(u32x4*)(WT + (size_t)map(n0 + n) * Kd + k0 + 8 * c) = o; }
    LDS_WAIT(); asm volatile("" ::: "memory");
}
__device__ __forceinline__ void prep_phase(const Frame& F, CArgs a) {
    const int lane = otid(), tid = F.wave * 64 + lane; (void)tid; (void)lane;
    unsigned char* ws = a->ws;
    LAS float* scr = (LAS float*)(F.lds + F.wave * PREP_SCR);
    constexpr int I_IN = 16 * 80, I_A = 8 * 16, I_B = 4 * 16, I_O = 16 * 16, I_L = I_IN + I_A + I_B + I_O;
    for (int it = F.gw; it < DEPTH * I_L; it += F.ngw) {
        const int l = it / I_L; int r = it - l * I_L;
        unsigned char* wl = ws + (size_t)l * WNE_LSTRIDE;
        if (r < I_IN) { transpose_item64(a->w_in + (size_t)l * DM * DIN, DIN, 64 * (r / 80), 64 * (r % 80), a->attn_g + l * DM, (bf16*)(wl + WS_WIN), DM, MapWin{}, scr, lane); continue; } r -= I_IN;
        if (r < I_A) { transpose_item64(a->w_a + (size_t)l * 512 * DM, DM, 64 * (r / 16), 64 * (r % 16), nullptr, (bf16*)(wl + WS_WAB) + 256, 768, MapPlain{}, scr, lane); continue; } r -= I_A;
        if (r < I_B) { transpose_item64(a->w_b + (size_t)l * 256 * DM, DM, 64 * (r / 16), 64 * (r % 16), nullptr, (bf16*)(wl + WS_WAB), 768, MapPlain{}, scr, lane); continue; } r -= I_B;
        transpose_item64(a->w_out + (size_t)l * DM * DM, DM, 64 * (r / 16), 64 * (r % 16), nullptr, (bf16*)(wl + WS_WOUT), DM, MapPlain{}, scr, lane);
    }
    for (int idx = F.bx * NTHREADS + tid; idx < DEPTH * 32 * 3 * 64 * 8; idx += F.G * NTHREADS) {
        const int l = idx / (32 * 3 * 64 * 8), id = idx - l * (32 * 3 * 64 * 8);
        const int j = id & 7, ln = (id >> 3) & 63, q = id >> 9, nt = q % 3, i = q / 3;
        const int k = 32 * i + 8 * (ln >> 4) + j, n = 16 * nt + (ln & 15);
        const float* wg = a->w_rg + (size_t)l * DM * 4; const float* we = a->w_re + (size_t)l * DM * NEXP;
        float v = 0.f; if (n < 4) v = wg[k * 4 + n]; else if (n < 36) v = we[k * NEXP + (n - 4)];
        v *= a->ffn_g[l * DM + k];
        const unsigned hb = cvtpk(v, 0.f) & 0xffffu; const float hf = __uint_as_float(hb << 16);
        const unsigned lb = cvtpk(v - hf, 0.f) & 0xffffu;
        ((bf16*)(ws + WS_WR + l * WR_LSTRIDE))[id] = (bf16)hb; ((bf16*)(ws + WS_WR + l * WR_LSTRIDE + WR_LO))[id] = (bf16)lb;
    }
    {
        float* rt = (float*)(ws + WS_ROPE);
        for (int idx = F.bx * NTHREADS + tid; idx < SEQ * 32; idx += F.G * NTHREADS) {
            const int pos = idx >> 5, i = idx & 31;
            const float inv = 1.0f / powf(10000.0f, (float)(2 * i) / 64.0f);
            const float ang = (float)pos * inv;
            const double ad = (double)ang, kd = __builtin_rint(ad * 0.15915494309189535);
            const float rf = (float)__builtin_fma(-kd, 6.283185307179586, ad);
            rt[idx * 2] = cosf(rf); rt[idx * 2 + 1] = sinf(rf);
        }
        bf16* xb = (bf16*)(ws + WS_XB); float* rs1 = (float*)(ws + WS_RS1);
        for (int m = F.gw; m < MTOK; m += F.ngw) {
            const f32x4* xr = (const f32x4*)(a->x + (size_t)m * DM) + lane;
            f32x4 v[4]; float s = 0.f;
#pragma unroll
            for (int j = 0; j < 4; ++j) { v[j] = xr[64 * j]; s += (v[j][0] * v[j][0] + v[j][1] * v[j][1]) + (v[j][2] * v[j][2] + v[j][3] * v[j][3]); }
            s = wave_sum(s, lane);
            u32x2* o = (u32x2*)(xb + (size_t)m * DM) + lane;
#pragma unroll
            for (int j = 0; j < 4; ++j) { u32x2 w; w.x = cvtpk(v[j][0], v[j][1]); w.y = cvtpk(v[j][2], v[j][3]); o[64 * j] = w; }
            if (lane == 0) rs1[m] = 1.0f / sqrtf(s * (1.0f / DM) + NORM_EPS);
        }
    }
}
__device__ __forceinline__ void prep_experts(const Frame& F, CArgs a, int l, int lane, int part, int w, int nw) {
    unsigned char* ws = a->ws;
    LAS float* scr = (LAS float*)(F.lds + F.wave * PREP_SCR);
    constexpr int I_G = 16 * 4, I_D = 4 * 16;
    const float* fg = a->ffn_g + l * DM;
    if (part == 0) {
        for (int it = w; it < NEXP * 2 * I_G; it += nw) {
            const int e = it / (2 * I_G); int r = it - e * (2 * I_G); const int t = r / I_G; r -= t * I_G;
            const size_t eo = ((size_t)l * NEXP + e) * DM * DEXP; const float* W = (t ? a->w_eu : a->w_eg) + eo;
            transpose_item64(W, DEXP, 64 * (r / 4), 64 * (r % 4), fg, (bf16*)(ws + WS_WGU) + (size_t)e * 512 * DM, DM, MapGU{t}, scr, lane);
        }
    } else {
        for (int it = w; it < NEXP * I_D; it += nw) {
            const int e = it / I_D, r = it - e * I_D;
            const size_t eo = ((size_t)l * NEXP + e) * DM * DEXP;
            transpose_item64(a->w_ed + eo, DM, 64 * (r / 16), 64 * (r % 16), nullptr, (bf16*)(ws + WS_WD) + (size_t)e * DM * DEXP, DEXP, MapPlain{}, scr, lane);
        }
    }
}

__device__ __forceinline__ int crow(int r, int hi) { return (r & 3) + 8 * (r >> 2) + 4 * hi; }
struct AttnUnit { int kcol, vcol, b, d, r, t0, span, W, qcol, tq; float m0, l0; bf16* outp; int opitch; float* lsep; bool valid; };
__device__ __forceinline__ AttnUnit attn_decode(int idx, int G, int bx, int wave, int l, CArgs a, bf16* ya, bf16* ob, float* lse) {
    AttnUnit U; U.valid = false;
    const int nA = (BATCH * 2 * 64 - bx + G - 1) / G;
    if (idx < nA) {
        const int u = bx + idx * G; const int qb = u & 63, kvh = (u >> 6) & 1, b = u >> 7; const int g = wave >> 1, hq = kvh * 4 + g;
        U.kcol = 512 + kvh * 64; U.vcol = 640 + kvh * 64; U.b = b; U.d = 1; U.r = 0; U.t0 = 2 * qb; U.span = 2; U.W = 4; U.qcol = hq * 64; U.tq = 2 * qb + (wave & 1);
        U.m0 = a->a_sink[l * 8 + hq] * LOG2E; U.l0 = 1.0f; U.outp = ya + hq * 64; U.opitch = 768; U.lsep = nullptr; U.valid = true; return U;
    }
    const int u = bx + (idx - nA) * G;
    if (u < 3 * 256) {
        const int grp = u >> 8; int q = u & 255;
        const int d = grp == 0 ? 1 : (grp == 1 ? 4 : 16), bpr = 16 / d;
        const int blk = q % bpr; q /= bpr; const int res = q % d; q /= d; const int h = q & 3, b = q >> 2;
        const int base = 768 + 768 * grp;
        U.kcol = base + 256 + h * 64; U.vcol = base + 512 + h * 64; U.b = b; U.d = d; U.r = res; U.t0 = 8 * blk; U.span = 8; U.W = 2; U.qcol = base + h * 64; U.tq = 8 * blk + wave;
        U.m0 = -1e30f; U.l0 = 0.0f; U.outp = ob + grp * 256 + h * 64; U.opitch = 768; U.lsep = lse + grp * 4 + h; U.valid = true;
    }
    return U;
}
__device__ __forceinline__ void attn_fetch(const bf16* P, const AttnUnit& U, int tid, u32x4 (&buf)[12]) {
    const int L32 = (SEQ / U.d) >> 5, jbase = U.t0 - U.W, ntile = U.span + 2 * U.W, nch = ntile * 512;
    const size_t tok0 = (size_t)U.b * SEQ + U.r;
#pragma unroll
    for (int i = 0; i < 12; ++i) {
        const int c = tid + 512 * i;
        if (c < nch) {
            const int kv = c >= ntile * 256, cc = kv ? c - ntile * 256 : c, row = cc >> 3, ch = cc & 7, tile = row >> 5, rr = row & 31, j = jbase + tile;
            if (j >= 0 && j < L32) buf[i] = *(const u32x4*)(P + (tok0 + (size_t)(32 * j + rr) * U.d) * NQKV + (kv ? U.vcol : U.kcol) + ch * 8);
        }
    }
}
__device__ __forceinline__ void attn_stage(const AttnUnit& U, int tid, const u32x4 (&buf)[12], LAS unsigned char* lds) {
    const int L32 = (SEQ / U.d) >> 5, jbase = U.t0 - U.W, ntile = U.span + 2 * U.W, nch = ntile * 512;
    LAS unsigned char* kimg = lds; LAS unsigned char* vimg = lds + ntile * 4096;
#pragma unroll
    for (int i = 0; i < 12; ++i) {
        const int c = tid + 512 * i;
        if (c < nch) {
            const int kv = c >= ntile * 256, cc = kv ? c - ntile * 256 : c, row = cc >> 3, ch = cc & 7, tile = row >> 5, rr = row & 31, j = jbase + tile;
            if (j >= 0 && j < L32) *(LAS u32x4*)((kv ? vimg : kimg) + tile * 4096 + rr * 128 + (kv ? ch : (ch ^ (rr & 7))) * 16) = buf[i];
        }
    }
}
template <int NT> __device__ __forceinline__ void attn_step(int j, int jbase, int tq, int W, const LAS unsigned char* kimg, const LAS unsigned char* vimg, int krd, int vrd, int r32, int hi,
                                                          const bf16x8 (&qf)[4], f32x16& o0, f32x16& o1, float& mrun, float& lrun) {
#define VTR(p, off) __builtin_bit_cast(s16x4, __builtin_amdgcn_ds_read_tr16_b64_v4i16((LAS s16x4*)((p) + (off))))
    bf16x8 kf[NT][4]; s16x4 va[NT][4], vb[NT][4];
#pragma unroll
    for (int t = 0; t < NT; ++t) {
        const LAS unsigned char* kl = kimg + (j + t - jbase) * 4096 + krd;
#pragma unroll
        for (int s = 0; s < 4; ++s) kf[t][s] = *(const LAS bf16x8*)(kl + (((2 * s + hi) ^ (r32 & 7)) * 16));
    }
#pragma unroll
    for (int t = 0; t < NT; ++t) {
        const LAS unsigned char* vl = vimg + (j + t - jbase) * 4096 + vrd;
#pragma unroll
        for (int q = 0; q < 4; ++q) { va[t][q] = VTR(vl, (16 * (q & 1)) * 128 + (q >> 1) * 64); vb[t][q] = VTR(vl, (16 * (q & 1) + 8) * 128 + (q >> 1) * 64); }
    }
    __builtin_amdgcn_sched_barrier(0);
    f32x16 sc[NT];
#pragma unroll
    for (int t = 0; t < NT; ++t) sc[t] = f32x16{};
#pragma unroll
    for (int s = 0; s < 4; ++s)
#pragma unroll
        for (int t = 0; t < NT; ++t) sc[t] = __builtin_amdgcn_mfma_f32_32x32x16_bf16(kf[t][s], qf[s], sc[t], 0, 0, 0);
#pragma unroll
    for (int t = 0; t < NT; ++t) {
        if (j + t == tq - W) {
#pragma unroll
            for (int g = 0; g < 16; ++g) if (crow(g, hi) < r32) sc[t][g] = -INFINITY;
        }
        if (j + t == tq + W) {
#pragma unroll
            for (int g = 0; g < 16; ++g) if (crow(g, hi) > r32) sc[t][g] = -INFINITY;
        }
    }
    float mx = -INFINITY;
#pragma unroll
    for (int t = 0; t < NT; ++t)
#pragma unroll
        for (int g = 0; g < 16; g += 4) mx = fmaxf(mx, fmaxf(fmaxf(sc[t][g], sc[t][g + 1]), fmaxf(sc[t][g + 2], sc[t][g + 3])));
    { const auto rr = __builtin_amdgcn_permlane32_swap(__float_as_uint(mx), __float_as_uint(mx), false, false); mx = fmaxf(__uint_as_float(rr[0]), __uint_as_float(rr[1])); }
    if (__any(mx > mrun + 8.0f)) {
        const float mnew = fmaxf(mrun, mx);
        const float alpha = fast_exp2(mrun - mnew);
        lrun *= alpha; mrun = mnew;
#pragma unroll
        for (int g = 0; g < 16; ++g) { o0[g] *= alpha; o1[g] *= alpha; }
    }
    float ps[4] = {0.f, 0.f, 0.f, 0.f};
#pragma unroll
    for (int t = 0; t < NT; ++t)
#pragma unroll
        for (int g = 0; g < 16; ++g) { sc[t][g] = fast_exp2(sc[t][g] - mrun); ps[g & 3] += sc[t][g]; }
    float psum = (ps[0] + ps[1]) + (ps[2] + ps[3]);
    { const auto rr = __builtin_amdgcn_permlane32_swap(__float_as_uint(psum), __float_as_uint(psum), false, false); psum = __uint_as_float(rr[0]) + __uint_as_float(rr[1]); }
    lrun += psum;
#define VFR(t, q) ((bf16x8){va[t][q][0], va[t][q][1], va[t][q][2], va[t][q][3], vb[t][q][0], vb[t][q][1], vb[t][q][2], vb[t][q][3]})
#pragma unroll
    for (int t = 0; t < NT; ++t) {
        u32x4 p0, p1;
        p0.x = cvtpk(sc[t][0], sc[t][1]); p0.y = cvtpk(sc[t][2], sc[t][3]); p0.z = cvtpk(sc[t][4], sc[t][5]); p0.w = cvtpk(sc[t][6], sc[t][7]);
        p1.x = cvtpk(sc[t][8], sc[t][9]); p1.y = cvtpk(sc[t][10], sc[t][11]); p1.z = cvtpk(sc[t][12], sc[t][13]); p1.w = cvtpk(sc[t][14], sc[t][15]);
        const bf16x8 pf0 = __builtin_bit_cast(bf16x8, p0), pf1 = __builtin_bit_cast(bf16x8, p1);
        o0 = __builtin_amdgcn_mfma_f32_32x32x16_bf16(VFR(t, 0), pf0, o0, 0, 0, 0);
        o1 = __builtin_amdgcn_mfma_f32_32x32x16_bf16(VFR(t, 2), pf0, o1, 0, 0, 0);
        o0 = __builtin_amdgcn_mfma_f32_32x32x16_bf16(VFR(t, 1), pf1, o0, 0, 0, 0);
        o1 = __builtin_amdgcn_mfma_f32_32x32x16_bf16(VFR(t, 3), pf1, o1, 0, 0, 0);
    }
#undef VFR
#undef VTR
}
__device__ __forceinline__ void attn_compute(const bf16* P, const AttnUnit& U, const bf16x8 (&qf)[4], LAS unsigned char* lds, LAS unsigned char* stg, int lane) {
    const int r32 = lane & 31, hi = lane >> 5;
    const int d = U.d, W = U.W, tq = U.tq;
    const int L32 = (SEQ / d) >> 5;
    const size_t tok0 = (size_t)U.b * SEQ + U.r;
    const int jbase = U.t0 - W, ntile = U.span + 2 * W;
    LAS unsigned char* kimg = lds; LAS unsigned char* vimg = lds + ntile * 4096;
    const size_t qtok = tok0 + (size_t)(32 * tq + r32) * d;
    f32x16 o0 = {}, o1 = {};
    float mrun = U.m0, lrun = U.l0;
    const int jlo = (tq - W) < 0 ? 0 : (tq - W), jhi = (tq + W) > (L32 - 1) ? (L32 - 1) : (tq + W);
    const int vrd = (4 * hi + ((lane & 15) >> 2)) * 128 + (16 * ((lane >> 4) & 1) + 4 * (lane & 3)) * 2;
    const int krd = r32 * 128;
    int j = jlo;
    for (; j + 1 <= jhi; j += 2) attn_step<2>(j, jbase, tq, W, kimg, vimg, krd, vrd, r32, hi, qf, o0, o1, mrun, lrun);
    if (j <= jhi) attn_step<1>(j, jbase, tq, W, kimg, vimg, krd, vrd, r32, hi, qf, o0, o1, mrun, lrun);
    const float inv = 1.0f / lrun;
#pragma unroll
    for (int g4 = 0; g4 < 4; ++g4) {
        u32x2 w0, w1;
        w0.x = cvtpk(o0[4 * g4] * inv, o0[4 * g4 + 1] * inv); w0.y = cvtpk(o0[4 * g4 + 2] * inv, o0[4 * g4 + 3] * inv);
        w1.x = cvtpk(o1[4 * g4] * inv, o1[4 * g4 + 1] * inv); w1.y = cvtpk(o1[4 * g4 + 2] * inv, o1[4 * g4 + 3] * inv);
        *(LAS u32x2*)(stg + r32 * 144 + (8 * g4 + 4 * hi) * 2) = w0;
        *(LAS u32x2*)(stg + r32 * 144 + 64 + (8 * g4 + 4 * hi) * 2) = w1;
    }
#pragma unroll
    for (int i = 0; i < 4; ++i) {
        const int row = i * 8 + (lane >> 3), ch = lane & 7;
        const u32x4 v = *(const LAS u32x4*)(stg + row * 144 + ch * 16);
        *(u32x4*)(U.outp + (tok0 + (size_t)(32 * tq + row) * d) * U.opitch + ch * 8) = v;
    }
    if (U.lsep && hi == 0) U.lsep[qtok * 12] = (mrun + log2f(lrun)) * LN2;
}
__device__ __forceinline__ void attn_phase(const Frame& F, CArgs a, int l) {
    const int lane = otid(), tid = F.wave * 64 + lane; (void)tid; (void)lane;
    unsigned char* ws = a->ws;
    const bf16* P = (const bf16*)(ws + WS_PQ);
    bf16* ya = (bf16*)(ws + WS_YAB) + 256; bf16* ob = (bf16*)a->out; float* lse = (float*)(ws + WS_LSE);
    const int r32 = lane & 31, hi = lane >> 5;
    u32x4 buf[12];
    LAS unsigned char* stg = F.lds + 98304 + F.wave * 4608;
    AttnUnit U = attn_decode(0, F.G, F.bx, F.wave, l, a, ya, ob, lse);
    if (U.valid) attn_fetch(P, U, tid, buf);
    for (int idx = 0; U.valid; ++idx) {
        attn_stage(U, tid, buf, F.lds);
        u32x4 qv[4];
#pragma unroll
        for (int i = 0; i < 4; ++i) { const int row = i * 8 + (lane >> 3), ch = lane & 7;
            qv[i] = *(const u32x4*)(P + ((size_t)U.b * SEQ + U.r + (size_t)(32 * U.tq + row) * U.d) * NQKV + U.qcol + ch * 8); }
        const AttnUnit Un = attn_decode(idx + 1, F.G, F.bx, F.wave, l, a, ya, ob, lse);
#pragma unroll
        for (int i = 0; i < 4; ++i) { const int row = i * 8 + (lane >> 3), ch = lane & 7; *(LAS u32x4*)(stg + row * 144 + ch * 16) = qv[i]; }
        bf16x8 qf[4];
#pragma unroll
        for (int s = 0; s < 4; ++s) qf[s] = *(const LAS bf16x8*)(stg + r32 * 144 + (2 * s + hi) * 16);
        __syncthreads();
        if (Un.valid) attn_fetch(P, Un, tid, buf);
        attn_compute(P, U, qf, F.lds, stg, lane);
        __syncthreads();
        U = Un;
    }
    prep_experts(F, a, l, lane, 0, F.gw, F.ngw);
    prep_experts(F, a, l, lane, 1, F.gw, F.ngw);
}
__device__ __forceinline__ void comb_rows(const Frame& F, CArgs a, int row0, int tid) {
    unsigned char* ws = a->ws;
    const bf16* ob = (const bf16*)a->out; const float* lse = (const float*)(ws + WS_LSE); bf16* yb = (bf16*)(ws + WS_YAB);
#pragma unroll 4
    for (int it = 0; it < 16; ++it) {
        const int idx = tid + it * NTHREADS;
        const int tok = row0 + (idx >> 5), c = idx & 31, h = c >> 3;
        const float l0 = lse[tok * 12 + h], l1 = lse[tok * 12 + 4 + h], l2 = lse[tok * 12 + 8 + h];
        const u32x4 a0 = *(const u32x4*)(ob + (size_t)tok * 768 + c * 8), a1 = *(const u32x4*)(ob + (size_t)tok * 768 + 256 + c * 8), a2 = *(const u32x4*)(ob + (size_t)tok * 768 + 512 + c * 8);
        const float mx = fmaxf(l0, fmaxf(l1, l2));
        float w0 = __expf(l0 - mx), w1 = __expf(l1 - mx), w2 = __expf(l2 - mx);
        const float inv = 1.0f / (w0 + w1 + w2); w0 *= inv; w1 *= inv; w2 *= inv;
        u32x4 o;
#define CMB(f) o.f = cvtpk(w0 * bflo(a0.f) + w1 * bflo(a1.f) + w2 * bflo(a2.f), w0 * bfhi(a0.f) + w1 * bfhi(a1.f) + w2 * bfhi(a2.f))
        CMB(x); CMB(y); CMB(z); CMB(w);
#undef CMB
        *(u32x4*)(yb + (size_t)tok * 768 + c * 8) = o;
    }
}

__device__ __forceinline__ void route_phase(const Frame& F, CArgs a, int l) {
    const int lane = otid(), tid = F.wave * 64 + lane;
    unsigned char* ws = a->ws;
    const bf16* xbf = (const bf16*)(ws + WS_XB); const u32x4* wrh = (const u32x4*)(ws + WS_WR + l * WR_LSTRIDE); const u32x4* wrl = (const u32x4*)(ws + WS_WR + l * WR_LSTRIDE + WR_LO);
    float* rs2 = (float*)(ws + WS_RS2); i32x4* tokinfo = (i32x4*)(ws + WS_TOKINFO); int* ltok = (int*)(ws + WS_LTOK); float* lw = (float*)(ws + WS_LW);
    int* cnt = (int*)(ws + WS_CTL) + CW_CNT + l * 32 * CNT_STRIDE;
    const float* brg = a->b_rg + l * 4; const float* bre = a->b_re + l * NEXP;
    LAS f32x4* part = (LAS f32x4*)(F.lds);
    LAS float* ssp = (LAS float*)(F.lds + 12288);
    LAS float* Lg = (LAS float*)(F.lds + 16384);
    LAS float* rsL = (LAS float*)(F.lds + 16384 + 12288);
    LAS int* lcnt = (LAS int*)(F.lds + 16384 + 12288 + 256);
    LAS int* lbase = lcnt + 32;
    const int rt = F.wave & 3, kh = F.wave >> 2;
    if (tid < 32) lcnt[tid] = 0;
    __syncthreads();
    for (int blk = F.bx; blk < MTOK / 64; blk += F.G) {
        const int row0 = blk * 64 + rt * 16;
        const u32x4* xr = (const u32x4*)(xbf + (size_t)(row0 + (lane & 15)) * DM + kh * 512) + (lane >> 4);
        const u32x4* wh = wrh + (size_t)(kh * 16) * 3 * 64 + lane; const u32x4* wl = wrl + (size_t)(kh * 16) * 3 * 64 + lane;
        f32x4 acc0 = {0.f, 0.f, 0.f, 0.f}, acc1 = acc0, acc2 = acc0; float ss = 0.f;
#pragma unroll 4
        for (int i = 0; i < 16; ++i) {
            const u32x4 xw = xr[4 * i];
            const u32x4 h0 = wh[(i * 3 + 0) * 64], h1 = wh[(i * 3 + 1) * 64], h2 = wh[(i * 3 + 2) * 64], l0 = wl[(i * 3 + 0) * 64], l1 = wl[(i * 3 + 1) * 64], l2 = wl[(i * 3 + 2) * 64];
            const float xv[8] = {bflo(xw.x), bfhi(xw.x), bflo(xw.y), bfhi(xw.y), bflo(xw.z), bfhi(xw.z), bflo(xw.w), bfhi(xw.w)};
#pragma unroll
            for (int j = 0; j < 8; ++j) ss += xv[j] * xv[j];
            const bf16x8 xf = __builtin_bit_cast(bf16x8, xw);
            acc0 = __builtin_amdgcn_mfma_f32_16x16x32_bf16(xf, __builtin_bit_cast(bf16x8, l0), acc0, 0, 0, 0);
            acc1 = __builtin_amdgcn_mfma_f32_16x16x32_bf16(xf, __builtin_bit_cast(bf16x8, l1), acc1, 0, 0, 0);
            acc2 = __builtin_amdgcn_mfma_f32_16x16x32_bf16(xf, __builtin_bit_cast(bf16x8, l2), acc2, 0, 0, 0);
            acc0 = __builtin_amdgcn_mfma_f32_16x16x32_bf16(xf, __builtin_bit_cast(bf16x8, h0), acc0, 0, 0, 0);
            acc1 = __builtin_amdgcn_mfma_f32_16x16x32_bf16(xf, __builtin_bit_cast(bf16x8, h1), acc1, 0, 0, 0);
            acc2 = __builtin_amdgcn_mfma_f32_16x16x32_bf16(xf, __builtin_bit_cast(bf16x8, h2), acc2, 0, 0, 0);
        }
        ss += shx(ss, 16, lane); ss += shx(ss, 32, lane);
        if (kh == 1) { part[(rt * 3 + 0) * 64 + lane] = acc0; part[(rt * 3 + 1) * 64 + lane] = acc1; part[(rt * 3 + 2) * 64 + lane] = acc2; if (lane < 16) ssp[rt * 16 + lane] = ss; }
        __syncthreads();
        if (kh == 0) {
            acc0 += part[(rt * 3 + 0) * 64 + lane]; acc1 += part[(rt * 3 + 1) * 64 + lane]; acc2 += part[(rt * 3 + 2) * 64 + lane];
            ss += ssp[rt * 16 + (lane & 15)];
#pragma unroll
            for (int g = 0; g < 4; ++g) { const int rw = rt * 16 + 4 * (lane >> 4) + g; Lg[rw * 48 + (lane & 15)] = acc0[g]; Lg[rw * 48 + 16 + (lane & 15)] = acc1[g]; Lg[rw * 48 + 32 + (lane & 15)] = acc2[g]; }
            if (lane < 16) rsL[rt * 16 + lane] = 1.0f / sqrtf(ss * (1.0f / DM) + NORM_EPS);
        }
        __syncthreads();
        int e1 = 0, e2 = 0, r1 = 0, r2 = 0; float w1 = 0.f, w2 = 0.f, rsv = 0.f;
        if (tid < 64) {
            const LAS float* Lr = Lg + tid * 48; rsv = rsL[tid];
            float gl[4];
#pragma unroll
            for (int g = 0; g < 4; ++g) gl[g] = Lr[g] * rsv + brg[g];
            int gi = 0; float gm = gl[0];
#pragma unroll
            for (int g = 1; g < 4; ++g) if (gl[g] > gm) { gm = gl[g]; gi = g; }
            float den = 0.f;
#pragma unroll
            for (int g = 0; g < 4; ++g) den += expf(gl[g] - gm);
            const float gw = 1.0f / den;
            float v1 = -INFINITY, v2 = -INFINITY; int i1 = 0, i2 = 0;
#pragma unroll
            for (int e = 0; e < 8; ++e) {
                const float v = Lr[4 + 8 * gi + e] * rsv + bre[8 * gi + e];
                if (v > v1) { v2 = v1; i2 = i1; v1 = v; i1 = e; } else if (v > v2) { v2 = v; i2 = e; }
            }
            const float p1 = 1.0f / (1.0f + expf(v2 - v1));
            e1 = 8 * gi + i1; e2 = 8 * gi + i2; w1 = p1 * gw; w2 = (1.0f - p1) * gw;
            r1 = __hip_atomic_fetch_add(&lcnt[e1], 1, __ATOMIC_RELAXED, __HIP_MEMORY_SCOPE_WORKGROUP); r2 = __hip_atomic_fetch_add(&lcnt[e2], 1, __ATOMIC_RELAXED, __HIP_MEMORY_SCOPE_WORKGROUP);
        }
        __syncthreads();
        if (tid < 32) { const int c = lcnt[tid]; lbase[tid] = c ? atomicAdd(&cnt[tid * CNT_STRIDE], c) : 0; lcnt[tid] = 0; }
        __syncthreads();
        if (tid < 64) {
            const int tok = blk * 64 + tid;
            const int pos1 = lbase[e1] + r1, pos2 = lbase[e2] + r2;
            ltok[e1 * MTOK + pos1] = tok; lw[e1 * MTOK + pos1] = w1;
            ltok[e2 * MTOK + pos2] = tok; lw[e2 * MTOK + pos2] = w2;
            tokinfo[tok] = (i32x4){e1, pos1, e2, pos2};
            rs2[tok] = rsv;
        }
        __syncthreads();
    }
}
__device__ __forceinline__ MoeTab moe_tables(const Frame& F, CArgs a, int l) {
    const int lane = otid(), tid = F.wave * 64 + lane; (void)tid; (void)lane;
    volatile LAS int* cntL = F.misc + 64; volatile LAS int* mtp = F.misc + 128; volatile LAS int* sp = F.misc + 192;
    const int* cnt = (const int*)(a->ws + WS_CTL) + CW_CNT + l * 32 * CNT_STRIDE;
    __syncthreads();
    if (tid < 32) cntL[tid] = __hip_atomic_load(cnt + tid * CNT_STRIDE, __ATOMIC_RELAXED, __HIP_MEMORY_SCOPE_AGENT);
    __syncthreads();
    if (tid == 0) { int mt = 0, s = 0; for (int e = 0; e < 32; ++e) { mtp[e] = mt; sp[e] = s; const int c = cntL[e]; mt += (c + 255) >> 8; s += c; } mtp[32] = mt; sp[32] = s; }
    __syncthreads();
    MoeTab T; T.cnt = cntL; T.mtpref = mtp; T.spref = sp; return T;
}
__device__ __forceinline__ void fin_phase(const Frame& F, CArgs a, int l, const MoeTab& T) {
    const int lane = otid(), tid = F.wave * 64 + lane; (void)tid;
    unsigned char* ws = a->ws;
    const i32x4* tokinfo = (const i32x4*)(ws + WS_TOKINFO); const bf16* Y = (const bf16*)(ws + WS_Y);
    bf16* xb = (bf16*)(ws + WS_XB); float* rs1 = (float*)(ws + WS_RS1);
    const int step = 2 * F.ngw;
    int m0 = 2 * F.gw;
    i32x4 tn0 = tokinfo[m0 < MTOK ? m0 : 0], tn1 = tokinfo[m0 + 1 < MTOK ? m0 + 1 : 0];
    for (; m0 < MTOK; m0 += step) {
        const i32x4 ti[2] = {tn0, tn1};
        const int mn = m0 + step;
        if (mn < MTOK) { tn0 = tokinfo[mn]; tn1 = tokinfo[mn + 1]; }
        u32x4 xv[2][2], p[2][2], q[2][2];
#pragma unroll
        for (int r = 0; r < 2; ++r) {
            const int m = m0 + r;
            const int s1 = T.spref[ti[r][0]] + ti[r][1], s2 = T.spref[ti[r][2]] + ti[r][3];
            const u32x4* xr = (const u32x4*)(xb + (size_t)m * DM) + lane;
            const u32x4* y1 = (const u32x4*)(Y + (size_t)s1 * DM) + lane; const u32x4* y2 = (const u32x4*)(Y + (size_t)s2 * DM) + lane;
#pragma unroll
            for (int j = 0; j < 2; ++j) { xv[r][j] = xr[64 * j]; p[r][j] = y1[64 * j]; q[r][j] = y2[64 * j]; }
        }
#pragma unroll
        for (int r = 0; r < 2; ++r) {
            const int m = m0 + r;
            float v[2][8]; float s = 0.f;
#pragma unroll
            for (int j = 0; j < 2; ++j) {
#define FINC(c, f) v[j][2 * c] = bflo(xv[r][j].f) + bflo(p[r][j].f) + bflo(q[r][j].f); v[j][2 * c + 1] = bfhi(xv[r][j].f) + bfhi(p[r][j].f) + bfhi(q[r][j].f);
                FINC(0, x) FINC(1, y) FINC(2, z) FINC(3, w)
#undef FINC
#pragma unroll
                for (int c = 0; c < 8; ++c) s += v[j][c] * v[j][c];
            }
            s = wave_sum(s, lane);
            const float rsv = 1.0f / sqrtf(s * (1.0f / DM) + NORM_EPS);
            if (l == DEPTH - 1) {
#pragma unroll
                for (int j = 0; j < 2; ++j) {
                    const f32x4* g = (const f32x4*)(a->fin_g + 512 * j + 8 * lane); f32x4* o = (f32x4*)(a->out + (size_t)m * DM + 512 * j + 8 * lane);
                    const f32x4 g0 = g[0], g1 = g[1];
                    o[0] = (f32x4){v[j][0] * rsv * g0[0], v[j][1] * rsv * g0[1], v[j][2] * rsv * g0[2], v[j][3] * rsv * g0[3]};
                    o[1] = (f32x4){v[j][4] * rsv * g1[0], v[j][5] * rsv * g1[1], v[j][6] * rsv * g1[2], v[j][7] * rsv * g1[3]};
                }
            } else {
                u32x4* o = (u32x4*)(xb + (size_t)m * DM) + lane;
#pragma unroll
                for (int j = 0; j < 2; ++j) { u32x4 w; w.x = cvtpk(v[j][0], v[j][1]); w.y = cvtpk(v[j][2], v[j][3]); w.z = cvtpk(v[j][4], v[j][5]); w.w = cvtpk(v[j][6], v[j][7]); o[64 * j] = w; }
                if (lane == 0) rs1[m] = rsv;
            }
        }
    }
}

constexpr int PH_PREP = 0, PH_GEMM1 = 1, PH_ATTN = 2, PH_MERGE = 3, PH_OUT = 4, PH_ROUTE = 5, PH_MOE = 6, PH_FIN = 7, PH_PER_LAYER = 8, NPHASE = PH_PER_LAYER * DEPTH - 1;

__global__ void __launch_bounds__(NTHREADS, 2) fwd_kernel(Args a_by_value) {
    extern __shared__ __attribute__((aligned(16))) unsigned char lds_raw[];
    Frame F;
    F.lds = (LAS unsigned char*)lds_raw; F.misc = (volatile LAS int*)(F.lds + MISC_OFF);
    F.wave = __builtin_amdgcn_readfirstlane((int)threadIdx.x >> 6);
    F.G = gridDim.x; { const int bx = blockIdx.x; F.vcu = (F.G % 8 == 0) ? (bx % 8) * (F.G / 8) + bx / 8 : bx; }
    F.gw = blockIdx.x * NWAVES + F.wave; F.ngw = F.G * NWAVES;
    CArgs a = (CArgs)__builtin_amdgcn_kernarg_segment_ptr();
    unsigned char* ws = a->ws;
    const int ph_lo = a->ph_lo, ph_hi = a->ph_hi;
    for (int u = threadIdx.x; u < 1024; u += NTHREADS) F.misc[u] = 0;
    __syncthreads();
#if !MK_MULTI
    XcdBarrier bar = xcd_barrier_post((unsigned*)(ws + WS_CTL) + CW_BAR, (volatile LAS unsigned*)(F.misc + 8));
#define GRID_BAR() xcd_barrier(bar, F.wave)
#else
#define GRID_BAR() do { } while (0)
#endif
    for (int ph = ph_lo, rep = 0; ph < ph_hi; ) {
        const int l = ph >= PH_PER_LAYER ? 1 : 0, k = ph >= PH_PER_LAYER ? ph - (PH_PER_LAYER - 1) : ph;
        const size_t wlo = (size_t)l * WNE_LSTRIDE;
        {
            int bx = blockIdx.x; asm volatile("" : "+s"(bx)); asm volatile("" : "+s"(a)); ws = a->ws;
            int wv = F.wave; asm volatile("" : "+s"(wv)); F.gw = bx * NWAVES + wv; F.bx = bx;
        }
        if (k == PH_PREP && (PHMASK & 1)) {
            prep_phase(F, a);
        } else if (k == PH_GEMM1 && (PHMASK & 2)) {
            DenseSched S; S.A = (const char*)(ws + WS_XB); S.Bt = (const char*)(ws + wlo + WS_WIN); S.K = DM; S.lda = DM; S.ldb = DM; S.ksplit = 0; S.wave = F.wave; S.so.init(MTOK, DIN, F.G, F.bx);
            EpiProj E{(bf16*)(ws + WS_PQ), (bf16*)(ws + WS_PG), (const float*)(ws + WS_RS1), (const f32x4*)(ws + WS_ROPE)};
            pg8::gemm_phase(F.lds, S, E);
        } else if (k == PH_ATTN && (PHMASK & 4)) {
            attn_phase(F, a, l);
        } else if (k == PH_MERGE && (PHMASK & 16)) {
            { pg8::StaticOrder so; so.init(MTOK, DM, F.G, F.bx); const int tid_ = F.wave * 64 + otid();
              for (int i = 0, pm, pn; so.next(i, pm, pn); ++i) comb_rows(F, a, pm * 256, tid_);
              VM_WAIT(); __syncthreads(); }
            DenseSched S; S.A = (const char*)(ws + WS_YAB); S.Bt = (const char*)(ws + wlo + WS_WAB); S.K = 768; S.lda = 768; S.ldb = 768; S.ksplit = 256; S.wave = F.wave; S.so.init(MTOK, DM, F.G, F.bx);
            EpiMerge E{(const unsigned char*)(ws + WS_PG), (bf16*)(ws + WS_MRG)};
            pg8::gemm_phase(F.lds, S, E);
        } else if (k == PH_OUT && (PHMASK & 32)) {
            DenseSched S; S.A = (const char*)(ws + WS_MRG); S.Bt = (const char*)(ws + wlo + WS_WOUT); S.K = DM; S.lda = DM; S.ldb = DM; S.ksplit = 0; S.wave = F.wave; S.so.init(MTOK, DM, F.G, F.bx);
            EpiResid E{(bf16*)(ws + WS_XB)};
            pg8::gemm_phase(F.lds, S, E);
        } else if (k == PH_ROUTE && (PHMASK & 64)) {
            route_phase(F, a, l);
        } else if (k == PH_MOE) {
            const MoeTab T = moe_tables(F, a, l);
            const int mtT = T.mtpref[32], nU = 2 * mtT, nU1 = nU < F.G ? nU : F.G, nU2 = nU - nU1, tready = nU1 >> 1;
            const int bx = F.vcu;
            unsigned* upd = (unsigned*)(ws + WS_CTL) + CW_UPD + l * 256 * UPD_STRIDE; unsigned* err = (unsigned*)(ws + WS_CTL) + CW_ERR;
            MoeSched<true> SU; SU.A = (const char*)(ws + WS_XB); SU.Bt = (const char*)(ws + WS_WGU); SU.K = DM; SU.lda = DM; SU.ldb = DM; SU.wave = F.wave; SU.ntn = 2; SU.bstride_e = (size_t)512 * DM * 2; SU.ltok = (const int*)(ws + WS_LTOK); SU.T = T; SU.upd = upd; SU.err = err;
            MoeSched<false> SD; SD.A = (const char*)(ws + WS_H); SD.Bt = (const char*)(ws + WS_WD); SD.K = DEXP; SD.lda = DEXP; SD.ldb = DEXP; SD.wave = F.wave; SD.ntn = 4; SD.bstride_e = (size_t)DM * DEXP * 2; SD.ltok = nullptr; SD.T = T; SD.upd = upd; SD.err = err;
            EpiSwiglu EU{(const int*)(ws + WS_LTOK), (const float*)(ws + WS_LW), (const float*)(ws + WS_RS2), (bf16*)(ws + WS_H)};
            EpiY ED{(bf16*)(ws + WS_Y)};
            SU.G1 = F.G; SU.c1 = bx; SU.lo1 = 0; SU.hi1 = nU; SU.G2 = 1; SU.c2 = -1; SU.lo2 = 0; SU.hi2 = 0;
            pg8::gemm_phase(F.lds, SU, EU);
            SD.G1 = F.G - nU2; SD.c1 = bx - nU2; SD.lo1 = 0; SD.hi1 = 4 * tready; SD.G2 = F.G; SD.c2 = bx; SD.lo2 = 4 * tready; SD.hi2 = 4 * mtT;
            pg8::gemm_phase(F.lds, SD, ED);
        } else if (k == PH_FIN && (PHMASK & 512)) {
            const MoeTab T = moe_tables(F, a, l);
            fin_phase(F, a, l, T);
        }
#if REP_MASK
        if (l == 0 && ((REP_MASK >> k) & 1) && rep < REP_N) { ++rep; GRID_BAR(); continue; }
        rep = 0;
#endif
        if (ph + 1 < ph_hi) { GRID_BAR();
#ifdef EXTRA_BAR
            for (int eb = 0; eb < EXTRA_BAR; ++eb) GRID_BAR();
#endif
        }
        ++ph;
    }
}

extern "C" void kernel_launch(void* const* d_in, const int* in_sizes, int n_in, void* d_out, int out_size, void* d_ws, size_t ws_size, hipStream_t stream) {
    static int grid = 0;
    if (grid == 0) {
        if (n_in != 16 || out_size != MTOK * DM || ws_size < WS_END) { fprintf(stderr, "kernel_launch: unexpected shapes (n_in %d out %d ws %zu)\n", n_in, out_size, ws_size); grid = -1; return; }
        int dev = 0, cus = 0, per_cu = 0;
        if (hipGetDevice(&dev) != hipSuccess || hipDeviceGetAttribute(&cus, hipDeviceAttributeMultiprocessorCount, dev) != hipSuccess) { grid = -1; return; }
        if (hipFuncSetAttribute((const void*)fwd_kernel, hipFuncAttributeMaxDynamicSharedMemorySize, LDS_BYTES) != hipSuccess) { fprintf(stderr, "kernel_launch: hipFuncSetAttribute failed\n"); grid = -1; return; }
        if (hipOccupancyMaxActiveBlocksPerMultiprocessor(&per_cu, (const void*)fwd_kernel, NTHREADS, LDS_BYTES) != hipSuccess || per_cu < 1) { fprintf(stderr, "kernel_launch: occupancy query says %d\n", per_cu); (void)hipGetLastError(); }
        grid = cus;
    }
    if (grid < 0) return;
    (void)hipMemsetAsync((char*)d_ws + WS_CTL, 0, CTL_BYTES, stream);
    Args a{};
    a.x = (const float*)d_in[0]; a.attn_g = (const float*)d_in[1]; a.w_in = (const float*)d_in[2]; a.a_sink = (const float*)d_in[3]; a.w_a = (const float*)d_in[4]; a.w_b = (const float*)d_in[5];
    a.w_out = (const float*)d_in[6]; a.ffn_g = (const float*)d_in[7]; a.w_rg = (const float*)d_in[8]; a.b_rg = (const float*)d_in[9]; a.w_re = (const float*)d_in[10]; a.b_re = (const float*)d_in[11];
    a.w_eg = (const float*)d_in[12]; a.w_eu = (const float*)d_in[13]; a.w_ed = (const float*)d_in[14]; a.fin_g = (const float*)d_in[15];
    a.out = (float*)d_out; a.ws = (unsigned char*)d_ws;
#if MK_MULTI
    for (int ph = 0; ph < NPHASE; ++ph) { a.ph_lo = ph; a.ph_hi = ph + 1; hipLaunchKernelGGL(fwd_kernel, dim3(grid), dim3(NTHREADS), LDS_BYTES, stream, a); }
#else
    a.ph_lo = 0; a.ph_hi = NPHASE;
    void* kargs[] = {&a};
    const hipError_t le = hipLaunchCooperativeKernel((const void*)fwd_kernel, dim3(grid), dim3(NTHREADS), kargs, LDS_BYTES, stream);
    if (le != hipSuccess) fprintf(stderr, "kernel_launch: cooperative launch failed: %s (grid %d)\n", hipGetErrorString(le), grid);
#endif
}
```

```cpp
#include <hip/hip_runtime.h>
#include <hip/hip_cooperative_groups.h>
#include <cstdio>
#include <cstdint>
namespace cg = cooperative_groups;

#ifndef REP_MASK
#define REP_MASK 0
#define REP_N 2
#endif
#ifndef PHMASK
#define PHMASK 1023
#endif
#ifndef MK_MULTI
#define MK_MULTI 0
#endif

#define LAS __attribute__((address_space(3)))
#define GAS __attribute__((address_space(1)))
typedef unsigned short bf16;
typedef short bf16x8 __attribute__((ext_vector_type(8)));
typedef short s16x4 __attribute__((ext_vector_type(4)));
typedef float f32x2 __attribute__((ext_vector_type(2)));
typedef float f32x4 __attribute__((ext_vector_type(4)));
typedef float f32x16 __attribute__((ext_vector_type(16)));
typedef unsigned u32x2 __attribute__((ext_vector_type(2)));
typedef unsigned u32x4 __attribute__((ext_vector_type(4)));
typedef int i32x4 __attribute__((ext_vector_type(4)));
typedef __bf16 bf16x2_t __attribute__((ext_vector_type(2)));

constexpr int BATCH = 4, SEQ = 4096, DM = 1024, DEPTH = 2, MTOK = BATCH * SEQ;
constexpr int NQKV = 3072, NGATE = 2048, DIN = NQKV + NGATE;
constexpr int NEXP = 32, DEXP = 256;
constexpr float NORM_EPS = 1e-6f;
constexpr float LOG2E = 1.4426950408889634f, LN2 = 0.6931471805599453f;
constexpr float QSCALE = 0.125f * LOG2E;
constexpr int NWAVES = 8, NTHREADS = 512;

constexpr size_t MiB = 1u << 20;
constexpr size_t WS_CTL = 0, CTL_BYTES = 1 * MiB;
constexpr size_t WS_ROPE = 1 * MiB;
constexpr size_t WS_WR = 2 * MiB, WR_LSTRIDE = 512 * 1024, WR_LO = 256 * 1024;
constexpr size_t WS_RS1 = 3 * MiB, WS_RS2 = 3 * MiB + 65536;
constexpr size_t WS_TOKINFO = 5 * MiB;
constexpr size_t WS_LTOK = 6 * MiB, WS_LW = 8 * MiB;
constexpr size_t WS_LSE = 10 * MiB;
constexpr size_t WS_WIN = 12 * MiB, WS_WAB = 22 * MiB, WS_WOUT = 24 * MiB, WNE_LSTRIDE = 14 * MiB;
constexpr size_t WS_WGU = 40 * MiB, WS_WD = 72 * MiB;
constexpr size_t WS_XB = 88 * MiB;
constexpr size_t WS_YAB = 120 * MiB;
constexpr size_t WS_PQ = 144 * MiB;
constexpr size_t WS_MRG = 176 * MiB, WS_H = 208 * MiB;
constexpr size_t WS_PG = 240 * MiB;
constexpr size_t WS_Y = 240 * MiB;
constexpr size_t WS_END = 304 * MiB;
constexpr int CW_CNT = 64, CNT_STRIDE = 64;
constexpr int CW_BAR = 8192;
constexpr int CW_UPD = 32768, UPD_STRIDE = 64;
constexpr int CW_ERR = 32;
constexpr int CW_PAN = 65536, PAN_STRIDE = 64;

constexpr int RING_BYTES = 131072;
constexpr int PREP_SCR = 16896;
constexpr int MISC_OFF = 8 * PREP_SCR;
constexpr int LDS_BYTES = 147456;

#define LDS_WAIT() asm volatile("s_waitcnt lgkmcnt(0)" ::: "memory")
#define VM_WAIT() asm volatile("s_waitcnt vmcnt(0)" ::: "memory")
__device__ __forceinline__ unsigned cvtpk(float lo, float hi) { f32x2 v = {lo, hi}; bf16x2_t b = __builtin_convertvector(v, bf16x2_t); return __builtin_bit_cast(unsigned, b); }
__device__ __forceinline__ float bf2f(unsigned short h) { return __uint_as_float(((unsigned)h) << 16); }
__device__ __forceinline__ float bflo(unsigned w) { return __uint_as_float(w << 16); }
__device__ __forceinline__ float bfhi(unsigned w) { return __uint_as_float(w & 0xffff0000u); }
__device__ __forceinline__ float fast_exp2(float x) { return __builtin_amdgcn_exp2f(x); }
__device__ __forceinline__ float fast_rcp(float x) { return __builtin_amdgcn_rcpf(x); }
__device__ __forceinline__ void store16_sc1(void* p, u32x4 v) { asm volatile("global_store_dwordx4 %0, %1, off sc1\n\ts_nop 1" :: "v"(p), "v"(v) : "memory"); }
__device__ __forceinline__ int olane() { unsigned z = 0u; asm volatile("" : "+v"(z)); return (int)__builtin_amdgcn_mbcnt_hi(~0u, __builtin_amdgcn_mbcnt_lo(~0u, z)); }
__device__ __forceinline__ float sigmoidf_fast(float v) { return fast_rcp(1.0f + fast_exp2(-v * LOG2E)); }

namespace pg8 {
constexpr int BM = 256, BK = 64, HALF = 128, HTB = HALF * BK * 2, STAGE_BYTES = 8 * HTB, NXCD = 8, WGM = 4;
__host__ __device__ __forceinline__ int lds_byte(int r, int c) { const int st = (r >> 4) * 2 + (c >> 5), rr = r & 15, cc = c & 31, ob = rr * 64 + cc * 2; return st * 1024 + (ob ^ (((ob >> 9) & 1) << 5)); }
__host__ __device__ __forceinline__ void stage_rc(int b, int& R, int& C) { const int st = b / 1024, sb = b % 1024, swz = sb ^ (((sb >> 9) & 1) << 5); R = (st >> 1) * 16 + swz / 64; C = (st & 1) * 32 + (swz % 64) / 2; }
__host__ __device__ __forceinline__ int perm32(int rho) { const int n = rho >> 4, i = rho & 15; return 8 * (i >> 2) + 4 * n + (i & 3); }

struct Unit { int pm, pn, e, nvalid, slot0, lpos0, nt, kofs, sub; };

struct StaticOrder {
    int nM, nN, nwg, G, c;
    __device__ void init(int M, int N, int G_, int c_) { nM = M / BM; nN = N / BM; nwg = nM * nN; G = G_; c = c_; }
    __device__ bool next(int i, int& pm, int& pn) const {
        const long L = (long)i * G + c; if (L >= nwg) return false;
        int wgid = (int)L; { const int q = nwg / NXCD, r = nwg % NXCD, xcd = wgid % NXCD, off = wgid / NXCD; wgid = (xcd < r ? xcd * (q + 1) : r * (q + 1) + (xcd - r) * q) + off; }
        const int nig = WGM * nN, gid = wgid / nig, fm = gid * WGM, gsz = (nM - fm) < WGM ? (nM - fm) : WGM;
        pm = fm + ((wgid % nig) % gsz); pn = (wgid % nig) / gsz; return true;
    }
};

template <class Epi, class Sched>
__device__ __forceinline__ void gemm_phase(LAS unsigned char* lds, const Sched& S, const Epi& E) {
    unsigned z_ = 0u; asm volatile("" : "+v"(z_)); const int tid_ = (int)__builtin_amdgcn_mbcnt_hi(~0u, __builtin_amdgcn_mbcnt_lo(~0u, z_)) + S.wave * 64;
    const int tid = tid_, wid = S.wave, lane = tid & 63, wr = wid >> 2, wc = wid & 3, fr = lane & 15, fq = lane >> 4;
    const int K = S.ldb;
    unsigned voffA[2], voffB[2];
#pragma unroll
    for (int i = 0; i < 2; ++i) { int R, C; stage_rc(tid * 16 + i * 8192, R, C); const int Rb = Epi::PERM ? ((R & ~31) + perm32(R & 31)) : R;
        voffA[i] = (unsigned)(R * S.lda + C) * 2u; voffB[i] = (unsigned)(Rb * K + C) * 2u; }
    const size_t kstep = (size_t)(BK * 2);
    const size_t hstepB = (size_t)HALF * K * 2, hstepA = (size_t)HALF * S.lda * 2;
    const unsigned ldsw = (unsigned)wid * 1024u;
    const int aoff = lds_byte(wr * 64 + fr, fq * 8), boff = lds_byte(wc * 32 + fr, fq * 8);
#define PG8_SA(b, h) (((b) * 2 + (h)) * HTB)
#define PG8_SB(b, h) ((4 + (b) * 2 + (h)) * HTB)
#define PG8_GLDS(src, dstoff) __builtin_amdgcn_global_load_lds((const unsigned*)(src), (LAS unsigned*)(lds + (dstoff)), 16, 0, 0)
#define PG8_STAGE_A(bufoff, up, h, VO) do { if constexpr (Sched::GATHER) { _Pragma("unroll") for (int _i = 0; _i < 2; ++_i) PG8_GLDS((up) + VO[_i], (bufoff) + ldsw + _i * 8192); } \
        else { const char* _b = (up) + (size_t)(h) * hstepA; _Pragma("unroll") for (int _i = 0; _i < 2; ++_i) PG8_GLDS(_b + voffA[_i], (bufoff) + ldsw + _i * 8192); } } while (0)
#define PG8_STAGE_B(bufoff, bp) do { _Pragma("unroll") for (int _i = 0; _i < 2; ++_i) PG8_GLDS((bp) + voffB[_i], (bufoff) + ldsw + _i * 8192); } while (0)
#define PG8_LDA(dst, b, h) do { _Pragma("unroll") for (int m = 0; m < 4; ++m) _Pragma("unroll") for (int k = 0; k < 2; ++k) dst[m][k] = *(const LAS bf16x8*)(lds + PG8_SA(b, h) + aoff + m * 2048 + k * 1024); } while (0)
#define PG8_LDB(dst, b, h) do { _Pragma("unroll") for (int n = 0; n < 2; ++n) _Pragma("unroll") for (int k = 0; k < 2; ++k) dst[n][k] = *(const LAS bf16x8*)(lds + PG8_SB(b, h) + boff + n * 2048 + k * 1024); } while (0)
#define PG8_MMA(ai, bj, At, Bt) do { __builtin_amdgcn_s_setprio(1); _Pragma("unroll") for (int m = 0; m < 4; ++m) _Pragma("unroll") for (int n = 0; n < 2; ++n) _Pragma("unroll") for (int k = 0; k < 2; ++k) \
        acc[ai][bj][m][n] = __builtin_amdgcn_mfma_f32_16x16x32_bf16(Bt[n][k], At[m][k], acc[ai][bj][m][n], 0, 0, 0); __builtin_amdgcn_s_setprio(0); } while (0)
#define PG8_WAIT_V(n) asm volatile("s_waitcnt vmcnt(" #n ")" ::: "memory")
#define PG8_WAIT_L(n) asm volatile("s_waitcnt lgkmcnt(" #n ")" ::: "memory")
#define PG8_BAR __builtin_amdgcn_s_barrier()
#define PG8_SCHED __builtin_amdgcn_sched_barrier(0)
    Unit cur, nxt; int ui = 0;
    if (!S.next(0, cur)) return;
    f32x4 acc[2][2][4][2];
#pragma unroll
    for (int a = 0; a < 2; ++a)
#pragma unroll
        for (int b = 0; b < 2; ++b)
#pragma unroll
            for (int m = 0; m < 4; ++m)
#pragma unroll
                for (int n = 0; n < 2; ++n) acc[a][b][m][n] = (f32x4){0.f, 0.f, 0.f, 0.f};
    bf16x8 At[4][2], B0[2][2], B1[2][2];
    const char* Ab = S.a_base();
    const char* cA = Ab; const char* cB = S.b_base(cur);
    unsigned vF0[2], vF1[2], vK[2];
    if constexpr (Sched::GATHER) {
#pragma unroll
        for (int i = 0; i < 2; ++i) { int R, C; stage_rc(tid * 16 + i * 8192, R, C); vF0[i] = S.a_off(cur, R) + (unsigned)(C * 2); vF1[i] = S.a_off(cur, HALF + R) + (unsigned)(C * 2); vK[i] = vF1[i]; }
    } else cA = Ab + S.a_unit_off(cur);
    S.a_ready(cur);
    PG8_STAGE_B(PG8_SB(0, 0), cB); PG8_STAGE_B(PG8_SB(0, 1), cB + hstepB); PG8_STAGE_A(PG8_SA(0, 0), cA, 0, vF0); PG8_STAGE_A(PG8_SA(0, 1), cA, 1, vF1);
    if (wr == 1) PG8_BAR;
    PG8_WAIT_V(2); PG8_BAR;
    PG8_STAGE_B(PG8_SB(1, 0), cB + kstep); PG8_STAGE_A(PG8_SA(1, 0), cA + kstep, 0, vF0); PG8_STAGE_B(PG8_SB(1, 1), cB + hstepB + kstep);
    PG8_WAIT_V(6); PG8_BAR;
    for (;;) {
        const bool has_next = S.next(ui + 1, nxt);
        const char* nA = cA; const char* nB = cB;
        if (has_next) { nB = S.b_base(nxt); if constexpr (!Sched::GATHER) nA = Ab + S.a_unit_off(nxt); }
        const int nt = cur.nt;
#pragma unroll 1
        for (int t = 0; t < nt; t += 2) {
            const bool last = (t == nt - 2);
            if (last && has_next) S.a_ready(nxt);
            const char* a1 = cA + (size_t)(t + 1) * kstep;
            const char* a2 = last ? nA : cA + (size_t)(t + 2) * kstep; const char* b2 = last ? nB : cB + (size_t)(t + 2) * kstep;
            const char* a3 = a2 + kstep; const char* b3 = b2 + kstep;
            if constexpr (Sched::GATHER) {
                if (last && has_next) {
#pragma unroll
                    for (int i = 0; i < 2; ++i) { int R, C; stage_rc(tid * 16 + i * 8192, R, C); vF0[i] = S.a_off(nxt, R) + (unsigned)(C * 2); vF1[i] = S.a_off(nxt, HALF + R) + (unsigned)(C * 2); }
                }
            }
            PG8_LDB(B0, 0, 0); PG8_LDB(B1, 0, 1); PG8_SCHED; PG8_LDA(At, 0, 0); PG8_STAGE_A(PG8_SA(1, 1), a1, 1, vK);
            PG8_WAIT_V(8); PG8_WAIT_L(0); PG8_BAR; PG8_MMA(0, 0, At, B0); PG8_MMA(0, 1, At, B1); PG8_BAR; PG8_SCHED;
            PG8_LDA(At, 0, 1); PG8_STAGE_B(PG8_SB(0, 0), b2); PG8_STAGE_B(PG8_SB(0, 1), b2 + hstepB); PG8_STAGE_A(PG8_SA(0, 0), a2, 0, vF0);
            PG8_WAIT_V(8); PG8_WAIT_L(0); PG8_BAR; PG8_MMA(1, 0, At, B0); PG8_MMA(1, 1, At, B1); PG8_BAR; PG8_SCHED;
            PG8_LDB(B0, 1, 0); PG8_LDB(B1, 1, 1); PG8_SCHED; PG8_LDA(At, 1, 0); PG8_STAGE_A(PG8_SA(0, 1), a2, 1, vF1);
            PG8_WAIT_V(8); PG8_WAIT_L(0); PG8_BAR; PG8_MMA(0, 0, At, B0); PG8_MMA(0, 1, At, B1); PG8_BAR; PG8_SCHED;
            PG8_LDA(At, 1, 1); PG8_STAGE_B(PG8_SB(1, 0), b3); PG8_STAGE_B(PG8_SB(1, 1), b3 + hstepB); PG8_STAGE_A(PG8_SA(1, 0), a3, 0, vF0);
            PG8_WAIT_V(8); PG8_WAIT_L(0); PG8_BAR; PG8_MMA(1, 0, At, B0); PG8_MMA(1, 1, At, B1); PG8_BAR; PG8_SCHED;
        }
        if (wr == 0) PG8_BAR;
        bool keep = false;
        if constexpr (Epi::HAS_MID) { if (cur.sub == 0) { E.mid(acc, cur, wr, wc, fr, fq); keep = true; } else E(acc, cur, wr, wc, fr, fq); }
        else E(acc, cur, wr, wc, fr, fq);
        S.done(cur);
        if (!has_next) break;
        if (!keep) {
#pragma unroll
        for (int a = 0; a < 2; ++a)
#pragma unroll
            for (int b = 0; b < 2; ++b)
#pragma unroll
                for (int m = 0; m < 4; ++m)
#pragma unroll
                    for (int n = 0; n < 2; ++n) acc[a][b][m][n] = (f32x4){0.f, 0.f, 0.f, 0.f};
        }
        cur = nxt; cA = nA; cB = nB; ++ui;
        if constexpr (Sched::GATHER) { vK[0] = vF1[0]; vK[1] = vF1[1]; }
        if (wr == 1) PG8_BAR;
    }
    PG8_WAIT_V(0);
    PG8_BAR;
#undef PG8_SA
#undef PG8_SB
#undef PG8_GLDS
#undef PG8_STAGE_A
#undef PG8_STAGE_B
#undef PG8_LDA
#undef PG8_LDB
#undef PG8_MMA
#undef PG8_WAIT_V
#undef PG8_WAIT_L
#undef PG8_BAR
#undef PG8_SCHED
}
}
using pg8::Unit;

struct DenseSched {
    static constexpr bool GATHER = false;
    const char* A; const char* Bt; int K; int lda; int ldb; int wave; int ksplit; pg8::StaticOrder so;
    __device__ __forceinline__ bool next(int i, Unit& u) const {
        int pm, pn; const int ti = ksplit ? (i >> 1) : i; if (!so.next(ti, pm, pn)) return false;
        u.pm = pm; u.pn = pn; u.e = 0; u.nvalid = 256; u.slot0 = pm * 256; u.lpos0 = 0;
        if (ksplit) { u.sub = i & 1; u.kofs = u.sub ? ksplit : 0; u.nt = (u.sub ? K - ksplit : ksplit) / 64; } else { u.sub = 1; u.kofs = 0; u.nt = K / 64; }
        return true; }
    __device__ __forceinline__ const char* a_base() const { return A; }
    __device__ __forceinline__ unsigned a_off(const Unit& u, int r) const { return 0u; }
    __device__ __forceinline__ size_t a_unit_off(const Unit& u) const { return ((size_t)u.pm * 256 * lda + u.kofs) * 2; }
    __device__ __forceinline__ const char* b_base(const Unit& u) const { return Bt + ((size_t)u.pn * 256 * ldb + u.kofs) * 2; }
    unsigned* waitp; unsigned need; unsigned* postp; unsigned* err;
    __device__ __forceinline__ void a_ready(const Unit& u) const {
        if (waitp) {
            if (wave == 0) {
                unsigned* p = waitp + u.pm * PAN_STRIDE; unsigned spins = 0;
                while ((unsigned)__builtin_amdgcn_readfirstlane(__hip_atomic_load(p, __ATOMIC_RELAXED, __HIP_MEMORY_SCOPE_AGENT)) < need) {
                    __builtin_amdgcn_s_sleep(2);
                    if (++spins > (1u << 22)) { __hip_atomic_store(err, 2u, __ATOMIC_RELAXED, __HIP_MEMORY_SCOPE_AGENT); break; }
                }
                __builtin_amdgcn_fence(__ATOMIC_ACQUIRE, "agent");
                asm volatile("s_waitcnt vmcnt(0)" ::: "memory");
            }
            asm volatile("" ::: "memory"); __builtin_amdgcn_s_barrier(); asm volatile("" ::: "memory");
        }
    }
    __device__ __forceinline__ void done(const Unit& u) const {
        if (postp && u.sub == 1) {
            asm volatile("s_waitcnt vmcnt(0)" ::: "memory");
            if (olane() == 0) __hip_atomic_fetch_add(postp + u.pm * PAN_STRIDE, 1u, __ATOMIC_RELAXED, __HIP_MEMORY_SCOPE_AGENT);
        }
    }
};
struct MoeTab { const volatile LAS int* cnt; const volatile LAS int* mtpref; const volatile LAS int* spref; };
template <bool GATHER_> struct MoeSched {
    static constexpr bool GATHER = GATHER_;
    const char* A; const char* Bt; int K; int lda; int ldb; int wave; int ntn; size_t bstride_e; const int* ltok; MoeTab T;
    int G1, c1, lo1, hi1, G2, c2, lo2, hi2; unsigned* upd; unsigned* err;
    __device__ __forceinline__ bool next(int i, Unit& u) const {
        int L;
        const int n1 = (c1 >= 0 && lo1 + c1 < hi1) ? (hi1 - lo1 - c1 + G1 - 1) / G1 : 0;
        if (i < n1) L = lo1 + c1 + i * G1;
        else { L = lo2 + c2 + (i - n1) * G2; if (c2 < 0 || L >= hi2) return false; }
        const int tix = L / ntn; u.pn = L - tix * ntn; u.pm = tix;
        int e = 0;
#pragma unroll 1
        for (int k = 1; k < 32; ++k) if (T.mtpref[k] <= tix) e = k;
        const int mt = tix - T.mtpref[e]; u.e = e; u.slot0 = T.spref[e] + 256 * mt; const int rem = T.cnt[e] - 256 * mt; u.nvalid = rem < 256 ? rem : 256; u.lpos0 = e * MTOK + 256 * mt; u.nt = K / 64; u.kofs = 0; u.sub = 1; return true;
    }
    __device__ __forceinline__ const char* a_base() const { return A; }
    __device__ __forceinline__ unsigned a_off(const Unit& u, int r) const { const int rr = r < u.nvalid ? r : u.nvalid - 1; return (unsigned)ltok[u.lpos0 + rr] * (unsigned)(lda * 2); }
    __device__ __forceinline__ size_t a_unit_off(const Unit& u) const { return (size_t)u.slot0 * lda * 2; }
    __device__ __forceinline__ const char* b_base(const Unit& u) const { return Bt + (size_t)u.e * bstride_e + (size_t)u.pn * 256 * K * 2; }
    __device__ __forceinline__ void a_ready(const Unit& u) const {
        if constexpr (!GATHER_) {
            if (wave == 0) {
                unsigned* p = upd + u.pm * UPD_STRIDE; unsigned spins = 0;
                while ((unsigned)__builtin_amdgcn_readfirstlane(__hip_atomic_load(p, __ATOMIC_RELAXED, __HIP_MEMORY_SCOPE_AGENT)) < 16u) {
                    __builtin_amdgcn_s_sleep(2);
                    if (++spins > (1u << 22)) { __hip_atomic_store(err, 1u, __ATOMIC_RELAXED, __HIP_MEMORY_SCOPE_AGENT); break; }
                }
                __builtin_amdgcn_fence(__ATOMIC_ACQUIRE, "agent");
                asm volatile("s_waitcnt vmcnt(0)" ::: "memory");
            }
            asm volatile("" ::: "memory"); __builtin_amdgcn_s_barrier(); asm volatile("" ::: "memory");
        }
    }
    __device__ __forceinline__ void done(const Unit& u) const {
        if constexpr (GATHER_) {
            asm volatile("s_waitcnt vmcnt(0)" ::: "memory");
            if (olane() == 0) __hip_atomic_fetch_add(upd + u.pm * UPD_STRIDE, 1u, __ATOMIC_RELAXED, __HIP_MEMORY_SCOPE_AGENT);
        }
    }
};

#define OPAQUE(p) asm volatile("" : "+v"(p))
struct EpiProj {
    static constexpr bool PERM = true, REPEAT = true, HAS_MID = false;
    bf16* Pq; bf16* Pg; const float* rs; const f32x4* rope;
    __device__ __forceinline__ static void rot(f32x4& c, const f32x4& st) {
        const f32x4 o = c;
        c[0] = o[0] * st[0] - o[1] * st[1]; c[1] = o[1] * st[0] + o[0] * st[1];
        c[2] = o[2] * st[2] - o[3] * st[3]; c[3] = o[3] * st[2] + o[2] * st[3];
    }
    __device__ __forceinline__ void operator()(const f32x4 (&acc)[2][2][4][2], const Unit& u, int wr, int wc, int fr, int fq) const {
        const int colh = wc * 32 + fq * 8;
        const int ib = (colh & 63) >> 2;
        const int row0 = u.pm * 256 + wr * 64 + fr;
        int mode[2]; bf16* ob[2]; size_t ostep[2];
#pragma unroll
        for (int bj = 0; bj < 2; ++bj) {
            const int h128 = 2 * u.pn + bj;
            if (h128 >= 24) mode[bj] = 3;
            else if (h128 < 6) mode[bj] = h128 < 4 ? 1 : (h128 == 4 ? 2 : 0);
            else { const int j = (h128 - 6) % 6; mode[bj] = j < 2 ? 1 : (j < 4 ? 2 : 0); }
            if (h128 < 24) { ob[bj] = Pq + h128 * 128 + colh + (size_t)row0 * NQKV; ostep[bj] = (size_t)NQKV * 16; }
            else { ob[bj] = Pg + (((h128 - 24) * 128 + colh) >> 1) + (size_t)row0 * (NGATE / 2); ostep[bj] = (size_t)(NGATE / 2) * 16; }
        }
        float rsv[8];
#pragma unroll
        for (int i = 0; i < 8; ++i) rsv[i] = rs[row0 + (i >> 2) * 128 + (i & 3) * 16];
        const f32x4* rp = rope + (size_t)(row0 & (SEQ - 1)) * 16 + ib;
        f32x4 c0 = rp[0], c1 = rp[1];
        const f32x4 s16a = rope[16 * 16 + ib], s16b = rope[16 * 16 + ib + 1], s80a = rope[80 * 16 + ib], s80b = rope[80 * 16 + ib + 1];
#pragma unroll
        for (int ai = 0; ai < 2; ++ai)
#pragma unroll
            for (int m = 0; m < 4; ++m) {
                OPAQUE(ob[0]); OPAQUE(ob[1]);
                const float s = rsv[ai * 4 + m];
#pragma unroll
                for (int bj = 0; bj < 2; ++bj) {
                    f32x4 v0 = acc[ai][bj][m][0] * s, v1 = acc[ai][bj][m][1] * s;
                    if (mode[bj] == 1 || mode[bj] == 2) {
                        f32x4 o0, o1;
                        o0[0] = v0[0] * c0[0] - v0[1] * c0[1]; o0[1] = v0[1] * c0[0] + v0[0] * c0[1];
                        o0[2] = v0[2] * c0[2] - v0[3] * c0[3]; o0[3] = v0[3] * c0[2] + v0[2] * c0[3];
                        o1[0] = v1[0] * c1[0] - v1[1] * c1[1]; o1[1] = v1[1] * c1[0] + v1[0] * c1[1];
                        o1[2] = v1[2] * c1[2] - v1[3] * c1[3]; o1[3] = v1[3] * c1[2] + v1[2] * c1[3];
                        const float qs = (mode[bj] == 1) ? QSCALE : 1.0f;
                        v0 = o0 * qs; v1 = o1 * qs;
                    } else if (mode[bj] == 3) {
#pragma unroll
                        for (int j = 0; j < 4; ++j) { v0[j] = sigmoidf_fast(v0[j]); v1[j] = sigmoidf_fast(v1[j]); }
                    }
                    if (mode[bj] == 3) {
                        unsigned q[8];
#pragma unroll
                        for (int j = 0; j < 4; ++j) { q[j] = (unsigned)fminf(v0[j] * 256.0f, 255.0f); q[4 + j] = (unsigned)fminf(v1[j] * 256.0f, 255.0f); }
                        u32x2 w; w.x = q[0] | (q[1] << 8) | (q[2] << 16) | (q[3] << 24); w.y = q[4] | (q[5] << 8) | (q[6] << 16) | (q[7] << 24);
                        *(u32x2*)(ob[bj]) = w;
                    } else {
                        u32x4 w; w.x = cvtpk(v0[0], v0[1]); w.y = cvtpk(v0[2], v0[3]); w.z = cvtpk(v1[0], v1[1]); w.w = cvtpk(v1[2], v1[3]);
                        *(u32x4*)(ob[bj]) = w;
                    }
                }
                if (m == 3) { rot(c0, s80a); rot(c1, s80b); } else { rot(c0, s16a); rot(c1, s16b); }
                const int adv = (m == 3) ? 5 : 1;
                ob[0] += ostep[0] * adv; ob[1] += ostep[1] * adv;
            }
    }
};
struct EpiMerge {
    static constexpr bool PERM = true, REPEAT = false, HAS_MID = true;
    const unsigned char* gate; bf16* out;
    __device__ __forceinline__ static float dq(unsigned w, int k) { return ((float)((w >> (8 * k)) & 255u) + 0.5f) * (1.0f / 256.0f); }
    __device__ __forceinline__ void mid(f32x4 (&acc)[2][2][4][2], const Unit& u, int wr, int wc, int fr, int fq) const {
        const int row0 = u.pm * 256 + wr * 64 + fr, col0 = u.pn * 256 + wc * 32 + fq * 8;
        const unsigned char* gp = gate + (size_t)row0 * NGATE + col0;
        u32x2 ga[2][2], gb[2][2];
#define EM_LOAD(slot, i) do { const size_t ro = (size_t)(16 * (i) + 64 * ((i) >> 2)) * NGATE; ga[slot][0] = *(const u32x2*)(gp + ro); ga[slot][1] = *(const u32x2*)(gp + ro + 128); \
        gb[slot][0] = *(const u32x2*)(gp + ro + 1024); gb[slot][1] = *(const u32x2*)(gp + ro + 1024 + 128); } while (0)
        EM_LOAD(0, 0);
#pragma unroll
        for (int i = 0; i < 8; ++i) {
            const int ai = i >> 2, m = i & 3, sl = i & 1;
            if (i + 1 < 8) { if (sl == 0) EM_LOAD(1, i + 1); else EM_LOAD(0, i + 1); }
#pragma unroll
            for (int bj = 0; bj < 2; ++bj) {
                const u32x2 A = ga[sl][bj], B = gb[sl][bj];
#pragma unroll
                for (int j = 0; j < 4; ++j) {
                    acc[ai][bj][m][0][j] *= dq(B.x, j) * fast_rcp(dq(A.x, j));
                    acc[ai][bj][m][1][j] *= dq(B.y, j) * fast_rcp(dq(A.y, j));
                }
            }
        }
#undef EM_LOAD
    }
    __device__ __forceinline__ void operator()(const f32x4 (&acc)[2][2][4][2], const Unit& u, int wr, int wc, int fr, int fq) const {
        const int row0 = u.pm * 256 + wr * 64 + fr, col0 = u.pn * 256 + wc * 32 + fq * 8;
        const unsigned char* gp = gate + (size_t)row0 * NGATE + col0; bf16* op = out + (size_t)row0 * DM + col0;
        u32x2 ga[2][2];
#define EF_LOAD(slot, i) do { const size_t ro = (size_t)(16 * (i) + 64 * ((i) >> 2)) * NGATE; ga[slot][0] = *(const u32x2*)(gp + ro); ga[slot][1] = *(const u32x2*)(gp + ro + 128); } while (0)
        EF_LOAD(0, 0);
#pragma unroll
        for (int i = 0; i < 8; ++i) {
            const int ai = i >> 2, m = i & 3, sl = i & 1;
            if (i + 1 < 8) { if (sl == 0) EF_LOAD(1, i + 1); else EF_LOAD(0, i + 1); }
            bf16* orow = op + (size_t)(16 * i + 64 * (i >> 2)) * DM;
#pragma unroll
            for (int bj = 0; bj < 2; ++bj) {
                const u32x2 A = ga[sl][bj];
                const f32x4 a0 = acc[ai][bj][m][0], a1 = acc[ai][bj][m][1];
                u32x4 w;
                w.x = cvtpk(a0[0] * dq(A.x, 0), a0[1] * dq(A.x, 1)); w.y = cvtpk(a0[2] * dq(A.x, 2), a0[3] * dq(A.x, 3));
                w.z = cvtpk(a1[0] * dq(A.y, 0), a1[1] * dq(A.y, 1)); w.w = cvtpk(a1[2] * dq(A.y, 2), a1[3] * dq(A.y, 3));
                store16_sc1(orow + bj * 128, w);
            }
            asm volatile("" ::: "memory");
        }
#undef EF_LOAD
    }
};
struct EpiResid {
    static constexpr bool PERM = true, REPEAT = false, HAS_MID = false;
    bf16* xb;
    __device__ __forceinline__ void operator()(const f32x4 (&acc)[2][2][4][2], const Unit& u, int wr, int wc, int fr, int fq) const {
        const int row0 = u.pm * 256 + wr * 64 + fr, col0 = u.pn * 256 + wc * 32 + fq * 8;
        bf16* xp = xb + (size_t)row0 * DM + col0;
        u32x4 p[2][2];
#define ER_LOAD(slot, i) do { const size_t ro = (size_t)(16 * (i) + 64 * ((i) >> 2)); p[slot][0] = *(const u32x4*)(xp + ro * DM); p[slot][1] = *(const u32x4*)(xp + ro * DM + 128); } while (0)
        ER_LOAD(0, 0);
#pragma unroll
        for (int i = 0; i < 8; ++i) {
            const int ai = i >> 2, m = i & 3, sl = i & 1;
            if (i + 1 < 8) { if (sl == 0) ER_LOAD(1, i + 1); else ER_LOAD(0, i + 1); }
            bf16* orow = xp + (size_t)(16 * i + 64 * (i >> 2)) * DM;
#pragma unroll
            for (int bj = 0; bj < 2; ++bj) {
                const u32x4 q = p[sl][bj];
                const f32x4 a0 = acc[ai][bj][m][0], a1 = acc[ai][bj][m][1];
                u32x4 w;
                w.x = cvtpk(a0[0] + bflo(q.x), a0[1] + bfhi(q.x)); w.y = cvtpk(a0[2] + bflo(q.y), a0[3] + bfhi(q.y));
                w.z = cvtpk(a1[0] + bflo(q.z), a1[1] + bfhi(q.z)); w.w = cvtpk(a1[2] + bflo(q.w), a1[3] + bfhi(q.w));
                store16_sc1(orow + bj * 128, w);
            }
            asm volatile("" ::: "memory");
        }
#undef ER_LOAD
    }
};
struct EpiSwiglu {
    static constexpr bool PERM = true, REPEAT = false, HAS_MID = false;
    const int* ltok; const float* lw; const float* rs; bf16* H;
    __device__ __forceinline__ void operator()(const f32x4 (&acc)[2][2][4][2], const Unit& u, int wr, int wc, int fr, int fq) const {
        int tok[8]; float w8[8], s8[8];
#pragma unroll
        for (int i = 0; i < 8; ++i) { const int rr = (i >> 2) * 128 + wr * 64 + (i & 3) * 16 + fr; const int rc = rr < u.nvalid ? rr : u.nvalid - 1; tok[i] = ltok[u.lpos0 + rc]; w8[i] = lw[u.lpos0 + rc]; }
#pragma unroll
        for (int i = 0; i < 8; ++i) s8[i] = rs[tok[i]];
#pragma unroll
        for (int ai = 0; ai < 2; ++ai)
#pragma unroll
            for (int m = 0; m < 4; ++m) {
                const int rr = ai * 128 + wr * 64 + m * 16 + fr;
                if (rr < u.nvalid) {
                    const float w = w8[ai * 4 + m], s = s8[ai * 4 + m];
#pragma unroll
                    for (int bj = 0; bj < 2; ++bj) {
                        const f32x4 a0 = acc[ai][bj][m][0] * s, a1 = acc[ai][bj][m][1] * s;
                        const float h0 = a0[0] * sigmoidf_fast(a0[0]) * a0[1] * w, h1 = a0[2] * sigmoidf_fast(a0[2]) * a0[3] * w;
                        const float h2 = a1[0] * sigmoidf_fast(a1[0]) * a1[1] * w, h3 = a1[2] * sigmoidf_fast(a1[2]) * a1[3] * w;
                        u32x2 o; o.x = cvtpk(h0, h1); o.y = cvtpk(h2, h3);
                        __hip_atomic_store((unsigned long long*)(H + (size_t)(u.slot0 + rr) * DEXP + u.pn * 128 + bj * 64 + wc * 16 + fq * 4), (unsigned long long)o.x | ((unsigned long long)o.y << 32), __ATOMIC_RELAXED, __HIP_MEMORY_SCOPE_AGENT);
                    }
                }
            }
    }
};
struct EpiY {
    static constexpr bool PERM = true, REPEAT = false, HAS_MID = false;
    bf16* Y;
    __device__ __forceinline__ void operator()(const f32x4 (&acc)[2][2][4][2], const Unit& u, int wr, int wc, int fr, int fq) const {
#pragma unroll
        for (int ai = 0; ai < 2; ++ai)
#pragma unroll
            for (int m = 0; m < 4; ++m) {
                const int rr = ai * 128 + wr * 64 + m * 16 + fr;
                if (rr < u.nvalid) {
#pragma unroll
                    for (int bj = 0; bj < 2; ++bj) {
                        const f32x4 a0 = acc[ai][bj][m][0], a1 = acc[ai][bj][m][1];
                        u32x4 w; w.x = cvtpk(a0[0], a0[1]); w.y = cvtpk(a0[2], a0[3]); w.z = cvtpk(a1[0], a1[1]); w.w = cvtpk(a1[2], a1[3]);
                        *(u32x4*)(Y + (size_t)(u.slot0 + rr) * DM + u.pn * 256 + bj * 128 + wc * 32 + fq * 8) = w;
                    }
                }
            }
    }
};

#define XB_TMO      128
#define XB_XCNT(j)  (256  + 64 * (j))
#define XB_XSUB(j)  (1280 + 64 * (j))
#define XB_XGEN(j)  (2304 + 64 * (j))
#define XB_TOP      3328
#define XB_TOPGEN   3392
#define XCD_BAR_WORDS 3456
#define XB_SPIN_CAP (1u << 18)
__device__ __forceinline__ unsigned xb_ld(unsigned* p)              { return __hip_atomic_load(p, __ATOMIC_RELAXED, __HIP_MEMORY_SCOPE_AGENT); }
__device__ __forceinline__ unsigned xb_add(unsigned* p, unsigned v) { return __hip_atomic_fetch_add(p, v, __ATOMIC_RELAXED, __HIP_MEMORY_SCOPE_AGENT); }
__device__ __forceinline__ unsigned xb_xcc_id() { return (unsigned)__builtin_amdgcn_s_getreg((3 << 11) | 20) & 0xFu; }
#define XB_SPIN(cond, bar) do { unsigned _sp = 0; while (cond) { __builtin_amdgcn_s_sleep(1); \
    if ((++_sp & 255u) == 0u) { if (xb_ld(&(bar)[XB_TMO])) break; if (_sp > XB_SPIN_CAP) { atomicAdd(&(bar)[XB_TMO], 1u); break; } } } } while (0)
struct XcdBarrier { unsigned* bar; unsigned x; volatile LAS unsigned* st; };
__device__ __forceinline__ XcdBarrier xcd_barrier_post(unsigned* bar, volatile LAS unsigned* st) {
    XcdBarrier b; b.bar = bar; b.x = xb_xcc_id(); b.st = st;
    if (threadIdx.x == 0) (void)xb_add(&bar[XB_XCNT(b.x)], 1u);
    return b;
}
__device__ __forceinline__ void xcd_barrier_complete(unsigned* bar, unsigned x, unsigned& nloc, unsigned& nx) {
    const unsigned G = gridDim.x * gridDim.y * gridDim.z;
    unsigned sum, cnt, mine, sp = 0u;
    for (;;) {
        sum = 0u; cnt = 0u; mine = 0u;
#pragma unroll
        for (unsigned j = 0; j < 16; ++j) { const unsigned c = xb_ld(&bar[XB_XCNT(j)]); sum += c; cnt += (c > 0u) ? 1u : 0u; mine = (j == x) ? c : mine; }
        if (sum == G) break;
        __builtin_amdgcn_s_sleep(1);
        if ((++sp & 255u) == 0u) { if (xb_ld(&bar[XB_TMO])) break; if (sp > XB_SPIN_CAP) { atomicAdd(&bar[XB_TMO], 1u); break; } }
    }
    nloc = mine > 0u ? mine : 1u; nx = cnt > 0u ? cnt : 1u;
}
__device__ __forceinline__ void xcd_barrier(const XcdBarrier& b, int wave) {
    asm volatile("s_waitcnt vmcnt(0)" ::: "memory");
    __syncthreads();
    unsigned zb_ = 0u; asm volatile("" : "+v"(zb_));
    if (wave == 0 && __builtin_amdgcn_mbcnt_hi(~0u, __builtin_amdgcn_mbcnt_lo(~0u, zb_)) == 0u) {
        unsigned* bar = b.bar;
        __builtin_amdgcn_s_waitcnt(0);
        unsigned nloc = b.st[0], nx = b.st[1];
        if (nloc == 0u) { xcd_barrier_complete(bar, b.x, nloc, nx); b.st[0] = nloc; b.st[1] = nx; }
        const unsigned old = xb_add(&bar[XB_XSUB(b.x)], 1u);
        const unsigned gen = old / nloc;
        if (old + 1u == (gen + 1u) * nloc) {
            __builtin_amdgcn_fence(__ATOMIC_RELEASE, "agent");
            asm volatile("s_waitcnt vmcnt(0)" ::: "memory");
            const unsigned og = xb_add(&bar[XB_TOP], 1u);
            const unsigned tg = og / nx;
            if (og + 1u == (tg + 1u) * nx) xb_add(&bar[XB_TOPGEN], 1u);
            else XB_SPIN(xb_ld(&bar[XB_TOPGEN]) == tg, bar);
            __builtin_amdgcn_fence(__ATOMIC_ACQUIRE, "agent");
            xb_add(&bar[XB_XGEN(b.x)], 1u);
            asm volatile("s_waitcnt vmcnt(0)" ::: "memory");
        } else {
            XB_SPIN(xb_ld(&bar[XB_XGEN(b.x)]) == gen, bar);
            __builtin_amdgcn_fence(__ATOMIC_ACQUIRE, "agent");
            asm volatile("s_waitcnt vmcnt(0)" ::: "memory");
        }
    }
    __syncthreads();
}

struct Args {
    const float* x; const float* attn_g; const float* w_in; const float* a_sink; const float* w_a; const float* w_b; const float* w_out; const float* ffn_g;
    const float* w_rg; const float* b_rg; const float* w_re; const float* b_re; const float* w_eg; const float* w_eu; const float* w_ed; const float* fin_g;
    float* out; unsigned char* ws; int ph_lo, ph_hi;
};
typedef const __attribute__((address_space(4))) Args* CArgs;
struct Frame {
    LAS unsigned char* lds; volatile LAS int* misc;
    int wave, G, vcu, gw, ngw, bx;
};
__device__ __forceinline__ int otid() { unsigned z = 0u; asm volatile("" : "+v"(z)); return (int)__builtin_amdgcn_mbcnt_hi(~0u, __builtin_amdgcn_mbcnt_lo(~0u, z)); }
__device__ __forceinline__ float shx(float v, int o, int lane) { return __int_as_float(__builtin_amdgcn_ds_bpermute((lane ^ o) << 2, __float_as_int(v))); }
__device__ __forceinline__ float wave_sum(float v, int lane) {
#pragma unroll
    for (int o = 1; o < 64; o <<= 1) v += shx(v, o, lane);
    return v;
}

struct MapPlain { __device__ __forceinline__ int operator()(int n) const { return n; } };
struct MapWin { __device__ __forceinline__ int operator()(int n) const {
        bool rope = false;
        if (n < 640) rope = true; else if (n >= 768 && n < NQKV) rope = ((n - 768) % 768) < 512;
        if (!rope) return n; const int d = n & 63; return (n & ~63) + 2 * (d & 31) + (d >> 5); } };
struct MapGU { int t; __device__ __forceinline__ int operator()(int n) const { return 2 * n + t; } };
template <class Map> __device__ __forceinline__ void transpose_item64(const float* W, int ldn, int k0, int n0, const float* gk, bf16* WT, int Kd, const Map& map, LAS float* scr, int lane) {
    const int kq = lane >> 4, n4 = (lane & 15) * 4;
    const float* src = W + (size_t)(k0 + kq) * ldn + n0 + n4;
    f32x4 v[16];
#pragma unroll
    for (int i = 0; i < 16; ++i) v[i] = *(const f32x4*)(src + (size_t)(4 * i) * ldn);
    if (gk) {
#pragma unroll
        for (int i = 0; i < 16; ++i) v[i] = v[i] * gk[k0 + 4 * i + kq];
    }
#pragma unroll
    for (int i = 0; i < 16; ++i) { LAS float* d = scr + (4 * i + kq) * 65 + n4; d[0] = v[i][0]; d[1] = v[i][1]; d[2] = v[i][2]; d[3] = v[i][3]; }
    LDS_WAIT(); asm volatile("" ::: "memory");
    const int c = lane & 7;
#pragma unroll
    for (int j = 0; j < 8; ++j) { const int n = (lane >> 3) + 8 * j; const LAS float* p = scr + (8 * c) * 65 + n;
        u32x4 o; o.x = cvtpk(p[0 * 65], p[1 * 65]); o.y = cvtpk(p[2 * 65], p[3 * 65]); o.z = cvtpk(p[4 * 65], p[5 * 65]); o.w = cvtpk(p[6 * 65], p[7 * 65]);
        *(u32x4*)(WT + (size_t)map(n0 + n) * Kd + k0 + 8 * c) = o; }
    LDS_WAIT(); asm volatile("" ::: "memory");
}
__device__ __forceinline__ void prep_phase(const Frame& F, CArgs a) {
    const int lane = otid(), tid = F.wave * 64 + lane; (void)tid; (void)lane;
    unsigned char* ws = a->ws;
    LAS float* scr = (LAS float*)(F.lds + F.wave * PREP_SCR);
    constexpr int I_IN = 16 * 80, I_A = 8 * 16, I_B = 4 * 16, I_O = 16 * 16, I_L = I_IN + I_A + I_B + I_O;
    for (int it = F.gw; it < DEPTH * I_L; it += F.ngw) {
        const int l = it / I_L; int r = it - l * I_L;
        unsigned char* wl = ws + (size_t)l * WNE_LSTRIDE;
        if (r < I_IN) { transpose_item64(a->w_in + (size_t)l * DM * DIN, DIN, 64 * (r / 80), 64 * (r % 80), a->attn_g + l * DM, (bf16*)(wl + WS_WIN), DM, MapWin{}, scr, lane); continue; } r -= I_IN;
        if (r < I_A) { transpose_item64(a->w_a + (size_t)l * 512 * DM, DM, 64 * (r / 16), 64 * (r % 16), nullptr, (bf16*)(wl + WS_WAB) + 256, 768, MapPlain{}, scr, lane); continue; } r -= I_A;
        if (r < I_B) { transpose_item64(a->w_b + (size_t)l * 256 * DM, DM, 64 * (r / 16), 64 * (r % 16), nullptr, (bf16*)(wl + WS_WAB), 768, MapPlain{}, scr, lane); continue; } r -= I_B;
        transpose_item64(a->w_out + (size_t)l * DM * DM, DM, 64 * (r / 16), 64 * (r % 16), nullptr, (bf16*)(wl + WS_WOUT), DM, MapPlain{}, scr, lane);
    }
    for (int idx = F.bx * NTHREADS + tid; idx < DEPTH * 32 * 3 * 64 * 8; idx += F.G * NTHREADS) {
        const int l = idx / (32 * 3 * 64 * 8), id = idx - l * (32 * 3 * 64 * 8);
        const int j = id & 7, ln = (id >> 3) & 63, q = id >> 9, nt = q % 3, i = q / 3;
        const int k = 32 * i + 8 * (ln >> 4) + j, n = 16 * nt + (ln & 15);
        const float* wg = a->w_rg + (size_t)l * DM * 4; const float* we = a->w_re + (size_t)l * DM * NEXP;
        float v = 0.f; if (n < 4) v = wg[k * 4 + n]; else if (n < 36) v = we[k * NEXP + (n - 4)];
        v *= a->ffn_g[l * DM + k];
        const unsigned hb = cvtpk(v, 0.f) & 0xffffu; const float hf = __uint_as_float(hb << 16);
        const unsigned lb = cvtpk(v - hf, 0.f) & 0xffffu;
        ((bf16*)(ws + WS_WR + l * WR_LSTRIDE))[id] = (bf16)hb; ((bf16*)(ws + WS_WR + l * WR_LSTRIDE + WR_LO))[id] = (bf16)lb;
    }
    {
        float* rt = (float*)(ws + WS_ROPE);
        for (int idx = F.bx * NTHREADS + tid; idx < SEQ * 32; idx += F.G * NTHREADS) {
            const int pos = idx >> 5, i = idx & 31;
            const float inv = 1.0f / powf(10000.0f, (float)(2 * i) / 64.0f);
            const float ang = (float)pos * inv;
            const double ad = (double)ang, kd = __builtin_rint(ad * 0.15915494309189535);
            const float rf = (float)__builtin_fma(-kd, 6.283185307179586, ad);
            rt[idx * 2] = cosf(rf); rt[idx * 2 + 1] = sinf(rf);
        }
        bf16* xb = (bf16*)(ws + WS_XB); float* rs1 = (float*)(ws + WS_RS1);
        for (int m = F.gw; m < MTOK; m += F.ngw) {
            const f32x4* xr = (const f32x4*)(a->x + (size_t)m * DM) + lane;
            f32x4 v[4]; float s = 0.f;
#pragma unroll
            for (int j = 0; j < 4; ++j) { v[j] = xr[64 * j]; s += (v[j][0] * v[j][0] + v[j][1] * v[j][1]) + (v[j][2] * v[j][2] + v[j][3] * v[j][3]); }
            s = wave_sum(s, lane);
            u32x2* o = (u32x2*)(xb + (size_t)m * DM) + lane;
#pragma unroll
            for (int j = 0; j < 4; ++j) { u32x2 w; w.x = cvtpk(v[j][0], v[j][1]); w.y = cvtpk(v[j][2], v[j][3]); o[64 * j] = w; }
            if (lane == 0) rs1[m] = 1.0f / sqrtf(s * (1.0f / DM) + NORM_EPS);
        }
    }
}
__device__ __forceinline__ void prep_experts(const Frame& F, CArgs a, int l, int lane, int part, int w, int nw) {
    unsigned char* ws = a->ws;
    LAS float* scr = (LAS float*)(F.lds + F.wave * PREP_SCR);
    constexpr int I_G = 16 * 4, I_D = 4 * 16;
    const float* fg = a->ffn_g + l * DM;
    if (part == 0) {
        for (int it = w; it < NEXP * 2 * I_G; it += nw) {
            const int e = it / (2 * I_G); int r = it - e * (2 * I_G); const int t = r / I_G; r -= t * I_G;
            const size_t eo = ((size_t)l * NEXP + e) * DM * DEXP; const float* W = (t ? a->w_eu : a->w_eg) + eo;
            transpose_item64(W, DEXP, 64 * (r / 4), 64 * (r % 4), fg, (bf16*)(ws + WS_WGU) + (size_t)e * 512 * DM, DM, MapGU{t}, scr, lane);
        }
    } else {
        for (int it = w; it < NEXP * I_D; it += nw) {
            const int e = it / I_D, r = it - e * I_D;
            const size_t eo = ((size_t)l * NEXP + e) * DM * DEXP;
            transpose_item64(a->w_ed + eo, DM, 64 * (r / 16), 64 * (r % 16), nullptr, (bf16*)(ws + WS_WD) + (size_t)e * DM * DEXP, DEXP, MapPlain{}, scr, lane);
        }
    }
}

__device__ __forceinline__ int crow(int r, int hi) { return (r & 3) + 8 * (r >> 2) + 4 * hi; }
struct AttnUnit { int kcol, vcol, b, d, r, t0, span, W, qcol, tq; float m0, l0; bf16* outp; int opitch; float* lsep; bool valid; };
__device__ __forceinline__ AttnUnit attn_decode(int idx, int G, int bx, int wave, int l, CArgs a, bf16* ya, bf16* ob, float* lse) {
    AttnUnit U; U.valid = false;
    const int nA = (BATCH * 2 * 64 - bx + G - 1) / G;
    if (idx < nA) {
        const int u = bx + idx * G; const int qb = u & 63, kvh = (u >> 6) & 1, b = u >> 7; const int g = wave >> 1, hq = kvh * 4 + g;
        U.kcol = 512 + kvh * 64; U.vcol = 640 + kvh * 64; U.b = b; U.d = 1; U.r = 0; U.t0 = 2 * qb; U.span = 2; U.W = 4; U.qcol = hq * 64; U.tq = 2 * qb + (wave & 1);
        U.m0 = a->a_sink[l * 8 + hq] * LOG2E; U.l0 = 1.0f; U.outp = ya + hq * 64; U.opitch = 768; U.lsep = nullptr; U.valid = true; return U;
    }
    const int u = bx + (idx - nA) * G;
    if (u < 3 * 256) {
        const int grp = u >> 8; int q = u & 255;
        const int d = grp == 0 ? 1 : (grp == 1 ? 4 : 16), bpr = 16 / d;
        const int blk = q % bpr; q /= bpr; const int res = q % d; q /= d; const int h = q & 3, b = q >> 2;
        const int base = 768 + 768 * grp;
        U.kcol = base + 256 + h * 64; U.vcol = base + 512 + h * 64; U.b = b; U.d = d; U.r = res; U.t0 = 8 * blk; U.span = 8; U.W = 2; U.qcol = base + h * 64; U.tq = 8 * blk + wave;
        U.m0 = -1e30f; U.l0 = 0.0f; U.outp = ob + grp * 256 + h * 64; U.opitch = 768; U.lsep = lse + grp * 4 + h; U.valid = true;
    }
    return U;
}
__device__ __forceinline__ void attn_fetch(const bf16* P, const AttnUnit& U, int tid, u32x4 (&buf)[12]) {
    const int L32 = (SEQ / U.d) >> 5, jbase = U.t0 - U.W, ntile = U.span + 2 * U.W, nch = ntile * 512;
    const size_t tok0 = (size_t)U.b * SEQ + U.r;
#pragma unroll
    for (int i = 0; i < 12; ++i) {
        const int c = tid + 512 * i;
        if (c < nch) {
            const int kv = c >= ntile * 256, cc = kv ? c - ntile * 256 : c, row = cc >> 3, ch = cc & 7, tile = row >> 5, rr = row & 31, j = jbase + tile;
            if (j >= 0 && j < L32) buf[i] = *(const u32x4*)(P + (tok0 + (size_t)(32 * j + rr) * U.d) * NQKV + (kv ? U.vcol : U.kcol) + ch * 8);
        }
    }
}
__device__ __forceinline__ void attn_stage(const AttnUnit& U, int tid, const u32x4 (&buf)[12], LAS unsigned char* lds) {
    const int L32 = (SEQ / U.d) >> 5, jbase = U.t0 - U.W, ntile = U.span + 2 * U.W, nch = ntile * 512;
    LAS unsigned char* kimg = lds; LAS unsigned char* vimg = lds + ntile * 4096;
#pragma unroll
    for (int i = 0; i < 12; ++i) {
        const int c = tid + 512 * i;
        if (c < nch) {
            const int kv = c >= ntile * 256, cc = kv ? c - ntile * 256 : c, row = cc >> 3, ch = cc & 7, tile = row >> 5, rr = row & 31, j = jbase + tile;
            if (j >= 0 && j < L32) *(LAS u32x4*)((kv ? vimg : kimg) + tile * 4096 + rr * 128 + (kv ? ch : (ch ^ (rr & 7))) * 16) = buf[i];
        }
    }
}
template <int NT> __device__ __forceinline__ void attn_step(int j, int jbase, int tq, int W, const LAS unsigned char* kimg, const LAS unsigned char* vimg, int krd, int vrd, int r32, int hi,
                                                          const bf16x8 (&qf)[4], f32x16& o0, f32x16& o1, float& mrun, float& lrun) {
#define VTR(p, off) __builtin_bit_cast(s16x4, __builtin_amdgcn_ds_read_tr16_b64_v4i16((LAS s16x4*)((p) + (off))))
    bf16x8 kf[NT][4]; s16x4 va[NT][4], vb[NT][4];
#pragma unroll
    for (int t = 0; t < NT; ++t) {
        const LAS unsigned char* kl = kimg + (j + t - jbase) * 4096 + krd;
#pragma unroll
        for (int s = 0; s < 4; ++s) kf[t][s] = *(const LAS bf16x8*)(kl + (((2 * s + hi) ^ (r32 & 7)) * 16));
    }
#pragma unroll
    for (int t = 0; t < NT; ++t) {
        const LAS unsigned char* vl = vimg + (j + t - jbase) * 4096 + vrd;
#pragma unroll
        for (int q = 0; q < 4; ++q) { va[t][q] = VTR(vl, (16 * (q & 1)) * 128 + (q >> 1) * 64); vb[t][q] = VTR(vl, (16 * (q & 1) + 8) * 128 + (q >> 1) * 64); }
    }
    __builtin_amdgcn_sched_barrier(0);
    f32x16 sc[NT];
#pragma unroll
    for (int t = 0; t < NT; ++t) sc[t] = f32x16{};
#pragma unroll
    for (int s = 0; s < 4; ++s)
#pragma unroll
        for (int t = 0; t < NT; ++t) sc[t] = __builtin_amdgcn_mfma_f32_32x32x16_bf16(kf[t][s], qf[s], sc[t], 0, 0, 0);
#pragma unroll
    for (int t = 0; t < NT; ++t) {
        if (j + t == tq - W) {
#pragma unroll
            for (int g = 0; g < 16; ++g) if (crow(g, hi) < r32) sc[t][g] = -INFINITY;
        }
        if (j + t == tq + W) {
#pragma unroll
            for (int g = 0; g < 16; ++g) if (crow(g, hi) > r32) sc[t][g] = -INFINITY;
        }
    }
    float mx = -INFINITY;
#pragma unroll
    for (int t = 0; t < NT; ++t)
#pragma unroll
        for (int g = 0; g < 16; g += 4) mx = fmaxf(mx, fmaxf(fmaxf(sc[t][g], sc[t][g + 1]), fmaxf(sc[t][g + 2], sc[t][g + 3])));
    { const auto rr = __builtin_amdgcn_permlane32_swap(__float_as_uint(mx), __float_as_uint(mx), false, false); mx = fmaxf(__uint_as_float(rr[0]), __uint_as_float(rr[1])); }
    if (__any(mx > mrun + 8.0f)) {
        const float mnew = fmaxf(mrun, mx);
        const float alpha = fast_exp2(mrun - mnew);
        lrun *= alpha; mrun = mnew;
#pragma unroll
        for (int g = 0; g < 16; ++g) { o0[g] *= alpha; o1[g] *= alpha; }
    }
    float ps[4] = {0.f, 0.f, 0.f, 0.f};
#pragma unroll
    for (int t = 0; t < NT; ++t)
#pragma unroll
        for (int g = 0; g < 16; ++g) { sc[t][g] = fast_exp2(sc[t][g] - mrun); ps[g & 3] += sc[t][g]; }
    float psum = (ps[0] + ps[1]) + (ps[2] + ps[3]);
    { const auto rr = __builtin_amdgcn_permlane32_swap(__float_as_uint(psum), __float_as_uint(psum), false, false); psum = __uint_as_float(rr[0]) + __uint_as_float(rr[1]); }
    lrun += psum;
#define VFR(t, q) ((bf16x8){va[t][q][0], va[t][q][1], va[t][q][2], va[t][q][3], vb[t][q][0], vb[t][q][1], vb[t][q][2], vb[t][q][3]})
#pragma unroll
    for (int t = 0; t < NT; ++t) {
        u32x4 p0, p1;
        p0.x = cvtpk(sc[t][0], sc[t][1]); p0.y = cvtpk(sc[t][2], sc[t][3]); p0.z = cvtpk(sc[t][4], sc[t][5]); p0.w = cvtpk(sc[t][6], sc[t][7]);
        p1.x = cvtpk(sc[t][8], sc[t][9]); p1.y = cvtpk(sc[t][10], sc[t][11]); p1.z = cvtpk(sc[t][12], sc[t][13]); p1.w = cvtpk(sc[t][14], sc[t][15]);
        const bf16x8 pf0 = __builtin_bit_cast(bf16x8, p0), pf1 = __builtin_bit_cast(bf16x8, p1);
        o0 = __builtin_amdgcn_mfma_f32_32x32x16_bf16(VFR(t, 0), pf0, o0, 0, 0, 0);
        o1 = __builtin_amdgcn_mfma_f32_32x32x16_bf16(VFR(t, 2), pf0, o1, 0, 0, 0);
        o0 = __builtin_amdgcn_mfma_f32_32x32x16_bf16(VFR(t, 1), pf1, o0, 0, 0, 0);
        o1 = __builtin_amdgcn_mfma_f32_32x32x16_bf16(VFR(t, 3), pf1, o1, 0, 0, 0);
    }
#undef VFR
#undef VTR
}
__device__ __forceinline__ void attn_compute(const bf16* P, const AttnUnit& U, const bf16x8 (&qf)[4], LAS unsigned char* lds, LAS unsigned char* stg, int lane) {
    const int r32 = lane & 31, hi = lane >> 5;
    const int d = U.d, W = U.W, tq = U.tq;
    const int L32 = (SEQ / d) >> 5;
    const size_t tok0 = (size_t)U.b * SEQ + U.r;
    const int jbase = U.t0 - W, ntile = U.span + 2 * W;
    LAS unsigned char* kimg = lds; LAS unsigned char* vimg = lds + ntile * 4096;
    const size_t qtok = tok0 + (size_t)(32 * tq + r32) * d;
    f32x16 o0 = {}, o1 = {};
    float mrun = U.m0, lrun = U.l0;
    const int jlo = (tq - W) < 0 ? 0 : (tq - W), jhi = (tq + W) > (L32 - 1) ? (L32 - 1) : (tq + W);
    const int vrd = (4 * hi + ((lane & 15) >> 2)) * 128 + (16 * ((lane >> 4) & 1) + 4 * (lane & 3)) * 2;
    const int krd = r32 * 128;
    int j = jlo;
    for (; j + 1 <= jhi; j += 2) attn_step<2>(j, jbase, tq, W, kimg, vimg, krd, vrd, r32, hi, qf, o0, o1, mrun, lrun);
    if (j <= jhi) attn_step<1>(j, jbase, tq, W, kimg, vimg, krd, vrd, r32, hi, qf, o0, o1, mrun, lrun);
    const float inv = 1.0f / lrun;
#pragma unroll
    for (int g4 = 0; g4 < 4; ++g4) {
        u32x2 w0, w1;
        w0.x = cvtpk(o0[4 * g4] * inv, o0[4 * g4 + 1] * inv); w0.y = cvtpk(o0[4 * g4 + 2] * inv, o0[4 * g4 + 3] * inv);
        w1.x = cvtpk(o1[4 * g4] * inv, o1[4 * g4 + 1] * inv); w1.y = cvtpk(o1[4 * g4 + 2] * inv, o1[4 * g4 + 3] * inv);
        *(LAS u32x2*)(stg + r32 * 144 + (8 * g4 + 4 * hi) * 2) = w0;
        *(LAS u32x2*)(stg + r32 * 144 + 64 + (8 * g4 + 4 * hi) * 2) = w1;
    }
#pragma unroll
    for (int i = 0; i < 4; ++i) {
        const int row = i * 8 + (lane >> 3), ch = lane & 7;
        const u32x4 v = *(const LAS u32x4*)(stg + row * 144 + ch * 16);
        *(u32x4*)(U.outp + (tok0 + (size_t)(32 * tq + row) * d) * U.opitch + ch * 8) = v;
    }
    if (U.lsep && hi == 0) U.lsep[qtok * 12] = (mrun + log2f(lrun)) * LN2;
}
__device__ __forceinline__ void attn_phase(const Frame& F, CArgs a, int l) {
    const int lane = otid(), tid = F.wave * 64 + lane; (void)tid; (void)lane;
    unsigned char* ws = a->ws;
    const bf16* P = (const bf16*)(ws + WS_PQ);
    bf16* ya = (bf16*)(ws + WS_YAB) + 256; bf16* ob = (bf16*)a->out; float* lse = (float*)(ws + WS_LSE);
    const int r32 = lane & 31, hi = lane >> 5;
    u32x4 buf[12];
    LAS unsigned char* stg = F.lds + 98304 + F.wave * 4608;
    AttnUnit U = attn_decode(0, F.G, F.bx, F.wave, l, a, ya, ob, lse);
    if (U.valid) attn_fetch(P, U, tid, buf);
    for (int idx = 0; U.valid; ++idx) {
        attn_stage(U, tid, buf, F.lds);
        u32x4 qv[4];
#pragma unroll
        for (int i = 0; i < 4; ++i) { const int row = i * 8 + (lane >> 3), ch = lane & 7;
            qv[i] = *(const u32x4*)(P + ((size_t)U.b * SEQ + U.r + (size_t)(32 * U.tq + row) * U.d) * NQKV + U.qcol + ch * 8); }
        const AttnUnit Un = attn_decode(idx + 1, F.G, F.bx, F.wave, l, a, ya, ob, lse);
#pragma unroll
        for (int i = 0; i < 4; ++i) { const int row = i * 8 + (lane >> 3), ch = lane & 7; *(LAS u32x4*)(stg + row * 144 + ch * 16) = qv[i]; }
        bf16x8 qf[4];
#pragma unroll
        for (int s = 0; s < 4; ++s) qf[s] = *(const LAS bf16x8*)(stg + r32 * 144 + (2 * s + hi) * 16);
        __syncthreads();
        if (Un.valid) attn_fetch(P, Un, tid, buf);
        attn_compute(P, U, qf, F.lds, stg, lane);
        __syncthreads();
        U = Un;
    }
    prep_experts(F, a, l, lane, 0, F.gw, F.ngw);
    prep_experts(F, a, l, lane, 1, F.gw, F.ngw);
}
__device__ __forceinline__ void comb_rows(const Frame& F, CArgs a, int row0, int tid) {
    unsigned char* ws = a->ws;
    const bf16* ob = (const bf16*)a->out; const float* lse = (const float*)(ws + WS_LSE); bf16* yb = (bf16*)(ws + WS_YAB);
#pragma unroll 4
    for (int it = 0; it < 16; ++it) {
        const int idx = tid + it * NTHREADS;
        const int tok = row0 + (idx >> 5), c = idx & 31, h = c >> 3;
        const float l0 = lse[tok * 12 + h], l1 = lse[tok * 12 + 4 + h], l2 = lse[tok * 12 + 8 + h];
        const u32x4 a0 = *(const u32x4*)(ob + (size_t)tok * 768 + c * 8), a1 = *(const u32x4*)(ob + (size_t)tok * 768 + 256 + c * 8), a2 = *(const u32x4*)(ob + (size_t)tok * 768 + 512 + c * 8);
        const float mx = fmaxf(l0, fmaxf(l1, l2));
        float w0 = __expf(l0 - mx), w1 = __expf(l1 - mx), w2 = __expf(l2 - mx);
        const float inv = 1.0f / (w0 + w1 + w2); w0 *= inv; w1 *= inv; w2 *= inv;
        u32x4 o;
#define CMB(f) o.f = cvtpk(w0 * bflo(a0.f) + w1 * bflo(a1.f) + w2 * bflo(a2.f), w0 * bfhi(a0.f) + w1 * bfhi(a1.f) + w2 * bfhi(a2.f))
        CMB(x); CMB(y); CMB(z); CMB(w);
#undef CMB
        *(u32x4*)(yb + (size_t)tok * 768 + c * 8) = o;
    }
}

__device__ __forceinline__ void route_phase(const Frame& F, CArgs a, int l, unsigned* waitp) {
    const int lane = otid(), tid = F.wave * 64 + lane;
    unsigned char* ws = a->ws;
    const bf16* xbf = (const bf16*)(ws + WS_XB); const u32x4* wrh = (const u32x4*)(ws + WS_WR + l * WR_LSTRIDE); const u32x4* wrl = (const u32x4*)(ws + WS_WR + l * WR_LSTRIDE + WR_LO);
    float* rs2 = (float*)(ws + WS_RS2); i32x4* tokinfo = (i32x4*)(ws + WS_TOKINFO); int* ltok = (int*)(ws + WS_LTOK); float* lw = (float*)(ws + WS_LW);
    int* cnt = (int*)(ws + WS_CTL) + CW_CNT + l * 32 * CNT_STRIDE;
    const float* brg = a->b_rg + l * 4; const float* bre = a->b_re + l * NEXP;
    LAS f32x4* part = (LAS f32x4*)(F.lds);
    LAS float* ssp = (LAS float*)(F.lds + 12288);
    LAS float* Lg = (LAS float*)(F.lds + 16384);
    LAS float* rsL = (LAS float*)(F.lds + 16384 + 12288);
    LAS int* lcnt = (LAS int*)(F.lds + 16384 + 12288 + 256);
    LAS int* lbase = lcnt + 32;
    const int rt = F.wave & 3, kh = F.wave >> 2;
    if (tid < 32) lcnt[tid] = 0;
    __syncthreads();
    for (int blk = F.bx; blk < MTOK / 64; blk += F.G) {
        if (waitp) {
            if (F.wave == 0) {
                unsigned* p = waitp + (blk >> 2) * PAN_STRIDE; unsigned spins = 0;
                while ((unsigned)__builtin_amdgcn_readfirstlane(__hip_atomic_load(p, __ATOMIC_RELAXED, __HIP_MEMORY_SCOPE_AGENT)) < 32u) {
                    __builtin_amdgcn_s_sleep(2);
                    if (++spins > (1u << 22)) { __hip_atomic_store((unsigned*)(ws + WS_CTL) + CW_ERR, 3u, __ATOMIC_RELAXED, __HIP_MEMORY_SCOPE_AGENT); break; }
                }
                __builtin_amdgcn_fence(__ATOMIC_ACQUIRE, "agent");
                asm volatile("s_waitcnt vmcnt(0)" ::: "memory");
            }
            __syncthreads();
        }
        const int row0 = blk * 64 + rt * 16;
        const u32x4* xr = (const u32x4*)(xbf + (size_t)(row0 + (lane & 15)) * DM + kh * 512) + (lane >> 4);
        const u32x4* wh = wrh + (size_t)(kh * 16) * 3 * 64 + lane; const u32x4* wl = wrl + (size_t)(kh * 16) * 3 * 64 + lane;
        f32x4 acc0 = {0.f, 0.f, 0.f, 0.f}, acc1 = acc0, acc2 = acc0; float ss = 0.f;
#pragma unroll 4
        for (int i = 0; i < 16; ++i) {
            const u32x4 xw = xr[4 * i];
            const u32x4 h0 = wh[(i * 3 + 0) * 64], h1 = wh[(i * 3 + 1) * 64], h2 = wh[(i * 3 + 2) * 64], l0 = wl[(i * 3 + 0) * 64], l1 = wl[(i * 3 + 1) * 64], l2 = wl[(i * 3 + 2) * 64];
            const float xv[8] = {bflo(xw.x), bfhi(xw.x), bflo(xw.y), bfhi(xw.y), bflo(xw.z), bfhi(xw.z), bflo(xw.w), bfhi(xw.w)};
#pragma unroll
            for (int j = 0; j < 8; ++j) ss += xv[j] * xv[j];
            const bf16x8 xf = __builtin_bit_cast(bf16x8, xw);
            acc0 = __builtin_amdgcn_mfma_f32_16x16x32_bf16(xf, __builtin_bit_cast(bf16x8, l0), acc0, 0, 0, 0);
            acc1 = __builtin_amdgcn_mfma_f32_16x16x32_bf16(xf, __builtin_bit_cast(bf16x8, l1), acc1, 0, 0, 0);
            acc2 = __builtin_amdgcn_mfma_f32_16x16x32_bf16(xf, __builtin_bit_cast(bf16x8, l2), acc2, 0, 0, 0);
            acc0 = __builtin_amdgcn_mfma_f32_16x16x32_bf16(xf, __builtin_bit_cast(bf16x8, h0), acc0, 0, 0, 0);
            acc1 = __builtin_amdgcn_mfma_f32_16x16x32_bf16(xf, __builtin_bit_cast(bf16x8, h1), acc1, 0, 0, 0);
            acc2 = __builtin_amdgcn_mfma_f32_16x16x32_bf16(xf, __builtin_bit_cast(bf16x8, h2), acc2, 0, 0, 0);
        }
        ss += shx(ss, 16, lane); ss += shx(ss, 32, lane);
        if (kh == 1) { part[(rt * 3 + 0) * 64 + lane] = acc0; part[(rt * 3 + 1) * 64 + lane] = acc1; part[(rt * 3 + 2) * 64 + lane] = acc2; if (lane < 16) ssp[rt * 16 + lane] = ss; }
        __syncthreads();
        if (kh == 0) {
            acc0 += part[(rt * 3 + 0) * 64 + lane]; acc1 += part[(rt * 3 + 1) * 64 + lane]; acc2 += part[(rt * 3 + 2) * 64 + lane];
            ss += ssp[rt * 16 + (lane & 15)];
#pragma unroll
            for (int g = 0; g < 4; ++g) { const int rw = rt * 16 + 4 * (lane >> 4) + g; Lg[rw * 48 + (lane & 15)] = acc0[g]; Lg[rw * 48 + 16 + (lane & 15)] = acc1[g]; Lg[rw * 48 + 32 + (lane & 15)] = acc2[g]; }
            if (lane < 16) rsL[rt * 16 + lane] = 1.0f / sqrtf(ss * (1.0f / DM) + NORM_EPS);
        }
        __syncthreads();
        int e1 = 0, e2 = 0, r1 = 0, r2 = 0; float w1 = 0.f, w2 = 0.f, rsv = 0.f;
        if (tid < 64) {
            const LAS float* Lr = Lg + tid * 48; rsv = rsL[tid];
            float gl[4];
#pragma unroll
            for (int g = 0; g < 4; ++g) gl[g] = Lr[g] * rsv + brg[g];
            int gi = 0; float gm = gl[0];
#pragma unroll
            for (int g = 1; g < 4; ++g) if (gl[g] > gm) { gm = gl[g]; gi = g; }
            float den = 0.f;
#pragma unroll
            for (int g = 0; g < 4; ++g) den += expf(gl[g] - gm);
            const float gw = 1.0f / den;
            float v1 = -INFINITY, v2 = -INFINITY; int i1 = 0, i2 = 0;
#pragma unroll
            for (int e = 0; e < 8; ++e) {
                const float v = Lr[4 + 8 * gi + e] * rsv + bre[8 * gi + e];
                if (v > v1) { v2 = v1; i2 = i1; v1 = v; i1 = e; } else if (v > v2) { v2 = v; i2 = e; }
            }
            const float p1 = 1.0f / (1.0f + expf(v2 - v1));
            e1 = 8 * gi + i1; e2 = 8 * gi + i2; w1 = p1 * gw; w2 = (1.0f - p1) * gw;
            r1 = __hip_atomic_fetch_add(&lcnt[e1], 1, __ATOMIC_RELAXED, __HIP_MEMORY_SCOPE_WORKGROUP); r2 = __hip_atomic_fetch_add(&lcnt[e2], 1, __ATOMIC_RELAXED, __HIP_MEMORY_SCOPE_WORKGROUP);
        }
        __syncthreads();
        if (tid < 32) { const int c = lcnt[tid]; lbase[tid] = c ? atomicAdd(&cnt[tid * CNT_STRIDE], c) : 0; lcnt[tid] = 0; }
        __syncthreads();
        if (tid < 64) {
            const int tok = blk * 64 + tid;
            const int pos1 = lbase[e1] + r1, pos2 = lbase[e2] + r2;
            ltok[e1 * MTOK + pos1] = tok; lw[e1 * MTOK + pos1] = w1;
            ltok[e2 * MTOK + pos2] = tok; lw[e2 * MTOK + pos2] = w2;
            tokinfo[tok] = (i32x4){e1, pos1, e2, pos2};
            rs2[tok] = rsv;
        }
        __syncthreads();
    }
}
__device__ __forceinline__ MoeTab moe_tables(const Frame& F, CArgs a, int l) {
    const int lane = otid(), tid = F.wave * 64 + lane; (void)tid; (void)lane;
    volatile LAS int* cntL = F.misc + 64; volatile LAS int* mtp = F.misc + 128; volatile LAS int* sp = F.misc + 192;
    const int* cnt = (const int*)(a->ws + WS_CTL) + CW_CNT + l * 32 * CNT_STRIDE;
    __syncthreads();
    if (tid < 32) cntL[tid] = __hip_atomic_load(cnt + tid * CNT_STRIDE, __ATOMIC_RELAXED, __HIP_MEMORY_SCOPE_AGENT);
    __syncthreads();
    if (tid == 0) { int mt = 0, s = 0; for (int e = 0; e < 32; ++e) { mtp[e] = mt; sp[e] = s; const int c = cntL[e]; mt += (c + 255) >> 8; s += c; } mtp[32] = mt; sp[32] = s; }
    __syncthreads();
    MoeTab T; T.cnt = cntL; T.mtpref = mtp; T.spref = sp; return T;
}
__device__ __forceinline__ void fin_phase(const Frame& F, CArgs a, int l, const MoeTab& T) {
    const int lane = otid(), tid = F.wave * 64 + lane; (void)tid;
    unsigned char* ws = a->ws;
    const i32x4* tokinfo = (const i32x4*)(ws + WS_TOKINFO); const bf16* Y = (const bf16*)(ws + WS_Y);
    bf16* xb = (bf16*)(ws + WS_XB); float* rs1 = (float*)(ws + WS_RS1);
    const int step = 2 * F.ngw;
    int m0 = 2 * F.gw;
    i32x4 tn0 = tokinfo[m0 < MTOK ? m0 : 0], tn1 = tokinfo[m0 + 1 < MTOK ? m0 + 1 : 0];
    for (; m0 < MTOK; m0 += step) {
        const i32x4 ti[2] = {tn0, tn1};
        const int mn = m0 + step;
        if (mn < MTOK) { tn0 = tokinfo[mn]; tn1 = tokinfo[mn + 1]; }
        u32x4 xv[2][2], p[2][2], q[2][2];
#pragma unroll
        for (int r = 0; r < 2; ++r) {
            const int m = m0 + r;
            const int s1 = T.spref[ti[r][0]] + ti[r][1], s2 = T.spref[ti[r][2]] + ti[r][3];
            const u32x4* xr = (const u32x4*)(xb + (size_t)m * DM) + lane;
            const u32x4* y1 = (const u32x4*)(Y + (size_t)s1 * DM) + lane; const u32x4* y2 = (const u32x4*)(Y + (size_t)s2 * DM) + lane;
#pragma unroll
            for (int j = 0; j < 2; ++j) { xv[r][j] = xr[64 * j]; p[r][j] = y1[64 * j]; q[r][j] = y2[64 * j]; }
        }
#pragma unroll
        for (int r = 0; r < 2; ++r) {
            const int m = m0 + r;
            float v[2][8]; float s = 0.f;
#pragma unroll
            for (int j = 0; j < 2; ++j) {
#define FINC(c, f) v[j][2 * c] = bflo(xv[r][j].f) + bflo(p[r][j].f) + bflo(q[r][j].f); v[j][2 * c + 1] = bfhi(xv[r][j].f) + bfhi(p[r][j].f) + bfhi(q[r][j].f);
                FINC(0, x) FINC(1, y) FINC(2, z) FINC(3, w)
#undef FINC
#pragma unroll
                for (int c = 0; c < 8; ++c) s += v[j][c] * v[j][c];
            }
            s = wave_sum(s, lane);
            const float rsv = 1.0f / sqrtf(s * (1.0f / DM) + NORM_EPS);
            if (l == DEPTH - 1) {
#pragma unroll
                for (int j = 0; j < 2; ++j) {
                    const f32x4* g = (const f32x4*)(a->fin_g + 512 * j + 8 * lane); f32x4* o = (f32x4*)(a->out + (size_t)m * DM + 512 * j + 8 * lane);
                    const f32x4 g0 = g[0], g1 = g[1];
                    o[0] = (f32x4){v[j][0] * rsv * g0[0], v[j][1] * rsv * g0[1], v[j][2] * rsv * g0[2], v[j][3] * rsv * g0[3]};
                    o[1] = (f32x4){v[j][4] * rsv * g1[0], v[j][5] * rsv * g1[1], v[j][6] * rsv * g1[2], v[j][7] * rsv * g1[3]};
                }
            } else {
                u32x4* o = (u32x4*)(xb + (size_t)m * DM) + lane;
#pragma unroll
                for (int j = 0; j < 2; ++j) { u32x4 w; w.x = cvtpk(v[j][0], v[j][1]); w.y = cvtpk(v[j][2], v[j][3]); w.z = cvtpk(v[j][4], v[j][5]); w.w = cvtpk(v[j][6], v[j][7]); o[64 * j] = w; }
                if (lane == 0) rs1[m] = rsv;
            }
        }
    }
}

constexpr int PH_PREP = 0, PH_GEMM1 = 1, PH_ATTN = 2, PH_MID = 3, PH_MOE = 4, PH_FIN = 5, PH_PER_LAYER = 6, NPHASE = PH_PER_LAYER * DEPTH - 1;

__global__ void __launch_bounds__(NTHREADS, 2) fwd_kernel(Args a_by_value) {
    extern __shared__ __attribute__((aligned(16))) unsigned char lds_raw[];
    Frame F;
    F.lds = (LAS unsigned char*)lds_raw; F.misc = (volatile LAS int*)(F.lds + MISC_OFF);
    F.wave = __builtin_amdgcn_readfirstlane((int)threadIdx.x >> 6);
    F.G = gridDim.x; { const int bx = blockIdx.x; F.vcu = (F.G % 8 == 0) ? (bx % 8) * (F.G / 8) + bx / 8 : bx; }
    F.gw = blockIdx.x * NWAVES + F.wave; F.ngw = F.G * NWAVES;
    CArgs a = (CArgs)__builtin_amdgcn_kernarg_segment_ptr();
    unsigned char* ws = a->ws;
    const int ph_lo = a->ph_lo, ph_hi = a->ph_hi;
    for (int u = threadIdx.x; u < 1024; u += NTHREADS) F.misc[u] = 0;
    __syncthreads();
#if !MK_MULTI
    XcdBarrier bar = xcd_barrier_post((unsigned*)(ws + WS_CTL) + CW_BAR, (volatile LAS unsigned*)(F.misc + 8));
#define GRID_BAR() xcd_barrier(bar, F.wave)
#else
#define GRID_BAR() do { } while (0)
#endif
    for (int ph = ph_lo, rep = 0; ph < ph_hi; ) {
        const int l = ph >= PH_PER_LAYER ? 1 : 0, k = ph >= PH_PER_LAYER ? ph - (PH_PER_LAYER - 1) : ph;
        const size_t wlo = (size_t)l * WNE_LSTRIDE;
        {
            int bx = blockIdx.x; asm volatile("" : "+s"(bx)); asm volatile("" : "+s"(a)); ws = a->ws;
            int wv = F.wave; asm volatile("" : "+s"(wv)); F.gw = bx * NWAVES + wv; F.bx = bx;
        }
        if (k == PH_PREP && (PHMASK & 1)) {
            prep_phase(F, a);
        } else if (k == PH_GEMM1 && (PHMASK & 2)) {
            DenseSched S; S.A = (const char*)(ws + WS_XB); S.Bt = (const char*)(ws + wlo + WS_WIN); S.K = DM; S.lda = DM; S.ldb = DM; S.ksplit = 0; S.wave = F.wave; S.so.init(MTOK, DIN, F.G, F.bx); S.waitp = nullptr; S.need = 0; S.postp = nullptr; S.err = nullptr;
            EpiProj E{(bf16*)(ws + WS_PQ), (bf16*)(ws + WS_PG), (const float*)(ws + WS_RS1), (const f32x4*)(ws + WS_ROPE)};
            pg8::gemm_phase(F.lds, S, E);
        } else if (k == PH_ATTN && (PHMASK & 4)) {
            attn_phase(F, a, l);
        } else if (k == PH_MID) {
            unsigned* pan = (unsigned*)(ws + WS_CTL) + CW_PAN + l * 3 * 64 * PAN_STRIDE; unsigned* err = (unsigned*)(ws + WS_CTL) + CW_ERR;
            { pg8::StaticOrder so; so.init(MTOK, DM, F.G, F.bx); const int tid_ = F.wave * 64 + otid();
              for (int i = 0, pm, pn; so.next(i, pm, pn); ++i) comb_rows(F, a, pm * 256, tid_);
              VM_WAIT(); __syncthreads(); }
            { DenseSched S; S.A = (const char*)(ws + WS_YAB); S.Bt = (const char*)(ws + wlo + WS_WAB); S.K = 768; S.lda = 768; S.ldb = 768; S.ksplit = 256; S.wave = F.wave; S.so.init(MTOK, DM, F.G, F.bx);
              S.waitp = nullptr; S.need = 0; S.postp = pan; S.err = err;
              EpiMerge E{(const unsigned char*)(ws + WS_PG), (bf16*)(ws + WS_MRG)};
              pg8::gemm_phase(F.lds, S, E); }
            { DenseSched S; S.A = (const char*)(ws + WS_MRG); S.Bt = (const char*)(ws + wlo + WS_WOUT); S.K = DM; S.lda = DM; S.ldb = DM; S.ksplit = 0; S.wave = F.wave; S.so.init(MTOK, DM, F.G, F.bx);
              S.waitp = pan; S.need = 32; S.postp = pan + 64 * PAN_STRIDE; S.err = err;
              EpiResid E{(bf16*)(ws + WS_XB)};
              pg8::gemm_phase(F.lds, S, E); }
            route_phase(F, a, l, pan + 64 * PAN_STRIDE);
        } else if (k == PH_MOE) {
            const MoeTab T = moe_tables(F, a, l);
            const int mtT = T.mtpref[32], nU = 2 * mtT, nU1 = nU < F.G ? nU : F.G, nU2 = nU - nU1, tready = nU1 >> 1;
            const int bx = F.vcu;
            unsigned* upd = (unsigned*)(ws + WS_CTL) + CW_UPD + l * 256 * UPD_STRIDE; unsigned* err = (unsigned*)(ws + WS_CTL) + CW_ERR;
            MoeSched<true> SU; SU.A = (const char*)(ws + WS_XB); SU.Bt = (const char*)(ws + WS_WGU); SU.K = DM; SU.lda = DM; SU.ldb = DM; SU.wave = F.wave; SU.ntn = 2; SU.bstride_e = (size_t)512 * DM * 2; SU.ltok = (const int*)(ws + WS_LTOK); SU.T = T; SU.upd = upd; SU.err = err;
            MoeSched<false> SD; SD.A = (const char*)(ws + WS_H); SD.Bt = (const char*)(ws + WS_WD); SD.K = DEXP; SD.lda = DEXP; SD.ldb = DEXP; SD.wave = F.wave; SD.ntn = 4; SD.bstride_e = (size_t)DM * DEXP * 2; SD.ltok = nullptr; SD.T = T; SD.upd = upd; SD.err = err;
            EpiSwiglu EU{(const int*)(ws + WS_LTOK), (const float*)(ws + WS_LW), (const float*)(ws + WS_RS2), (bf16*)(ws + WS_H)};
            EpiY ED{(bf16*)(ws + WS_Y)};
            SU.G1 = F.G; SU.c1 = bx; SU.lo1 = 0; SU.hi1 = nU; SU.G2 = 1; SU.c2 = -1; SU.lo2 = 0; SU.hi2 = 0;
            pg8::gemm_phase(F.lds, SU, EU);
            SD.G1 = F.G - nU2; SD.c1 = bx - nU2; SD.lo1 = 0; SD.hi1 = 4 * tready; SD.G2 = F.G; SD.c2 = bx; SD.lo2 = 4 * tready; SD.hi2 = 4 * mtT;
            pg8::gemm_phase(F.lds, SD, ED);
        } else if (k == PH_FIN && (PHMASK & 512)) {
            const MoeTab T = moe_tables(F, a, l);
            fin_phase(F, a, l, T);
        }
#if REP_MASK
        if (l == 0 && ((REP_MASK >> k) & 1) && rep < REP_N) { ++rep; GRID_BAR(); continue; }
        rep = 0;
#endif
        if (ph + 1 < ph_hi) { GRID_BAR();
#ifdef EXTRA_BAR
            for (int eb = 0; eb < EXTRA_BAR; ++eb) GRID_BAR();
#endif
        }
        ++ph;
    }
}

extern "C" void kernel_launch(void* const* d_in, const int* in_sizes, int n_in, void* d_out, int out_size, void* d_ws, size_t ws_size, hipStream_t stream) {
    static int grid = 0;
    if (grid == 0) {
        if (n_in != 16 || out_size != MTOK * DM || ws_size < WS_END) { fprintf(stderr, "kernel_launch: unexpected shapes (n_in %d out %d ws %zu)\n", n_in, out_size, ws_size); grid = -1; return; }
        int dev = 0, cus = 0, per_cu = 0;
        if (hipGetDevice(&dev) != hipSuccess || hipDeviceGetAttribute(&cus, hipDeviceAttributeMultiprocessorCount, dev) != hipSuccess) { grid = -1; return; }
        if (hipFuncSetAttribute((const void*)fwd_kernel, hipFuncAttributeMaxDynamicSharedMemorySize, LDS_BYTES) != hipSuccess) { fprintf(stderr, "kernel_launch: hipFuncSetAttribute failed\n"); grid = -1; return; }
        if (hipOccupancyMaxActiveBlocksPerMultiprocessor(&per_cu, (const void*)fwd_kernel, NTHREADS, LDS_BYTES) != hipSuccess || per_cu < 1) { fprintf(stderr, "kernel_launch: occupancy query says %d\n", per_cu); (void)hipGetLastError(); }
        grid = cus;
    }
    if (grid < 0) return;
    (void)hipMemsetAsync((char*)d_ws + WS_CTL, 0, CTL_BYTES, stream);
    Args a{};
    a.x = (const float*)d_in[0]; a.attn_g = (const float*)d_in[1]; a.w_in = (const float*)d_in[2]; a.a_sink = (const float*)d_in[3]; a.w_a = (const float*)d_in[4]; a.w_b = (const float*)d_in[5];
    a.w_out = (const float*)d_in[6]; a.ffn_g = (const float*)d_in[7]; a.w_rg = (const float*)d_in[8]; a.b_rg = (const float*)d_in[9]; a.w_re = (const float*)d_in[10]; a.b_re = (const float*)d_in[11];
    a.w_eg = (const float*)d_in[12]; a.w_eu = (const float*)d_in[13]; a.w_ed = (const float*)d_in[14]; a.fin_g = (const float*)d_in[15];
    a.out = (float*)d_out; a.ws = (unsigned char*)d_ws;
#if MK_MULTI
    for (int ph = 0; ph < NPHASE; ++ph) { a.ph_lo = ph; a.ph_hi = ph + 1; hipLaunchKernelGGL(fwd_kernel, dim3(grid), dim3(NTHREADS), LDS_BYTES, stream, a); }
#else
    a.ph_lo = 0; a.ph_hi = NPHASE;
    void* kargs[] = {&a};
    const hipError_t le = hipLaunchCooperativeKernel((const void*)fwd_kernel, dim3(grid), dim3(NTHREADS), kargs, LDS_BYTES, stream);
    if (le != hipSuccess) fprintf(stderr, "kernel_launch: cooperative launch failed: %s (grid %d)\n", hipGetErrorString(le), grid);
#endif
}
```

```cpp
#include <hip/hip_runtime.h>
#include <hip/hip_cooperative_groups.h>
#include <cstdio>
#include <cstdint>
namespace cg = cooperative_groups;

#ifndef REP_MASK
#define REP_MASK 0
#define REP_N 2
#endif
#ifndef PHMASK
#define PHMASK 1023
#endif
#ifndef MK_MULTI
#define MK_MULTI 0
#endif

#define LAS __attribute__((address_space(3)))
#define GAS __attribute__((address_space(1)))
typedef unsigned short bf16;
typedef short bf16x8 __attribute__((ext_vector_type(8)));
typedef short s16x4 __attribute__((ext_vector_type(4)));
typedef float f32x2 __attribute__((ext_vector_type(2)));
typedef float f32x4 __attribute__((ext_vector_type(4)));
typedef float f32x16 __attribute__((ext_vector_type(16)));
typedef unsigned u32x2 __attribute__((ext_vector_type(2)));
typedef unsigned u32x4 __attribute__((ext_vector_type(4)));
typedef int i32x4 __attribute__((ext_vector_type(4)));
typedef __bf16 bf16x2_t __attribute__((ext_vector_type(2)));

constexpr int BATCH = 4, SEQ = 4096, DM = 1024, DEPTH = 2, MTOK = BATCH * SEQ;
constexpr int NQKV = 3072, NGATE = 2048, DIN = NQKV + NGATE;
constexpr int NEXP = 32, DEXP = 256;
constexpr float NORM_EPS = 1e-6f;
constexpr float LOG2E = 1.4426950408889634f, LN2 = 0.6931471805599453f;
constexpr float QSCALE = 0.125f * LOG2E;
constexpr int NWAVES = 8, NTHREADS = 512;

constexpr size_t MiB = 1u << 20;
constexpr size_t WS_CTL = 0, CTL_BYTES = 1 * MiB;
constexpr size_t WS_ROPE = 1 * MiB;
constexpr size_t WS_WR = 2 * MiB, WR_LSTRIDE = 512 * 1024, WR_LO = 256 * 1024;
constexpr size_t WS_RS1 = 3 * MiB, WS_RS2 = 3 * MiB + 65536;
constexpr size_t WS_TOKINFO = 5 * MiB;
constexpr size_t WS_LTOK = 6 * MiB, WS_LW = 8 * MiB;
constexpr size_t WS_LSE = 10 * MiB;
constexpr size_t WS_WIN = 12 * MiB, WS_WAB = 22 * MiB, WS_WOUT = 24 * MiB, WNE_LSTRIDE = 14 * MiB;
constexpr size_t WS_WGU = 40 * MiB, WS_WD = 72 * MiB;
constexpr size_t WS_XB = 88 * MiB;
constexpr size_t WS_YAB = 120 * MiB;
constexpr size_t WS_PQ = 144 * MiB;
constexpr size_t WS_MRG = 176 * MiB, WS_H = 208 * MiB;
constexpr size_t WS_PG = 240 * MiB;
constexpr size_t WS_Y = 240 * MiB;
constexpr size_t WS_END = 304 * MiB;
constexpr int CW_CNT = 64, CNT_STRIDE = 64;
constexpr int CW_BAR = 8192;
constexpr int CW_UPD = 32768, UPD_STRIDE = 64;
constexpr int CW_ERR = 32;
constexpr int CW_PAN = 65536, PAN_STRIDE = 64;

constexpr int RING_BYTES = 131072;
constexpr int PREP_SCR = 16896;
constexpr int MISC_OFF = 8 * PREP_SCR;
constexpr int LDS_BYTES = 147456;

#define LDS_WAIT() asm volatile("s_waitcnt lgkmcnt(0)" ::: "memory")
#define VM_WAIT() asm volatile("s_waitcnt vmcnt(0)" ::: "memory")
__device__ __forceinline__ unsigned cvtpk(float lo, float hi) { f32x2 v = {lo, hi}; bf16x2_t b = __builtin_convertvector(v, bf16x2_t); return __builtin_bit_cast(unsigned, b); }
__device__ __forceinline__ float bf2f(unsigned short h) { return __uint_as_float(((unsigned)h) << 16); }
__device__ __forceinline__ float bflo(unsigned w) { return __uint_as_float(w << 16); }
__device__ __forceinline__ float bfhi(unsigned w) { return __uint_as_float(w & 0xffff0000u); }
__device__ __forceinline__ float fast_exp2(float x) { return __builtin_amdgcn_exp2f(x); }
__device__ __forceinline__ float fast_rcp(float x) { return __builtin_amdgcn_rcpf(x); }
__device__ __forceinline__ void store16_sc1(void* p, u32x4 v) { asm volatile("global_store_dwordx4 %0, %1, off sc1\n\ts_nop 1" :: "v"(p), "v"(v) : "memory"); }
__device__ __forceinline__ int olane() { unsigned z = 0u; asm volatile("" : "+v"(z)); return (int)__builtin_amdgcn_mbcnt_hi(~0u, __builtin_amdgcn_mbcnt_lo(~0u, z)); }
__device__ __forceinline__ float sigmoidf_fast(float v) { return fast_rcp(1.0f + fast_exp2(-v * LOG2E)); }

namespace pg8 {
constexpr int BM = 256, BK = 64, HALF = 128, HTB = HALF * BK * 2, STAGE_BYTES = 8 * HTB, NXCD = 8, WGM = 4;
__host__ __device__ __forceinline__ int lds_byte(int r, int c) { const int st = (r >> 4) * 2 + (c >> 5), rr = r & 15, cc = c & 31, ob = rr * 64 + cc * 2; return st * 1024 + (ob ^ (((ob >> 9) & 1) << 5)); }
__host__ __device__ __forceinline__ void stage_rc(int b, int& R, int& C) { const int st = b / 1024, sb = b % 1024, swz = sb ^ (((sb >> 9) & 1) << 5); R = (st >> 1) * 16 + swz / 64; C = (st & 1) * 32 + (swz % 64) / 2; }
__host__ __device__ __forceinline__ int perm32(int rho) { const int n = rho >> 4, i = rho & 15; return 8 * (i >> 2) + 4 * n + (i & 3); }

struct Unit { int pm, pn, e, nvalid, slot0, lpos0, nt, kofs, sub, waitk; };

struct StaticOrder {
    int nM, nN, nwg, G, c;
    __device__ void init(int M, int N, int G_, int c_) { nM = M / BM; nN = N / BM; nwg = nM * nN; G = G_; c = c_; }
    __device__ bool next(int i, int& pm, int& pn) const {
        const long L = (long)i * G + c; if (L >= nwg) return false;
        int wgid = (int)L; { const int q = nwg / NXCD, r = nwg % NXCD, xcd = wgid % NXCD, off = wgid / NXCD; wgid = (xcd < r ? xcd * (q + 1) : r * (q + 1) + (xcd - r) * q) + off; }
        const int nig = WGM * nN, gid = wgid / nig, fm = gid * WGM, gsz = (nM - fm) < WGM ? (nM - fm) : WGM;
        pm = fm + ((wgid % nig) % gsz); pn = (wgid % nig) / gsz; return true;
    }
};

template <class Epi, class Sched>
__device__ __forceinline__ void gemm_phase(LAS unsigned char* lds, const Sched& S, const Epi& E) {
    unsigned z_ = 0u; asm volatile("" : "+v"(z_)); const int tid_ = (int)__builtin_amdgcn_mbcnt_hi(~0u, __builtin_amdgcn_mbcnt_lo(~0u, z_)) + S.wave * 64;
    const int tid = tid_, wid = S.wave, lane = tid & 63, wr = wid >> 2, wc = wid & 3, fr = lane & 15, fq = lane >> 4;
    const int K = S.ldb;
    unsigned voffA[2], voffB[2];
#pragma unroll
    for (int i = 0; i < 2; ++i) { int R, C; stage_rc(tid * 16 + i * 8192, R, C); const int Rb = Epi::PERM ? ((R & ~31) + perm32(R & 31)) : R;
        voffA[i] = (unsigned)(R * S.lda + C) * 2u; voffB[i] = (unsigned)(Rb * K + C) * 2u; }
    const size_t kstep = (size_t)(BK * 2);
    const size_t hstepB = (size_t)HALF * K * 2, hstepA = (size_t)HALF * S.lda * 2;
    const unsigned ldsw = (unsigned)wid * 1024u;
    const int aoff = lds_byte(wr * 64 + fr, fq * 8), boff = lds_byte(wc * 32 + fr, fq * 8);
#define PG8_SA(b, h) (((b) * 2 + (h)) * HTB)
#define PG8_SB(b, h) ((4 + (b) * 2 + (h)) * HTB)
#define PG8_GLDS(src, dstoff) __builtin_amdgcn_global_load_lds((const unsigned*)(src), (LAS unsigned*)(lds + (dstoff)), 16, 0, 0)
#define PG8_STAGE_A(bufoff, up, h, VO) do { if constexpr (Sched::GATHER) { _Pragma("unroll") for (int _i = 0; _i < 2; ++_i) PG8_GLDS((up) + VO[_i], (bufoff) + ldsw + _i * 8192); } \
        else { const char* _b = (up) + (size_t)(h) * hstepA; _Pragma("unroll") for (int _i = 0; _i < 2; ++_i) PG8_GLDS(_b + voffA[_i], (bufoff) + ldsw + _i * 8192); } } while (0)
#define PG8_STAGE_B(bufoff, bp) do { _Pragma("unroll") for (int _i = 0; _i < 2; ++_i) PG8_GLDS((bp) + voffB[_i], (bufoff) + ldsw + _i * 8192); } while (0)
#define PG8_LDA(dst, b, h) do { _Pragma("unroll") for (int m = 0; m < 4; ++m) _Pragma("unroll") for (int k = 0; k < 2; ++k) dst[m][k] = *(const LAS bf16x8*)(lds + PG8_SA(b, h) + aoff + m * 2048 + k * 1024); } while (0)
#define PG8_LDB(dst, b, h) do { _Pragma("unroll") for (int n = 0; n < 2; ++n) _Pragma("unroll") for (int k = 0; k < 2; ++k) dst[n][k] = *(const LAS bf16x8*)(lds + PG8_SB(b, h) + boff + n * 2048 + k * 1024); } while (0)
#define PG8_MMA(ai, bj, At, Bt) do { __builtin_amdgcn_s_setprio(1); _Pragma("unroll") for (int m = 0; m < 4; ++m) _Pragma("unroll") for (int n = 0; n < 2; ++n) _Pragma("unroll") for (int k = 0; k < 2; ++k) \
        acc[ai][bj][m][n] = __builtin_amdgcn_mfma_f32_16x16x32_bf16(Bt[n][k], At[m][k], acc[ai][bj][m][n], 0, 0, 0); __builtin_amdgcn_s_setprio(0); } while (0)
#define PG8_WAIT_V(n) asm volatile("s_waitcnt vmcnt(" #n ")" ::: "memory")
#define PG8_WAIT_L(n) asm volatile("s_waitcnt lgkmcnt(" #n ")" ::: "memory")
#define PG8_BAR __builtin_amdgcn_s_barrier()
#define PG8_SCHED __builtin_amdgcn_sched_barrier(0)
    Unit cur, nxt; int ui = 0;
    if (!S.next(0, cur)) return;
    f32x4 acc[2][2][4][2];
#pragma unroll
    for (int a = 0; a < 2; ++a)
#pragma unroll
        for (int b = 0; b < 2; ++b)
#pragma unroll
            for (int m = 0; m < 4; ++m)
#pragma unroll
                for (int n = 0; n < 2; ++n) acc[a][b][m][n] = (f32x4){0.f, 0.f, 0.f, 0.f};
    bf16x8 At[4][2], B0[2][2], B1[2][2];
    const char* Ab = S.a_base();
    const char* cA = Ab; const char* cB = S.b_base(cur);
    unsigned vF0[2], vF1[2], vK[2];
    if constexpr (Sched::GATHER) {
#pragma unroll
        for (int i = 0; i < 2; ++i) { int R, C; stage_rc(tid * 16 + i * 8192, R, C); vF0[i] = S.a_off(cur, R) + (unsigned)(C * 2); vF1[i] = S.a_off(cur, HALF + R) + (unsigned)(C * 2); vK[i] = vF1[i]; }
    } else cA = Ab + S.a_unit_off(cur);
    S.a_ready(cur);
    PG8_STAGE_B(PG8_SB(0, 0), cB); PG8_STAGE_B(PG8_SB(0, 1), cB + hstepB); PG8_STAGE_A(PG8_SA(0, 0), cA, 0, vF0); PG8_STAGE_A(PG8_SA(0, 1), cA, 1, vF1);
    if (wr == 1) PG8_BAR;
    PG8_WAIT_V(2); PG8_BAR;
    PG8_STAGE_B(PG8_SB(1, 0), cB + kstep); PG8_STAGE_A(PG8_SA(1, 0), cA + kstep, 0, vF0); PG8_STAGE_B(PG8_SB(1, 1), cB + hstepB + kstep);
    PG8_WAIT_V(6); PG8_BAR;
    for (;;) {
        const bool has_next = S.next(ui + 1, nxt);
        const char* nA = cA; const char* nB = cB;
        if (has_next) { nB = S.b_base(nxt); if constexpr (!Sched::GATHER) nA = Ab + S.a_unit_off(nxt); }
        const int nt = cur.nt;
#pragma unroll 1
        for (int t = 0; t < nt; t += 2) {
            const bool last = (t == nt - 2);
            if (last && has_next) S.a_ready(nxt);
            const char* a1 = cA + (size_t)(t + 1) * kstep;
            const char* a2 = last ? nA : cA + (size_t)(t + 2) * kstep; const char* b2 = last ? nB : cB + (size_t)(t + 2) * kstep;
            const char* a3 = a2 + kstep; const char* b3 = b2 + kstep;
            if constexpr (Sched::GATHER) {
                if (last && has_next) {
#pragma unroll
                    for (int i = 0; i < 2; ++i) { int R, C; stage_rc(tid * 16 + i * 8192, R, C); vF0[i] = S.a_off(nxt, R) + (unsigned)(C * 2); vF1[i] = S.a_off(nxt, HALF + R) + (unsigned)(C * 2); }
                }
            }
            PG8_LDB(B0, 0, 0); PG8_LDB(B1, 0, 1); PG8_SCHED; PG8_LDA(At, 0, 0); PG8_STAGE_A(PG8_SA(1, 1), a1, 1, vK);
            PG8_WAIT_V(8); PG8_WAIT_L(0); PG8_BAR; PG8_MMA(0, 0, At, B0); PG8_MMA(0, 1, At, B1); PG8_BAR; PG8_SCHED;
            PG8_LDA(At, 0, 1); PG8_STAGE_B(PG8_SB(0, 0), b2); PG8_STAGE_B(PG8_SB(0, 1), b2 + hstepB); PG8_STAGE_A(PG8_SA(0, 0), a2, 0, vF0);
            PG8_WAIT_V(8); PG8_WAIT_L(0); PG8_BAR; PG8_MMA(1, 0, At, B0); PG8_MMA(1, 1, At, B1); PG8_BAR; PG8_SCHED;
            PG8_LDB(B0, 1, 0); PG8_LDB(B1, 1, 1); PG8_SCHED; PG8_LDA(At, 1, 0); PG8_STAGE_A(PG8_SA(0, 1), a2, 1, vF1);
            PG8_WAIT_V(8); PG8_WAIT_L(0); PG8_BAR; PG8_MMA(0, 0, At, B0); PG8_MMA(0, 1, At, B1); PG8_BAR; PG8_SCHED;
            PG8_LDA(At, 1, 1); PG8_STAGE_B(PG8_SB(1, 0), b3); PG8_STAGE_B(PG8_SB(1, 1), b3 + hstepB); PG8_STAGE_A(PG8_SA(1, 0), a3, 0, vF0);
            PG8_WAIT_V(8); PG8_WAIT_L(0); PG8_BAR; PG8_MMA(1, 0, At, B0); PG8_MMA(1, 1, At, B1); PG8_BAR; PG8_SCHED;
        }
        if (wr == 0) PG8_BAR;
        bool keep = false;
        if constexpr (Epi::HAS_MID) { if (cur.sub == 0) { E.mid(acc, cur, wr, wc, fr, fq); keep = true; } else E(acc, cur, wr, wc, fr, fq); }
        else E(acc, cur, wr, wc, fr, fq);
        S.done(cur);
        if (!has_next) break;
        if (!keep) {
#pragma unroll
        for (int a = 0; a < 2; ++a)
#pragma unroll
            for (int b = 0; b < 2; ++b)
#pragma unroll
                for (int m = 0; m < 4; ++m)
#pragma unroll
                    for (int n = 0; n < 2; ++n) acc[a][b][m][n] = (f32x4){0.f, 0.f, 0.f, 0.f};
        }
        cur = nxt; cA = nA; cB = nB; ++ui;
        if constexpr (Sched::GATHER) { vK[0] = vF1[0]; vK[1] = vF1[1]; }
        if (wr == 1) PG8_BAR;
    }
    PG8_WAIT_V(0);
    PG8_BAR;
#undef PG8_SA
#undef PG8_SB
#undef PG8_GLDS
#undef PG8_STAGE_A
#undef PG8_STAGE_B
#undef PG8_LDA
#undef PG8_LDB
#undef PG8_MMA
#undef PG8_WAIT_V
#undef PG8_WAIT_L
#undef PG8_BAR
#undef PG8_SCHED
}
}
using pg8::Unit;

struct DenseSched {
    static constexpr bool GATHER = false;
    const char* A; const char* Bt; int K; int lda; int ldb; int wave; int ksplit; pg8::StaticOrder so;
    __device__ __forceinline__ bool next(int i, Unit& u) const {
        int pm, pn; const int ti = ksplit ? (i >> 1) : i; if (!so.next(ti, pm, pn)) return false;
        u.pm = pm; u.pn = pn; u.e = 0; u.nvalid = 256; u.slot0 = pm * 256; u.lpos0 = 0; u.waitk = 1;
        if (ksplit) { u.sub = i & 1; u.kofs = u.sub ? ksplit : 0; u.nt = (u.sub ? K - ksplit : ksplit) / 64; } else { u.sub = 1; u.kofs = 0; u.nt = K / 64; }
        return true; }
    __device__ __forceinline__ const char* a_base() const { return A; }
    __device__ __forceinline__ unsigned a_off(const Unit& u, int r) const { return 0u; }
    __device__ __forceinline__ size_t a_unit_off(const Unit& u) const { return ((size_t)u.pm * 256 * lda + u.kofs) * 2; }
    __device__ __forceinline__ const char* b_base(const Unit& u) const { return Bt + ((size_t)u.pn * 256 * ldb + u.kofs) * 2; }
    unsigned* waitp; unsigned need; unsigned* postp; unsigned* err;
    __device__ __forceinline__ void a_ready(const Unit& u) const {
        if (waitp) {
            if (wave == 0) {
                unsigned* p = waitp + u.pm * PAN_STRIDE; unsigned spins = 0;
                while ((unsigned)__builtin_amdgcn_readfirstlane(__hip_atomic_load(p, __ATOMIC_RELAXED, __HIP_MEMORY_SCOPE_AGENT)) < need) {
                    __builtin_amdgcn_s_sleep(2);
                    if (++spins > (1u << 22)) { __hip_atomic_store(err, 2u, __ATOMIC_RELAXED, __HIP_MEMORY_SCOPE_AGENT); break; }
                }
                __builtin_amdgcn_fence(__ATOMIC_ACQUIRE, "agent");
                asm volatile("s_waitcnt vmcnt(0)" ::: "memory");
            }
            asm volatile("" ::: "memory"); __builtin_amdgcn_s_barrier(); asm volatile("" ::: "memory");
        }
    }
    __device__ __forceinline__ void done(const Unit& u) const {
        if (postp && u.sub == 1) {
            asm volatile("s_waitcnt vmcnt(0)" ::: "memory");
            if (olane() == 0) __hip_atomic_fetch_add(postp + u.pm * PAN_STRIDE, 1u, __ATOMIC_RELAXED, __HIP_MEMORY_SCOPE_AGENT);
        }
    }
};
struct MoeTab { const volatile LAS int* cnt; const volatile LAS int* mtpref; const volatile LAS int* spref; };
template <bool GATHER_> struct MoeSched {
    static constexpr bool GATHER = GATHER_;
    const char* A; const char* Bt; int K; int lda; int ldb; int wave; int ntn; size_t bstride_e; const int* ltok; MoeTab T;
    int G1, c1, lo1, hi1, G2, c2, lo2, hi2; unsigned* upd; unsigned* err;
    __device__ __forceinline__ bool next(int i, Unit& u) const {
        int L;
        const int n1 = (c1 >= 0 && lo1 + c1 < hi1) ? (hi1 - lo1 - c1 + G1 - 1) / G1 : 0;
        if (i < n1) { L = lo1 + c1 + i * G1; u.waitk = (i == 0) ? 2 : 0; }
        else { L = lo2 + c2 + (i - n1) * G2; if (c2 < 0 || L >= hi2) return false; u.waitk = 1; }
        const int tix = L / ntn; u.pn = L - tix * ntn; u.pm = tix;
        int e = 0;
#pragma unroll 1
        for (int k = 1; k < 32; ++k) if (T.mtpref[k] <= tix) e = k;
        const int mt = tix - T.mtpref[e]; u.e = e; u.slot0 = T.spref[e] + 256 * mt; const int rem = T.cnt[e] - 256 * mt; u.nvalid = rem < 256 ? rem : 256; u.lpos0 = e * MTOK + 256 * mt; u.nt = K / 64; u.kofs = 0; u.sub = 1; return true;
    }
    __device__ __forceinline__ const char* a_base() const { return A; }
    __device__ __forceinline__ unsigned a_off(const Unit& u, int r) const { const int rr = r < u.nvalid ? r : u.nvalid - 1; return (unsigned)ltok[u.lpos0 + rr] * (unsigned)(lda * 2); }
    __device__ __forceinline__ size_t a_unit_off(const Unit& u) const { return (size_t)u.slot0 * lda * 2; }
    __device__ __forceinline__ const char* b_base(const Unit& u) const { return Bt + (size_t)u.e * bstride_e + (size_t)u.pn * 256 * K * 2; }
    __device__ __forceinline__ void a_ready(const Unit& u) const {
        if constexpr (!GATHER_) {
            if (u.waitk == 0) return;
            if (wave == 0) {
                const int n1 = (c1 >= 0 && lo1 + c1 < hi1) ? (hi1 - lo1 - c1 + G1 - 1) / G1 : 0;
                const int nw = (u.waitk == 2) ? n1 : 1;
                unsigned spins = 0;
                for (int q = 0; q < nw; ++q) {
                    const int tix = (u.waitk == 2) ? (lo1 + c1 + q * G1) / ntn : u.pm;
                    unsigned* p = upd + tix * UPD_STRIDE;
                    while ((unsigned)__builtin_amdgcn_readfirstlane(__hip_atomic_load(p, __ATOMIC_RELAXED, __HIP_MEMORY_SCOPE_AGENT)) < 16u) {
                        __builtin_amdgcn_s_sleep(2);
                        if (++spins > (1u << 22)) { __hip_atomic_store(err, 1u, __ATOMIC_RELAXED, __HIP_MEMORY_SCOPE_AGENT); break; }
                    }
                }
                __builtin_amdgcn_fence(__ATOMIC_ACQUIRE, "agent");
                asm volatile("s_waitcnt vmcnt(0)" ::: "memory");
            }
            asm volatile("" ::: "memory"); __builtin_amdgcn_s_barrier(); asm volatile("" ::: "memory");
        }
    }
    __device__ __forceinline__ void done(const Unit& u) const {
        if constexpr (GATHER_) {
            asm volatile("s_waitcnt vmcnt(0)" ::: "memory");
            if (olane() == 0) __hip_atomic_fetch_add(upd + u.pm * UPD_STRIDE, 1u, __ATOMIC_RELAXED, __HIP_MEMORY_SCOPE_AGENT);
        }
    }
};

#define OPAQUE(p) asm volatile("" : "+v"(p))
struct EpiProj {
    static constexpr bool PERM = true, REPEAT = true, HAS_MID = false;
    bf16* Pq; bf16* Pg; const float* rs; const f32x4* rope;
    __device__ __forceinline__ static void rot(f32x4& c, const f32x4& st) {
        const f32x4 o = c;
        c[0] = o[0] * st[0] - o[1] * st[1]; c[1] = o[1] * st[0] + o[0] * st[1];
        c[2] = o[2] * st[2] - o[3] * st[3]; c[3] = o[3] * st[2] + o[2] * st[3];
    }
    __device__ __forceinline__ void operator()(const f32x4 (&acc)[2][2][4][2], const Unit& u, int wr, int wc, int fr, int fq) const {
        const int colh = wc * 32 + fq * 8;
        const int ib = (colh & 63) >> 2;
        const int row0 = u.pm * 256 + wr * 64 + fr;
        int mode[2]; bf16* ob[2]; size_t ostep[2];
#pragma unroll
        for (int bj = 0; bj < 2; ++bj) {
            const int h128 = 2 * u.pn + bj;
            if (h128 >= 24) mode[bj] = 3;
            else if (h128 < 6) mode[bj] = h128 < 4 ? 1 : (h128 == 4 ? 2 : 0);
            else { const int j = (h128 - 6) % 6; mode[bj] = j < 2 ? 1 : (j < 4 ? 2 : 0); }
            if (h128 < 24) { ob[bj] = Pq + h128 * 128 + colh + (size_t)row0 * NQKV; ostep[bj] = (size_t)NQKV * 16; }
            else { ob[bj] = Pg + (((h128 - 24) * 128 + colh) >> 1) + (size_t)row0 * (NGATE / 2); ostep[bj] = (size_t)(NGATE / 2) * 16; }
        }
        float rsv[8];
#pragma unroll
        for (int i = 0; i < 8; ++i) rsv[i] = rs[row0 + (i >> 2) * 128 + (i & 3) * 16];
        const f32x4* rp = rope + (size_t)(row0 & (SEQ - 1)) * 16 + ib;
        f32x4 c0 = rp[0], c1 = rp[1];
        const f32x4 s16a = rope[16 * 16 + ib], s16b = rope[16 * 16 + ib + 1], s80a = rope[80 * 16 + ib], s80b = rope[80 * 16 + ib + 1];
#pragma unroll
        for (int ai = 0; ai < 2; ++ai)
#pragma unroll
            for (int m = 0; m < 4; ++m) {
                OPAQUE(ob[0]); OPAQUE(ob[1]);
                const float s = rsv[ai * 4 + m];
#pragma unroll
                for (int bj = 0; bj < 2; ++bj) {
                    f32x4 v0 = acc[ai][bj][m][0] * s, v1 = acc[ai][bj][m][1] * s;
                    if (mode[bj] == 1 || mode[bj] == 2) {
                        f32x4 o0, o1;
                        o0[0] = v0[0] * c0[0] - v0[1] * c0[1]; o0[1] = v0[1] * c0[0] + v0[0] * c0[1];
                        o0[2] = v0[2] * c0[2] - v0[3] * c0[3]; o0[3] = v0[3] * c0[2] + v0[2] * c0[3];
                        o1[0] = v1[0] * c1[0] - v1[1] * c1[1]; o1[1] = v1[1] * c1[0] + v1[0] * c1[1];
                        o1[2] = v1[2] * c1[2] - v1[3] * c1[3]; o1[3] = v1[3] * c1[2] + v1[2] * c1[3];
                        const float qs = (mode[bj] == 1) ? QSCALE : 1.0f;
                        v0 = o0 * qs; v1 = o1 * qs;
                    } else if (mode[bj] == 3) {
#pragma unroll
                        for (int j = 0; j < 4; ++j) { v0[j] = sigmoidf_fast(v0[j]); v1[j] = sigmoidf_fast(v1[j]); }
                    }
                    if (mode[bj] == 3) {
                        unsigned q[8];
#pragma unroll
                        for (int j = 0; j < 4; ++j) { q[j] = (unsigned)fminf(v0[j] * 256.0f, 255.0f); q[4 + j] = (unsigned)fminf(v1[j] * 256.0f, 255.0f); }
                        u32x2 w; w.x = q[0] | (q[1] << 8) | (q[2] << 16) | (q[3] << 24); w.y = q[4] | (q[5] << 8) | (q[6] << 16) | (q[7] << 24);
                        *(u32x2*)(ob[bj]) = w;
                    } else {
                        u32x4 w; w.x = cvtpk(v0[0], v0[1]); w.y = cvtpk(v0[2], v0[3]); w.z = cvtpk(v1[0], v1[1]); w.w = cvtpk(v1[2], v1[3]);
                        *(u32x4*)(ob[bj]) = w;
                    }
                }
                if (m == 3) { rot(c0, s80a); rot(c1, s80b); } else { rot(c0, s16a); rot(c1, s16b); }
                const int adv = (m == 3) ? 5 : 1;
                ob[0] += ostep[0] * adv; ob[1] += ostep[1] * adv;
            }
    }
};
struct EpiMerge {
    static constexpr bool PERM = true, REPEAT = false, HAS_MID = true;
    const unsigned char* gate; bf16* out;
    __device__ __forceinline__ static float dq(unsigned w, int k) { return ((float)((w >> (8 * k)) & 255u) + 0.5f) * (1.0f / 256.0f); }
    __device__ __forceinline__ void mid(f32x4 (&acc)[2][2][4][2], const Unit& u, int wr, int wc, int fr, int fq) const {
        const int row0 = u.pm * 256 + wr * 64 + fr, col0 = u.pn * 256 + wc * 32 + fq * 8;
        const unsigned char* gp = gate + (size_t)row0 * NGATE + col0;
        u32x2 ga[2][2], gb[2][2];
#define EM_LOAD(slot, i) do { const size_t ro = (size_t)(16 * (i) + 64 * ((i) >> 2)) * NGATE; ga[slot][0] = *(const u32x2*)(gp + ro); ga[slot][1] = *(const u32x2*)(gp + ro + 128); \
        gb[slot][0] = *(const u32x2*)(gp + ro + 1024); gb[slot][1] = *(const u32x2*)(gp + ro + 1024 + 128); } while (0)
        EM_LOAD(0, 0);
#pragma unroll
        for (int i = 0; i < 8; ++i) {
            const int ai = i >> 2, m = i & 3, sl = i & 1;
            if (i + 1 < 8) { if (sl == 0) EM_LOAD(1, i + 1); else EM_LOAD(0, i + 1); }
#pragma unroll
            for (int bj = 0; bj < 2; ++bj) {
                const u32x2 A = ga[sl][bj], B = gb[sl][bj];
#pragma unroll
                for (int j = 0; j < 4; ++j) {
                    acc[ai][bj][m][0][j] *= dq(B.x, j) * fast_rcp(dq(A.x, j));
                    acc[ai][bj][m][1][j] *= dq(B.y, j) * fast_rcp(dq(A.y, j));
                }
            }
        }
#undef EM_LOAD
    }
    __device__ __forceinline__ void operator()(const f32x4 (&acc)[2][2][4][2], const Unit& u, int wr, int wc, int fr, int fq) const {
        const int row0 = u.pm * 256 + wr * 64 + fr, col0 = u.pn * 256 + wc * 32 + fq * 8;
        const unsigned char* gp = gate + (size_t)row0 * NGATE + col0; bf16* op = out + (size_t)row0 * DM + col0;
        u32x2 ga[2][2];
#define EF_LOAD(slot, i) do { const size_t ro = (size_t)(16 * (i) + 64 * ((i) >> 2)) * NGATE; ga[slot][0] = *(const u32x2*)(gp + ro); ga[slot][1] = *(const u32x2*)(gp + ro + 128); } while (0)
        EF_LOAD(0, 0);
#pragma unroll
        for (int i = 0; i < 8; ++i) {
            const int ai = i >> 2, m = i & 3, sl = i & 1;
            if (i + 1 < 8) { if (sl == 0) EF_LOAD(1, i + 1); else EF_LOAD(0, i + 1); }
            bf16* orow = op + (size_t)(16 * i + 64 * (i >> 2)) * DM;
#pragma unroll
            for (int bj = 0; bj < 2; ++bj) {
                const u32x2 A = ga[sl][bj];
                const f32x4 a0 = acc[ai][bj][m][0], a1 = acc[ai][bj][m][1];
                u32x4 w;
                w.x = cvtpk(a0[0] * dq(A.x, 0), a0[1] * dq(A.x, 1)); w.y = cvtpk(a0[2] * dq(A.x, 2), a0[3] * dq(A.x, 3));
                w.z = cvtpk(a1[0] * dq(A.y, 0), a1[1] * dq(A.y, 1)); w.w = cvtpk(a1[2] * dq(A.y, 2), a1[3] * dq(A.y, 3));
                store16_sc1(orow + bj * 128, w);
            }
            asm volatile("" ::: "memory");
        }
#undef EF_LOAD
    }
};
struct EpiResid {
    static constexpr bool PERM = true, REPEAT = false, HAS_MID = false;
    bf16* xb;
    __device__ __forceinline__ void operator()(const f32x4 (&acc)[2][2][4][2], const Unit& u, int wr, int wc, int fr, int fq) const {
        const int row0 = u.pm * 256 + wr * 64 + fr, col0 = u.pn * 256 + wc * 32 + fq * 8;
        bf16* xp = xb + (size_t)row0 * DM + col0;
        u32x4 p[2][2];
#define ER_LOAD(slot, i) do { const size_t ro = (size_t)(16 * (i) + 64 * ((i) >> 2)); p[slot][0] = *(const u32x4*)(xp + ro * DM); p[slot][1] = *(const u32x4*)(xp + ro * DM + 128); } while (0)
        ER_LOAD(0, 0);
#pragma unroll
        for (int i = 0; i < 8; ++i) {
            const int ai = i >> 2, m = i & 3, sl = i & 1;
            if (i + 1 < 8) { if (sl == 0) ER_LOAD(1, i + 1); else ER_LOAD(0, i + 1); }
            bf16* orow = xp + (size_t)(16 * i + 64 * (i >> 2)) * DM;
#pragma unroll
            for (int bj = 0; bj < 2; ++bj) {
                const u32x4 q = p[sl][bj];
                const f32x4 a0 = acc[ai][bj][m][0], a1 = acc[ai][bj][m][1];
                u32x4 w;
                w.x = cvtpk(a0[0] + bflo(q.x), a0[1] + bfhi(q.x)); w.y = cvtpk(a0[2] + bflo(q.y), a0[3] + bfhi(q.y));
                w.z = cvtpk(a1[0] + bflo(q.z), a1[1] + bfhi(q.z)); w.w = cvtpk(a1[2] + bflo(q.w), a1[3] + bfhi(q.w));
                store16_sc1(orow + bj * 128, w);
            }
            asm volatile("" ::: "memory");
        }
#undef ER_LOAD
    }
};
struct EpiSwiglu {
    static constexpr bool PERM = true, REPEAT = false, HAS_MID = false;
    const int* ltok; const float* lw; const float* rs; bf16* H;
    __device__ __forceinline__ void operator()(const f32x4 (&acc)[2][2][4][2], const Unit& u, int wr, int wc, int fr, int fq) const {
        int tok[8]; float w8[8], s8[8];
#pragma unroll
        for (int i = 0; i < 8; ++i) { const int rr = (i >> 2) * 128 + wr * 64 + (i & 3) * 16 + fr; const int rc = rr < u.nvalid ? rr : u.nvalid - 1; tok[i] = ltok[u.lpos0 + rc]; w8[i] = lw[u.lpos0 + rc]; }
#pragma unroll
        for (int i = 0; i < 8; ++i) s8[i] = rs[tok[i]];
#pragma unroll
        for (int ai = 0; ai < 2; ++ai)
#pragma unroll
            for (int m = 0; m < 4; ++m) {
                const int rr = ai * 128 + wr * 64 + m * 16 + fr;
                if (rr < u.nvalid) {
                    const float w = w8[ai * 4 + m], s = s8[ai * 4 + m];
#pragma unroll
                    for (int bj = 0; bj < 2; ++bj) {
                        const f32x4 a0 = acc[ai][bj][m][0] * s, a1 = acc[ai][bj][m][1] * s;
                        const float h0 = a0[0] * sigmoidf_fast(a0[0]) * a0[1] * w, h1 = a0[2] * sigmoidf_fast(a0[2]) * a0[3] * w;
                        const float h2 = a1[0] * sigmoidf_fast(a1[0]) * a1[1] * w, h3 = a1[2] * sigmoidf_fast(a1[2]) * a1[3] * w;
                        u32x2 o; o.x = cvtpk(h0, h1); o.y = cvtpk(h2, h3);
                        __hip_atomic_store((unsigned long long*)(H + (size_t)(u.slot0 + rr) * DEXP + u.pn * 128 + bj * 64 + wc * 16 + fq * 4), (unsigned long long)o.x | ((unsigned long long)o.y << 32), __ATOMIC_RELAXED, __HIP_MEMORY_SCOPE_AGENT);
                    }
                }
            }
    }
};
struct EpiY {
    static constexpr bool PERM = true, REPEAT = false, HAS_MID = false;
    bf16* Y;
    __device__ __forceinline__ void operator()(const f32x4 (&acc)[2][2][4][2], const Unit& u, int wr, int wc, int fr, int fq) const {
#pragma unroll
        for (int ai = 0; ai < 2; ++ai)
#pragma unroll
            for (int m = 0; m < 4; ++m) {
                const int rr = ai * 128 + wr * 64 + m * 16 + fr;
                if (rr < u.nvalid) {
#pragma unroll
                    for (int bj = 0; bj < 2; ++bj) {
                        const f32x4 a0 = acc[ai][bj][m][0], a1 = acc[ai][bj][m][1];
                        u32x4 w; w.x = cvtpk(a0[0], a0[1]); w.y = cvtpk(a0[2], a0[3]); w.z = cvtpk(a1[0], a1[1]); w.w = cvtpk(a1[2], a1[3]);
                        *(u32x4*)(Y + (size_t)(u.slot0 + rr) * DM + u.pn * 256 + bj * 128 + wc * 32 + fq * 8) = w;
                    }
                }
            }
    }
};

#define XB_TMO      128
#define XB_XCNT(j)  (256  + 64 * (j))
#define XB_XSUB(j)  (1280 + 64 * (j))
#define XB_XGEN(j)  (2304 + 64 * (j))
#define XB_TOP      3328
#define XB_TOPGEN   3392
#define XCD_BAR_WORDS 3456
#define XB_SPIN_CAP (1u << 18)
__device__ __forceinline__ unsigned xb_ld(unsigned* p)              { return __hip_atomic_load(p, __ATOMIC_RELAXED, __HIP_MEMORY_SCOPE_AGENT); }
__device__ __forceinline__ unsigned xb_add(unsigned* p, unsigned v) { return __hip_atomic_fetch_add(p, v, __ATOMIC_RELAXED, __HIP_MEMORY_SCOPE_AGENT); }
__device__ __forceinline__ unsigned xb_xcc_id() { return (unsigned)__builtin_amdgcn_s_getreg((3 << 11) | 20) & 0xFu; }
#define XB_SPIN(cond, bar) do { unsigned _sp = 0; while (cond) { __builtin_amdgcn_s_sleep(1); \
    if ((++_sp & 255u) == 0u) { if (xb_ld(&(bar)[XB_TMO])) break; if (_sp > XB_SPIN_CAP) { atomicAdd(&(bar)[XB_TMO], 1u); break; } } } } while (0)
struct XcdBarrier { unsigned* bar; unsigned x; volatile LAS unsigned* st; };
__device__ __forceinline__ XcdBarrier xcd_barrier_post(unsigned* bar, volatile LAS unsigned* st) {
    XcdBarrier b; b.bar = bar; b.x = xb_xcc_id(); b.st = st;
    if (threadIdx.x == 0) (void)xb_add(&bar[XB_XCNT(b.x)], 1u);
    return b;
}
__device__ __forceinline__ void xcd_barrier_complete(unsigned* bar, unsigned x, unsigned& nloc, unsigned& nx) {
    const unsigned G = gridDim.x * gridDim.y * gridDim.z;
    unsigned sum, cnt, mine, sp = 0u;
    for (;;) {
        sum = 0u; cnt = 0u; mine = 0u;
#pragma unroll
        for (unsigned j = 0; j < 16; ++j) { const unsigned c = xb_ld(&bar[XB_XCNT(j)]); sum += c; cnt += (c > 0u) ? 1u : 0u; mine = (j == x) ? c : mine; }
        if (sum == G) break;
        __builtin_amdgcn_s_sleep(1);
        if ((++sp & 255u) == 0u) { if (xb_ld(&bar[XB_TMO])) break; if (sp > XB_SPIN_CAP) { atomicAdd(&bar[XB_TMO], 1u); break; } }
    }
    nloc = mine > 0u ? mine : 1u; nx = cnt > 0u ? cnt : 1u;
}
__device__ __forceinline__ void xcd_barrier(const XcdBarrier& b, int wave) {
    asm volatile("s_waitcnt vmcnt(0)" ::: "memory");
    __syncthreads();
    unsigned zb_ = 0u; asm volatile("" : "+v"(zb_));
    if (wave == 0 && __builtin_amdgcn_mbcnt_hi(~0u, __builtin_amdgcn_mbcnt_lo(~0u, zb_)) == 0u) {
        unsigned* bar = b.bar;
        __builtin_amdgcn_s_waitcnt(0);
        unsigned nloc = b.st[0], nx = b.st[1];
        if (nloc == 0u) { xcd_barrier_complete(bar, b.x, nloc, nx); b.st[0] = nloc; b.st[1] = nx; }
        const unsigned old = xb_add(&bar[XB_XSUB(b.x)], 1u);
        const unsigned gen = old / nloc;
        if (old + 1u == (gen + 1u) * nloc) {
            __builtin_amdgcn_fence(__ATOMIC_RELEASE, "agent");
            asm volatile("s_waitcnt vmcnt(0)" ::: "memory");
            const unsigned og = xb_add(&bar[XB_TOP], 1u);
            const unsigned tg = og / nx;
            if (og + 1u == (tg + 1u) * nx) xb_add(&bar[XB_TOPGEN], 1u);
            else XB_SPIN(xb_ld(&bar[XB_TOPGEN]) == tg, bar);
            __builtin_amdgcn_fence(__ATOMIC_ACQUIRE, "agent");
            xb_add(&bar[XB_XGEN(b.x)], 1u);
            asm volatile("s_waitcnt vmcnt(0)" ::: "memory");
        } else {
            XB_SPIN(xb_ld(&bar[XB_XGEN(b.x)]) == gen, bar);
            __builtin_amdgcn_fence(__ATOMIC_ACQUIRE, "agent");
            asm volatile("s_waitcnt vmcnt(0)" ::: "memory");
        }
    }
    __syncthreads();
}

struct Args {
    const float* x; const float* attn_g; const float* w_in; const float* a_sink; const float* w_a; const float* w_b; const float* w_out; const float* ffn_g;
    const float* w_rg; const float* b_rg; const float* w_re; const float* b_re; const float* w_eg; const float* w_eu; const float* w_ed; const float* fin_g;
    float* out; unsigned char* ws; int ph_lo, ph_hi;
};
typedef const __attribute__((address_space(4))) Args* CArgs;
struct Frame {
    LAS unsigned char* lds; volatile LAS int* misc;
    int wave, G, vcu, gw, ngw, bx;
};
__device__ __forceinline__ int otid() { unsigned z = 0u; asm volatile("" : "+v"(z)); return (int)__builtin_amdgcn_mbcnt_hi(~0u, __builtin_amdgcn_mbcnt_lo(~0u, z)); }
__device__ __forceinline__ float shx(float v, int o, int lane) { return __int_as_float(__builtin_amdgcn_ds_bpermute((lane ^ o) << 2, __float_as_int(v))); }
__device__ __forceinline__ float wave_sum(float v, int lane) {
#pragma unroll
    for (int o = 1; o < 64; o <<= 1) v += shx(v, o, lane);
    return v;
}

struct MapPlain { __device__ __forceinline__ int operator()(int n) const { return n; } };
struct MapWin { __device__ __forceinline__ int operator()(int n) const {
        bool rope = false;
        if (n < 640) rope = true; else if (n >= 768 && n < NQKV) rope = ((n - 768) % 768) < 512;
        if (!rope) return n; const int d = n & 63; return (n & ~63) + 2 * (d & 31) + (d >> 5); } };
struct MapGU { int t; __device__ __forceinline__ int operator()(int n) const { return 2 * n + t; } };
template <class Map> __device__ __forceinline__ void transpose_item64(const float* W, int ldn, int k0, int n0, const float* gk, bf16* WT, int Kd, const Map& map, LAS float* scr, int lane) {
    const int kq = lane >> 4, n4 = (lane & 15) * 4;
    const float* src = W + (size_t)(k0 + kq) * ldn + n0 + n4;
    f32x4 v[16];
#pragma unroll
    for (int i = 0; i < 16; ++i) v[i] = *(const f32x4*)(src + (size_t)(4 * i) * ldn);
    if (gk) {
#pragma unroll
        for (int i = 0; i < 16; ++i) v[i] = v[i] * gk[k0 + 4 * i + kq];
    }
#pragma unroll
    for (int i = 0; i < 16; ++i) { LAS float* d = scr + (4 * i + kq) * 65 + n4; d[0] = v[i][0]; d[1] = v[i][1]; d[2] = v[i][2]; d[3] = v[i][3]; }
    LDS_WAIT(); asm volatile("" ::: "memory");
    const int c = lane & 7;
#pragma unroll
    for (int j = 0; j < 8; ++j) { const int n = (lane >> 3) + 8 * j; const LAS float* p = scr + (8 * c) * 65 + n;
        u32x4 o; o.x = cvtpk(p[0 * 65], p[1 * 65]); o.y = cvtpk(p[2 * 65], p[3 * 65]); o.z = cvtpk(p[4 * 65], p[5 * 65]); o.w = cvtpk(p[6 * 65], p[7 * 65]);
        *(u32x4*)(WT + (size_t)map(n0 + n) * Kd + k0 + 8 * c) = o; }
    LDS_WAIT(); asm volatile("" ::: "memory");
}
__device__ __forceinline__ void prep_phase(const Frame& F, CArgs a) {
    const int lane = otid(), tid = F.wave * 64 + lane; (void)tid; (void)lane;
    unsigned char* ws = a->ws;
    LAS float* scr = (LAS float*)(F.lds + F.wave * PREP_SCR);
    constexpr int I_IN = 16 * 80, I_A = 8 * 16, I_B = 4 * 16, I_O = 16 * 16, I_L = I_IN + I_A + I_B + I_O;
    for (int it = F.gw; it < DEPTH * I_L; it += F.ngw) {
        const int l = it / I_L; int r = it - l * I_L;
        unsigned char* wl = ws + (size_t)l * WNE_LSTRIDE;
        if (r < I_IN) { transpose_item64(a->w_in + (size_t)l * DM * DIN, DIN, 64 * (r / 80), 64 * (r % 80), a->attn_g + l * DM, (bf16*)(wl + WS_WIN), DM, MapWin{}, scr, lane); continue; } r -= I_IN;
        if (r < I_A) { transpose_item64(a->w_a + (size_t)l * 512 * DM, DM, 64 * (r / 16), 64 * (r % 16), nullptr, (bf16*)(wl + WS_WAB) + 256, 768, MapPlain{}, scr, lane); continue; } r -= I_A;
        if (r < I_B) { transpose_item64(a->w_b + (size_t)l * 256 * DM, DM, 64 * (r / 16), 64 * (r % 16), nullptr, (bf16*)(wl + WS_WAB), 768, MapPlain{}, scr, lane); continue; } r -= I_B;
        transpose_item64(a->w_out + (size_t)l * DM * DM, DM, 64 * (r / 16), 64 * (r % 16), nullptr, (bf16*)(wl + WS_WOUT), DM, MapPlain{}, scr, lane);
    }
    for (int idx = F.bx * NTHREADS + tid; idx < DEPTH * 32 * 3 * 64 * 8; idx += F.G * NTHREADS) {
        const int l = idx / (32 * 3 * 64 * 8), id = idx - l * (32 * 3 * 64 * 8);
        const int j = id & 7, ln = (id >> 3) & 63, q = id >> 9, nt = q % 3, i = q / 3;
        const int k = 32 * i + 8 * (ln >> 4) + j, n = 16 * nt + (ln & 15);
        const float* wg = a->w_rg + (size_t)l * DM * 4; const float* we = a->w_re + (size_t)l * DM * NEXP;
        float v = 0.f; if (n < 4) v = wg[k * 4 + n]; else if (n < 36) v = we[k * NEXP + (n - 4)];
        v *= a->ffn_g[l * DM + k];
        const unsigned hb = cvtpk(v, 0.f) & 0xffffu; const float hf = __uint_as_float(hb << 16);
        const unsigned lb = cvtpk(v - hf, 0.f) & 0xffffu;
        ((bf16*)(ws + WS_WR + l * WR_LSTRIDE))[id] = (bf16)hb; ((bf16*)(ws + WS_WR + l * WR_LSTRIDE + WR_LO))[id] = (bf16)lb;
    }
    {
        float* rt = (float*)(ws + WS_ROPE);
        for (int idx = F.bx * NTHREADS + tid; idx < SEQ * 32; idx += F.G * NTHREADS) {
            const int pos = idx >> 5, i = idx & 31;
            const float inv = 1.0f / powf(10000.0f, (float)(2 * i) / 64.0f);
            const float ang = (float)pos * inv;
            const double ad = (double)ang, kd = __builtin_rint(ad * 0.15915494309189535);
            const float rf = (float)__builtin_fma(-kd, 6.283185307179586, ad);
            rt[idx * 2] = cosf(rf); rt[idx * 2 + 1] = sinf(rf);
        }
        bf16* xb = (bf16*)(ws + WS_XB); float* rs1 = (float*)(ws + WS_RS1);
        for (int m = F.gw; m < MTOK; m += F.ngw) {
            const f32x4* xr = (const f32x4*)(a->x + (size_t)m * DM) + lane;
            f32x4 v[4]; float s = 0.f;
#pragma unroll
            for (int j = 0; j < 4; ++j) { v[j] = xr[64 * j]; s += (v[j][0] * v[j][0] + v[j][1] * v[j][1]) + (v[j][2] * v[j][2] + v[j][3] * v[j][3]); }
            s = wave_sum(s, lane);
            u32x2* o = (u32x2*)(xb + (size_t)m * DM) + lane;
#pragma unroll
            for (int j = 0; j < 4; ++j) { u32x2 w; w.x = cvtpk(v[j][0], v[j][1]); w.y = cvtpk(v[j][2], v[j][3]); o[64 * j] = w; }
            if (lane == 0) rs1[m] = 1.0f / sqrtf(s * (1.0f / DM) + NORM_EPS);
        }
    }
}
__device__ __forceinline__ void prep_experts(const Frame& F, CArgs a, int l, int lane, int part, int w, int nw) {
    unsigned char* ws = a->ws;
    LAS float* scr = (LAS float*)(F.lds + F.wave * PREP_SCR);
    constexpr int I_G = 16 * 4, I_D = 4 * 16;
    const float* fg = a->ffn_g + l * DM;
    if (part == 0) {
        for (int it = w; it < NEXP * 2 * I_G; it += nw) {
            const int e = it / (2 * I_G); int r = it - e * (2 * I_G); const int t = r / I_G; r -= t * I_G;
            const size_t eo = ((size_t)l * NEXP + e) * DM * DEXP; const float* W = (t ? a->w_eu : a->w_eg) + eo;
            transpose_item64(W, DEXP, 64 * (r / 4), 64 * (r % 4), fg, (bf16*)(ws + WS_WGU) + (size_t)e * 512 * DM, DM, MapGU{t}, scr, lane);
        }
    } else {
        for (int it = w; it < NEXP * I_D; it += nw) {
            const int e = it / I_D, r = it - e * I_D;
            const size_t eo = ((size_t)l * NEXP + e) * DM * DEXP;
            transpose_item64(a->w_ed + eo, DM, 64 * (r / 16), 64 * (r % 16), nullptr, (bf16*)(ws + WS_WD) + (size_t)e * DM * DEXP, DEXP, MapPlain{}, scr, lane);
        }
    }
}

__device__ __forceinline__ int crow(int r, int hi) { return (r & 3) + 8 * (r >> 2) + 4 * hi; }
struct AttnUnit { int kcol, vcol, b, d, r, t0, span, W, qcol, tq; float m0, l0; bf16* outp; int opitch; float* lsep; bool valid; };
__device__ __forceinline__ AttnUnit attn_decode(int idx, int G, int bx, int wave, int l, CArgs a, bf16* ya, bf16* ob, float* lse) {
    AttnUnit U; U.valid = false;
    const int nA = (BATCH * 2 * 64 - bx + G - 1) / G;
    if (idx < nA) {
        const int u = bx + idx * G; const int qb = u & 63, kvh = (u >> 6) & 1, b = u >> 7; const int g = wave >> 1, hq = kvh * 4 + g;
        U.kcol = 512 + kvh * 64; U.vcol = 640 + kvh * 64; U.b = b; U.d = 1; U.r = 0; U.t0 = 2 * qb; U.span = 2; U.W = 4; U.qcol = hq * 64; U.tq = 2 * qb + (wave & 1);
        U.m0 = a->a_sink[l * 8 + hq] * LOG2E; U.l0 = 1.0f; U.outp = ya + hq * 64; U.opitch = 768; U.lsep = nullptr; U.valid = true; return U;
    }
    const int u = bx + (idx - nA) * G;
    if (u < 3 * 256) {
        const int grp = u >> 8; int q = u & 255;
        const int d = grp == 0 ? 1 : (grp == 1 ? 4 : 16), bpr = 16 / d;
        const int blk = q % bpr; q /= bpr; const int res = q % d; q /= d; const int h = q & 3, b = q >> 2;
        const int base = 768 + 768 * grp;
        U.kcol = base + 256 + h * 64; U.vcol = base + 512 + h * 64; U.b = b; U.d = d; U.r = res; U.t0 = 8 * blk; U.span = 8; U.W = 2; U.qcol = base + h * 64; U.tq = 8 * blk + wave;
        U.m0 = -1e30f; U.l0 = 0.0f; U.outp = ob + grp * 256 + h * 64; U.opitch = 768; U.lsep = lse + grp * 4 + h; U.valid = true;
    }
    return U;
}
__device__ __forceinline__ void attn_fetch(const bf16* P, const AttnUnit& U, int tid, u32x4 (&buf)[12]) {
    const int L32 = (SEQ / U.d) >> 5, jbase = U.t0 - U.W, ntile = U.span + 2 * U.W, nch = ntile * 512;
    const size_t tok0 = (size_t)U.b * SEQ + U.r;
#pragma unroll
    for (int i = 0; i < 12; ++i) {
        const int c = tid + 512 * i;
        if (c < nch) {
            const int kv = c >= ntile * 256, cc = kv ? c - ntile * 256 : c, row = cc >> 3, ch = cc & 7, tile = row >> 5, rr = row & 31, j = jbase + tile;
            if (j >= 0 && j < L32) buf[i] = *(const u32x4*)(P + (tok0 + (size_t)(32 * j + rr) * U.d) * NQKV + (kv ? U.vcol : U.kcol) + ch * 8);
        }
    }
}
__device__ __forceinline__ void attn_stage(const AttnUnit& U, int tid, const u32x4 (&buf)[12], LAS unsigned char* lds) {
    const int L32 = (SEQ / U.d) >> 5, jbase = U.t0 - U.W, ntile = U.span + 2 * U.W, nch = ntile * 512;
    LAS unsigned char* kimg = lds; LAS unsigned char* vimg = lds + ntile * 4096;
#pragma unroll
    for (int i = 0; i < 12; ++i) {
        const int c = tid + 512 * i;
        if (c < nch) {
            const int kv = c >= ntile * 256, cc = kv ? c - ntile * 256 : c, row = cc >> 3, ch = cc & 7, tile = row >> 5, rr = row & 31, j = jbase + tile;
            if (j >= 0 && j < L32) *(LAS u32x4*)((kv ? vimg : kimg) + tile * 4096 + rr * 128 + (kv ? ch : (ch ^ (rr & 7))) * 16) = buf[i];
        }
    }
}
template <int NT> __device__ __forceinline__ void attn_step(int j, int jbase, int tq, int W, const LAS unsigned char* kimg, const LAS unsigned char* vimg, int krd, int vrd, int r32, int hi,
                                                          const bf16x8 (&qf)[4], f32x16& o0, f32x16& o1, float& mrun, float& lrun) {
#define VTR(p, off) __builtin_bit_cast(s16x4, __builtin_amdgcn_ds_read_tr16_b64_v4i16((LAS s16x4*)((p) + (off))))
    bf16x8 kf[NT][4]; s16x4 va[NT][4], vb[NT][4];
#pragma unroll
    for (int t = 0; t < NT; ++t) {
        const LAS unsigned char* kl = kimg + (j + t - jbase) * 4096 + krd;
#pragma unroll
        for (int s = 0; s < 4; ++s) kf[t][s] = *(const LAS bf16x8*)(kl + (((2 * s + hi) ^ (r32 & 7)) * 16));
    }
#pragma unroll
    for (int t = 0; t < NT; ++t) {
        const LAS unsigned char* vl = vimg + (j + t - jbase) * 4096 + vrd;
#pragma unroll
        for (int q = 0; q < 4; ++q) { va[t][q] = VTR(vl, (16 * (q & 1)) * 128 + (q >> 1) * 64); vb[t][q] = VTR(vl, (16 * (q & 1) + 8) * 128 + (q >> 1) * 64); }
    }
    __builtin_amdgcn_sched_barrier(0);
    f32x16 sc[NT];
#pragma unroll
    for (int t = 0; t < NT; ++t) sc[t] = f32x16{};
#pragma unroll
    for (int s = 0; s < 4; ++s)
#pragma unroll
        for (int t = 0; t < NT; ++t) sc[t] = __builtin_amdgcn_mfma_f32_32x32x16_bf16(kf[t][s], qf[s], sc[t], 0, 0, 0);
#pragma unroll
    for (int t = 0; t < NT; ++t) {
        if (j + t == tq - W) {
#pragma unroll
            for (int g = 0; g < 16; ++g) if (crow(g, hi) < r32) sc[t][g] = -INFINITY;
        }
        if (j + t == tq + W) {
#pragma unroll
            for (int g = 0; g < 16; ++g) if (crow(g, hi) > r32) sc[t][g] = -INFINITY;
        }
    }
    float mx = -INFINITY;
#pragma unroll
    for (int t = 0; t < NT; ++t)
#pragma unroll
        for (int g = 0; g < 16; g += 4) mx = fmaxf(mx, fmaxf(fmaxf(sc[t][g], sc[t][g + 1]), fmaxf(sc[t][g + 2], sc[t][g + 3])));
    { const auto rr = __builtin_amdgcn_permlane32_swap(__float_as_uint(mx), __float_as_uint(mx), false, false); mx = fmaxf(__uint_as_float(rr[0]), __uint_as_float(rr[1])); }
    if (__any(mx > mrun + 8.0f)) {
        const float mnew = fmaxf(mrun, mx);
        const float alpha = fast_exp2(mrun - mnew);
        lrun *= alpha; mrun = mnew;
#pragma unroll
        for (int g = 0; g < 16; ++g) { o0[g] *= alpha; o1[g] *= alpha; }
    }
    float ps[4] = {0.f, 0.f, 0.f, 0.f};
#pragma unroll
    for (int t = 0; t < NT; ++t)
#pragma unroll
        for (int g = 0; g < 16; ++g) { sc[t][g] = fast_exp2(sc[t][g] - mrun); ps[g & 3] += sc[t][g]; }
    float psum = (ps[0] + ps[1]) + (ps[2] + ps[3]);
    { const auto rr = __builtin_amdgcn_permlane32_swap(__float_as_uint(psum), __float_as_uint(psum), false, false); psum = __uint_as_float(rr[0]) + __uint_as_float(rr[1]); }
    lrun += psum;
#define VFR(t, q) ((bf16x8){va[t][q][0], va[t][q][1], va[t][q][2], va[t][q][3], vb[t][q][0], vb[t][q][1], vb[t][q][2], vb[t][q][3]})
#pragma unroll
    for (int t = 0; t < NT; ++t) {
        u32x4 p0, p1;
        p0.x = cvtpk(sc[t][0], sc[t][1]); p0.y = cvtpk(sc[t][2], sc[t][3]); p0.z = cvtpk(sc[t][4], sc[t][5]); p0.w = cvtpk(sc[t][6], sc[t][7]);
        p1.x = cvtpk(sc[t][8], sc[t][9]); p1.y = cvtpk(sc[t][10], sc[t][11]); p1.z = cvtpk(sc[t][12], sc[t][13]); p1.w = cvtpk(sc[t][14], sc[t][15]);
        const bf16x8 pf0 = __builtin_bit_cast(bf16x8, p0), pf1 = __builtin_bit_cast(bf16x8, p1);
        o0 = __builtin_amdgcn_mfma_f32_32x32x16_bf16(VFR(t, 0), pf0, o0, 0, 0, 0);
        o1 = __builtin_amdgcn_mfma_f32_32x32x16_bf16(VFR(t, 2), pf0, o1, 0, 0, 0);
        o0 = __builtin_amdgcn_mfma_f32_32x32x16_bf16(VFR(t, 1), pf1, o0, 0, 0, 0);
        o1 = __builtin_amdgcn_mfma_f32_32x32x16_bf16(VFR(t, 3), pf1, o1, 0, 0, 0);
    }
#undef VFR
#undef VTR
}
__device__ __forceinline__ void attn_compute(const bf16* P, const AttnUnit& U, const bf16x8 (&qf)[4], LAS unsigned char* lds, LAS unsigned char* stg, int lane) {
    const int r32 = lane & 31, hi = lane >> 5;
    const int d = U.d, W = U.W, tq = U.tq;
    const int L32 = (SEQ / d) >> 5;
    const size_t tok0 = (size_t)U.b * SEQ + U.r;
    const int jbase = U.t0 - W, ntile = U.span + 2 * W;
    LAS unsigned char* kimg = lds; LAS unsigned char* vimg = lds + ntile * 4096;
    const size_t qtok = tok0 + (size_t)(32 * tq + r32) * d;
    f32x16 o0 = {}, o1 = {};
    float mrun = U.m0, lrun = U.l0;
    const int jlo = (tq - W) < 0 ? 0 : (tq - W), jhi = (tq + W) > (L32 - 1) ? (L32 - 1) : (tq + W);
    const int vrd = (4 * hi + ((lane & 15) >> 2)) * 128 + (16 * ((lane >> 4) & 1) + 4 * (lane & 3)) * 2;
    const int krd = r32 * 128;
    int j = jlo;
    for (; j + 1 <= jhi; j += 2) attn_step<2>(j, jbase, tq, W, kimg, vimg, krd, vrd, r32, hi, qf, o0, o1, mrun, lrun);
    if (j <= jhi) attn_step<1>(j, jbase, tq, W, kimg, vimg, krd, vrd, r32, hi, qf, o0, o1, mrun, lrun);
    const float inv = 1.0f / lrun;
#pragma unroll
    for (int g4 = 0; g4 < 4; ++g4) {
        u32x2 w0, w1;
        w0.x = cvtpk(o0[4 * g4] * inv, o0[4 * g4 + 1] * inv); w0.y = cvtpk(o0[4 * g4 + 2] * inv, o0[4 * g4 + 3] * inv);
        w1.x = cvtpk(o1[4 * g4] * inv, o1[4 * g4 + 1] * inv); w1.y = cvtpk(o1[4 * g4 + 2] * inv, o1[4 * g4 + 3] * inv);
        *(LAS u32x2*)(stg + r32 * 144 + (8 * g4 + 4 * hi) * 2) = w0;
        *(LAS u32x2*)(stg + r32 * 144 + 64 + (8 * g4 + 4 * hi) * 2) = w1;
    }
#pragma unroll
    for (int i = 0; i < 4; ++i) {
        const int row = i * 8 + (lane >> 3), ch = lane & 7;
        const u32x4 v = *(const LAS u32x4*)(stg + row * 144 + ch * 16);
        *(u32x4*)(U.outp + (tok0 + (size_t)(32 * tq + row) * d) * U.opitch + ch * 8) = v;
    }
    if (U.lsep && hi == 0) U.lsep[qtok * 12] = (mrun + log2f(lrun)) * LN2;
}
__device__ __forceinline__ void attn_phase(const Frame& F, CArgs a, int l) {
    const int lane = otid(), tid = F.wave * 64 + lane; (void)tid; (void)lane;
    unsigned char* ws = a->ws;
    const bf16* P = (const bf16*)(ws + WS_PQ);
    bf16* ya = (bf16*)(ws + WS_YAB) + 256; bf16* ob = (bf16*)a->out; float* lse = (float*)(ws + WS_LSE);
    const int r32 = lane & 31, hi = lane >> 5;
    u32x4 buf[12];
    LAS unsigned char* stg = F.lds + 98304 + F.wave * 4608;
    AttnUnit U = attn_decode(0, F.G, F.bx, F.wave, l, a, ya, ob, lse);
    if (U.valid) attn_fetch(P, U, tid, buf);
    for (int idx = 0; U.valid; ++idx) {
        attn_stage(U, tid, buf, F.lds);
        u32x4 qv[4];
#pragma unroll
        for (int i = 0; i < 4; ++i) { const int row = i * 8 + (lane >> 3), ch = lane & 7;
            qv[i] = *(const u32x4*)(P + ((size_t)U.b * SEQ + U.r + (size_t)(32 * U.tq + row) * U.d) * NQKV + U.qcol + ch * 8); }
        const AttnUnit Un = attn_decode(idx + 1, F.G, F.bx, F.wave, l, a, ya, ob, lse);
#pragma unroll
        for (int i = 0; i < 4; ++i) { const int row = i * 8 + (lane >> 3), ch = lane & 7; *(LAS u32x4*)(stg + row * 144 + ch * 16) = qv[i]; }
        bf16x8 qf[4];
#pragma unroll
        for (int s = 0; s < 4; ++s) qf[s] = *(const LAS bf16x8*)(stg + r32 * 144 + (2 * s + hi) * 16);
        __syncthreads();
        if (Un.valid) attn_fetch(P, Un, tid, buf);
        attn_compute(P, U, qf, F.lds, stg, lane);
        __syncthreads();
        U = Un;
    }
    prep_experts(F, a, l, lane, 0, F.gw, F.ngw);
    prep_experts(F, a, l, lane, 1, F.gw, F.ngw);
}
__device__ __forceinline__ void comb_rows(const Frame& F, CArgs a, int row0, int tid) {
    unsigned char* ws = a->ws;
    const bf16* ob = (const bf16*)a->out; const float* lse = (const float*)(ws + WS_LSE); bf16* yb = (bf16*)(ws + WS_YAB);
#pragma unroll 4
    for (int it = 0; it < 16; ++it) {
        const int idx = tid + it * NTHREADS;
        const int tok = row0 + (idx >> 5), c = idx & 31, h = c >> 3;
        const float l0 = lse[tok * 12 + h], l1 = lse[tok * 12 + 4 + h], l2 = lse[tok * 12 + 8 + h];
        const u32x4 a0 = *(const u32x4*)(ob + (size_t)tok * 768 + c * 8), a1 = *(const u32x4*)(ob + (size_t)tok * 768 + 256 + c * 8), a2 = *(const u32x4*)(ob + (size_t)tok * 768 + 512 + c * 8);
        const float mx = fmaxf(l0, fmaxf(l1, l2));
        float w0 = __expf(l0 - mx), w1 = __expf(l1 - mx), w2 = __expf(l2 - mx);
        const float inv = 1.0f / (w0 + w1 + w2); w0 *= inv; w1 *= inv; w2 *= inv;
        u32x4 o;
#define CMB(f) o.f = cvtpk(w0 * bflo(a0.f) + w1 * bflo(a1.f) + w2 * bflo(a2.f), w0 * bfhi(a0.f) + w1 * bfhi(a1.f) + w2 * bfhi(a2.f))
        CMB(x); CMB(y); CMB(z); CMB(w);
#undef CMB
        *(u32x4*)(yb + (size_t)tok * 768 + c * 8) = o;
    }
}

__device__ __forceinline__ void route_phase(const Frame& F, CArgs a, int l, unsigned* waitp) {
    const int lane = otid(), tid = F.wave * 64 + lane;
    unsigned char* ws = a->ws;
    const bf16* xbf = (const bf16*)(ws + WS_XB); const u32x4* wrh = (const u32x4*)(ws + WS_WR + l * WR_LSTRIDE); const u32x4* wrl = (const u32x4*)(ws + WS_WR + l * WR_LSTRIDE + WR_LO);
    float* rs2 = (float*)(ws + WS_RS2); i32x4* tokinfo = (i32x4*)(ws + WS_TOKINFO); int* ltok = (int*)(ws + WS_LTOK); float* lw = (float*)(ws + WS_LW);
    int* cnt = (int*)(ws + WS_CTL) + CW_CNT + l * 32 * CNT_STRIDE;
    const float* brg = a->b_rg + l * 4; const float* bre = a->b_re + l * NEXP;
    LAS f32x4* part = (LAS f32x4*)(F.lds);
    LAS float* ssp = (LAS float*)(F.lds + 12288);
    LAS float* Lg = (LAS float*)(F.lds + 16384);
    LAS float* rsL = (LAS float*)(F.lds + 16384 + 12288);
    LAS int* lcnt = (LAS int*)(F.lds + 16384 + 12288 + 256);
    LAS int* lbase = lcnt + 32;
    const int rt = F.wave & 3, kh = F.wave >> 2;
    if (tid < 32) lcnt[tid] = 0;
    __syncthreads();
    for (int blk = F.bx; blk < MTOK / 64; blk += F.G) {
        if (waitp) {
            if (F.wave == 0) {
                unsigned* p = waitp + (blk >> 2) * PAN_STRIDE; unsigned spins = 0;
                while ((unsigned)__builtin_amdgcn_readfirstlane(__hip_atomic_load(p, __ATOMIC_RELAXED, __HIP_MEMORY_SCOPE_AGENT)) < 32u) {
                    __builtin_amdgcn_s_sleep(2);
                    if (++spins > (1u << 22)) { __hip_atomic_store((unsigned*)(ws + WS_CTL) + CW_ERR, 3u, __ATOMIC_RELAXED, __HIP_MEMORY_SCOPE_AGENT); break; }
                }
                __builtin_amdgcn_fence(__ATOMIC_ACQUIRE, "agent");
                asm volatile("s_waitcnt vmcnt(0)" ::: "memory");
            }
            __syncthreads();
        }
        const int row0 = blk * 64 + rt * 16;
        const u32x4* xr = (const u32x4*)(xbf + (size_t)(row0 + (lane & 15)) * DM + kh * 512) + (lane >> 4);
        const u32x4* wh = wrh + (size_t)(kh * 16) * 3 * 64 + lane; const u32x4* wl = wrl + (size_t)(kh * 16) * 3 * 64 + lane;
        f32x4 acc0 = {0.f, 0.f, 0.f, 0.f}, acc1 = acc0, acc2 = acc0; float ss = 0.f;
#pragma unroll 4
        for (int i = 0; i < 16; ++i) {
            const u32x4 xw = xr[4 * i];
            const u32x4 h0 = wh[(i * 3 + 0) * 64], h1 = wh[(i * 3 + 1) * 64], h2 = wh[(i * 3 + 2) * 64], l0 = wl[(i * 3 + 0) * 64], l1 = wl[(i * 3 + 1) * 64], l2 = wl[(i * 3 + 2) * 64];
            const float xv[8] = {bflo(xw.x), bfhi(xw.x), bflo(xw.y), bfhi(xw.y), bflo(xw.z), bfhi(xw.z), bflo(xw.w), bfhi(xw.w)};
#pragma unroll
            for (int j = 0; j < 8; ++j) ss += xv[j] * xv[j];
            const bf16x8 xf = __builtin_bit_cast(bf16x8, xw);
            acc0 = __builtin_amdgcn_mfma_f32_16x16x32_bf16(xf, __builtin_bit_cast(bf16x8, l0), acc0, 0, 0, 0);
            acc1 = __builtin_amdgcn_mfma_f32_16x16x32_bf16(xf, __builtin_bit_cast(bf16x8, l1), acc1, 0, 0, 0);
            acc2 = __builtin_amdgcn_mfma_f32_16x16x32_bf16(xf, __builtin_bit_cast(bf16x8, l2), acc2, 0, 0, 0);
            acc0 = __builtin_amdgcn_mfma_f32_16x16x32_bf16(xf, __builtin_bit_cast(bf16x8, h0), acc0, 0, 0, 0);
            acc1 = __builtin_amdgcn_mfma_f32_16x16x32_bf16(xf, __builtin_bit_cast(bf16x8, h1), acc1, 0, 0, 0);
            acc2 = __builtin_amdgcn_mfma_f32_16x16x32_bf16(xf, __builtin_bit_cast(bf16x8, h2), acc2, 0, 0, 0);
        }
        ss += shx(ss, 16, lane); ss += shx(ss, 32, lane);
        if (kh == 1) { part[(rt * 3 + 0) * 64 + lane] = acc0; part[(rt * 3 + 1) * 64 + lane] = acc1; part[(rt * 3 + 2) * 64 + lane] = acc2; if (lane < 16) ssp[rt * 16 + lane] = ss; }
        __syncthreads();
        if (kh == 0) {
            acc0 += part[(rt * 3 + 0) * 64 + lane]; acc1 += part[(rt * 3 + 1) * 64 + lane]; acc2 += part[(rt * 3 + 2) * 64 + lane];
            ss += ssp[rt * 16 + (lane & 15)];
#pragma unroll
            for (int g = 0; g < 4; ++g) { const int rw = rt * 16 + 4 * (lane >> 4) + g; Lg[rw * 48 + (lane & 15)] = acc0[g]; Lg[rw * 48 + 16 + (lane & 15)] = acc1[g]; Lg[rw * 48 + 32 + (lane & 15)] = acc2[g]; }
            if (lane < 16) rsL[rt * 16 + lane] = 1.0f / sqrtf(ss * (1.0f / DM) + NORM_EPS);
        }
        __syncthreads();
        int e1 = 0, e2 = 0, r1 = 0, r2 = 0; float w1 = 0.f, w2 = 0.f, rsv = 0.f;
        if (tid < 64) {
            const LAS float* Lr = Lg + tid * 48; rsv = rsL[tid];
            float gl[4];
#pragma unroll
            for (int g = 0; g < 4; ++g) gl[g] = Lr[g] * rsv + brg[g];
            int gi = 0; float gm = gl[0];
#pragma unroll
            for (int g = 1; g < 4; ++g) if (gl[g] > gm) { gm = gl[g]; gi = g; }
            float den = 0.f;
#pragma unroll
            for (int g = 0; g < 4; ++g) den += expf(gl[g] - gm);
            const float gw = 1.0f / den;
            float v1 = -INFINITY, v2 = -INFINITY; int i1 = 0, i2 = 0;
#pragma unroll
            for (int e = 0; e < 8; ++e) {
                const float v = Lr[4 + 8 * gi + e] * rsv + bre[8 * gi + e];
                if (v > v1) { v2 = v1; i2 = i1; v1 = v; i1 = e; } else if (v > v2) { v2 = v; i2 = e; }
            }
            const float p1 = 1.0f / (1.0f + expf(v2 - v1));
            e1 = 8 * gi + i1; e2 = 8 * gi + i2; w1 = p1 * gw; w2 = (1.0f - p1) * gw;
            r1 = __hip_atomic_fetch_add(&lcnt[e1], 1, __ATOMIC_RELAXED, __HIP_MEMORY_SCOPE_WORKGROUP); r2 = __hip_atomic_fetch_add(&lcnt[e2], 1, __ATOMIC_RELAXED, __HIP_MEMORY_SCOPE_WORKGROUP);
        }
        __syncthreads();
        if (tid < 32) { const int c = lcnt[tid]; lbase[tid] = c ? atomicAdd(&cnt[tid * CNT_STRIDE], c) : 0; lcnt[tid] = 0; }
        __syncthreads();
        if (tid < 64) {
            const int tok = blk * 64 + tid;
            const int pos1 = lbase[e1] + r1, pos2 = lbase[e2] + r2;
            ltok[e1 * MTOK + pos1] = tok; lw[e1 * MTOK + pos1] = w1;
            ltok[e2 * MTOK + pos2] = tok; lw[e2 * MTOK + pos2] = w2;
            tokinfo[tok] = (i32x4){e1, pos1, e2, pos2};
            rs2[tok] = rsv;
        }
        __syncthreads();
    }
}
__device__ __forceinline__ MoeTab moe_tables(const Frame& F, CArgs a, int l) {
    const int lane = otid(), tid = F.wave * 64 + lane; (void)tid; (void)lane;
    volatile LAS int* cntL = F.misc + 64; volatile LAS int* mtp = F.misc + 128; volatile LAS int* sp = F.misc + 192;
    const int* cnt = (const int*)(a->ws + WS_CTL) + CW_CNT + l * 32 * CNT_STRIDE;
    __syncthreads();
    if (tid < 32) cntL[tid] = __hip_atomic_load(cnt + tid * CNT_STRIDE, __ATOMIC_RELAXED, __HIP_MEMORY_SCOPE_AGENT);
    __syncthreads();
    if (tid == 0) { int mt = 0, s = 0; for (int e = 0; e < 32; ++e) { mtp[e] = mt; sp[e] = s; const int c = cntL[e]; mt += (c + 255) >> 8; s += c; } mtp[32] = mt; sp[32] = s; }
    __syncthreads();
    MoeTab T; T.cnt = cntL; T.mtpref = mtp; T.spref = sp; return T;
}
__device__ __forceinline__ void fin_phase(const Frame& F, CArgs a, int l, const MoeTab& T) {
    const int lane = otid(), tid = F.wave * 64 + lane; (void)tid;
    unsigned char* ws = a->ws;
    const i32x4* tokinfo = (const i32x4*)(ws + WS_TOKINFO); const bf16* Y = (const bf16*)(ws + WS_Y);
    bf16* xb = (bf16*)(ws + WS_XB); float* rs1 = (float*)(ws + WS_RS1);
    const int step = 2 * F.ngw;
    int m0 = 2 * F.gw;
    i32x4 tn0 = tokinfo[m0 < MTOK ? m0 : 0], tn1 = tokinfo[m0 + 1 < MTOK ? m0 + 1 : 0];
    for (; m0 < MTOK; m0 += step) {
        const i32x4 ti[2] = {tn0, tn1};
        const int mn = m0 + step;
        if (mn < MTOK) { tn0 = tokinfo[mn]; tn1 = tokinfo[mn + 1]; }
        u32x4 xv[2][2], p[2][2], q[2][2];
#pragma unroll
        for (int r = 0; r < 2; ++r) {
            const int m = m0 + r;
            const int s1 = T.spref[ti[r][0]] + ti[r][1], s2 = T.spref[ti[r][2]] + ti[r][3];
            const u32x4* xr = (const u32x4*)(xb + (size_t)m * DM) + lane;
            const u32x4* y1 = (const u32x4*)(Y + (size_t)s1 * DM) + lane; const u32x4* y2 = (const u32x4*)(Y + (size_t)s2 * DM) + lane;
#pragma unroll
            for (int j = 0; j < 2; ++j) { xv[r][j] = xr[64 * j]; p[r][j] = y1[64 * j]; q[r][j] = y2[64 * j]; }
        }
#pragma unroll
        for (int r = 0; r < 2; ++r) {
            const int m = m0 + r;
            float v[2][8]; float s = 0.f;
#pragma unroll
            for (int j = 0; j < 2; ++j) {
#define FINC(c, f) v[j][2 * c] = bflo(xv[r][j].f) + bflo(p[r][j].f) + bflo(q[r][j].f); v[j][2 * c + 1] = bfhi(xv[r][j].f) + bfhi(p[r][j].f) + bfhi(q[r][j].f);
                FINC(0, x) FINC(1, y) FINC(2, z) FINC(3, w)
#undef FINC
#pragma unroll
                for (int c = 0; c < 8; ++c) s += v[j][c] * v[j][c];
            }
            s = wave_sum(s, lane);
            const float rsv = 1.0f / sqrtf(s * (1.0f / DM) + NORM_EPS);
            if (l == DEPTH - 1) {
#pragma unroll
                for (int j = 0; j < 2; ++j) {
                    const f32x4* g = (const f32x4*)(a->fin_g + 512 * j + 8 * lane); f32x4* o = (f32x4*)(a->out + (size_t)m * DM + 512 * j + 8 * lane);
                    const f32x4 g0 = g[0], g1 = g[1];
                    o[0] = (f32x4){v[j][0] * rsv * g0[0], v[j][1] * rsv * g0[1], v[j][2] * rsv * g0[2], v[j][3] * rsv * g0[3]};
                    o[1] = (f32x4){v[j][4] * rsv * g1[0], v[j][5] * rsv * g1[1], v[j][6] * rsv * g1[2], v[j][7] * rsv * g1[3]};
                }
            } else {
                u32x4* o = (u32x4*)(xb + (size_t)m * DM) + lane;
#pragma unroll
                for (int j = 0; j < 2; ++j) { u32x4 w; w.x = cvtpk(v[j][0], v[j][1]); w.y = cvtpk(v[j][2], v[j][3]); w.z = cvtpk(v[j][4], v[j][5]); w.w = cvtpk(v[j][6], v[j][7]); o[64 * j] = w; }
                if (lane == 0) rs1[m] = rsv;
            }
        }
    }
}

constexpr int PH_PREP = 0, PH_GEMM1 = 1, PH_ATTN = 2, PH_MID = 3, PH_MOE = 4, PH_FIN = 5, PH_PER_LAYER = 6, NPHASE = PH_PER_LAYER * DEPTH - 1;

__global__ void __launch_bounds__(NTHREADS, 2) fwd_kernel(Args a_by_value) {
    extern __shared__ __attribute__((aligned(16))) unsigned char lds_raw[];
    Frame F;
    F.lds = (LAS unsigned char*)lds_raw; F.misc = (volatile LAS int*)(F.lds + MISC_OFF);
    F.wave = __builtin_amdgcn_readfirstlane((int)threadIdx.x >> 6);
    F.G = gridDim.x; { const int bx = blockIdx.x; F.vcu = (F.G % 8 == 0) ? (bx % 8) * (F.G / 8) + bx / 8 : bx; }
    F.gw = blockIdx.x * NWAVES + F.wave; F.ngw = F.G * NWAVES;
    CArgs a = (CArgs)__builtin_amdgcn_kernarg_segment_ptr();
    unsigned char* ws = a->ws;
    const int ph_lo = a->ph_lo, ph_hi = a->ph_hi;
    for (int u = threadIdx.x; u < 1024; u += NTHREADS) F.misc[u] = 0;
    __syncthreads();
#if !MK_MULTI
    XcdBarrier bar = xcd_barrier_post((unsigned*)(ws + WS_CTL) + CW_BAR, (volatile LAS unsigned*)(F.misc + 8));
#define GRID_BAR() xcd_barrier(bar, F.wave)
#else
#define GRID_BAR() do { } while (0)
#endif
    for (int ph = ph_lo, rep = 0; ph < ph_hi; ) {
        const int l = ph >= PH_PER_LAYER ? 1 : 0, k = ph >= PH_PER_LAYER ? ph - (PH_PER_LAYER - 1) : ph;
        const size_t wlo = (size_t)l * WNE_LSTRIDE;
        {
            int bx = blockIdx.x; asm volatile("" : "+s"(bx)); asm volatile("" : "+s"(a)); ws = a->ws;
            int wv = F.wave; asm volatile("" : "+s"(wv)); F.gw = bx * NWAVES + wv; F.bx = bx;
        }
        if (k == PH_PREP && (PHMASK & 1)) {
            prep_phase(F, a);
        } else if (k == PH_GEMM1 && (PHMASK & 2)) {
            DenseSched S; S.A = (const char*)(ws + WS_XB); S.Bt = (const char*)(ws + wlo + WS_WIN); S.K = DM; S.lda = DM; S.ldb = DM; S.ksplit = 0; S.wave = F.wave; S.so.init(MTOK, DIN, F.G, F.bx); S.waitp = nullptr; S.need = 0; S.postp = nullptr; S.err = nullptr;
            EpiProj E{(bf16*)(ws + WS_PQ), (bf16*)(ws + WS_PG), (const float*)(ws + WS_RS1), (const f32x4*)(ws + WS_ROPE)};
            pg8::gemm_phase(F.lds, S, E);
        } else if (k == PH_ATTN && (PHMASK & 4)) {
            attn_phase(F, a, l);
        } else if (k == PH_MID) {
            unsigned* pan = (unsigned*)(ws + WS_CTL) + CW_PAN + l * 3 * 64 * PAN_STRIDE; unsigned* err = (unsigned*)(ws + WS_CTL) + CW_ERR;
            { pg8::StaticOrder so; so.init(MTOK, DM, F.G, F.bx); const int tid_ = F.wave * 64 + otid();
              for (int i = 0, pm, pn; so.next(i, pm, pn); ++i) comb_rows(F, a, pm * 256, tid_);
              VM_WAIT(); __syncthreads(); }
            { DenseSched S; S.A = (const char*)(ws + WS_YAB); S.Bt = (const char*)(ws + wlo + WS_WAB); S.K = 768; S.lda = 768; S.ldb = 768; S.ksplit = 256; S.wave = F.wave; S.so.init(MTOK, DM, F.G, F.bx);
              S.waitp = nullptr; S.need = 0; S.postp = pan; S.err = err;
              EpiMerge E{(const unsigned char*)(ws + WS_PG), (bf16*)(ws + WS_MRG)};
              pg8::gemm_phase(F.lds, S, E); }
            { DenseSched S; S.A = (const char*)(ws + WS_MRG); S.Bt = (const char*)(ws + wlo + WS_WOUT); S.K = DM; S.lda = DM; S.ldb = DM; S.ksplit = 0; S.wave = F.wave; S.so.init(MTOK, DM, F.G, F.bx);
              S.waitp = pan; S.need = 32; S.postp = pan + 64 * PAN_STRIDE; S.err = err;
              EpiResid E{(bf16*)(ws + WS_XB)};
              pg8::gemm_phase(F.lds, S, E); }
            route_phase(F, a, l, pan + 64 * PAN_STRIDE);
        } else if (k == PH_MOE) {
            const MoeTab T = moe_tables(F, a, l);
            const int mtT = T.mtpref[32], nU = 2 * mtT, nU1 = nU < F.G ? nU : F.G, nU2 = nU - nU1, tready = nU1 >> 1;
            const int bx = F.vcu;
            unsigned* upd = (unsigned*)(ws + WS_CTL) + CW_UPD + l * 256 * UPD_STRIDE; unsigned* err = (unsigned*)(ws + WS_CTL) + CW_ERR;
            MoeSched<true> SU; SU.A = (const char*)(ws + WS_XB); SU.Bt = (const char*)(ws + WS_WGU); SU.K = DM; SU.lda = DM; SU.ldb = DM; SU.wave = F.wave; SU.ntn = 2; SU.bstride_e = (size_t)512 * DM * 2; SU.ltok = (const int*)(ws + WS_LTOK); SU.T = T; SU.upd = upd; SU.err = err;
            MoeSched<false> SD; SD.A = (const char*)(ws + WS_H); SD.Bt = (const char*)(ws + WS_WD); SD.K = DEXP; SD.lda = DEXP; SD.ldb = DEXP; SD.wave = F.wave; SD.ntn = 4; SD.bstride_e = (size_t)DM * DEXP * 2; SD.ltok = nullptr; SD.T = T; SD.upd = upd; SD.err = err;
            EpiSwiglu EU{(const int*)(ws + WS_LTOK), (const float*)(ws + WS_LW), (const float*)(ws + WS_RS2), (bf16*)(ws + WS_H)};
            EpiY ED{(bf16*)(ws + WS_Y)};
            SU.G1 = F.G; SU.c1 = bx; SU.lo1 = 0; SU.hi1 = nU; SU.G2 = 1; SU.c2 = -1; SU.lo2 = 0; SU.hi2 = 0;
            pg8::gemm_phase(F.lds, SU, EU);
            SD.G1 = F.G - nU2; SD.c1 = bx - nU2; SD.lo1 = 0; SD.hi1 = 4 * tready;
            { const int extra = (4 * tready) % SD.G1;
              SD.G2 = SD.G1 - extra; SD.c2 = SD.c1 >= extra ? SD.c1 - extra : -1; SD.lo2 = 4 * tready; SD.hi2 = 4 * mtT; }
            pg8::gemm_phase(F.lds, SD, ED);
        } else if (k == PH_FIN && (PHMASK & 512)) {
            const MoeTab T = moe_tables(F, a, l);
            fin_phase(F, a, l, T);
        }
#if REP_MASK
        if (l == 0 && ((REP_MASK >> k) & 1) && rep < REP_N) { ++rep; GRID_BAR(); continue; }
        rep = 0;
#endif
        if (ph + 1 < ph_hi) { GRID_BAR();
#ifdef EXTRA_BAR
            for (int eb = 0; eb < EXTRA_BAR; ++eb) GRID_BAR();
#endif
        }
        ++ph;
    }
}

extern "C" void kernel_launch(void* const* d_in, const int* in_sizes, int n_in, void* d_out, int out_size, void* d_ws, size_t ws_size, hipStream_t stream) {
    static int grid = 0;
    if (grid == 0) {
        if (n_in != 16 || out_size != MTOK * DM || ws_size < WS_END) { fprintf(stderr, "kernel_launch: unexpected shapes (n_in %d out %d ws %zu)\n", n_in, out_size, ws_size); grid = -1; return; }
        int dev = 0, cus = 0, per_cu = 0;
        if (hipGetDevice(&dev) != hipSuccess || hipDeviceGetAttribute(&cus, hipDeviceAttributeMultiprocessorCount, dev) != hipSuccess) { grid = -1; return; }
        if (hipFuncSetAttribute((const void*)fwd_kernel, hipFuncAttributeMaxDynamicSharedMemorySize, LDS_BYTES) != hipSuccess) { fprintf(stderr, "kernel_launch: hipFuncSetAttribute failed\n"); grid = -1; return; }
        if (hipOccupancyMaxActiveBlocksPerMultiprocessor(&per_cu, (const void*)fwd_kernel, NTHREADS, LDS_BYTES) != hipSuccess || per_cu < 1) { fprintf(stderr, "kernel_launch: occupancy query says %d\n", per_cu); (void)hipGetLastError(); }
        grid = cus;
    }
    if (grid < 0) return;
    (void)hipMemsetAsync((char*)d_ws + WS_CTL, 0, CTL_BYTES, stream);
    Args a{};
    a.x = (const float*)d_in[0]; a.attn_g = (const float*)d_in[1]; a.w_in = (const float*)d_in[2]; a.a_sink = (const float*)d_in[3]; a.w_a = (const float*)d_in[4]; a.w_b = (const float*)d_in[5];
    a.w_out = (const float*)d_in[6]; a.ffn_g = (const float*)d_in[7]; a.w_rg = (const float*)d_in[8]; a.b_rg = (const float*)d_in[9]; a.w_re = (const float*)d_in[10]; a.b_re = (const float*)d_in[11];
    a.w_eg = (const float*)d_in[12]; a.w_eu = (const float*)d_in[13]; a.w_ed = (const float*)d_in[14]; a.fin_g = (const float*)d_in[15];
    a.out = (float*)d_out; a.ws = (unsigned char*)d_ws;
#if MK_MULTI
    for (int ph = 0; ph < NPHASE; ++ph) { a.ph_lo = ph; a.ph_hi = ph + 1; hipLaunchKernelGGL(fwd_kernel, dim3(grid), dim3(NTHREADS), LDS_BYTES, stream, a); }
#else
    a.ph_lo = 0; a.ph_hi = NPHASE;
    void* kargs[] = {&a};
    const hipError_t le = hipLaunchCooperativeKernel((const void*)fwd_kernel, dim3(grid), dim3(NTHREADS), kargs, LDS_BYTES, stream);
    if (le != hipSuccess) fprintf(stderr, "kernel_launch: cooperative launch failed: %s (grid %d)\n", hipGetErrorString(le), grid);
#endif
}
```

```cpp
#include <hip/hip_runtime.h>
#include <hip/hip_cooperative_groups.h>
#include <cstdio>
#include <cstdint>
namespace cg = cooperative_groups;

#ifndef REP_MASK
#define REP_MASK 0
#define REP_N 2
#endif
#ifndef PHMASK
#define PHMASK 1023
#endif
#ifndef MK_MULTI
#define MK_MULTI 0
#endif

#define LAS __attribute__((address_space(3)))
#define GAS __attribute__((address_space(1)))
typedef unsigned short bf16;
typedef short bf16x8 __attribute__((ext_vector_type(8)));
typedef short s16x4 __attribute__((ext_vector_type(4)));
typedef float f32x2 __attribute__((ext_vector_type(2)));
typedef float f32x4 __attribute__((ext_vector_type(4)));
typedef float f32x16 __attribute__((ext_vector_type(16)));
typedef unsigned u32x2 __attribute__((ext_vector_type(2)));
typedef unsigned u32x4 __attribute__((ext_vector_type(4)));
typedef int i32x4 __attribute__((ext_vector_type(4)));
typedef __bf16 bf16x2_t __attribute__((ext_vector_type(2)));

constexpr int BATCH = 4, SEQ = 4096, DM = 1024, DEPTH = 2, MTOK = BATCH * SEQ;
constexpr int NQKV = 3072, NGATE = 2048, DIN = NQKV + NGATE;
constexpr int NEXP = 32, DEXP = 256;
constexpr float NORM_EPS = 1e-6f;
constexpr float LOG2E = 1.4426950408889634f, LN2 = 0.6931471805599453f;
constexpr float QSCALE = 0.125f * LOG2E;
constexpr int NWAVES = 8, NTHREADS = 512;

constexpr size_t MiB = 1u << 20;
constexpr size_t WS_CTL = 0, CTL_BYTES = 1 * MiB;
constexpr size_t WS_ROPE = 1 * MiB;
constexpr size_t WS_WR = 2 * MiB, WR_LSTRIDE = 512 * 1024, WR_LO = 256 * 1024;
constexpr size_t WS_RS1 = 3 * MiB, WS_RS2 = 3 * MiB + 65536;
constexpr size_t WS_TOKINFO = 5 * MiB;
constexpr size_t WS_LTOK = 6 * MiB, WS_LW = 8 * MiB;
constexpr size_t WS_LSE = 10 * MiB;
constexpr size_t WS_WIN = 12 * MiB, WS_WAB = 22 * MiB, WS_WOUT = 24 * MiB, WNE_LSTRIDE = 14 * MiB;
constexpr size_t WS_WGU = 40 * MiB, WS_WD = 72 * MiB;
constexpr size_t WS_XB = 88 * MiB;
constexpr size_t WS_YAB = 120 * MiB;
constexpr size_t WS_PQ = 144 * MiB;
constexpr size_t WS_MRG = 176 * MiB, WS_H = 208 * MiB;
constexpr size_t WS_PG = 240 * MiB;
constexpr size_t WS_Y = 240 * MiB;
constexpr size_t WS_END = 304 * MiB;
constexpr int CW_CNT = 64, CNT_STRIDE = 64;
constexpr int CW_BAR = 8192;
constexpr int CW_UPD = 32768, UPD_STRIDE = 64;
constexpr int CW_ERR = 32;
constexpr int CW_PAN = 65536, PAN_STRIDE = 64;

constexpr int RING_BYTES = 131072;
constexpr int PREP_SCR = 16896;
constexpr int MISC_OFF = 8 * PREP_SCR;
constexpr int LDS_BYTES = 147456;

#define LDS_WAIT() asm volatile("s_waitcnt lgkmcnt(0)" ::: "memory")
#define VM_WAIT() asm volatile("s_waitcnt vmcnt(0)" ::: "memory")
__device__ __forceinline__ unsigned cvtpk(float lo, float hi) { f32x2 v = {lo, hi}; bf16x2_t b = __builtin_convertvector(v, bf16x2_t); return __builtin_bit_cast(unsigned, b); }
__device__ __forceinline__ float bf2f(unsigned short h) { return __uint_as_float(((unsigned)h) << 16); }
__device__ __forceinline__ float bflo(unsigned w) { return __uint_as_float(w << 16); }
__device__ __forceinline__ float bfhi(unsigned w) { return __uint_as_float(w & 0xffff0000u); }
__device__ __forceinline__ float fast_exp2(float x) { return __builtin_amdgcn_exp2f(x); }
__device__ __forceinline__ float fast_rcp(float x) { return __builtin_amdgcn_rcpf(x); }
__device__ __forceinline__ void store16_sc1(void* p, u32x4 v) { asm volatile("global_store_dwordx4 %0, %1, off sc1\n\ts_nop 1" :: "v"(p), "v"(v) : "memory"); }
__device__ __forceinline__ int olane() { unsigned z = 0u; asm volatile("" : "+v"(z)); return (int)__builtin_amdgcn_mbcnt_hi(~0u, __builtin_amdgcn_mbcnt_lo(~0u, z)); }
__device__ __forceinline__ float sigmoidf_fast(float v) { return fast_rcp(1.0f + fast_exp2(-v * LOG2E)); }

namespace pg8 {
constexpr int BM = 256, BK = 64, HALF = 128, HTB = HALF * BK * 2, STAGE_BYTES = 8 * HTB, NXCD = 8, WGM = 4;
__host__ __device__ __forceinline__ int lds_byte(int r, int c) { const int st = (r >> 4) * 2 + (c >> 5), rr = r & 15, cc = c & 31, ob = rr * 64 + cc * 2; return st * 1024 + (ob ^ (((ob >> 9) & 1) << 5)); }
__host__ __device__ __forceinline__ void stage_rc(int b, int& R, int& C) { const int st = b / 1024, sb = b % 1024, swz = sb ^ (((sb >> 9) & 1) << 5); R = (st >> 1) * 16 + swz / 64; C = (st & 1) * 32 + (swz % 64) / 2; }
__host__ __device__ __forceinline__ int perm32(int rho) { const int n = rho >> 4, i = rho & 15; return 8 * (i >> 2) + 4 * n + (i & 3); }

struct Unit { int pm, pn, e, nvalid, slot0, lpos0, nt, kofs, sub, waitk; };

struct StaticOrder {
    int nM, nN, nwg, G, c;
    __device__ void init(int M, int N, int G_, int c_) { nM = M / BM; nN = N / BM; nwg = nM * nN; G = G_; c = c_; }
    __device__ bool next(int i, int& pm, int& pn) const {
        const long L = (long)i * G + c; if (L >= nwg) return false;
        int wgid = (int)L; { const int q = nwg / NXCD, r = nwg % NXCD, xcd = wgid % NXCD, off = wgid / NXCD; wgid = (xcd < r ? xcd * (q + 1) : r * (q + 1) + (xcd - r) * q) + off; }
        const int nig = WGM * nN, gid = wgid / nig, fm = gid * WGM, gsz = (nM - fm) < WGM ? (nM - fm) : WGM;
        pm = fm + ((wgid % nig) % gsz); pn = (wgid % nig) / gsz; return true;
    }
};

template <class Epi, class Sched>
__device__ __forceinline__ void gemm_phase(LAS unsigned char* lds, const Sched& S, const Epi& E) {
    unsigned z_ = 0u; asm volatile("" : "+v"(z_)); const int tid_ = (int)__builtin_amdgcn_mbcnt_hi(~0u, __builtin_amdgcn_mbcnt_lo(~0u, z_)) + S.wave * 64;
    const int tid = tid_, wid = S.wave, lane = tid & 63, wr = wid >> 2, wc = wid & 3, fr = lane & 15, fq = lane >> 4;
    const int K = S.ldb;
    unsigned voffA[2], voffB[2];
#pragma unroll
    for (int i = 0; i < 2; ++i) { int R, C; stage_rc(tid * 16 + i * 8192, R, C); const int Rb = Epi::PERM ? ((R & ~31) + perm32(R & 31)) : R;
        voffA[i] = (unsigned)(R * S.lda + C) * 2u; voffB[i] = (unsigned)(Rb * K + C) * 2u; }
    const size_t kstep = (size_t)(BK * 2);
    const size_t hstepB = (size_t)HALF * K * 2, hstepA = (size_t)HALF * S.lda * 2;
    const unsigned ldsw = (unsigned)wid * 1024u;
    const int aoff = lds_byte(wr * 64 + fr, fq * 8), boff = lds_byte(wc * 32 + fr, fq * 8);
#define PG8_SA(b, h) (((b) * 2 + (h)) * HTB)
#define PG8_SB(b, h) ((4 + (b) * 2 + (h)) * HTB)
#define PG8_GLDS(src, dstoff) __builtin_amdgcn_global_load_lds((const unsigned*)(src), (LAS unsigned*)(lds + (dstoff)), 16, 0, 0)
#define PG8_STAGE_A(bufoff, up, h, VO) do { if constexpr (Sched::GATHER) { _Pragma("unroll") for (int _i = 0; _i < 2; ++_i) PG8_GLDS((up) + VO[_i], (bufoff) + ldsw + _i * 8192); } \
        else { const char* _b = (up) + (size_t)(h) * hstepA; _Pragma("unroll") for (int _i = 0; _i < 2; ++_i) PG8_GLDS(_b + voffA[_i], (bufoff) + ldsw + _i * 8192); } } while (0)
#define PG8_STAGE_B(bufoff, bp) do { _Pragma("unroll") for (int _i = 0; _i < 2; ++_i) PG8_GLDS((bp) + voffB[_i], (bufoff) + ldsw + _i * 8192); } while (0)
#define PG8_LDA(dst, b, h) do { _Pragma("unroll") for (int m = 0; m < 4; ++m) _Pragma("unroll") for (int k = 0; k < 2; ++k) dst[m][k] = *(const LAS bf16x8*)(lds + PG8_SA(b, h) + aoff + m * 2048 + k * 1024); } while (0)
#define PG8_LDB(dst, b, h) do { _Pragma("unroll") for (int n = 0; n < 2; ++n) _Pragma("unroll") for (int k = 0; k < 2; ++k) dst[n][k] = *(const LAS bf16x8*)(lds + PG8_SB(b, h) + boff + n * 2048 + k * 1024); } while (0)
#define PG8_MMA(ai, bj, At, Bt) do { __builtin_amdgcn_s_setprio(1); _Pragma("unroll") for (int m = 0; m < 4; ++m) _Pragma("unroll") for (int n = 0; n < 2; ++n) _Pragma("unroll") for (int k = 0; k < 2; ++k) \
        acc[ai][bj][m][n] = __builtin_amdgcn_mfma_f32_16x16x32_bf16(Bt[n][k], At[m][k], acc[ai][bj][m][n], 0, 0, 0); __builtin_amdgcn_s_setprio(0); } while (0)
#define PG8_WAIT_V(n) asm volatile("s_waitcnt vmcnt(" #n ")" ::: "memory")
#define PG8_WAIT_L(n) asm volatile("s_waitcnt lgkmcnt(" #n ")" ::: "memory")
#define PG8_BAR __builtin_amdgcn_s_barrier()
#define PG8_SCHED __builtin_amdgcn_sched_barrier(0)
    Unit cur, nxt; int ui = 0;
    if (!S.next(0, cur)) return;
    f32x4 acc[2][2][4][2];
#pragma unroll
    for (int a = 0; a < 2; ++a)
#pragma unroll
        for (int b = 0; b < 2; ++b)
#pragma unroll
            for (int m = 0; m < 4; ++m)
#pragma unroll
                for (int n = 0; n < 2; ++n) acc[a][b][m][n] = (f32x4){0.f, 0.f, 0.f, 0.f};
    bf16x8 At[4][2], B0[2][2], B1[2][2];
    const char* Ab = S.a_base();
    const char* cA = Ab; const char* cB = S.b_base(cur);
    unsigned vF0[2], vF1[2], vK[2];
    if constexpr (Sched::GATHER) {
#pragma unroll
        for (int i = 0; i < 2; ++i) { int R, C; stage_rc(tid * 16 + i * 8192, R, C); vF0[i] = S.a_off(cur, R) + (unsigned)(C * 2); vF1[i] = S.a_off(cur, HALF + R) + (unsigned)(C * 2); vK[i] = vF1[i]; }
    } else cA = Ab + S.a_unit_off(cur);
    S.a_ready(cur);
    PG8_STAGE_B(PG8_SB(0, 0), cB); PG8_STAGE_B(PG8_SB(0, 1), cB + hstepB); PG8_STAGE_A(PG8_SA(0, 0), cA, 0, vF0); PG8_STAGE_A(PG8_SA(0, 1), cA, 1, vF1);
    if (wr == 1) PG8_BAR;
    PG8_WAIT_V(2); PG8_BAR;
    PG8_STAGE_B(PG8_SB(1, 0), cB + kstep); PG8_STAGE_A(PG8_SA(1, 0), cA + kstep, 0, vF0); PG8_STAGE_B(PG8_SB(1, 1), cB + hstepB + kstep);
    PG8_WAIT_V(6); PG8_BAR;
    for (;;) {
        const bool has_next = S.next(ui + 1, nxt);
        const char* nA = cA; const char* nB = cB;
        if (has_next) { nB = S.b_base(nxt); if constexpr (!Sched::GATHER) nA = Ab + S.a_unit_off(nxt); }
        const int nt = cur.nt;
#pragma unroll 1
        for (int t = 0; t < nt; t += 2) {
            const bool last = (t == nt - 2);
            if (last && has_next) S.a_ready(nxt);
            const char* a1 = cA + (size_t)(t + 1) * kstep;
            const char* a2 = last ? nA : cA + (size_t)(t + 2) * kstep; const char* b2 = last ? nB : cB + (size_t)(t + 2) * kstep;
            const char* a3 = a2 + kstep; const char* b3 = b2 + kstep;
            if constexpr (Sched::GATHER) {
                if (last && has_next) {
#pragma unroll
                    for (int i = 0; i < 2; ++i) { int R, C; stage_rc(tid * 16 + i * 8192, R, C); vF0[i] = S.a_off(nxt, R) + (unsigned)(C * 2); vF1[i] = S.a_off(nxt, HALF + R) + (unsigned)(C * 2); }
                }
            }
            PG8_LDB(B0, 0, 0); PG8_LDB(B1, 0, 1); PG8_SCHED; PG8_LDA(At, 0, 0); PG8_STAGE_A(PG8_SA(1, 1), a1, 1, vK);
            PG8_WAIT_V(8); PG8_WAIT_L(0); PG8_BAR; PG8_MMA(0, 0, At, B0); PG8_MMA(0, 1, At, B1); PG8_BAR; PG8_SCHED;
            PG8_LDA(At, 0, 1); PG8_STAGE_B(PG8_SB(0, 0), b2); PG8_STAGE_B(PG8_SB(0, 1), b2 + hstepB); PG8_STAGE_A(PG8_SA(0, 0), a2, 0, vF0);
            PG8_WAIT_V(8); PG8_WAIT_L(0); PG8_BAR; PG8_MMA(1, 0, At, B0); PG8_MMA(1, 1, At, B1); PG8_BAR; PG8_SCHED;
            PG8_LDB(B0, 1, 0); PG8_LDB(B1, 1, 1); PG8_SCHED; PG8_LDA(At, 1, 0); PG8_STAGE_A(PG8_SA(0, 1), a2, 1, vF1);
            PG8_WAIT_V(8); PG8_WAIT_L(0); PG8_BAR; PG8_MMA(0, 0, At, B0); PG8_MMA(0, 1, At, B1); PG8_BAR; PG8_SCHED;
            PG8_LDA(At, 1, 1); PG8_STAGE_B(PG8_SB(1, 0), b3); PG8_STAGE_B(PG8_SB(1, 1), b3 + hstepB); PG8_STAGE_A(PG8_SA(1, 0), a3, 0, vF0);
            PG8_WAIT_V(8); PG8_WAIT_L(0); PG8_BAR; PG8_MMA(1, 0, At, B0); PG8_MMA(1, 1, At, B1); PG8_BAR; PG8_SCHED;
        }
        if (wr == 0) PG8_BAR;
        bool keep = false;
        if constexpr (Epi::HAS_MID) { if (cur.sub == 0) { E.mid(acc, cur, wr, wc, fr, fq); keep = true; } else E(acc, cur, wr, wc, fr, fq); }
        else E(acc, cur, wr, wc, fr, fq);
        S.done(cur);
        if (!has_next) break;
        if (!keep) {
#pragma unroll
        for (int a = 0; a < 2; ++a)
#pragma unroll
            for (int b = 0; b < 2; ++b)
#pragma unroll
                for (int m = 0; m < 4; ++m)
#pragma unroll
                    for (int n = 0; n < 2; ++n) acc[a][b][m][n] = (f32x4){0.f, 0.f, 0.f, 0.f};
        }
        cur = nxt; cA = nA; cB = nB; ++ui;
        if constexpr (Sched::GATHER) { vK[0] = vF1[0]; vK[1] = vF1[1]; }
        if (wr == 1) PG8_BAR;
    }
    PG8_WAIT_V(0);
    PG8_BAR;
#undef PG8_SA
#undef PG8_SB
#undef PG8_GLDS
#undef PG8_STAGE_A
#undef PG8_STAGE_B
#undef PG8_LDA
#undef PG8_LDB
#undef PG8_MMA
#undef PG8_WAIT_V
#undef PG8_WAIT_L
#undef PG8_BAR
#undef PG8_SCHED
}
}
using pg8::Unit;

struct DenseSched {
    static constexpr bool GATHER = false;
    const char* A; const char* Bt; int K; int lda; int ldb; int wave; int ksplit; pg8::StaticOrder so;
    __device__ __forceinline__ bool next(int i, Unit& u) const {
        int pm, pn; const int ti = ksplit ? (i >> 1) : i; if (!so.next(ti, pm, pn)) return false;
        u.pm = pm; u.pn = pn; u.e = 0; u.nvalid = 256; u.slot0 = pm * 256; u.lpos0 = 0; u.waitk = 1;
        if (ksplit) { u.sub = i & 1; u.kofs = u.sub ? ksplit : 0; u.nt = (u.sub ? K - ksplit : ksplit) / 64; } else { u.sub = 1; u.kofs = 0; u.nt = K / 64; }
        return true; }
    __device__ __forceinline__ const char* a_base() const { return A; }
    __device__ __forceinline__ unsigned a_off(const Unit& u, int r) const { return 0u; }
    __device__ __forceinline__ size_t a_unit_off(const Unit& u) const { return ((size_t)u.pm * 256 * lda + u.kofs) * 2; }
    __device__ __forceinline__ const char* b_base(const Unit& u) const { return Bt + ((size_t)u.pn * 256 * ldb + u.kofs) * 2; }
    unsigned* waitp; unsigned need; unsigned* postp; unsigned* err;
    __device__ __forceinline__ void a_ready(const Unit& u) const {
        if (waitp) {
            if (wave == 0) {
                unsigned* p = waitp + u.pm * PAN_STRIDE; unsigned spins = 0;
                while ((unsigned)__builtin_amdgcn_readfirstlane(__hip_atomic_load(p, __ATOMIC_RELAXED, __HIP_MEMORY_SCOPE_AGENT)) < need) {
                    __builtin_amdgcn_s_sleep(2);
                    if (++spins > (1u << 22)) { __hip_atomic_store(err, 2u, __ATOMIC_RELAXED, __HIP_MEMORY_SCOPE_AGENT); break; }
                }
                __builtin_amdgcn_fence(__ATOMIC_ACQUIRE, "agent");
                asm volatile("s_waitcnt vmcnt(0)" ::: "memory");
            }
            asm volatile("" ::: "memory"); __builtin_amdgcn_s_barrier(); asm volatile("" ::: "memory");
        }
    }
    __device__ __forceinline__ void done(const Unit& u) const {
        if (postp && u.sub == 1) {
            asm volatile("s_waitcnt vmcnt(0)" ::: "memory");
            if (olane() == 0) __hip_atomic_fetch_add(postp + u.pm * PAN_STRIDE, 1u, __ATOMIC_RELAXED, __HIP_MEMORY_SCOPE_AGENT);
        }
    }
};
struct MoeTab { const volatile LAS int* cnt; const volatile LAS int* mtpref; const volatile LAS int* spref; };
template <bool GATHER_> struct MoeSched {
    static constexpr bool GATHER = GATHER_;
    const char* A; const char* Bt; int K; int lda; int ldb; int wave; int ntn; size_t bstride_e; const int* ltok; MoeTab T;
    int G1, c1, lo1, hi1, G2, c2, lo2, hi2; unsigned* upd; unsigned* err;
    __device__ __forceinline__ bool next(int i, Unit& u) const {
        int L;
        const int n1 = (c1 >= 0 && lo1 + c1 < hi1) ? (hi1 - lo1 - c1 + G1 - 1) / G1 : 0;
        if (i < n1) { L = lo1 + c1 + i * G1; u.waitk = (i == 0) ? 2 : 0; }
        else { L = lo2 + c2 + (i - n1) * G2; if (c2 < 0 || L >= hi2) return false; u.waitk = 1; }
        const int tix = L / ntn; u.pn = L - tix * ntn; u.pm = tix;
        int e = 0;
#pragma unroll 1
        for (int k = 1; k < 32; ++k) if (T.mtpref[k] <= tix) e = k;
        const int mt = tix - T.mtpref[e]; u.e = e; u.slot0 = T.spref[e] + 256 * mt; const int rem = T.cnt[e] - 256 * mt; u.nvalid = rem < 256 ? rem : 256; u.lpos0 = e * MTOK + 256 * mt; u.nt = K / 64; u.kofs = 0; u.sub = 1; return true;
    }
    __device__ __forceinline__ const char* a_base() const { return A; }
    __device__ __forceinline__ unsigned a_off(const Unit& u, int r) const { const int rr = r < u.nvalid ? r : u.nvalid - 1; return (unsigned)ltok[u.lpos0 + rr] * (unsigned)(lda * 2); }
    __device__ __forceinline__ size_t a_unit_off(const Unit& u) const { return (size_t)u.slot0 * lda * 2; }
    __device__ __forceinline__ const char* b_base(const Unit& u) const { return Bt + (size_t)u.e * bstride_e + (size_t)u.pn * 256 * K * 2; }
    __device__ __forceinline__ void a_ready(const Unit& u) const {
        if constexpr (!GATHER_) {
            if (u.waitk == 0) return;
            if (wave == 0) {
                const int n1 = (c1 >= 0 && lo1 + c1 < hi1) ? (hi1 - lo1 - c1 + G1 - 1) / G1 : 0;
                const int nw = (u.waitk == 2) ? n1 : 1;
                unsigned spins = 0;
                for (int q = 0; q < nw; ++q) {
                    const int tix = (u.waitk == 2) ? (lo1 + c1 + q * G1) / ntn : u.pm;
                    unsigned* p = upd + tix * UPD_STRIDE;
                    while ((unsigned)__builtin_amdgcn_readfirstlane(__hip_atomic_load(p, __ATOMIC_RELAXED, __HIP_MEMORY_SCOPE_AGENT)) < 16u) {
                        __builtin_amdgcn_s_sleep(2);
                        if (++spins > (1u << 22)) { __hip_atomic_store(err, 1u, __ATOMIC_RELAXED, __HIP_MEMORY_SCOPE_AGENT); break; }
                    }
                }
                __builtin_amdgcn_fence(__ATOMIC_ACQUIRE, "agent");
                asm volatile("s_waitcnt vmcnt(0)" ::: "memory");
            }
            asm volatile("" ::: "memory"); __builtin_amdgcn_s_barrier(); asm volatile("" ::: "memory");
        }
    }
    __device__ __forceinline__ void done(const Unit& u) const {
        if constexpr (GATHER_) {
            asm volatile("s_waitcnt vmcnt(0)" ::: "memory");
            if (olane() == 0) __hip_atomic_fetch_add(upd + u.pm * UPD_STRIDE, 1u, __ATOMIC_RELAXED, __HIP_MEMORY_SCOPE_AGENT);
        }
    }
};

#define OPAQUE(p) asm volatile("" : "+v"(p))
struct EpiProj {
    static constexpr bool PERM = true, REPEAT = true, HAS_MID = false;
    bf16* Pq; bf16* Pg; const float* rs; const f32x4* rope;
    __device__ __forceinline__ static void rot(f32x4& c, const f32x4& st) {
        const f32x4 o = c;
        c[0] = o[0] * st[0] - o[1] * st[1]; c[1] = o[1] * st[0] + o[0] * st[1];
        c[2] = o[2] * st[2] - o[3] * st[3]; c[3] = o[3] * st[2] + o[2] * st[3];
    }
    __device__ __forceinline__ void operator()(const f32x4 (&acc)[2][2][4][2], const Unit& u, int wr, int wc, int fr, int fq) const {
        const int colh = wc * 32 + fq * 8;
        const int ib = (colh & 63) >> 2;
        const int row0 = u.pm * 256 + wr * 64 + fr;
        int mode[2]; bf16* ob[2]; size_t ostep[2];
#pragma unroll
        for (int bj = 0; bj < 2; ++bj) {
            const int h128 = 2 * u.pn + bj;
            if (h128 >= 24) mode[bj] = 3;
            else if (h128 < 6) mode[bj] = h128 < 4 ? 1 : (h128 == 4 ? 2 : 0);
            else { const int j = (h128 - 6) % 6; mode[bj] = j < 2 ? 1 : (j < 4 ? 2 : 0); }
            if (h128 < 24) { ob[bj] = Pq + h128 * 128 + colh + (size_t)row0 * NQKV; ostep[bj] = (size_t)NQKV * 16; }
            else { ob[bj] = Pg + (((h128 - 24) * 128 + colh) >> 1) + (size_t)row0 * (NGATE / 2); ostep[bj] = (size_t)(NGATE / 2) * 16; }
        }
        float rsv[8];
#pragma unroll
        for (int i = 0; i < 8; ++i) rsv[i] = rs[row0 + (i >> 2) * 128 + (i & 3) * 16];
        const f32x4* rp = rope + (size_t)(row0 & (SEQ - 1)) * 16 + ib;
        f32x4 c0 = rp[0], c1 = rp[1];
        const f32x4 s16a = rope[16 * 16 + ib], s16b = rope[16 * 16 + ib + 1], s80a = rope[80 * 16 + ib], s80b = rope[80 * 16 + ib + 1];
#pragma unroll
        for (int ai = 0; ai < 2; ++ai)
#pragma unroll
            for (int m = 0; m < 4; ++m) {
                OPAQUE(ob[0]); OPAQUE(ob[1]);
                const float s = rsv[ai * 4 + m];
#pragma unroll
                for (int bj = 0; bj < 2; ++bj) {
                    f32x4 v0 = acc[ai][bj][m][0] * s, v1 = acc[ai][bj][m][1] * s;
                    if (mode[bj] == 1 || mode[bj] == 2) {
                        f32x4 o0, o1;
                        o0[0] = v0[0] * c0[0] - v0[1] * c0[1]; o0[1] = v0[1] * c0[0] + v0[0] * c0[1];
                        o0[2] = v0[2] * c0[2] - v0[3] * c0[3]; o0[3] = v0[3] * c0[2] + v0[2] * c0[3];
                        o1[0] = v1[0] * c1[0] - v1[1] * c1[1]; o1[1] = v1[1] * c1[0] + v1[0] * c1[1];
                        o1[2] = v1[2] * c1[2] - v1[3] * c1[3]; o1[3] = v1[3] * c1[2] + v1[2] * c1[3];
                        const float qs = (mode[bj] == 1) ? QSCALE : 1.0f;
                        v0 = o0 * qs; v1 = o1 * qs;
                    } else if (mode[bj] == 3) {
#pragma unroll
                        for (int j = 0; j < 4; ++j) { v0[j] = sigmoidf_fast(v0[j]); v1[j] = sigmoidf_fast(v1[j]); }
                    }
                    if (mode[bj] == 3) {
                        unsigned q[8];
#pragma unroll
                        for (int j = 0; j < 4; ++j) { q[j] = (unsigned)fminf(v0[j] * 256.0f, 255.0f); q[4 + j] = (unsigned)fminf(v1[j] * 256.0f, 255.0f); }
                        u32x2 w; w.x = q[0] | (q[1] << 8) | (q[2] << 16) | (q[3] << 24); w.y = q[4] | (q[5] << 8) | (q[6] << 16) | (q[7] << 24);
                        *(u32x2*)(ob[bj]) = w;
                    } else {
                        u32x4 w; w.x = cvtpk(v0[0], v0[1]); w.y = cvtpk(v0[2], v0[3]); w.z = cvtpk(v1[0], v1[1]); w.w = cvtpk(v1[2], v1[3]);
                        *(u32x4*)(ob[bj]) = w;
                    }
                }
                if (m == 3) { rot(c0, s80a); rot(c1, s80b); } else { rot(c0, s16a); rot(c1, s16b); }
                const int adv = (m == 3) ? 5 : 1;
                ob[0] += ostep[0] * adv; ob[1] += ostep[1] * adv;
            }
    }
};
struct EpiMerge {
    static constexpr bool PERM = true, REPEAT = false, HAS_MID = true;
    const unsigned char* gate; bf16* out;
    __device__ __forceinline__ static float dq(unsigned w, int k) { return ((float)((w >> (8 * k)) & 255u) + 0.5f) * (1.0f / 256.0f); }
    __device__ __forceinline__ void mid(f32x4 (&acc)[2][2][4][2], const Unit& u, int wr, int wc, int fr, int fq) const {
        const int row0 = u.pm * 256 + wr * 64 + fr, col0 = u.pn * 256 + wc * 32 + fq * 8;
        const unsigned char* gp = gate + (size_t)row0 * NGATE + col0;
        u32x2 ga[2][2], gb[2][2];
#define EM_LOAD(slot, i) do { const size_t ro = (size_t)(16 * (i) + 64 * ((i) >> 2)) * NGATE; ga[slot][0] = *(const u32x2*)(gp + ro); ga[slot][1] = *(const u32x2*)(gp + ro + 128); \
        gb[slot][0] = *(const u32x2*)(gp + ro + 1024); gb[slot][1] = *(const u32x2*)(gp + ro + 1024 + 128); } while (0)
        EM_LOAD(0, 0);
#pragma unroll
        for (int i = 0; i < 8; ++i) {
            const int ai = i >> 2, m = i & 3, sl = i & 1;
            if (i + 1 < 8) { if (sl == 0) EM_LOAD(1, i + 1); else EM_LOAD(0, i + 1); }
#pragma unroll
            for (int bj = 0; bj < 2; ++bj) {
                const u32x2 A = ga[sl][bj], B = gb[sl][bj];
#pragma unroll
                for (int j = 0; j < 4; ++j) {
                    acc[ai][bj][m][0][j] *= dq(B.x, j) * fast_rcp(dq(A.x, j));
                    acc[ai][bj][m][1][j] *= dq(B.y, j) * fast_rcp(dq(A.y, j));
                }
            }
        }
#undef EM_LOAD
    }
    __device__ __forceinline__ void operator()(const f32x4 (&acc)[2][2][4][2], const Unit& u, int wr, int wc, int fr, int fq) const {
        const int row0 = u.pm * 256 + wr * 64 + fr, col0 = u.pn * 256 + wc * 32 + fq * 8;
        const unsigned char* gp = gate + (size_t)row0 * NGATE + col0; bf16* op = out + (size_t)row0 * DM + col0;
        u32x2 ga[2][2];
#define EF_LOAD(slot, i) do { const size_t ro = (size_t)(16 * (i) + 64 * ((i) >> 2)) * NGATE; ga[slot][0] = *(const u32x2*)(gp + ro); ga[slot][1] = *(const u32x2*)(gp + ro + 128); } while (0)
        EF_LOAD(0, 0);
#pragma unroll
        for (int i = 0; i < 8; ++i) {
            const int ai = i >> 2, m = i & 3, sl = i & 1;
            if (i + 1 < 8) { if (sl == 0) EF_LOAD(1, i + 1); else EF_LOAD(0, i + 1); }
            bf16* orow = op + (size_t)(16 * i + 64 * (i >> 2)) * DM;
#pragma unroll
            for (int bj = 0; bj < 2; ++bj) {
                const u32x2 A = ga[sl][bj];
                const f32x4 a0 = acc[ai][bj][m][0], a1 = acc[ai][bj][m][1];
                u32x4 w;
                w.x = cvtpk(a0[0] * dq(A.x, 0), a0[1] * dq(A.x, 1)); w.y = cvtpk(a0[2] * dq(A.x, 2), a0[3] * dq(A.x, 3));
                w.z = cvtpk(a1[0] * dq(A.y, 0), a1[1] * dq(A.y, 1)); w.w = cvtpk(a1[2] * dq(A.y, 2), a1[3] * dq(A.y, 3));
                store16_sc1(orow + bj * 128, w);
            }
            asm volatile("" ::: "memory");
        }
#undef EF_LOAD
    }
};
struct EpiResid {
    static constexpr bool PERM = true, REPEAT = false, HAS_MID = false;
    bf16* xb;
    __device__ __forceinline__ void operator()(const f32x4 (&acc)[2][2][4][2], const Unit& u, int wr, int wc, int fr, int fq) const {
        const int row0 = u.pm * 256 + wr * 64 + fr, col0 = u.pn * 256 + wc * 32 + fq * 8;
        bf16* xp = xb + (size_t)row0 * DM + col0;
        u32x4 p[2][2];
#define ER_LOAD(slot, i) do { const size_t ro = (size_t)(16 * (i) + 64 * ((i) >> 2)); p[slot][0] = *(const u32x4*)(xp + ro * DM); p[slot][1] = *(const u32x4*)(xp + ro * DM + 128); } while (0)
        ER_LOAD(0, 0);
#pragma unroll
        for (int i = 0; i < 8; ++i) {
            const int ai = i >> 2, m = i & 3, sl = i & 1;
            if (i + 1 < 8) { if (sl == 0) ER_LOAD(1, i + 1); else ER_LOAD(0, i + 1); }
            bf16* orow = xp + (size_t)(16 * i + 64 * (i >> 2)) * DM;
#pragma unroll
            for (int bj = 0; bj < 2; ++bj) {
                const u32x4 q = p[sl][bj];
                const f32x4 a0 = acc[ai][bj][m][0], a1 = acc[ai][bj][m][1];
                u32x4 w;
                w.x = cvtpk(a0[0] + bflo(q.x), a0[1] + bfhi(q.x)); w.y = cvtpk(a0[2] + bflo(q.y), a0[3] + bfhi(q.y));
                w.z = cvtpk(a1[0] + bflo(q.z), a1[1] + bfhi(q.z)); w.w = cvtpk(a1[2] + bflo(q.w), a1[3] + bfhi(q.w));
                store16_sc1(orow + bj * 128, w);
            }
            asm volatile("" ::: "memory");
        }
#undef ER_LOAD
    }
};
struct EpiSwiglu {
    static constexpr bool PERM = true, REPEAT = false, HAS_MID = false;
    const int* ltok; const float* lw; const float* rs; bf16* H;
    __device__ __forceinline__ void operator()(const f32x4 (&acc)[2][2][4][2], const Unit& u, int wr, int wc, int fr, int fq) const {
        int tok[8]; float w8[8], s8[8];
#pragma unroll
        for (int i = 0; i < 8; ++i) { const int rr = (i >> 2) * 128 + wr * 64 + (i & 3) * 16 + fr; const int rc = rr < u.nvalid ? rr : u.nvalid - 1; tok[i] = ltok[u.lpos0 + rc]; w8[i] = lw[u.lpos0 + rc]; }
#pragma unroll
        for (int i = 0; i < 8; ++i) s8[i] = rs[tok[i]];
#pragma unroll
        for (int ai = 0; ai < 2; ++ai)
#pragma unroll
            for (int m = 0; m < 4; ++m) {
                const int rr = ai * 128 + wr * 64 + m * 16 + fr;
                if (rr < u.nvalid) {
                    const float w = w8[ai * 4 + m], s = s8[ai * 4 + m];
#pragma unroll
                    for (int bj = 0; bj < 2; ++bj) {
                        const f32x4 a0 = acc[ai][bj][m][0] * s, a1 = acc[ai][bj][m][1] * s;
                        const float h0 = a0[0] * sigmoidf_fast(a0[0]) * a0[1] * w, h1 = a0[2] * sigmoidf_fast(a0[2]) * a0[3] * w;
                        const float h2 = a1[0] * sigmoidf_fast(a1[0]) * a1[1] * w, h3 = a1[2] * sigmoidf_fast(a1[2]) * a1[3] * w;
                        u32x2 o; o.x = cvtpk(h0, h1); o.y = cvtpk(h2, h3);
                        __hip_atomic_store((unsigned long long*)(H + (size_t)(u.slot0 + rr) * DEXP + u.pn * 128 + bj * 64 + wc * 16 + fq * 4), (unsigned long long)o.x | ((unsigned long long)o.y << 32), __ATOMIC_RELAXED, __HIP_MEMORY_SCOPE_AGENT);
                    }
                }
            }
    }
};
struct EpiY {
    static constexpr bool PERM = true, REPEAT = false, HAS_MID = false;
    bf16* Y;
    __device__ __forceinline__ void operator()(const f32x4 (&acc)[2][2][4][2], const Unit& u, int wr, int wc, int fr, int fq) const {
#pragma unroll
        for (int ai = 0; ai < 2; ++ai)
#pragma unroll
            for (int m = 0; m < 4; ++m) {
                const int rr = ai * 128 + wr * 64 + m * 16 + fr;
                if (rr < u.nvalid) {
#pragma unroll
                    for (int bj = 0; bj < 2; ++bj) {
                        const f32x4 a0 = acc[ai][bj][m][0], a1 = acc[ai][bj][m][1];
                        u32x4 w; w.x = cvtpk(a0[0], a0[1]); w.y = cvtpk(a0[2], a0[3]); w.z = cvtpk(a1[0], a1[1]); w.w = cvtpk(a1[2], a1[3]);
                        *(u32x4*)(Y + (size_t)(u.slot0 + rr) * DM + u.pn * 256 + bj * 128 + wc * 32 + fq * 8) = w;
                    }
                }
            }
    }
};

#define XB_TMO      128
#define XB_XCNT(j)  (256  + 64 * (j))
#define XB_XSUB(j)  (1280 + 64 * (j))
#define XB_XGEN(j)  (2304 + 64 * (j))
#define XB_TOP      3328
#define XB_TOPGEN   3392
#define XCD_BAR_WORDS 3456
#define XB_SPIN_CAP (1u << 18)
__device__ __forceinline__ unsigned xb_ld(unsigned* p)              { return __hip_atomic_load(p, __ATOMIC_RELAXED, __HIP_MEMORY_SCOPE_AGENT); }
__device__ __forceinline__ unsigned xb_add(unsigned* p, unsigned v) { return __hip_atomic_fetch_add(p, v, __ATOMIC_RELAXED, __HIP_MEMORY_SCOPE_AGENT); }
__device__ __forceinline__ unsigned xb_xcc_id() { return (unsigned)__builtin_amdgcn_s_getreg((3 << 11) | 20) & 0xFu; }
#define XB_SPIN(cond, bar) do { unsigned _sp = 0; while (cond) { __builtin_amdgcn_s_sleep(1); \
    if ((++_sp & 255u) == 0u) { if (xb_ld(&(bar)[XB_TMO])) break; if (_sp > XB_SPIN_CAP) { atomicAdd(&(bar)[XB_TMO], 1u); break; } } } } while (0)
struct XcdBarrier { unsigned* bar; unsigned x; volatile LAS unsigned* st; };
__device__ __forceinline__ XcdBarrier xcd_barrier_post(unsigned* bar, volatile LAS unsigned* st) {
    XcdBarrier b; b.bar = bar; b.x = xb_xcc_id(); b.st = st;
    if (threadIdx.x == 0) (void)xb_add(&bar[XB_XCNT(b.x)], 1u);
    return b;
}
__device__ __forceinline__ void xcd_barrier_complete(unsigned* bar, unsigned x, unsigned& nloc, unsigned& nx) {
    const unsigned G = gridDim.x * gridDim.y * gridDim.z;
    unsigned sum, cnt, mine, sp = 0u;
    for (;;) {
        sum = 0u; cnt = 0u; mine = 0u;
#pragma unroll
        for (unsigned j = 0; j < 16; ++j) { const unsigned c = xb_ld(&bar[XB_XCNT(j)]); sum += c; cnt += (c > 0u) ? 1u : 0u; mine = (j == x) ? c : mine; }
        if (sum == G) break;
        __builtin_amdgcn_s_sleep(1);
        if ((++sp & 255u) == 0u) { if (xb_ld(&bar[XB_TMO])) break; if (sp > XB_SPIN_CAP) { atomicAdd(&bar[XB_TMO], 1u); break; } }
    }
    nloc = mine > 0u ? mine : 1u; nx = cnt > 0u ? cnt : 1u;
}
__device__ __forceinline__ void xcd_barrier(const XcdBarrier& b, int wave) {
    asm volatile("s_waitcnt vmcnt(0)" ::: "memory");
    __syncthreads();
    unsigned zb_ = 0u; asm volatile("" : "+v"(zb_));
    if (wave == 0 && __builtin_amdgcn_mbcnt_hi(~0u, __builtin_amdgcn_mbcnt_lo(~0u, zb_)) == 0u) {
        unsigned* bar = b.bar;
        __builtin_amdgcn_s_waitcnt(0);
        unsigned nloc = b.st[0], nx = b.st[1];
        if (nloc == 0u) { xcd_barrier_complete(bar, b.x, nloc, nx); b.st[0] = nloc; b.st[1] = nx; }
        const unsigned old = xb_add(&bar[XB_XSUB(b.x)], 1u);
        const unsigned gen = old / nloc;
        if (old + 1u == (gen + 1u) * nloc) {
            __builtin_amdgcn_fence(__ATOMIC_RELEASE, "agent");
            asm volatile("s_waitcnt vmcnt(0)" ::: "memory");
            const unsigned og = xb_add(&bar[XB_TOP], 1u);
            const unsigned tg = og / nx;
            if (og + 1u == (tg + 1u) * nx) xb_add(&bar[XB_TOPGEN], 1u);
            else XB_SPIN(xb_ld(&bar[XB_TOPGEN]) == tg, bar);
            __builtin_amdgcn_fence(__ATOMIC_ACQUIRE, "agent");
            xb_add(&bar[XB_XGEN(b.x)], 1u);
            asm volatile("s_waitcnt vmcnt(0)" ::: "memory");
        } else {
            XB_SPIN(xb_ld(&bar[XB_XGEN(b.x)]) == gen, bar);
            __builtin_amdgcn_fence(__ATOMIC_ACQUIRE, "agent");
            asm volatile("s_waitcnt vmcnt(0)" ::: "memory");
        }
    }
    __syncthreads();
}

struct Args {
    const float* x; const float* attn_g; const float* w_in; const float* a_sink; const float* w_a; const float* w_b; const float* w_out; const float* ffn_g;
    const float* w_rg; const float* b_rg; const float* w_re; const float* b_re; const float* w_eg; const float* w_eu; const float* w_ed; const float* fin_g;
    float* out; unsigned char* ws; int ph_lo, ph_hi;
};
typedef const __attribute__((address_space(4))) Args* CArgs;
struct Frame {
    LAS unsigned char* lds; volatile LAS int* misc;
    int wave, G, vcu, gw, ngw, bx;
};
__device__ __forceinline__ int otid() { unsigned z = 0u; asm volatile("" : "+v"(z)); return (int)__builtin_amdgcn_mbcnt_hi(~0u, __builtin_amdgcn_mbcnt_lo(~0u, z)); }
__device__ __forceinline__ float shx(float v, int o, int lane) { return __int_as_float(__builtin_amdgcn_ds_bpermute((lane ^ o) << 2, __float_as_int(v))); }
__device__ __forceinline__ float wave_sum(float v, int lane) {
#pragma unroll
    for (int o = 1; o < 64; o <<= 1) v += shx(v, o, lane);
    return v;
}

struct MapPlain { __device__ __forceinline__ int operator()(int n) const { return n; } };
struct MapWin { __device__ __forceinline__ int operator()(int n) const {
        bool rope = false;
        if (n < 640) rope = true; else if (n >= 768 && n < NQKV) rope = ((n - 768) % 768) < 512;
        if (!rope) return n; const int d = n & 63; return (n & ~63) + 2 * (d & 31) + (d >> 5); } };
struct MapGU { int t; __device__ __forceinline__ int operator()(int n) const { return 2 * n + t; } };
template <class Map> __device__ __forceinline__ void transpose_item64(const float* W, int ldn, int k0, int n0, const float* gk, bf16* WT, int Kd, const Map& map, LAS float* scr, int lane) {
    const int kq = lane >> 4, n4 = (lane & 15) * 4;
    const float* src = W + (size_t)(k0 + kq) * ldn + n0 + n4;
    f32x4 v[16];
#pragma unroll
    for (int i = 0; i < 16; ++i) v[i] = __builtin_nontemporal_load((const f32x4*)(src + (size_t)(4 * i) * ldn));
    if (gk) {
#pragma unroll
        for (int i = 0; i < 16; ++i) v[i] = v[i] * gk[k0 + 4 * i + kq];
    }
#pragma unroll
    for (int i = 0; i < 16; ++i) { LAS float* d = scr + (4 * i + kq) * 65 + n4; d[0] = v[i][0]; d[1] = v[i][1]; d[2] = v[i][2]; d[3] = v[i][3]; }
    LDS_WAIT(); asm volatile("" ::: "memory");
    const int c = lane & 7;
#pragma unroll
    for (int j = 0; j < 8; ++j) { const int n = (lane >> 3) + 8 * j; const LAS float* p = scr + (8 * c) * 65 + n;
        u32x4 o; o.x = cvtpk(p[0 * 65], p[1 * 65]); o.y = cvtpk(p[2 * 65], p[3 * 65]); o.z = cvtpk(p[4 * 65], p[5 * 65]); o.w = cvtpk(p[6 * 65], p[7 * 65]);
        *(u32x4*)(WT + (size_t)map(n0 + n) * Kd + k0 + 8 * c) = o; }
    LDS_WAIT(); asm volatile("" ::: "memory");
}
__device__ __forceinline__ void prep_phase(const Frame& F, CArgs a) {
    const int lane = otid(), tid = F.wave * 64 + lane; (void)tid; (void)lane;
    unsigned char* ws = a->ws;
    LAS float* scr = (LAS float*)(F.lds + F.wave * PREP_SCR);
    constexpr int I_IN = 16 * 80, I_A = 8 * 16, I_B = 4 * 16, I_O = 16 * 16, I_L = I_IN + I_A + I_B + I_O;
    for (int it = F.gw; it < DEPTH * I_L; it += F.ngw) {
        const int l = it / I_L; int r = it - l * I_L;
        unsigned char* wl = ws + (size_t)l * WNE_LSTRIDE;
        if (r < I_IN) { transpose_item64(a->w_in + (size_t)l * DM * DIN, DIN, 64 * (r / 80), 64 * (r % 80), a->attn_g + l * DM, (bf16*)(wl + WS_WIN), DM, MapWin{}, scr, lane); continue; } r -= I_IN;
        if (r < I_A) { transpose_item64(a->w_a + (size_t)l * 512 * DM, DM, 64 * (r / 16), 64 * (r % 16), nullptr, (bf16*)(wl + WS_WAB) + 256, 768, MapPlain{}, scr, lane); continue; } r -= I_A;
        if (r < I_B) { transpose_item64(a->w_b + (size_t)l * 256 * DM, DM, 64 * (r / 16), 64 * (r % 16), nullptr, (bf16*)(wl + WS_WAB), 768, MapPlain{}, scr, lane); continue; } r -= I_B;
        transpose_item64(a->w_out + (size_t)l * DM * DM, DM, 64 * (r / 16), 64 * (r % 16), nullptr, (bf16*)(wl + WS_WOUT), DM, MapPlain{}, scr, lane);
    }
    for (int idx = F.bx * NTHREADS + tid; idx < DEPTH * 32 * 3 * 64 * 8; idx += F.G * NTHREADS) {
        const int l = idx / (32 * 3 * 64 * 8), id = idx - l * (32 * 3 * 64 * 8);
        const int j = id & 7, ln = (id >> 3) & 63, q = id >> 9, nt = q % 3, i = q / 3;
        const int k = 32 * i + 8 * (ln >> 4) + j, n = 16 * nt + (ln & 15);
        const float* wg = a->w_rg + (size_t)l * DM * 4; const float* we = a->w_re + (size_t)l * DM * NEXP;
        float v = 0.f; if (n < 4) v = wg[k * 4 + n]; else if (n < 36) v = we[k * NEXP + (n - 4)];
        v *= a->ffn_g[l * DM + k];
        const unsigned hb = cvtpk(v, 0.f) & 0xffffu; const float hf = __uint_as_float(hb << 16);
        const unsigned lb = cvtpk(v - hf, 0.f) & 0xffffu;
        ((bf16*)(ws + WS_WR + l * WR_LSTRIDE))[id] = (bf16)hb; ((bf16*)(ws + WS_WR + l * WR_LSTRIDE + WR_LO))[id] = (bf16)lb;
    }
    {
        float* rt = (float*)(ws + WS_ROPE);
        for (int idx = F.bx * NTHREADS + tid; idx < SEQ * 32; idx += F.G * NTHREADS) {
            const int pos = idx >> 5, i = idx & 31;
            const float inv = 1.0f / powf(10000.0f, (float)(2 * i) / 64.0f);
            const float ang = (float)pos * inv;
            const double ad = (double)ang, kd = __builtin_rint(ad * 0.15915494309189535);
            const float rf = (float)__builtin_fma(-kd, 6.283185307179586, ad);
            rt[idx * 2] = cosf(rf); rt[idx * 2 + 1] = sinf(rf);
        }
        bf16* xb = (bf16*)(ws + WS_XB); float* rs1 = (float*)(ws + WS_RS1);
        for (int m = F.gw; m < MTOK; m += F.ngw) {
            const f32x4* xr = (const f32x4*)(a->x + (size_t)m * DM) + lane;
            f32x4 v[4]; float s = 0.f;
#pragma unroll
            for (int j = 0; j < 4; ++j) { v[j] = __builtin_nontemporal_load(xr + 64 * j); s += (v[j][0] * v[j][0] + v[j][1] * v[j][1]) + (v[j][2] * v[j][2] + v[j][3] * v[j][3]); }
            s = wave_sum(s, lane);
            u32x2* o = (u32x2*)(xb + (size_t)m * DM) + lane;
#pragma unroll
            for (int j = 0; j < 4; ++j) { u32x2 w; w.x = cvtpk(v[j][0], v[j][1]); w.y = cvtpk(v[j][2], v[j][3]); o[64 * j] = w; }
            if (lane == 0) rs1[m] = 1.0f / sqrtf(s * (1.0f / DM) + NORM_EPS);
        }
    }
}
__device__ __forceinline__ void prep_experts(const Frame& F, CArgs a, int l, int lane, int part, int w, int nw) {
    unsigned char* ws = a->ws;
    LAS float* scr = (LAS float*)(F.lds + F.wave * PREP_SCR);
    constexpr int I_G = 16 * 4, I_D = 4 * 16;
    const float* fg = a->ffn_g + l * DM;
    if (part == 0) {
        for (int it = w; it < NEXP * 2 * I_G; it += nw) {
            const int e = it / (2 * I_G); int r = it - e * (2 * I_G); const int t = r / I_G; r -= t * I_G;
            const size_t eo = ((size_t)l * NEXP + e) * DM * DEXP; const float* W = (t ? a->w_eu : a->w_eg) + eo;
            transpose_item64(W, DEXP, 64 * (r / 4), 64 * (r % 4), fg, (bf16*)(ws + WS_WGU) + (size_t)e * 512 * DM, DM, MapGU{t}, scr, lane);
        }
    } else {
        for (int it = w; it < NEXP * I_D; it += nw) {
            const int e = it / I_D, r = it - e * I_D;
            const size_t eo = ((size_t)l * NEXP + e) * DM * DEXP;
            transpose_item64(a->w_ed + eo, DM, 64 * (r / 16), 64 * (r % 16), nullptr, (bf16*)(ws + WS_WD) + (size_t)e * DM * DEXP, DEXP, MapPlain{}, scr, lane);
        }
    }
}

__device__ __forceinline__ int crow(int r, int hi) { return (r & 3) + 8 * (r >> 2) + 4 * hi; }
struct AttnUnit { int kcol, vcol, b, d, r, t0, span, W, qcol, tq; float m0, l0; bf16* outp; int opitch; float* lsep; bool valid; };
__device__ __forceinline__ AttnUnit attn_decode(int idx, int G, int bx, int wave, int l, CArgs a, bf16* ya, bf16* ob, float* lse) {
    AttnUnit U; U.valid = false;
    const int nA = (BATCH * 2 * 64 - bx + G - 1) / G;
    if (idx < nA) {
        const int u = bx + idx * G; const int qb = u & 63, kvh = (u >> 6) & 1, b = u >> 7; const int g = wave >> 1, hq = kvh * 4 + g;
        U.kcol = 512 + kvh * 64; U.vcol = 640 + kvh * 64; U.b = b; U.d = 1; U.r = 0; U.t0 = 2 * qb; U.span = 2; U.W = 4; U.qcol = hq * 64; U.tq = 2 * qb + (wave & 1);
        U.m0 = a->a_sink[l * 8 + hq] * LOG2E; U.l0 = 1.0f; U.outp = ya + hq * 64; U.opitch = 768; U.lsep = nullptr; U.valid = true; return U;
    }
    const int u = bx + (idx - nA) * G;
    if (u < 3 * 256) {
        const int grp = u >> 8; int q = u & 255;
        const int d = grp == 0 ? 1 : (grp == 1 ? 4 : 16), bpr = 16 / d;
        const int blk = q % bpr; q /= bpr; const int res = q % d; q /= d; const int h = q & 3, b = q >> 2;
        const int base = 768 + 768 * grp;
        U.kcol = base + 256 + h * 64; U.vcol = base + 512 + h * 64; U.b = b; U.d = d; U.r = res; U.t0 = 8 * blk; U.span = 8; U.W = 2; U.qcol = base + h * 64; U.tq = 8 * blk + wave;
        U.m0 = -1e30f; U.l0 = 0.0f; U.outp = ob + grp * 256 + h * 64; U.opitch = 768; U.lsep = lse + grp * 4 + h; U.valid = true;
    }
    return U;
}
__device__ __forceinline__ void attn_fetch(const bf16* P, const AttnUnit& U, int tid, u32x4 (&buf)[12]) {
    const int L32 = (SEQ / U.d) >> 5, jbase = U.t0 - U.W, ntile = U.span + 2 * U.W, nch = ntile * 512;
    const size_t tok0 = (size_t)U.b * SEQ + U.r;
#pragma unroll
    for (int i = 0; i < 12; ++i) {
        const int c = tid + 512 * i;
        if (c < nch) {
            const int kv = c >= ntile * 256, cc = kv ? c - ntile * 256 : c, row = cc >> 3, ch = cc & 7, tile = row >> 5, rr = row & 31, j = jbase + tile;
            if (j >= 0 && j < L32) buf[i] = __builtin_nontemporal_load((const u32x4*)(P + (tok0 + (size_t)(32 * j + rr) * U.d) * NQKV + (kv ? U.vcol : U.kcol) + ch * 8));
        }
    }
}
__device__ __forceinline__ void attn_stage(const AttnUnit& U, int tid, const u32x4 (&buf)[12], LAS unsigned char* lds) {
    const int L32 = (SEQ / U.d) >> 5, jbase = U.t0 - U.W, ntile = U.span + 2 * U.W, nch = ntile * 512;
    LAS unsigned char* kimg = lds; LAS unsigned char* vimg = lds + ntile * 4096;
#pragma unroll
    for (int i = 0; i < 12; ++i) {
        const int c = tid + 512 * i;
        if (c < nch) {
            const int kv = c >= ntile * 256, cc = kv ? c - ntile * 256 : c, row = cc >> 3, ch = cc & 7, tile = row >> 5, rr = row & 31, j = jbase + tile;
            if (j >= 0 && j < L32) *(LAS u32x4*)((kv ? vimg : kimg) + tile * 4096 + rr * 128 + (kv ? ch : (ch ^ (rr & 7))) * 16) = buf[i];
        }
    }
}
template <int NT> __device__ __forceinline__ void attn_step(int j, int jbase, int tq, int W, const LAS unsigned char* kimg, const LAS unsigned char* vimg, int krd, int vrd, int r32, int hi,
                                                          const bf16x8 (&qf)[4], f32x16& o0, f32x16& o1, float& mrun, float& lrun) {
#define VTR(p, off) __builtin_bit_cast(s16x4, __builtin_amdgcn_ds_read_tr16_b64_v4i16((LAS s16x4*)((p) + (off))))
    bf16x8 kf[NT][4]; s16x4 va[NT][4], vb[NT][4];
#pragma unroll
    for (int t = 0; t < NT; ++t) {
        const LAS unsigned char* kl = kimg + (j + t - jbase) * 4096 + krd;
#pragma unroll
        for (int s = 0; s < 4; ++s) kf[t][s] = *(const LAS bf16x8*)(kl + (((2 * s + hi) ^ (r32 & 7)) * 16));
    }
#pragma unroll
    for (int t = 0; t < NT; ++t) {
        const LAS unsigned char* vl = vimg + (j + t - jbase) * 4096 + vrd;
#pragma unroll
        for (int q = 0; q < 4; ++q) { va[t][q] = VTR(vl, (16 * (q & 1)) * 128 + (q >> 1) * 64); vb[t][q] = VTR(vl, (16 * (q & 1) + 8) * 128 + (q >> 1) * 64); }
    }
    __builtin_amdgcn_sched_barrier(0);
    f32x16 sc[NT];
#pragma unroll
    for (int t = 0; t < NT; ++t) sc[t] = f32x16{};
#pragma unroll
    for (int s = 0; s < 4; ++s)
#pragma unroll
        for (int t = 0; t < NT; ++t) sc[t] = __builtin_amdgcn_mfma_f32_32x32x16_bf16(kf[t][s], qf[s], sc[t], 0, 0, 0);
#pragma unroll
    for (int t = 0; t < NT; ++t) {
        if (j + t == tq - W) {
#pragma unroll
            for (int g = 0; g < 16; ++g) if (crow(g, hi) < r32) sc[t][g] = -INFINITY;
        }
        if (j + t == tq + W) {
#pragma unroll
            for (int g = 0; g < 16; ++g) if (crow(g, hi) > r32) sc[t][g] = -INFINITY;
        }
    }
    float mx = -INFINITY;
#pragma unroll
    for (int t = 0; t < NT; ++t)
#pragma unroll
        for (int g = 0; g < 16; g += 4) mx = fmaxf(mx, fmaxf(fmaxf(sc[t][g], sc[t][g + 1]), fmaxf(sc[t][g + 2], sc[t][g + 3])));
    { const auto rr = __builtin_amdgcn_permlane32_swap(__float_as_uint(mx), __float_as_uint(mx), false, false); mx = fmaxf(__uint_as_float(rr[0]), __uint_as_float(rr[1])); }
    if (__any(mx > mrun + 8.0f)) {
        const float mnew = fmaxf(mrun, mx);
        const float alpha = fast_exp2(mrun - mnew);
        lrun *= alpha; mrun = mnew;
#pragma unroll
        for (int g = 0; g < 16; ++g) { o0[g] *= alpha; o1[g] *= alpha; }
    }
    float ps[4] = {0.f, 0.f, 0.f, 0.f};
#pragma unroll
    for (int t = 0; t < NT; ++t)
#pragma unroll
        for (int g = 0; g < 16; ++g) { sc[t][g] = fast_exp2(sc[t][g] - mrun); ps[g & 3] += sc[t][g]; }
    float psum = (ps[0] + ps[1]) + (ps[2] + ps[3]);
    { const auto rr = __builtin_amdgcn_permlane32_swap(__float_as_uint(psum), __float_as_uint(psum), false, false); psum = __uint_as_float(rr[0]) + __uint_as_float(rr[1]); }
    lrun += psum;
#define VFR(t, q) ((bf16x8){va[t][q][0], va[t][q][1], va[t][q][2], va[t][q][3], vb[t][q][0], vb[t][q][1], vb[t][q][2], vb[t][q][3]})
#pragma unroll
    for (int t = 0; t < NT; ++t) {
        u32x4 p0, p1;
        p0.x = cvtpk(sc[t][0], sc[t][1]); p0.y = cvtpk(sc[t][2], sc[t][3]); p0.z = cvtpk(sc[t][4], sc[t][5]); p0.w = cvtpk(sc[t][6], sc[t][7]);
        p1.x = cvtpk(sc[t][8], sc[t][9]); p1.y = cvtpk(sc[t][10], sc[t][11]); p1.z = cvtpk(sc[t][12], sc[t][13]); p1.w = cvtpk(sc[t][14], sc[t][15]);
        const bf16x8 pf0 = __builtin_bit_cast(bf16x8, p0), pf1 = __builtin_bit_cast(bf16x8, p1);
        o0 = __builtin_amdgcn_mfma_f32_32x32x16_bf16(VFR(t, 0), pf0, o0, 0, 0, 0);
        o1 = __builtin_amdgcn_mfma_f32_32x32x16_bf16(VFR(t, 2), pf0, o1, 0, 0, 0);
        o0 = __builtin_amdgcn_mfma_f32_32x32x16_bf16(VFR(t, 1), pf1, o0, 0, 0, 0);
        o1 = __builtin_amdgcn_mfma_f32_32x32x16_bf16(VFR(t, 3), pf1, o1, 0, 0, 0);
    }
#undef VFR
#undef VTR
}
__device__ __forceinline__ void attn_compute(const bf16* P, const AttnUnit& U, const bf16x8 (&qf)[4], LAS unsigned char* lds, LAS unsigned char* stg, int lane) {
    const int r32 = lane & 31, hi = lane >> 5;
    const int d = U.d, W = U.W, tq = U.tq;
    const int L32 = (SEQ / d) >> 5;
    const size_t tok0 = (size_t)U.b * SEQ + U.r;
    const int jbase = U.t0 - W, ntile = U.span + 2 * W;
    LAS unsigned char* kimg = lds; LAS unsigned char* vimg = lds + ntile * 4096;
    const size_t qtok = tok0 + (size_t)(32 * tq + r32) * d;
    f32x16 o0 = {}, o1 = {};
    float mrun = U.m0, lrun = U.l0;
    const int jlo = (tq - W) < 0 ? 0 : (tq - W), jhi = (tq + W) > (L32 - 1) ? (L32 - 1) : (tq + W);
    const int vrd = (4 * hi + ((lane & 15) >> 2)) * 128 + (16 * ((lane >> 4) & 1) + 4 * (lane & 3)) * 2;
    const int krd = r32 * 128;
    int j = jlo;
    for (; j + 1 <= jhi; j += 2) attn_step<2>(j, jbase, tq, W, kimg, vimg, krd, vrd, r32, hi, qf, o0, o1, mrun, lrun);
    if (j <= jhi) attn_step<1>(j, jbase, tq, W, kimg, vimg, krd, vrd, r32, hi, qf, o0, o1, mrun, lrun);
    const float inv = 1.0f / lrun;
#pragma unroll
    for (int g4 = 0; g4 < 4; ++g4) {
        u32x2 w0, w1;
        w0.x = cvtpk(o0[4 * g4] * inv, o0[4 * g4 + 1] * inv); w0.y = cvtpk(o0[4 * g4 + 2] * inv, o0[4 * g4 + 3] * inv);
        w1.x = cvtpk(o1[4 * g4] * inv, o1[4 * g4 + 1] * inv); w1.y = cvtpk(o1[4 * g4 + 2] * inv, o1[4 * g4 + 3] * inv);
        *(LAS u32x2*)(stg + r32 * 144 + (8 * g4 + 4 * hi) * 2) = w0;
        *(LAS u32x2*)(stg + r32 * 144 + 64 + (8 * g4 + 4 * hi) * 2) = w1;
    }
#pragma unroll
    for (int i = 0; i < 4; ++i) {
        const int row = i * 8 + (lane >> 3), ch = lane & 7;
        const u32x4 v = *(const LAS u32x4*)(stg + row * 144 + ch * 16);
        *(u32x4*)(U.outp + (tok0 + (size_t)(32 * tq + row) * d) * U.opitch + ch * 8) = v;
    }
    if (U.lsep && hi == 0) U.lsep[qtok * 12] = (mrun + log2f(lrun)) * LN2;
}
__device__ __forceinline__ void attn_phase(const Frame& F, CArgs a, int l) {
    const int lane = otid(), tid = F.wave * 64 + lane; (void)tid; (void)lane;
    unsigned char* ws = a->ws;
    const bf16* P = (const bf16*)(ws + WS_PQ);
    bf16* ya = (bf16*)(ws + WS_YAB) + 256; bf16* ob = (bf16*)a->out; float* lse = (float*)(ws + WS_LSE);
    const int r32 = lane & 31, hi = lane >> 5;
    u32x4 buf[12];
    LAS unsigned char* stg = F.lds + 98304 + F.wave * 4608;
    AttnUnit U = attn_decode(0, F.G, F.bx, F.wave, l, a, ya, ob, lse);
    if (U.valid) attn_fetch(P, U, tid, buf);
    for (int idx = 0; U.valid; ++idx) {
        attn_stage(U, tid, buf, F.lds);
        u32x4 qv[4];
#pragma unroll
        for (int i = 0; i < 4; ++i) { const int row = i * 8 + (lane >> 3), ch = lane & 7;
            qv[i] = __builtin_nontemporal_load((const u32x4*)(P + ((size_t)U.b * SEQ + U.r + (size_t)(32 * U.tq + row) * U.d) * NQKV + U.qcol + ch * 8)); }
        const AttnUnit Un = attn_decode(idx + 1, F.G, F.bx, F.wave, l, a, ya, ob, lse);
#pragma unroll
        for (int i = 0; i < 4; ++i) { const int row = i * 8 + (lane >> 3), ch = lane & 7; *(LAS u32x4*)(stg + row * 144 + ch * 16) = qv[i]; }
        bf16x8 qf[4];
#pragma unroll
        for (int s = 0; s < 4; ++s) qf[s] = *(const LAS bf16x8*)(stg + r32 * 144 + (2 * s + hi) * 16);
        __syncthreads();
        if (Un.valid) attn_fetch(P, Un, tid, buf);
        attn_compute(P, U, qf, F.lds, stg, lane);
        __syncthreads();
        U = Un;
    }
    prep_experts(F, a, l, lane, 0, F.gw, F.ngw);
    prep_experts(F, a, l, lane, 1, F.gw, F.ngw);
}
__device__ __forceinline__ void comb_rows(const Frame& F, CArgs a, int row0, int tid) {
    unsigned char* ws = a->ws;
    const bf16* ob = (const bf16*)a->out; const float* lse = (const float*)(ws + WS_LSE); bf16* yb = (bf16*)(ws + WS_YAB);
#pragma unroll 4
    for (int it = 0; it < 16; ++it) {
        const int idx = tid + it * NTHREADS;
        const int tok = row0 + (idx >> 5), c = idx & 31, h = c >> 3;
        const float l0 = lse[tok * 12 + h], l1 = lse[tok * 12 + 4 + h], l2 = lse[tok * 12 + 8 + h];
        const u32x4 a0 = *(const u32x4*)(ob + (size_t)tok * 768 + c * 8), a1 = *(const u32x4*)(ob + (size_t)tok * 768 + 256 + c * 8), a2 = *(const u32x4*)(ob + (size_t)tok * 768 + 512 + c * 8);
        const float mx = fmaxf(l0, fmaxf(l1, l2));
        float w0 = __expf(l0 - mx), w1 = __expf(l1 - mx), w2 = __expf(l2 - mx);
        const float inv = 1.0f / (w0 + w1 + w2); w0 *= inv; w1 *= inv; w2 *= inv;
        u32x4 o;
#define CMB(f) o.f = cvtpk(w0 * bflo(a0.f) + w1 * bflo(a1.f) + w2 * bflo(a2.f), w0 * bfhi(a0.f) + w1 * bfhi(a1.f) + w2 * bfhi(a2.f))
        CMB(x); CMB(y); CMB(z); CMB(w);
#undef CMB
        *(u32x4*)(yb + (size_t)tok * 768 + c * 8) = o;
    }
}

__device__ __forceinline__ void route_phase(const Frame& F, CArgs a, int l, unsigned* waitp) {
    const int lane = otid(), tid = F.wave * 64 + lane;
    unsigned char* ws = a->ws;
    const bf16* xbf = (const bf16*)(ws + WS_XB); const u32x4* wrh = (const u32x4*)(ws + WS_WR + l * WR_LSTRIDE); const u32x4* wrl = (const u32x4*)(ws + WS_WR + l * WR_LSTRIDE + WR_LO);
    float* rs2 = (float*)(ws + WS_RS2); i32x4* tokinfo = (i32x4*)(ws + WS_TOKINFO); int* ltok = (int*)(ws + WS_LTOK); float* lw = (float*)(ws + WS_LW);
    int* cnt = (int*)(ws + WS_CTL) + CW_CNT + l * 32 * CNT_STRIDE;
    const float* brg = a->b_rg + l * 4; const float* bre = a->b_re + l * NEXP;
    LAS f32x4* part = (LAS f32x4*)(F.lds);
    LAS float* ssp = (LAS float*)(F.lds + 12288);
    LAS float* Lg = (LAS float*)(F.lds + 16384);
    LAS float* rsL = (LAS float*)(F.lds + 16384 + 12288);
    LAS int* lcnt = (LAS int*)(F.lds + 16384 + 12288 + 256);
    LAS int* lbase = lcnt + 32;
    const int rt = F.wave & 3, kh = F.wave >> 2;
    if (tid < 32) lcnt[tid] = 0;
    __syncthreads();
    for (int blk = F.bx; blk < MTOK / 64; blk += F.G) {
        if (waitp) {
            if (F.wave == 0) {
                unsigned* p = waitp + (blk >> 2) * PAN_STRIDE; unsigned spins = 0;
                while ((unsigned)__builtin_amdgcn_readfirstlane(__hip_atomic_load(p, __ATOMIC_RELAXED, __HIP_MEMORY_SCOPE_AGENT)) < 32u) {
                    __builtin_amdgcn_s_sleep(2);
                    if (++spins > (1u << 22)) { __hip_atomic_store((unsigned*)(ws + WS_CTL) + CW_ERR, 3u, __ATOMIC_RELAXED, __HIP_MEMORY_SCOPE_AGENT); break; }
                }
                __builtin_amdgcn_fence(__ATOMIC_ACQUIRE, "agent");
                asm volatile("s_waitcnt vmcnt(0)" ::: "memory");
            }
            __syncthreads();
        }
        const int row0 = blk * 64 + rt * 16;
        const u32x4* xr = (const u32x4*)(xbf + (size_t)(row0 + (lane & 15)) * DM + kh * 512) + (lane >> 4);
        const u32x4* wh = wrh + (size_t)(kh * 16) * 3 * 64 + lane; const u32x4* wl = wrl + (size_t)(kh * 16) * 3 * 64 + lane;
        f32x4 acc0 = {0.f, 0.f, 0.f, 0.f}, acc1 = acc0, acc2 = acc0; float ss = 0.f;
#pragma unroll 4
        for (int i = 0; i < 16; ++i) {
            const u32x4 xw = xr[4 * i];
            const u32x4 h0 = wh[(i * 3 + 0) * 64], h1 = wh[(i * 3 + 1) * 64], h2 = wh[(i * 3 + 2) * 64], l0 = wl[(i * 3 + 0) * 64], l1 = wl[(i * 3 + 1) * 64], l2 = wl[(i * 3 + 2) * 64];
            const float xv[8] = {bflo(xw.x), bfhi(xw.x), bflo(xw.y), bfhi(xw.y), bflo(xw.z), bfhi(xw.z), bflo(xw.w), bfhi(xw.w)};
#pragma unroll
            for (int j = 0; j < 8; ++j) ss += xv[j] * xv[j];
            const bf16x8 xf = __builtin_bit_cast(bf16x8, xw);
            acc0 = __builtin_amdgcn_mfma_f32_16x16x32_bf16(xf, __builtin_bit_cast(bf16x8, l0), acc0, 0, 0, 0);
            acc1 = __builtin_amdgcn_mfma_f32_16x16x32_bf16(xf, __builtin_bit_cast(bf16x8, l1), acc1, 0, 0, 0);
            acc2 = __builtin_amdgcn_mfma_f32_16x16x32_bf16(xf, __builtin_bit_cast(bf16x8, l2), acc2, 0, 0, 0);
            acc0 = __builtin_amdgcn_mfma_f32_16x16x32_bf16(xf, __builtin_bit_cast(bf16x8, h0), acc0, 0, 0, 0);
            acc1 = __builtin_amdgcn_mfma_f32_16x16x32_bf16(xf, __builtin_bit_cast(bf16x8, h1), acc1, 0, 0, 0);
            acc2 = __builtin_amdgcn_mfma_f32_16x16x32_bf16(xf, __builtin_bit_cast(bf16x8, h2), acc2, 0, 0, 0);
        }
        ss += shx(ss, 16, lane); ss += shx(ss, 32, lane);
        if (kh == 1) { part[(rt * 3 + 0) * 64 + lane] = acc0; part[(rt * 3 + 1) * 64 + lane] = acc1; part[(rt * 3 + 2) * 64 + lane] = acc2; if (lane < 16) ssp[rt * 16 + lane] = ss; }
        __syncthreads();
        if (kh == 0) {
            acc0 += part[(rt * 3 + 0) * 64 + lane]; acc1 += part[(rt * 3 + 1) * 64 + lane]; acc2 += part[(rt * 3 + 2) * 64 + lane];
            ss += ssp[rt * 16 + (lane & 15)];
#pragma unroll
            for (int g = 0; g < 4; ++g) { const int rw = rt * 16 + 4 * (lane >> 4) + g; Lg[rw * 48 + (lane & 15)] = acc0[g]; Lg[rw * 48 + 16 + (lane & 15)] = acc1[g]; Lg[rw * 48 + 32 + (lane & 15)] = acc2[g]; }
            if (lane < 16) rsL[rt * 16 + lane] = 1.0f / sqrtf(ss * (1.0f / DM) + NORM_EPS);
        }
        __syncthreads();
        int e1 = 0, e2 = 0, r1 = 0, r2 = 0; float w1 = 0.f, w2 = 0.f, rsv = 0.f;
        if (tid < 64) {
            const LAS float* Lr = Lg + tid * 48; rsv = rsL[tid];
            float gl[4];
#pragma unroll
            for (int g = 0; g < 4; ++g) gl[g] = Lr[g] * rsv + brg[g];
            int gi = 0; float gm = gl[0];
#pragma unroll
            for (int g = 1; g < 4; ++g) if (gl[g] > gm) { gm = gl[g]; gi = g; }
            float den = 0.f;
#pragma unroll
            for (int g = 0; g < 4; ++g) den += expf(gl[g] - gm);
            const float gw = 1.0f / den;
            float v1 = -INFINITY, v2 = -INFINITY; int i1 = 0, i2 = 0;
#pragma unroll
            for (int e = 0; e < 8; ++e) {
                const float v = Lr[4 + 8 * gi + e] * rsv + bre[8 * gi + e];
                if (v > v1) { v2 = v1; i2 = i1; v1 = v; i1 = e; } else if (v > v2) { v2 = v; i2 = e; }
            }
            const float p1 = 1.0f / (1.0f + expf(v2 - v1));
            e1 = 8 * gi + i1; e2 = 8 * gi + i2; w1 = p1 * gw; w2 = (1.0f - p1) * gw;
            r1 = __hip_atomic_fetch_add(&lcnt[e1], 1, __ATOMIC_RELAXED, __HIP_MEMORY_SCOPE_WORKGROUP); r2 = __hip_atomic_fetch_add(&lcnt[e2], 1, __ATOMIC_RELAXED, __HIP_MEMORY_SCOPE_WORKGROUP);
        }
        __syncthreads();
        if (tid < 32) { const int c = lcnt[tid]; lbase[tid] = c ? atomicAdd(&cnt[tid * CNT_STRIDE], c) : 0; lcnt[tid] = 0; }
        __syncthreads();
        if (tid < 64) {
            const int tok = blk * 64 + tid;
            const int pos1 = lbase[e1] + r1, pos2 = lbase[e2] + r2;
            ltok[e1 * MTOK + pos1] = tok; lw[e1 * MTOK + pos1] = w1;
            ltok[e2 * MTOK + pos2] = tok; lw[e2 * MTOK + pos2] = w2;
            tokinfo[tok] = (i32x4){e1, pos1, e2, pos2};
            rs2[tok] = rsv;
        }
        __syncthreads();
    }
}
__device__ __forceinline__ MoeTab moe_tables(const Frame& F, CArgs a, int l) {
    const int lane = otid(), tid = F.wave * 64 + lane; (void)tid; (void)lane;
    volatile LAS int* cntL = F.misc + 64; volatile LAS int* mtp = F.misc + 128; volatile LAS int* sp = F.misc + 192;
    const int* cnt = (const int*)(a->ws + WS_CTL) + CW_CNT + l * 32 * CNT_STRIDE;
    __syncthreads();
    if (tid < 32) cntL[tid] = __hip_atomic_load(cnt + tid * CNT_STRIDE, __ATOMIC_RELAXED, __HIP_MEMORY_SCOPE_AGENT);
    __syncthreads();
    if (tid == 0) { int mt = 0, s = 0; for (int e = 0; e < 32; ++e) { mtp[e] = mt; sp[e] = s; const int c = cntL[e]; mt += (c + 255) >> 8; s += c; } mtp[32] = mt; sp[32] = s; }
    __syncthreads();
    MoeTab T; T.cnt = cntL; T.mtpref = mtp; T.spref = sp; return T;
}
__device__ __forceinline__ void fin_phase(const Frame& F, CArgs a, int l, const MoeTab& T) {
    const int lane = otid(), tid = F.wave * 64 + lane; (void)tid;
    unsigned char* ws = a->ws;
    const i32x4* tokinfo = (const i32x4*)(ws + WS_TOKINFO); const bf16* Y = (const bf16*)(ws + WS_Y);
    bf16* xb = (bf16*)(ws + WS_XB); float* rs1 = (float*)(ws + WS_RS1);
    const int step = 2 * F.ngw;
    int m0 = 2 * F.gw;
    i32x4 tn0 = tokinfo[m0 < MTOK ? m0 : 0], tn1 = tokinfo[m0 + 1 < MTOK ? m0 + 1 : 0];
    for (; m0 < MTOK; m0 += step) {
        const i32x4 ti[2] = {tn0, tn1};
        const int mn = m0 + step;
        if (mn < MTOK) { tn0 = tokinfo[mn]; tn1 = tokinfo[mn + 1]; }
        u32x4 xv[2][2], p[2][2], q[2][2];
#pragma unroll
        for (int r = 0; r < 2; ++r) {
            const int m = m0 + r;
            const int s1 = T.spref[ti[r][0]] + ti[r][1], s2 = T.spref[ti[r][2]] + ti[r][3];
            const u32x4* xr = (const u32x4*)(xb + (size_t)m * DM) + lane;
            const u32x4* y1 = (const u32x4*)(Y + (size_t)s1 * DM) + lane; const u32x4* y2 = (const u32x4*)(Y + (size_t)s2 * DM) + lane;
#pragma unroll
            for (int j = 0; j < 2; ++j) { xv[r][j] = xr[64 * j]; p[r][j] = __builtin_nontemporal_load(y1 + 64 * j); q[r][j] = __builtin_nontemporal_load(y2 + 64 * j); }
        }
#pragma unroll
        for (int r = 0; r < 2; ++r) {
            const int m = m0 + r;
            float v[2][8]; float s = 0.f;
#pragma unroll
            for (int j = 0; j < 2; ++j) {
#define FINC(c, f) v[j][2 * c] = bflo(xv[r][j].f) + bflo(p[r][j].f) + bflo(q[r][j].f); v[j][2 * c + 1] = bfhi(xv[r][j].f) + bfhi(p[r][j].f) + bfhi(q[r][j].f);
                FINC(0, x) FINC(1, y) FINC(2, z) FINC(3, w)
#undef FINC
#pragma unroll
                for (int c = 0; c < 8; ++c) s += v[j][c] * v[j][c];
            }
            s = wave_sum(s, lane);
            const float rsv = 1.0f / sqrtf(s * (1.0f / DM) + NORM_EPS);
            if (l == DEPTH - 1) {
#pragma unroll
                for (int j = 0; j < 2; ++j) {
                    const f32x4* g = (const f32x4*)(a->fin_g + 512 * j + 8 * lane); f32x4* o = (f32x4*)(a->out + (size_t)m * DM + 512 * j + 8 * lane);
                    const f32x4 g0 = g[0], g1 = g[1];
                    __builtin_nontemporal_store((f32x4){v[j][0] * rsv * g0[0], v[j][1] * rsv * g0[1], v[j][2] * rsv * g0[2], v[j][3] * rsv * g0[3]}, o);
                    __builtin_nontemporal_store((f32x4){v[j][4] * rsv * g1[0], v[j][5] * rsv * g1[1], v[j][6] * rsv * g1[2], v[j][7] * rsv * g1[3]}, o + 1);
                }
            } else {
                u32x4* o = (u32x4*)(xb + (size_t)m * DM) + lane;
#pragma unroll
                for (int j = 0; j < 2; ++j) { u32x4 w; w.x = cvtpk(v[j][0], v[j][1]); w.y = cvtpk(v[j][2], v[j][3]); w.z = cvtpk(v[j][4], v[j][5]); w.w = cvtpk(v[j][6], v[j][7]); o[64 * j] = w; }
                if (lane == 0) rs1[m] = rsv;
            }
        }
    }
}

constexpr int PH_PREP = 0, PH_GEMM1 = 1, PH_ATTN = 2, PH_MID = 3, PH_MOE = 4, PH_FIN = 5, PH_PER_LAYER = 6, NPHASE = PH_PER_LAYER * DEPTH - 1;

__global__ void __launch_bounds__(NTHREADS, 2) fwd_kernel(Args a_by_value) {
    extern __shared__ __attribute__((aligned(16))) unsigned char lds_raw[];
    Frame F;
    F.lds = (LAS unsigned char*)lds_raw; F.misc = (volatile LAS int*)(F.lds + MISC_OFF);
    F.wave = __builtin_amdgcn_readfirstlane((int)threadIdx.x >> 6);
    F.G = gridDim.x; { const int bx = blockIdx.x; F.vcu = (F.G % 8 == 0) ? (bx % 8) * (F.G / 8) + bx / 8 : bx; }
    F.gw = blockIdx.x * NWAVES + F.wave; F.ngw = F.G * NWAVES;
    CArgs a = (CArgs)__builtin_amdgcn_kernarg_segment_ptr();
    unsigned char* ws = a->ws;
    const int ph_lo = a->ph_lo, ph_hi = a->ph_hi;
    for (int u = threadIdx.x; u < 1024; u += NTHREADS) F.misc[u] = 0;
    __syncthreads();
#if !MK_MULTI
    XcdBarrier bar = xcd_barrier_post((unsigned*)(ws + WS_CTL) + CW_BAR, (volatile LAS unsigned*)(F.misc + 8));
#define GRID_BAR() xcd_barrier(bar, F.wave)
#else
#define GRID_BAR() do { } while (0)
#endif
    for (int ph = ph_lo, rep = 0; ph < ph_hi; ) {
        const int l = ph >= PH_PER_LAYER ? 1 : 0, k = ph >= PH_PER_LAYER ? ph - (PH_PER_LAYER - 1) : ph;
        const size_t wlo = (size_t)l * WNE_LSTRIDE;
        {
            int bx = blockIdx.x; asm volatile("" : "+s"(bx)); asm volatile("" : "+s"(a)); ws = a->ws;
            int wv = F.wave; asm volatile("" : "+s"(wv)); F.gw = bx * NWAVES + wv; F.bx = bx;
        }
        if (k == PH_PREP && (PHMASK & 1)) {
            prep_phase(F, a);
        } else if (k == PH_GEMM1 && (PHMASK & 2)) {
            DenseSched S; S.A = (const char*)(ws + WS_XB); S.Bt = (const char*)(ws + wlo + WS_WIN); S.K = DM; S.lda = DM; S.ldb = DM; S.ksplit = 0; S.wave = F.wave; S.so.init(MTOK, DIN, F.G, F.bx); S.waitp = nullptr; S.need = 0; S.postp = nullptr; S.err = nullptr;
            EpiProj E{(bf16*)(ws + WS_PQ), (bf16*)(ws + WS_PG), (const float*)(ws + WS_RS1), (const f32x4*)(ws + WS_ROPE)};
            pg8::gemm_phase(F.lds, S, E);
        } else if (k == PH_ATTN && (PHMASK & 4)) {
            attn_phase(F, a, l);
        } else if (k == PH_MID) {
            unsigned* pan = (unsigned*)(ws + WS_CTL) + CW_PAN + l * 3 * 64 * PAN_STRIDE; unsigned* err = (unsigned*)(ws + WS_CTL) + CW_ERR;
            { pg8::StaticOrder so; so.init(MTOK, DM, F.G, F.bx); const int tid_ = F.wave * 64 + otid();
              for (int i = 0, pm, pn; so.next(i, pm, pn); ++i) comb_rows(F, a, pm * 256, tid_);
              VM_WAIT(); __syncthreads(); }
            { DenseSched S; S.A = (const char*)(ws + WS_YAB); S.Bt = (const char*)(ws + wlo + WS_WAB); S.K = 768; S.lda = 768; S.ldb = 768; S.ksplit = 256; S.wave = F.wave; S.so.init(MTOK, DM, F.G, F.bx);
              S.waitp = nullptr; S.need = 0; S.postp = pan; S.err = err;
              EpiMerge E{(const unsigned char*)(ws + WS_PG), (bf16*)(ws + WS_MRG)};
              pg8::gemm_phase(F.lds, S, E); }
            { DenseSched S; S.A = (const char*)(ws + WS_MRG); S.Bt = (const char*)(ws + wlo + WS_WOUT); S.K = DM; S.lda = DM; S.ldb = DM; S.ksplit = 0; S.wave = F.wave; S.so.init(MTOK, DM, F.G, F.bx);
              S.waitp = pan; S.need = 32; S.postp = pan + 64 * PAN_STRIDE; S.err = err;
              EpiResid E{(bf16*)(ws + WS_XB)};
              pg8::gemm_phase(F.lds, S, E); }
            route_phase(F, a, l, pan + 64 * PAN_STRIDE);
        } else if (k == PH_MOE) {
            const MoeTab T = moe_tables(F, a, l);
            const int mtT = T.mtpref[32], nU = 2 * mtT, nU1 = nU < F.G ? nU : F.G, nU2 = nU - nU1, tready = nU1 >> 1;
            const int bx = F.vcu;
            unsigned* upd = (unsigned*)(ws + WS_CTL) + CW_UPD + l * 256 * UPD_STRIDE; unsigned* err = (unsigned*)(ws + WS_CTL) + CW_ERR;
            MoeSched<true> SU; SU.A = (const char*)(ws + WS_XB); SU.Bt = (const char*)(ws + WS_WGU); SU.K = DM; SU.lda = DM; SU.ldb = DM; SU.wave = F.wave; SU.ntn = 2; SU.bstride_e = (size_t)512 * DM * 2; SU.ltok = (const int*)(ws + WS_LTOK); SU.T = T; SU.upd = upd; SU.err = err;
            MoeSched<false> SD; SD.A = (const char*)(ws + WS_H); SD.Bt = (const char*)(ws + WS_WD); SD.K = DEXP; SD.lda = DEXP; SD.ldb = DEXP; SD.wave = F.wave; SD.ntn = 4; SD.bstride_e = (size_t)DM * DEXP * 2; SD.ltok = nullptr; SD.T = T; SD.upd = upd; SD.err = err;
            EpiSwiglu EU{(const int*)(ws + WS_LTOK), (const float*)(ws + WS_LW), (const float*)(ws + WS_RS2), (bf16*)(ws + WS_H)};
            EpiY ED{(bf16*)(ws + WS_Y)};
            SU.G1 = F.G; SU.c1 = bx; SU.lo1 = 0; SU.hi1 = nU; SU.G2 = 1; SU.c2 = -1; SU.lo2 = 0; SU.hi2 = 0;
            pg8::gemm_phase(F.lds, SU, EU);
            SD.G1 = F.G - nU2; SD.c1 = bx - nU2; SD.lo1 = 0; SD.hi1 = 4 * tready;
            { const int extra = (4 * tready) % SD.G1;
              SD.G2 = SD.G1 - extra; SD.c2 = SD.c1 >= extra ? SD.c1 - extra : -1; SD.lo2 = 4 * tready; SD.hi2 = 4 * mtT; }
            pg8::gemm_phase(F.lds, SD, ED);
        } else if (k == PH_FIN && (PHMASK & 512)) {
            const MoeTab T = moe_tables(F, a, l);
            fin_phase(F, a, l, T);
        }
#if REP_MASK
        if (l == 0 && ((REP_MASK >> k) & 1) && rep < REP_N) { ++rep; GRID_BAR(); continue; }
        rep = 0;
#endif
        if (ph + 1 < ph_hi) { GRID_BAR();
#ifdef EXTRA_BAR
            for (int eb = 0; eb < EXTRA_BAR; ++eb) GRID_BAR();
#endif
        }
        ++ph;
    }
}

extern "C" void kernel_launch(void* const* d_in, const int* in_sizes, int n_in, void* d_out, int out_size, void* d_ws, size_t ws_size, hipStream_t stream) {
    static int grid = 0;
    if (grid == 0) {
        if (n_in != 16 || out_size != MTOK * DM || ws_size < WS_END) { fprintf(stderr, "kernel_launch: unexpected shapes (n_in %d out %d ws %zu)\n", n_in, out_size, ws_size); grid = -1; return; }
        int dev = 0, cus = 0, per_cu = 0;
        if (hipGetDevice(&dev) != hipSuccess || hipDeviceGetAttribute(&cus, hipDeviceAttributeMultiprocessorCount, dev) != hipSuccess) { grid = -1; return; }
        if (hipFuncSetAttribute((const void*)fwd_kernel, hipFuncAttributeMaxDynamicSharedMemorySize, LDS_BYTES) != hipSuccess) { fprintf(stderr, "kernel_launch: hipFuncSetAttribute failed\n"); grid = -1; return; }
        if (hipOccupancyMaxActiveBlocksPerMultiprocessor(&per_cu, (const void*)fwd_kernel, NTHREADS, LDS_BYTES) != hipSuccess || per_cu < 1) { fprintf(stderr, "kernel_launch: occupancy query says %d\n", per_cu); (void)hipGetLastError(); }
        grid = cus;
    }
    if (grid < 0) return;
    (void)hipMemsetAsync((char*)d_ws + WS_CTL, 0, CTL_BYTES, stream);
    Args a{};
    a.x = (const float*)d_in[0]; a.attn_g = (const float*)d_in[1]; a.w_in = (const float*)d_in[2]; a.a_sink = (const float*)d_in[3]; a.w_a = (const float*)d_in[4]; a.w_b = (const float*)d_in[5];
    a.w_out = (const float*)d_in[6]; a.ffn_g = (const float*)d_in[7]; a.w_rg = (const float*)d_in[8]; a.b_rg = (const float*)d_in[9]; a.w_re = (const float*)d_in[10]; a.b_re = (const float*)d_in[11];
    a.w_eg = (const float*)d_in[12]; a.w_eu = (const float*)d_in[13]; a.w_ed = (const float*)d_in[14]; a.fin_g = (const float*)d_in[15];
    a.out = (float*)d_out; a.ws = (unsigned char*)d_ws;
#if MK_MULTI
    for (int ph = 0; ph < NPHASE; ++ph) { a.ph_lo = ph; a.ph_hi = ph + 1; hipLaunchKernelGGL(fwd_kernel, dim3(grid), dim3(NTHREADS), LDS_BYTES, stream, a); }
#else
    a.ph_lo = 0; a.ph_hi = NPHASE;
    void* kargs[] = {&a};
    const hipError_t le = hipLaunchCooperativeKernel((const void*)fwd_kernel, dim3(grid), dim3(NTHREADS), kargs, LDS_BYTES, stream);
    if (le != hipSuccess) fprintf(stderr, "kernel_launch: cooperative launch failed: %s (grid %d)\n", hipGetErrorString(le), grid);
#endif
}
```

```cpp
#include <hip/hip_runtime.h>
#include <hip/hip_cooperative_groups.h>
#include <cstdio>
#include <cstdint>
namespace cg = cooperative_groups;

#ifndef REP_MASK
#define REP_MASK 0
#define REP_N 2
#endif
#ifndef PHMASK
#define PHMASK 1023
#endif
#ifndef MK_MULTI
#define MK_MULTI 0
#endif

#define LAS __attribute__((address_space(3)))
#define GAS __attribute__((address_space(1)))
typedef unsigned short bf16;
typedef short bf16x8 __attribute__((ext_vector_type(8)));
typedef short s16x4 __attribute__((ext_vector_type(4)));
typedef float f32x2 __attribute__((ext_vector_type(2)));
typedef float f32x4 __attribute__((ext_vector_type(4)));
typedef float f32x16 __attribute__((ext_vector_type(16)));
typedef unsigned u32x2 __attribute__((ext_vector_type(2)));
typedef unsigned u32x4 __attribute__((ext_vector_type(4)));
typedef int i32x4 __attribute__((ext_vector_type(4)));
typedef __bf16 bf16x2_t __attribute__((ext_vector_type(2)));

constexpr int BATCH = 4, SEQ = 4096, DM = 1024, DEPTH = 2, MTOK = BATCH * SEQ;
constexpr int NQKV = 3072, NGATE = 2048, DIN = NQKV + NGATE;
constexpr int NEXP = 32, DEXP = 256;
constexpr float NORM_EPS = 1e-6f;
constexpr float LOG2E = 1.4426950408889634f, LN2 = 0.6931471805599453f;
constexpr float QSCALE = 0.125f * LOG2E;
constexpr int NWAVES = 8, NTHREADS = 512;

constexpr size_t MiB = 1u << 20;
constexpr size_t WS_CTL = 0, CTL_BYTES = 1 * MiB;
constexpr size_t WS_ROPE = 1 * MiB;
constexpr size_t WS_WR = 2 * MiB, WR_LSTRIDE = 512 * 1024, WR_LO = 256 * 1024;
constexpr size_t WS_RS1 = 3 * MiB, WS_RS2 = 3 * MiB + 65536;
constexpr size_t WS_TOKINFO = 5 * MiB;
constexpr size_t WS_LTOK = 6 * MiB, WS_LW = 8 * MiB;
constexpr size_t WS_LSE = 10 * MiB;
constexpr size_t WS_WIN = 12 * MiB, WS_WAB = 22 * MiB, WS_WOUT = 24 * MiB, WNE_LSTRIDE = 14 * MiB;
constexpr size_t WS_WGU = 40 * MiB, WS_WD = 72 * MiB;
constexpr size_t WS_XB = 88 * MiB;
constexpr size_t WS_YAB = 120 * MiB;
constexpr size_t WS_PQ = 144 * MiB;
constexpr size_t WS_MRG = 176 * MiB, WS_H = 208 * MiB;
constexpr size_t WS_PG = 240 * MiB;
constexpr size_t WS_Y = 240 * MiB;
constexpr size_t WS_END = 304 * MiB;
constexpr int CW_CNT = 64, CNT_STRIDE = 64;
constexpr int CW_BAR = 8192;
constexpr int CW_UPD = 32768, UPD_STRIDE = 64;
constexpr int CW_ERR = 32;
constexpr int CW_PAN = 65536, PAN_STRIDE = 64;

constexpr int RING_BYTES = 131072;
constexpr int PREP_SCR = 16896;
constexpr int MISC_OFF = 8 * PREP_SCR;
constexpr int LDS_BYTES = 147456;

#define LDS_WAIT() asm volatile("s_waitcnt lgkmcnt(0)" ::: "memory")
#define VM_WAIT() asm volatile("s_waitcnt vmcnt(0)" ::: "memory")
__device__ __forceinline__ unsigned cvtpk(float lo, float hi) { f32x2 v = {lo, hi}; bf16x2_t b = __builtin_convertvector(v, bf16x2_t); return __builtin_bit_cast(unsigned, b); }
__device__ __forceinline__ float bf2f(unsigned short h) { return __uint_as_float(((unsigned)h) << 16); }
__device__ __forceinline__ float bflo(unsigned w) { return __uint_as_float(w << 16); }
__device__ __forceinline__ float bfhi(unsigned w) { return __uint_as_float(w & 0xffff0000u); }
__device__ __forceinline__ float fast_exp2(float x) { return __builtin_amdgcn_exp2f(x); }
__device__ __forceinline__ float fast_rcp(float x) { return __builtin_amdgcn_rcpf(x); }
__device__ __forceinline__ void store16_sc1(void* p, u32x4 v) { asm volatile("global_store_dwordx4 %0, %1, off sc1\n\ts_nop 1" :: "v"(p), "v"(v) : "memory"); }
__device__ __forceinline__ int olane() { unsigned z = 0u; asm volatile("" : "+v"(z)); return (int)__builtin_amdgcn_mbcnt_hi(~0u, __builtin_amdgcn_mbcnt_lo(~0u, z)); }
__device__ __forceinline__ float sigmoidf_fast(float v) { return fast_rcp(1.0f + fast_exp2(-v * LOG2E)); }

namespace pg8 {
constexpr int BM = 256, BK = 64, HALF = 128, HTB = HALF * BK * 2, STAGE_BYTES = 8 * HTB, NXCD = 8, WGM = 4;
__host__ __device__ __forceinline__ int lds_byte(int r, int c) { const int st = (r >> 4) * 2 + (c >> 5), rr = r & 15, cc = c & 31, ob = rr * 64 + cc * 2; return st * 1024 + (ob ^ (((ob >> 9) & 1) << 5)); }
__host__ __device__ __forceinline__ void stage_rc(int b, int& R, int& C) { const int st = b / 1024, sb = b % 1024, swz = sb ^ (((sb >> 9) & 1) << 5); R = (st >> 1) * 16 + swz / 64; C = (st & 1) * 32 + (swz % 64) / 2; }
__host__ __device__ __forceinline__ int perm32(int rho) { const int n = rho >> 4, i = rho & 15; return 8 * (i >> 2) + 4 * n + (i & 3); }

struct Unit { int pm, pn, e, nvalid, slot0, lpos0, nt, kofs, sub, waitk; };

struct StaticOrder {
    int nM, nN, nwg, G, c;
    __device__ void init(int M, int N, int G_, int c_) { nM = M / BM; nN = N / BM; nwg = nM * nN; G = G_; c = c_; }
    __device__ bool next(int i, int& pm, int& pn) const {
        const long L = (long)i * G + c; if (L >= nwg) return false;
        int wgid = (int)L; { const int q = nwg / NXCD, r = nwg % NXCD, xcd = wgid % NXCD, off = wgid / NXCD; wgid = (xcd < r ? xcd * (q + 1) : r * (q + 1) + (xcd - r) * q) + off; }
        const int nig = WGM * nN, gid = wgid / nig, fm = gid * WGM, gsz = (nM - fm) < WGM ? (nM - fm) : WGM;
        pm = fm + ((wgid % nig) % gsz); pn = (wgid % nig) / gsz; return true;
    }
};

template <class Epi, class Sched>
__device__ __forceinline__ void gemm_phase(LAS unsigned char* lds, const Sched& S, const Epi& E) {
    unsigned z_ = 0u; asm volatile("" : "+v"(z_)); const int tid_ = (int)__builtin_amdgcn_mbcnt_hi(~0u, __builtin_amdgcn_mbcnt_lo(~0u, z_)) + S.wave * 64;
    const int tid = tid_, wid = S.wave, lane = tid & 63, wr = wid >> 2, wc = wid & 3, fr = lane & 15, fq = lane >> 4;
    const int K = S.ldb;
    unsigned voffA[2], voffB[2];
#pragma unroll
    for (int i = 0; i < 2; ++i) { int R, C; stage_rc(tid * 16 + i * 8192, R, C); const int Rb = Epi::PERM ? ((R & ~31) + perm32(R & 31)) : R;
        voffA[i] = (unsigned)(R * S.lda + C) * 2u; voffB[i] = (unsigned)(Rb * K + C) * 2u; }
    const size_t kstep = (size_t)(BK * 2);
    const size_t hstepB = (size_t)HALF * K * 2, hstepA = (size_t)HALF * S.lda * 2;
    const unsigned ldsw = (unsigned)wid * 1024u;
    const int aoff = lds_byte(wr * 64 + fr, fq * 8), boff = lds_byte(wc * 32 + fr, fq * 8);
#define PG8_SA(b, h) (((b) * 2 + (h)) * HTB)
#define PG8_SB(b, h) ((4 + (b) * 2 + (h)) * HTB)
#define PG8_GLDS(src, dstoff) __builtin_amdgcn_global_load_lds((const unsigned*)(src), (LAS unsigned*)(lds + (dstoff)), 16, 0, 0)
#define PG8_STAGE_A(bufoff, up, h, VO) do { if constexpr (Sched::GATHER) { _Pragma("unroll") for (int _i = 0; _i < 2; ++_i) PG8_GLDS((up) + VO[_i], (bufoff) + ldsw + _i * 8192); } \
        else { const char* _b = (up) + (size_t)(h) * hstepA; _Pragma("unroll") for (int _i = 0; _i < 2; ++_i) PG8_GLDS(_b + voffA[_i], (bufoff) + ldsw + _i * 8192); } } while (0)
#define PG8_STAGE_B(bufoff, bp) do { _Pragma("unroll") for (int _i = 0; _i < 2; ++_i) PG8_GLDS((bp) + voffB[_i], (bufoff) + ldsw + _i * 8192); } while (0)
#define PG8_LDA(dst, b, h) do { _Pragma("unroll") for (int m = 0; m < 4; ++m) _Pragma("unroll") for (int k = 0; k < 2; ++k) dst[m][k] = *(const LAS bf16x8*)(lds + PG8_SA(b, h) + aoff + m * 2048 + k * 1024); } while (0)
#define PG8_LDB(dst, b, h) do { _Pragma("unroll") for (int n = 0; n < 2; ++n) _Pragma("unroll") for (int k = 0; k < 2; ++k) dst[n][k] = *(const LAS bf16x8*)(lds + PG8_SB(b, h) + boff + n * 2048 + k * 1024); } while (0)
#define PG8_MMA(ai, bj, At, Bt) do { __builtin_amdgcn_s_setprio(1); _Pragma("unroll") for (int m = 0; m < 4; ++m) _Pragma("unroll") for (int n = 0; n < 2; ++n) _Pragma("unroll") for (int k = 0; k < 2; ++k) \
        acc[ai][bj][m][n] = __builtin_amdgcn_mfma_f32_16x16x32_bf16(Bt[n][k], At[m][k], acc[ai][bj][m][n], 0, 0, 0); __builtin_amdgcn_s_setprio(0); } while (0)
#define PG8_WAIT_V(n) asm volatile("s_waitcnt vmcnt(" #n ")" ::: "memory")
#define PG8_WAIT_L(n) asm volatile("s_waitcnt lgkmcnt(" #n ")" ::: "memory")
#define PG8_BAR __builtin_amdgcn_s_barrier()
#define PG8_SCHED __builtin_amdgcn_sched_barrier(0)
    Unit cur, nxt; int ui = 0;
    if (!S.next(0, cur)) return;
    f32x4 acc[2][2][4][2];
#pragma unroll
    for (int a = 0; a < 2; ++a)
#pragma unroll
        for (int b = 0; b < 2; ++b)
#pragma unroll
            for (int m = 0; m < 4; ++m)
#pragma unroll
                for (int n = 0; n < 2; ++n) acc[a][b][m][n] = (f32x4){0.f, 0.f, 0.f, 0.f};
    bf16x8 At[4][2], B0[2][2], B1[2][2];
    const char* Ab = S.a_base();
    const char* cA = Ab; const char* cB = S.b_base(cur);
    unsigned vF0[2], vF1[2], vK[2];
    if constexpr (Sched::GATHER) {
#pragma unroll
        for (int i = 0; i < 2; ++i) { int R, C; stage_rc(tid * 16 + i * 8192, R, C); vF0[i] = S.a_off(cur, R) + (unsigned)(C * 2); vF1[i] = S.a_off(cur, HALF + R) + (unsigned)(C * 2); vK[i] = vF1[i]; }
    } else cA = Ab + S.a_unit_off(cur);
    S.a_ready(cur);
    PG8_STAGE_B(PG8_SB(0, 0), cB); PG8_STAGE_B(PG8_SB(0, 1), cB + hstepB); PG8_STAGE_A(PG8_SA(0, 0), cA, 0, vF0); PG8_STAGE_A(PG8_SA(0, 1), cA, 1, vF1);
    if (wr == 1) PG8_BAR;
    PG8_WAIT_V(2); PG8_BAR;
    PG8_STAGE_B(PG8_SB(1, 0), cB + kstep); PG8_STAGE_A(PG8_SA(1, 0), cA + kstep, 0, vF0); PG8_STAGE_B(PG8_SB(1, 1), cB + hstepB + kstep);
    PG8_WAIT_V(6); PG8_BAR;
    for (;;) {
        const bool has_next = S.next(ui + 1, nxt);
        const char* nA = cA; const char* nB = cB;
        if (has_next) { nB = S.b_base(nxt); if constexpr (!Sched::GATHER) nA = Ab + S.a_unit_off(nxt); }
        const int nt = cur.nt;
#pragma unroll 1
        for (int t = 0; t < nt; t += 2) {
            const bool last = (t == nt - 2);
            if (last && has_next) S.a_ready(nxt);
            const char* a1 = cA + (size_t)(t + 1) * kstep;
            const char* a2 = last ? nA : cA + (size_t)(t + 2) * kstep; const char* b2 = last ? nB : cB + (size_t)(t + 2) * kstep;
            const char* a3 = a2 + kstep; const char* b3 = b2 + kstep;
            if constexpr (Sched::GATHER) {
                if (last && has_next) {
#pragma unroll
                    for (int i = 0; i < 2; ++i) { int R, C; stage_rc(tid * 16 + i * 8192, R, C); vF0[i] = S.a_off(nxt, R) + (unsigned)(C * 2); vF1[i] = S.a_off(nxt, HALF + R) + (unsigned)(C * 2); }
                }
            }
            PG8_LDB(B0, 0, 0); PG8_LDB(B1, 0, 1); PG8_SCHED; PG8_LDA(At, 0, 0); PG8_STAGE_A(PG8_SA(1, 1), a1, 1, vK);
            PG8_WAIT_V(8); PG8_WAIT_L(0); PG8_BAR; PG8_MMA(0, 0, At, B0); PG8_MMA(0, 1, At, B1); PG8_BAR; PG8_SCHED;
            PG8_LDA(At, 0, 1); PG8_STAGE_B(PG8_SB(0, 0), b2); PG8_STAGE_B(PG8_SB(0, 1), b2 + hstepB); PG8_STAGE_A(PG8_SA(0, 0), a2, 0, vF0);
            PG8_WAIT_V(8); PG8_WAIT_L(0); PG8_BAR; PG8_MMA(1, 0, At, B0); PG8_MMA(1, 1, At, B1); PG8_BAR; PG8_SCHED;
            PG8_LDB(B0, 1, 0); PG8_LDB(B1, 1, 1); PG8_SCHED; PG8_LDA(At, 1, 0); PG8_STAGE_A(PG8_SA(0, 1), a2, 1, vF1);
            PG8_WAIT_V(8); PG8_WAIT_L(0); PG8_BAR; PG8_MMA(0, 0, At, B0); PG8_MMA(0, 1, At, B1); PG8_BAR; PG8_SCHED;
            PG8_LDA(At, 1, 1); PG8_STAGE_B(PG8_SB(1, 0), b3); PG8_STAGE_B(PG8_SB(1, 1), b3 + hstepB); PG8_STAGE_A(PG8_SA(1, 0), a3, 0, vF0);
            PG8_WAIT_V(8); PG8_WAIT_L(0); PG8_BAR; PG8_MMA(1, 0, At, B0); PG8_MMA(1, 1, At, B1); PG8_BAR; PG8_SCHED;
        }
        if (wr == 0) PG8_BAR;
        bool keep = false;
        if constexpr (Epi::HAS_MID) { if (cur.sub == 0) { E.mid(acc, cur, wr, wc, fr, fq); keep = true; } else E(acc, cur, wr, wc, fr, fq); }
        else E(acc, cur, wr, wc, fr, fq);
        S.done(cur);
        if (!has_next) break;
        if (!keep) {
#pragma unroll
        for (int a = 0; a < 2; ++a)
#pragma unroll
            for (int b = 0; b < 2; ++b)
#pragma unroll
                for (int m = 0; m < 4; ++m)
#pragma unroll
                    for (int n = 0; n < 2; ++n) acc[a][b][m][n] = (f32x4){0.f, 0.f, 0.f, 0.f};
        }
        cur = nxt; cA = nA; cB = nB; ++ui;
        if constexpr (Sched::GATHER) { vK[0] = vF1[0]; vK[1] = vF1[1]; }
        if (wr == 1) PG8_BAR;
    }
    PG8_WAIT_V(0);
    PG8_BAR;
#undef PG8_SA
#undef PG8_SB
#undef PG8_GLDS
#undef PG8_STAGE_A
#undef PG8_STAGE_B
#undef PG8_LDA
#undef PG8_LDB
#undef PG8_MMA
#undef PG8_WAIT_V
#undef PG8_WAIT_L
#undef PG8_BAR
#undef PG8_SCHED
}
}
using pg8::Unit;

struct DenseSched {
    static constexpr bool GATHER = false;
    const char* A; const char* Bt; int K; int lda; int ldb; int wave; int ksplit; pg8::StaticOrder so;
    __device__ __forceinline__ bool next(int i, Unit& u) const {
        int pm, pn; const int ti = ksplit ? (i >> 1) : i; if (!so.next(ti, pm, pn)) return false;
        u.pm = pm; u.pn = pn; u.e = 0; u.nvalid = 256; u.slot0 = pm * 256; u.lpos0 = 0; u.waitk = 1;
        if (ksplit) { u.sub = i & 1; u.kofs = u.sub ? ksplit : 0; u.nt = (u.sub ? K - ksplit : ksplit) / 64; } else { u.sub = 1; u.kofs = 0; u.nt = K / 64; }
        return true; }
    __device__ __forceinline__ const char* a_base() const { return A; }
    __device__ __forceinline__ unsigned a_off(const Unit& u, int r) const { return 0u; }
    __device__ __forceinline__ size_t a_unit_off(const Unit& u) const { return ((size_t)u.pm * 256 * lda + u.kofs) * 2; }
    __device__ __forceinline__ const char* b_base(const Unit& u) const { return Bt + ((size_t)u.pn * 256 * ldb + u.kofs) * 2; }
    unsigned* waitp; unsigned need; unsigned* postp; unsigned* err;
    __device__ __forceinline__ void a_ready(const Unit& u) const {
        if (waitp) {
            if (wave == 0) {
                unsigned* p = waitp + u.pm * PAN_STRIDE; unsigned spins = 0;
                while ((unsigned)__builtin_amdgcn_readfirstlane(__hip_atomic_load(p, __ATOMIC_RELAXED, __HIP_MEMORY_SCOPE_AGENT)) < need) {
                    __builtin_amdgcn_s_sleep(2);
                    if (++spins > (1u << 22)) { __hip_atomic_store(err, 2u, __ATOMIC_RELAXED, __HIP_MEMORY_SCOPE_AGENT); break; }
                }
                __builtin_amdgcn_fence(__ATOMIC_ACQUIRE, "agent");
                asm volatile("s_waitcnt vmcnt(0)" ::: "memory");
            }
            asm volatile("" ::: "memory"); __builtin_amdgcn_s_barrier(); asm volatile("" ::: "memory");
        }
    }
    __device__ __forceinline__ void done(const Unit& u) const {
        if (postp && u.sub == 1) {
            asm volatile("s_waitcnt vmcnt(0)" ::: "memory");
            if (olane() == 0) __hip_atomic_fetch_add(postp + u.pm * PAN_STRIDE, 1u, __ATOMIC_RELAXED, __HIP_MEMORY_SCOPE_AGENT);
        }
    }
};
struct MoeTab { const volatile LAS int* cnt; const volatile LAS int* mtpref; const volatile LAS int* spref; const volatile LAS int* tile_e; };
template <bool GATHER_> struct MoeSched {
    static constexpr bool GATHER = GATHER_;
    const char* A; const char* Bt; int K; int lda; int ldb; int wave; int ntn; size_t bstride_e; const int* ltok; MoeTab T;
    int G1, c1, lo1, hi1, G2, c2, lo2, hi2; unsigned* upd; unsigned* err;
    __device__ __forceinline__ bool next(int i, Unit& u) const {
        int L;
        const int n1 = (c1 >= 0 && lo1 + c1 < hi1) ? (hi1 - lo1 - c1 + G1 - 1) / G1 : 0;
        if (i < n1) { L = lo1 + c1 + i * G1; u.waitk = (i == 0) ? 2 : 0; }
        else { L = lo2 + c2 + (i - n1) * G2; if (c2 < 0 || L >= hi2) return false; u.waitk = 1; }
        const int tix = L / ntn; u.pn = L - tix * ntn; u.pm = tix;
        const int e = T.tile_e[tix];
        const int mt = tix - T.mtpref[e]; u.e = e; u.slot0 = T.spref[e] + 256 * mt; const int rem = T.cnt[e] - 256 * mt; u.nvalid = rem < 256 ? rem : 256; u.lpos0 = e * MTOK + 256 * mt; u.nt = K / 64; u.kofs = 0; u.sub = 1; return true;
    }
    __device__ __forceinline__ const char* a_base() const { return A; }
    __device__ __forceinline__ unsigned a_off(const Unit& u, int r) const { const int rr = r < u.nvalid ? r : u.nvalid - 1; return (unsigned)ltok[u.lpos0 + rr] * (unsigned)(lda * 2); }
    __device__ __forceinline__ size_t a_unit_off(const Unit& u) const { return (size_t)u.slot0 * lda * 2; }
    __device__ __forceinline__ const char* b_base(const Unit& u) const { return Bt + (size_t)u.e * bstride_e + (size_t)u.pn * 256 * K * 2; }
    __device__ __forceinline__ void a_ready(const Unit& u) const {
        if constexpr (!GATHER_) {
            if (u.waitk == 0) return;
            if (wave == 0) {
                const int n1 = (c1 >= 0 && lo1 + c1 < hi1) ? (hi1 - lo1 - c1 + G1 - 1) / G1 : 0;
                const int nw = (u.waitk == 2) ? n1 : 1;
                unsigned spins = 0;
                for (int q = 0; q < nw; ++q) {
                    const int tix = (u.waitk == 2) ? (lo1 + c1 + q * G1) / ntn : u.pm;
                    unsigned* p = upd + tix * UPD_STRIDE;
                    while ((unsigned)__builtin_amdgcn_readfirstlane(__hip_atomic_load(p, __ATOMIC_RELAXED, __HIP_MEMORY_SCOPE_AGENT)) < 16u) {
                        __builtin_amdgcn_s_sleep(2);
                        if (++spins > (1u << 22)) { __hip_atomic_store(err, 1u, __ATOMIC_RELAXED, __HIP_MEMORY_SCOPE_AGENT); break; }
                    }
                }
                __builtin_amdgcn_fence(__ATOMIC_ACQUIRE, "agent");
                asm volatile("s_waitcnt vmcnt(0)" ::: "memory");
            }
            asm volatile("" ::: "memory"); __builtin_amdgcn_s_barrier(); asm volatile("" ::: "memory");
        }
    }
    __device__ __forceinline__ void done(const Unit& u) const {
        if constexpr (GATHER_) {
            asm volatile("s_waitcnt vmcnt(0)" ::: "memory");
            if (olane() == 0) __hip_atomic_fetch_add(upd + u.pm * UPD_STRIDE, 1u, __ATOMIC_RELAXED, __HIP_MEMORY_SCOPE_AGENT);
        }
    }
};

#define OPAQUE(p) asm volatile("" : "+v"(p))
struct EpiProj {
    static constexpr bool PERM = true, REPEAT = true, HAS_MID = false;
    bf16* Pq; bf16* Pg; const float* rs; const f32x4* rope;
    __device__ __forceinline__ static void rot(f32x4& c, const f32x4& st) {
        const f32x4 o = c;
        c[0] = o[0] * st[0] - o[1] * st[1]; c[1] = o[1] * st[0] + o[0] * st[1];
        c[2] = o[2] * st[2] - o[3] * st[3]; c[3] = o[3] * st[2] + o[2] * st[3];
    }
    __device__ __forceinline__ void operator()(const f32x4 (&acc)[2][2][4][2], const Unit& u, int wr, int wc, int fr, int fq) const {
        const int colh = wc * 32 + fq * 8;
        const int ib = (colh & 63) >> 2;
        const int row0 = u.pm * 256 + wr * 64 + fr;
        int mode[2]; bf16* ob[2]; size_t ostep[2];
#pragma unroll
        for (int bj = 0; bj < 2; ++bj) {
            const int h128 = 2 * u.pn + bj;
            if (h128 >= 24) mode[bj] = 3;
            else if (h128 < 6) mode[bj] = h128 < 4 ? 1 : (h128 == 4 ? 2 : 0);
            else { const int j = (h128 - 6) % 6; mode[bj] = j < 2 ? 1 : (j < 4 ? 2 : 0); }
            if (h128 < 24) { ob[bj] = Pq + h128 * 128 + colh + (size_t)row0 * NQKV; ostep[bj] = (size_t)NQKV * 16; }
            else { ob[bj] = Pg + (((h128 - 24) * 128 + colh) >> 1) + (size_t)row0 * (NGATE / 2); ostep[bj] = (size_t)(NGATE / 2) * 16; }
        }
        float rsv[8];
#pragma unroll
        for (int i = 0; i < 8; ++i) rsv[i] = rs[row0 + (i >> 2) * 128 + (i & 3) * 16];
        const f32x4* rp = rope + (size_t)(row0 & (SEQ - 1)) * 16 + ib;
        f32x4 c0 = rp[0], c1 = rp[1];
        const f32x4 s16a = rope[16 * 16 + ib], s16b = rope[16 * 16 + ib + 1], s80a = rope[80 * 16 + ib], s80b = rope[80 * 16 + ib + 1];
#pragma unroll
        for (int ai = 0; ai < 2; ++ai)
#pragma unroll
            for (int m = 0; m < 4; ++m) {
                OPAQUE(ob[0]); OPAQUE(ob[1]);
                const float s = rsv[ai * 4 + m];
#pragma unroll
                for (int bj = 0; bj < 2; ++bj) {
                    f32x4 v0 = acc[ai][bj][m][0] * s, v1 = acc[ai][bj][m][1] * s;
                    if (mode[bj] == 1 || mode[bj] == 2) {
                        f32x4 o0, o1;
                        o0[0] = v0[0] * c0[0] - v0[1] * c0[1]; o0[1] = v0[1] * c0[0] + v0[0] * c0[1];
                        o0[2] = v0[2] * c0[2] - v0[3] * c0[3]; o0[3] = v0[3] * c0[2] + v0[2] * c0[3];
                        o1[0] = v1[0] * c1[0] - v1[1] * c1[1]; o1[1] = v1[1] * c1[0] + v1[0] * c1[1];
                        o1[2] = v1[2] * c1[2] - v1[3] * c1[3]; o1[3] = v1[3] * c1[2] + v1[2] * c1[3];
                        const float qs = (mode[bj] == 1) ? QSCALE : 1.0f;
                        v0 = o0 * qs; v1 = o1 * qs;
                    } else if (mode[bj] == 3) {
#pragma unroll
                        for (int j = 0; j < 4; ++j) { v0[j] = sigmoidf_fast(v0[j]); v1[j] = sigmoidf_fast(v1[j]); }
                    }
                    if (mode[bj] == 3) {
                        unsigned q[8];
#pragma unroll
                        for (int j = 0; j < 4; ++j) { q[j] = (unsigned)fminf(v0[j] * 256.0f, 255.0f); q[4 + j] = (unsigned)fminf(v1[j] * 256.0f, 255.0f); }
                        u32x2 w; w.x = q[0] | (q[1] << 8) | (q[2] << 16) | (q[3] << 24); w.y = q[4] | (q[5] << 8) | (q[6] << 16) | (q[7] << 24);
                        *(u32x2*)(ob[bj]) = w;
                    } else {
                        u32x4 w; w.x = cvtpk(v0[0], v0[1]); w.y = cvtpk(v0[2], v0[3]); w.z = cvtpk(v1[0], v1[1]); w.w = cvtpk(v1[2], v1[3]);
                        *(u32x4*)(ob[bj]) = w;
                    }
                }
                if (m == 3) { rot(c0, s80a); rot(c1, s80b); } else { rot(c0, s16a); rot(c1, s16b); }
                const int adv = (m == 3) ? 5 : 1;
                ob[0] += ostep[0] * adv; ob[1] += ostep[1] * adv;
            }
    }
};
struct EpiMerge {
    static constexpr bool PERM = true, REPEAT = false, HAS_MID = true;
    const unsigned char* gate; bf16* out;
    __device__ __forceinline__ static float dq(unsigned w, int k) { return ((float)((w >> (8 * k)) & 255u) + 0.5f) * (1.0f / 256.0f); }
    __device__ __forceinline__ void mid(f32x4 (&acc)[2][2][4][2], const Unit& u, int wr, int wc, int fr, int fq) const {
        const int row0 = u.pm * 256 + wr * 64 + fr, col0 = u.pn * 256 + wc * 32 + fq * 8;
        const unsigned char* gp = gate + (size_t)row0 * NGATE + col0;
        u32x2 ga[2][2], gb[2][2];
#define EM_LOAD(slot, i) do { const size_t ro = (size_t)(16 * (i) + 64 * ((i) >> 2)) * NGATE; ga[slot][0] = *(const u32x2*)(gp + ro); ga[slot][1] = *(const u32x2*)(gp + ro + 128); \
        gb[slot][0] = *(const u32x2*)(gp + ro + 1024); gb[slot][1] = *(const u32x2*)(gp + ro + 1024 + 128); } while (0)
        EM_LOAD(0, 0);
#pragma unroll
        for (int i = 0; i < 8; ++i) {
            const int ai = i >> 2, m = i & 3, sl = i & 1;
            if (i + 1 < 8) { if (sl == 0) EM_LOAD(1, i + 1); else EM_LOAD(0, i + 1); }
#pragma unroll
            for (int bj = 0; bj < 2; ++bj) {
                const u32x2 A = ga[sl][bj], B = gb[sl][bj];
#pragma unroll
                for (int j = 0; j < 4; ++j) {
                    acc[ai][bj][m][0][j] *= dq(B.x, j) * fast_rcp(dq(A.x, j));
                    acc[ai][bj][m][1][j] *= dq(B.y, j) * fast_rcp(dq(A.y, j));
                }
            }
        }
#undef EM_LOAD
    }
    __device__ __forceinline__ void operator()(const f32x4 (&acc)[2][2][4][2], const Unit& u, int wr, int wc, int fr, int fq) const {
        const int row0 = u.pm * 256 + wr * 64 + fr, col0 = u.pn * 256 + wc * 32 + fq * 8;
        const unsigned char* gp = gate + (size_t)row0 * NGATE + col0; bf16* op = out + (size_t)row0 * DM + col0;
        u32x2 ga[2][2];
#define EF_LOAD(slot, i) do { const size_t ro = (size_t)(16 * (i) + 64 * ((i) >> 2)) * NGATE; ga[slot][0] = *(const u32x2*)(gp + ro); ga[slot][1] = *(const u32x2*)(gp + ro + 128); } while (0)
        EF_LOAD(0, 0);
#pragma unroll
        for (int i = 0; i < 8; ++i) {
            const int ai = i >> 2, m = i & 3, sl = i & 1;
            if (i + 1 < 8) { if (sl == 0) EF_LOAD(1, i + 1); else EF_LOAD(0, i + 1); }
            bf16* orow = op + (size_t)(16 * i + 64 * (i >> 2)) * DM;
#pragma unroll
            for (int bj = 0; bj < 2; ++bj) {
                const u32x2 A = ga[sl][bj];
                const f32x4 a0 = acc[ai][bj][m][0], a1 = acc[ai][bj][m][1];
                u32x4 w;
                w.x = cvtpk(a0[0] * dq(A.x, 0), a0[1] * dq(A.x, 1)); w.y = cvtpk(a0[2] * dq(A.x, 2), a0[3] * dq(A.x, 3));
                w.z = cvtpk(a1[0] * dq(A.y, 0), a1[1] * dq(A.y, 1)); w.w = cvtpk(a1[2] * dq(A.y, 2), a1[3] * dq(A.y, 3));
                store16_sc1(orow + bj * 128, w);
            }
            asm volatile("" ::: "memory");
        }
#undef EF_LOAD
    }
};
struct EpiResid {
    static constexpr bool PERM = true, REPEAT = false, HAS_MID = false;
    bf16* xb;
    __device__ __forceinline__ void operator()(const f32x4 (&acc)[2][2][4][2], const Unit& u, int wr, int wc, int fr, int fq) const {
        const int row0 = u.pm * 256 + wr * 64 + fr, col0 = u.pn * 256 + wc * 32 + fq * 8;
        bf16* xp = xb + (size_t)row0 * DM + col0;
        u32x4 p[2][2];
#define ER_LOAD(slot, i) do { const size_t ro = (size_t)(16 * (i) + 64 * ((i) >> 2)); p[slot][0] = *(const u32x4*)(xp + ro * DM); p[slot][1] = *(const u32x4*)(xp + ro * DM + 128); } while (0)
        ER_LOAD(0, 0);
#pragma unroll
        for (int i = 0; i < 8; ++i) {
            const int ai = i >> 2, m = i & 3, sl = i & 1;
            if (i + 1 < 8) { if (sl == 0) ER_LOAD(1, i + 1); else ER_LOAD(0, i + 1); }
            bf16* orow = xp + (size_t)(16 * i + 64 * (i >> 2)) * DM;
#pragma unroll
            for (int bj = 0; bj < 2; ++bj) {
                const u32x4 q = p[sl][bj];
                const f32x4 a0 = acc[ai][bj][m][0], a1 = acc[ai][bj][m][1];
                u32x4 w;
                w.x = cvtpk(a0[0] + bflo(q.x), a0[1] + bfhi(q.x)); w.y = cvtpk(a0[2] + bflo(q.y), a0[3] + bfhi(q.y));
                w.z = cvtpk(a1[0] + bflo(q.z), a1[1] + bfhi(q.z)); w.w = cvtpk(a1[2] + bflo(q.w), a1[3] + bfhi(q.w));
                store16_sc1(orow + bj * 128, w);
            }
            asm volatile("" ::: "memory");
        }
#undef ER_LOAD
    }
};
struct EpiSwiglu {
    static constexpr bool PERM = true, REPEAT = false, HAS_MID = false;
    const int* ltok; const float* lw; const float* rs; bf16* H;
    __device__ __forceinline__ void operator()(const f32x4 (&acc)[2][2][4][2], const Unit& u, int wr, int wc, int fr, int fq) const {
        int tok[8]; float w8[8], s8[8];
#pragma unroll
        for (int i = 0; i < 8; ++i) { const int rr = (i >> 2) * 128 + wr * 64 + (i & 3) * 16 + fr; const int rc = rr < u.nvalid ? rr : u.nvalid - 1; tok[i] = ltok[u.lpos0 + rc]; w8[i] = lw[u.lpos0 + rc]; }
#pragma unroll
        for (int i = 0; i < 8; ++i) s8[i] = rs[tok[i]];
#pragma unroll
        for (int ai = 0; ai < 2; ++ai)
#pragma unroll
            for (int m = 0; m < 4; ++m) {
                const int rr = ai * 128 + wr * 64 + m * 16 + fr;
                if (rr < u.nvalid) {
                    const float w = w8[ai * 4 + m], s = s8[ai * 4 + m];
#pragma unroll
                    for (int bj = 0; bj < 2; ++bj) {
                        const f32x4 a0 = acc[ai][bj][m][0] * s, a1 = acc[ai][bj][m][1] * s;
                        const float h0 = a0[0] * sigmoidf_fast(a0[0]) * a0[1] * w, h1 = a0[2] * sigmoidf_fast(a0[2]) * a0[3] * w;
                        const float h2 = a1[0] * sigmoidf_fast(a1[0]) * a1[1] * w, h3 = a1[2] * sigmoidf_fast(a1[2]) * a1[3] * w;
                        u32x2 o; o.x = cvtpk(h0, h1); o.y = cvtpk(h2, h3);
                        __hip_atomic_store((unsigned long long*)(H + (size_t)(u.slot0 + rr) * DEXP + u.pn * 128 + bj * 64 + wc * 16 + fq * 4), (unsigned long long)o.x | ((unsigned long long)o.y << 32), __ATOMIC_RELAXED, __HIP_MEMORY_SCOPE_AGENT);
                    }
                }
            }
    }
};
struct EpiY {
    static constexpr bool PERM = true, REPEAT = false, HAS_MID = false;
    bf16* Y;
    __device__ __forceinline__ void operator()(const f32x4 (&acc)[2][2][4][2], const Unit& u, int wr, int wc, int fr, int fq) const {
#pragma unroll
        for (int ai = 0; ai < 2; ++ai)
#pragma unroll
            for (int m = 0; m < 4; ++m) {
                const int rr = ai * 128 + wr * 64 + m * 16 + fr;
                if (rr < u.nvalid) {
#pragma unroll
                    for (int bj = 0; bj < 2; ++bj) {
                        const f32x4 a0 = acc[ai][bj][m][0], a1 = acc[ai][bj][m][1];
                        u32x4 w; w.x = cvtpk(a0[0], a0[1]); w.y = cvtpk(a0[2], a0[3]); w.z = cvtpk(a1[0], a1[1]); w.w = cvtpk(a1[2], a1[3]);
                        *(u32x4*)(Y + (size_t)(u.slot0 + rr) * DM + u.pn * 256 + bj * 128 + wc * 32 + fq * 8) = w;
                    }
                }
            }
    }
};

#define XB_TMO      128
#define XB_XCNT(j)  (256  + 64 * (j))
#define XB_XSUB(j)  (1280 + 64 * (j))
#define XB_XGEN(j)  (2304 + 64 * (j))
#define XB_TOP      3328
#define XB_TOPGEN   3392
#define XCD_BAR_WORDS 3456
#define XB_SPIN_CAP (1u << 18)
__device__ __forceinline__ unsigned xb_ld(unsigned* p)              { return __hip_atomic_load(p, __ATOMIC_RELAXED, __HIP_MEMORY_SCOPE_AGENT); }
__device__ __forceinline__ unsigned xb_add(unsigned* p, unsigned v) { return __hip_atomic_fetch_add(p, v, __ATOMIC_RELAXED, __HIP_MEMORY_SCOPE_AGENT); }
__device__ __forceinline__ unsigned xb_xcc_id() { return (unsigned)__builtin_amdgcn_s_getreg((3 << 11) | 20) & 0xFu; }
#define XB_SPIN(cond, bar) do { unsigned _sp = 0; while (cond) { __builtin_amdgcn_s_sleep(1); \
    if ((++_sp & 255u) == 0u) { if (xb_ld(&(bar)[XB_TMO])) break; if (_sp > XB_SPIN_CAP) { atomicAdd(&(bar)[XB_TMO], 1u); break; } } } } while (0)
struct XcdBarrier { unsigned* bar; unsigned x; volatile LAS unsigned* st; };
__device__ __forceinline__ XcdBarrier xcd_barrier_post(unsigned* bar, volatile LAS unsigned* st) {
    XcdBarrier b; b.bar = bar; b.x = xb_xcc_id(); b.st = st;
    if (threadIdx.x == 0) (void)xb_add(&bar[XB_XCNT(b.x)], 1u);
    return b;
}
__device__ __forceinline__ void xcd_barrier_complete(unsigned* bar, unsigned x, unsigned& nloc, unsigned& nx) {
    const unsigned G = gridDim.x * gridDim.y * gridDim.z;
    unsigned sum, cnt, mine, sp = 0u;
    for (;;) {
        sum = 0u; cnt = 0u; mine = 0u;
#pragma unroll
        for (unsigned j = 0; j < 16; ++j) { const unsigned c = xb_ld(&bar[XB_XCNT(j)]); sum += c; cnt += (c > 0u) ? 1u : 0u; mine = (j == x) ? c : mine; }
        if (sum == G) break;
        __builtin_amdgcn_s_sleep(1);
        if ((++sp & 255u) == 0u) { if (xb_ld(&bar[XB_TMO])) break; if (sp > XB_SPIN_CAP) { atomicAdd(&bar[XB_TMO], 1u); break; } }
    }
    nloc = mine > 0u ? mine : 1u; nx = cnt > 0u ? cnt : 1u;
}
__device__ __forceinline__ void xcd_barrier(const XcdBarrier& b, int wave) {
    asm volatile("s_waitcnt vmcnt(0)" ::: "memory");
    __syncthreads();
    unsigned zb_ = 0u; asm volatile("" : "+v"(zb_));
    if (wave == 0 && __builtin_amdgcn_mbcnt_hi(~0u, __builtin_amdgcn_mbcnt_lo(~0u, zb_)) == 0u) {
        unsigned* bar = b.bar;
        __builtin_amdgcn_s_waitcnt(0);
        unsigned nloc = b.st[0], nx = b.st[1];
        if (nloc == 0u) { xcd_barrier_complete(bar, b.x, nloc, nx); b.st[0] = nloc; b.st[1] = nx; }
        const unsigned old = xb_add(&bar[XB_XSUB(b.x)], 1u);
        const unsigned gen = old / nloc;
        if (old + 1u == (gen + 1u) * nloc) {
            __builtin_amdgcn_fence(__ATOMIC_RELEASE, "agent");
            asm volatile("s_waitcnt vmcnt(0)" ::: "memory");
            const unsigned og = xb_add(&bar[XB_TOP], 1u);
            const unsigned tg = og / nx;
            if (og + 1u == (tg + 1u) * nx) xb_add(&bar[XB_TOPGEN], 1u);
            else XB_SPIN(xb_ld(&bar[XB_TOPGEN]) == tg, bar);
            __builtin_amdgcn_fence(__ATOMIC_ACQUIRE, "agent");
            xb_add(&bar[XB_XGEN(b.x)], 1u);
            asm volatile("s_waitcnt vmcnt(0)" ::: "memory");
        } else {
            XB_SPIN(xb_ld(&bar[XB_XGEN(b.x)]) == gen, bar);
            __builtin_amdgcn_fence(__ATOMIC_ACQUIRE, "agent");
            asm volatile("s_waitcnt vmcnt(0)" ::: "memory");
        }
    }
    __syncthreads();
}

struct Args {
    const float* x; const float* attn_g; const float* w_in; const float* a_sink; const float* w_a; const float* w_b; const float* w_out; const float* ffn_g;
    const float* w_rg; const float* b_rg; const float* w_re; const float* b_re; const float* w_eg; const float* w_eu; const float* w_ed; const float* fin_g;
    float* out; unsigned char* ws; int ph_lo, ph_hi;
};
typedef const __attribute__((address_space(4))) Args* CArgs;
struct Frame {
    LAS unsigned char* lds; volatile LAS int* misc;
    int wave, G, vcu, gw, ngw, bx;
};
__device__ __forceinline__ int otid() { unsigned z = 0u; asm volatile("" : "+v"(z)); return (int)__builtin_amdgcn_mbcnt_hi(~0u, __builtin_amdgcn_mbcnt_lo(~0u, z)); }
__device__ __forceinline__ float shx(float v, int o, int lane) { return __int_as_float(__builtin_amdgcn_ds_bpermute((lane ^ o) << 2, __float_as_int(v))); }
__device__ __forceinline__ float wave_sum(float v, int lane) {
#pragma unroll
    for (int o = 1; o < 64; o <<= 1) v += shx(v, o, lane);
    return v;
}

struct MapPlain { __device__ __forceinline__ int operator()(int n) const { return n; } };
struct MapWin { __device__ __forceinline__ int operator()(int n) const {
        bool rope = false;
        if (n < 640) rope = true; else if (n >= 768 && n < NQKV) rope = ((n - 768) % 768) < 512;
        if (!rope) return n; const int d = n & 63; return (n & ~63) + 2 * (d & 31) + (d >> 5); } };
struct MapGU { int t; __device__ __forceinline__ int operator()(int n) const { return 2 * n + t; } };
template <class Map> __device__ __forceinline__ void transpose_item64(const float* W, int ldn, int k0, int n0, const float* gk, bf16* WT, int Kd, const Map& map, LAS float* scr, int lane) {
    const int kq = lane >> 4, n4 = (lane & 15) * 4;
    const float* src = W + (size_t)(k0 + kq) * ldn + n0 + n4;
    f32x4 v[16];
#pragma unroll
    for (int i = 0; i < 16; ++i) v[i] = __builtin_nontemporal_load((const f32x4*)(src + (size_t)(4 * i) * ldn));
    if (gk) {
#pragma unroll
        for (int i = 0; i < 16; ++i) v[i] = v[i] * gk[k0 + 4 * i + kq];
    }
#pragma unroll
    for (int i = 0; i < 16; ++i) { LAS float* d = scr + (4 * i + kq) * 65 + n4; d[0] = v[i][0]; d[1] = v[i][1]; d[2] = v[i][2]; d[3] = v[i][3]; }
    LDS_WAIT(); asm volatile("" ::: "memory");
    const int c = lane & 7;
#pragma unroll
    for (int j = 0; j < 8; ++j) { const int n = (lane >> 3) + 8 * j; const LAS float* p = scr + (8 * c) * 65 + n;
        u32x4 o; o.x = cvtpk(p[0 * 65], p[1 * 65]); o.y = cvtpk(p[2 * 65], p[3 * 65]); o.z = cvtpk(p[4 * 65], p[5 * 65]); o.w = cvtpk(p[6 * 65], p[7 * 65]);
        *(u32x4*)(WT + (size_t)map(n0 + n) * Kd + k0 + 8 * c) = o; }
    LDS_WAIT(); asm volatile("" ::: "memory");
}
__device__ __forceinline__ void prep_phase(const Frame& F, CArgs a) {
    const int lane = otid(), tid = F.wave * 64 + lane; (void)tid; (void)lane;
    unsigned char* ws = a->ws;
    LAS float* scr = (LAS float*)(F.lds + F.wave * PREP_SCR);
    constexpr int I_IN = 16 * 80, I_A = 8 * 16, I_B = 4 * 16, I_O = 16 * 16, I_L = I_IN + I_A + I_B + I_O;
    for (int it = F.gw; it < DEPTH * I_L; it += F.ngw) {
        const int l = it / I_L; int r = it - l * I_L;
        unsigned char* wl = ws + (size_t)l * WNE_LSTRIDE;
        if (r < I_IN) { transpose_item64(a->w_in + (size_t)l * DM * DIN, DIN, 64 * (r / 80), 64 * (r % 80), a->attn_g + l * DM, (bf16*)(wl + WS_WIN), DM, MapWin{}, scr, lane); continue; } r -= I_IN;
        if (r < I_A) { transpose_item64(a->w_a + (size_t)l * 512 * DM, DM, 64 * (r / 16), 64 * (r % 16), nullptr, (bf16*)(wl + WS_WAB) + 256, 768, MapPlain{}, scr, lane); continue; } r -= I_A;
        if (r < I_B) { transpose_item64(a->w_b + (size_t)l * 256 * DM, DM, 64 * (r / 16), 64 * (r % 16), nullptr, (bf16*)(wl + WS_WAB), 768, MapPlain{}, scr, lane); continue; } r -= I_B;
        transpose_item64(a->w_out + (size_t)l * DM * DM, DM, 64 * (r / 16), 64 * (r % 16), nullptr, (bf16*)(wl + WS_WOUT), DM, MapPlain{}, scr, lane);
    }
    for (int idx = F.bx * NTHREADS + tid; idx < DEPTH * 32 * 3 * 64 * 8; idx += F.G * NTHREADS) {
        const int l = idx / (32 * 3 * 64 * 8), id = idx - l * (32 * 3 * 64 * 8);
        const int j = id & 7, ln = (id >> 3) & 63, q = id >> 9, nt = q % 3, i = q / 3;
        const int k = 32 * i + 8 * (ln >> 4) + j, n = 16 * nt + (ln & 15);
        const float* wg = a->w_rg + (size_t)l * DM * 4; const float* we = a->w_re + (size_t)l * DM * NEXP;
        float v = 0.f; if (n < 4) v = wg[k * 4 + n]; else if (n < 36) v = we[k * NEXP + (n - 4)];
        v *= a->ffn_g[l * DM + k];
        const unsigned hb = cvtpk(v, 0.f) & 0xffffu; const float hf = __uint_as_float(hb << 16);
        const unsigned lb = cvtpk(v - hf, 0.f) & 0xffffu;
        ((bf16*)(ws + WS_WR + l * WR_LSTRIDE))[id] = (bf16)hb; ((bf16*)(ws + WS_WR + l * WR_LSTRIDE + WR_LO))[id] = (bf16)lb;
    }
    {
        float* rt = (float*)(ws + WS_ROPE);
        for (int idx = F.bx * NTHREADS + tid; idx < SEQ * 32; idx += F.G * NTHREADS) {
            const int pos = idx >> 5, i = idx & 31;
            const float inv = 1.0f / powf(10000.0f, (float)(2 * i) / 64.0f);
            const float ang = (float)pos * inv;
            const double ad = (double)ang, kd = __builtin_rint(ad * 0.15915494309189535);
            const float rf = (float)__builtin_fma(-kd, 6.283185307179586, ad);
            rt[idx * 2] = cosf(rf); rt[idx * 2 + 1] = sinf(rf);
        }
        bf16* xb = (bf16*)(ws + WS_XB); float* rs1 = (float*)(ws + WS_RS1);
        for (int m = F.gw; m < MTOK; m += F.ngw) {
            const f32x4* xr = (const f32x4*)(a->x + (size_t)m * DM) + lane;
            f32x4 v[4]; float s = 0.f;
#pragma unroll
            for (int j = 0; j < 4; ++j) { v[j] = __builtin_nontemporal_load(xr + 64 * j); s += (v[j][0] * v[j][0] + v[j][1] * v[j][1]) + (v[j][2] * v[j][2] + v[j][3] * v[j][3]); }
            s = wave_sum(s, lane);
            u32x2* o = (u32x2*)(xb + (size_t)m * DM) + lane;
#pragma unroll
            for (int j = 0; j < 4; ++j) { u32x2 w; w.x = cvtpk(v[j][0], v[j][1]); w.y = cvtpk(v[j][2], v[j][3]); o[64 * j] = w; }
            if (lane == 0) rs1[m] = 1.0f / sqrtf(s * (1.0f / DM) + NORM_EPS);
        }
    }
}
__device__ __forceinline__ void prep_experts(const Frame& F, CArgs a, int l, int lane, int part, int w, int nw) {
    unsigned char* ws = a->ws;
    LAS float* scr = (LAS float*)(F.lds + F.wave * PREP_SCR);
    constexpr int I_G = 16 * 4, I_D = 4 * 16;
    const float* fg = a->ffn_g + l * DM;
    if (part == 0) {
        for (int it = w; it < NEXP * 2 * I_G; it += nw) {
            const int e = it / (2 * I_G); int r = it - e * (2 * I_G); const int t = r / I_G; r -= t * I_G;
            const size_t eo = ((size_t)l * NEXP + e) * DM * DEXP; const float* W = (t ? a->w_eu : a->w_eg) + eo;
            transpose_item64(W, DEXP, 64 * (r / 4), 64 * (r % 4), fg, (bf16*)(ws + WS_WGU) + (size_t)e * 512 * DM, DM, MapGU{t}, scr, lane);
        }
    } else {
        for (int it = w; it < NEXP * I_D; it += nw) {
            const int e = it / I_D, r = it - e * I_D;
            const size_t eo = ((size_t)l * NEXP + e) * DM * DEXP;
            transpose_item64(a->w_ed + eo, DM, 64 * (r / 16), 64 * (r % 16), nullptr, (bf16*)(ws + WS_WD) + (size_t)e * DM * DEXP, DEXP, MapPlain{}, scr, lane);
        }
    }
}

__device__ __forceinline__ int crow(int r, int hi) { return (r & 3) + 8 * (r >> 2) + 4 * hi; }
struct AttnUnit { int kcol, vcol, b, d, r, t0, span, W, qcol, tq; float m0, l0; bf16* outp; int opitch; float* lsep; bool valid; };
__device__ __forceinline__ AttnUnit attn_decode(int idx, int G, int bx, int wave, int l, CArgs a, bf16* ya, bf16* ob, float* lse) {
    AttnUnit U; U.valid = false;
    const int nA = (BATCH * 2 * 64 - bx + G - 1) / G;
    if (idx < nA) {
        const int u = bx + idx * G; const int qb = u & 63, kvh = (u >> 6) & 1, b = u >> 7; const int g = wave >> 1, hq = kvh * 4 + g;
        U.kcol = 512 + kvh * 64; U.vcol = 640 + kvh * 64; U.b = b; U.d = 1; U.r = 0; U.t0 = 2 * qb; U.span = 2; U.W = 4; U.qcol = hq * 64; U.tq = 2 * qb + (wave & 1);
        U.m0 = a->a_sink[l * 8 + hq] * LOG2E; U.l0 = 1.0f; U.outp = ya + hq * 64; U.opitch = 768; U.lsep = nullptr; U.valid = true; return U;
    }
    const int u = bx + (idx - nA) * G;
    if (u < 3 * 256) {
        const int grp = u >> 8; int q = u & 255;
        const int d = grp == 0 ? 1 : (grp == 1 ? 4 : 16), bpr = 16 / d;
        const int blk = q % bpr; q /= bpr; const int res = q % d; q /= d; const int h = q & 3, b = q >> 2;
        const int base = 768 + 768 * grp;
        U.kcol = base + 256 + h * 64; U.vcol = base + 512 + h * 64; U.b = b; U.d = d; U.r = res; U.t0 = 8 * blk; U.span = 8; U.W = 2; U.qcol = base + h * 64; U.tq = 8 * blk + wave;
        U.m0 = -1e30f; U.l0 = 0.0f; U.outp = ob + grp * 256 + h * 64; U.opitch = 768; U.lsep = lse + grp * 4 + h; U.valid = true;
    }
    return U;
}
__device__ __forceinline__ void attn_fetch(const bf16* P, const AttnUnit& U, int tid, u32x4 (&buf)[12]) {
    const int L32 = (SEQ / U.d) >> 5, jbase = U.t0 - U.W, ntile = U.span + 2 * U.W, nch = ntile * 512;
    const size_t tok0 = (size_t)U.b * SEQ + U.r;
#pragma unroll
    for (int i = 0; i < 12; ++i) {
        const int c = tid + 512 * i;
        if (c < nch) {
            const int kv = c >= ntile * 256, cc = kv ? c - ntile * 256 : c, row = cc >> 3, ch = cc & 7, tile = row >> 5, rr = row & 31, j = jbase + tile;
            if (j >= 0 && j < L32) buf[i] = __builtin_nontemporal_load((const u32x4*)(P + (tok0 + (size_t)(32 * j + rr) * U.d) * NQKV + (kv ? U.vcol : U.kcol) + ch * 8));
        }
    }
}
__device__ __forceinline__ void attn_stage(const AttnUnit& U, int tid, const u32x4 (&buf)[12], LAS unsigned char* lds) {
    const int L32 = (SEQ / U.d) >> 5, jbase = U.t0 - U.W, ntile = U.span + 2 * U.W, nch = ntile * 512;
    LAS unsigned char* kimg = lds; LAS unsigned char* vimg = lds + ntile * 4096;
#pragma unroll
    for (int i = 0; i < 12; ++i) {
        const int c = tid + 512 * i;
        if (c < nch) {
            const int kv = c >= ntile * 256, cc = kv ? c - ntile * 256 : c, row = cc >> 3, ch = cc & 7, tile = row >> 5, rr = row & 31, j = jbase + tile;
            if (j >= 0 && j < L32) *(LAS u32x4*)((kv ? vimg : kimg) + tile * 4096 + rr * 128 + (kv ? ch : (ch ^ (rr & 7))) * 16) = buf[i];
        }
    }
}
template <int NT> __device__ __forceinline__ void attn_step(int j, int jbase, int tq, int W, const LAS unsigned char* kimg, const LAS unsigned char* vimg, int krd, int vrd, int r32, int hi,
                                                          const bf16x8 (&qf)[4], f32x16& o0, f32x16& o1, float& mrun, float& lrun) {
#define VTR(p, off) __builtin_bit_cast(s16x4, __builtin_amdgcn_ds_read_tr16_b64_v4i16((LAS s16x4*)((p) + (off))))
    bf16x8 kf[NT][4]; s16x4 va[NT][4], vb[NT][4];
#pragma unroll
    for (int t = 0; t < NT; ++t) {
        const LAS unsigned char* kl = kimg + (j + t - jbase) * 4096 + krd;
#pragma unroll
        for (int s = 0; s < 4; ++s) kf[t][s] = *(const LAS bf16x8*)(kl + (((2 * s + hi) ^ (r32 & 7)) * 16));
    }
#pragma unroll
    for (int t = 0; t < NT; ++t) {
        const LAS unsigned char* vl = vimg + (j + t - jbase) * 4096 + vrd;
#pragma unroll
        for (int q = 0; q < 4; ++q) { va[t][q] = VTR(vl, (16 * (q & 1)) * 128 + (q >> 1) * 64); vb[t][q] = VTR(vl, (16 * (q & 1) + 8) * 128 + (q >> 1) * 64); }
    }
    __builtin_amdgcn_sched_barrier(0);
    f32x16 sc[NT];
#pragma unroll
    for (int t = 0; t < NT; ++t) sc[t] = f32x16{};
#pragma unroll
    for (int s = 0; s < 4; ++s)
#pragma unroll
        for (int t = 0; t < NT; ++t) sc[t] = __builtin_amdgcn_mfma_f32_32x32x16_bf16(kf[t][s], qf[s], sc[t], 0, 0, 0);
#pragma unroll
    for (int t = 0; t < NT; ++t) {
        if (j + t == tq - W) {
#pragma unroll
            for (int g = 0; g < 16; ++g) if (crow(g, hi) < r32) sc[t][g] = -INFINITY;
        }
        if (j + t == tq + W) {
#pragma unroll
            for (int g = 0; g < 16; ++g) if (crow(g, hi) > r32) sc[t][g] = -INFINITY;
        }
    }
    float mx = -INFINITY;
#pragma unroll
    for (int t = 0; t < NT; ++t)
#pragma unroll
        for (int g = 0; g < 16; g += 4) mx = fmaxf(mx, fmaxf(fmaxf(sc[t][g], sc[t][g + 1]), fmaxf(sc[t][g + 2], sc[t][g + 3])));
    { const auto rr = __builtin_amdgcn_permlane32_swap(__float_as_uint(mx), __float_as_uint(mx), false, false); mx = fmaxf(__uint_as_float(rr[0]), __uint_as_float(rr[1])); }
    if (__any(mx > mrun + 8.0f)) {
        const float mnew = fmaxf(mrun, mx);
        const float alpha = fast_exp2(mrun - mnew);
        lrun *= alpha; mrun = mnew;
#pragma unroll
        for (int g = 0; g < 16; ++g) { o0[g] *= alpha; o1[g] *= alpha; }
    }
    float ps[4] = {0.f, 0.f, 0.f, 0.f};
#pragma unroll
    for (int t = 0; t < NT; ++t)
#pragma unroll
        for (int g = 0; g < 16; ++g) { sc[t][g] = fast_exp2(sc[t][g] - mrun); ps[g & 3] += sc[t][g]; }
    float psum = (ps[0] + ps[1]) + (ps[2] + ps[3]);
    { const auto rr = __builtin_amdgcn_permlane32_swap(__float_as_uint(psum), __float_as_uint(psum), false, false); psum = __uint_as_float(rr[0]) + __uint_as_float(rr[1]); }
    lrun += psum;
#define VFR(t, q) ((bf16x8){va[t][q][0], va[t][q][1], va[t][q][2], va[t][q][3], vb[t][q][0], vb[t][q][1], vb[t][q][2], vb[t][q][3]})
#pragma unroll
    for (int t = 0; t < NT; ++t) {
        u32x4 p0, p1;
        p0.x = cvtpk(sc[t][0], sc[t][1]); p0.y = cvtpk(sc[t][2], sc[t][3]); p0.z = cvtpk(sc[t][4], sc[t][5]); p0.w = cvtpk(sc[t][6], sc[t][7]);
        p1.x = cvtpk(sc[t][8], sc[t][9]); p1.y = cvtpk(sc[t][10], sc[t][11]); p1.z = cvtpk(sc[t][12], sc[t][13]); p1.w = cvtpk(sc[t][14], sc[t][15]);
        const bf16x8 pf0 = __builtin_bit_cast(bf16x8, p0), pf1 = __builtin_bit_cast(bf16x8, p1);
        o0 = __builtin_amdgcn_mfma_f32_32x32x16_bf16(VFR(t, 0), pf0, o0, 0, 0, 0);
        o1 = __builtin_amdgcn_mfma_f32_32x32x16_bf16(VFR(t, 2), pf0, o1, 0, 0, 0);
        o0 = __builtin_amdgcn_mfma_f32_32x32x16_bf16(VFR(t, 1), pf1, o0, 0, 0, 0);
        o1 = __builtin_amdgcn_mfma_f32_32x32x16_bf16(VFR(t, 3), pf1, o1, 0, 0, 0);
    }
#undef VFR
#undef VTR
}
__device__ __forceinline__ void attn_compute(const bf16* P, const AttnUnit& U, const bf16x8 (&qf)[4], LAS unsigned char* lds, LAS unsigned char* stg, int lane) {
    const int r32 = lane & 31, hi = lane >> 5;
    const int d = U.d, W = U.W, tq = U.tq;
    const int L32 = (SEQ / d) >> 5;
    const size_t tok0 = (size_t)U.b * SEQ + U.r;
    const int jbase = U.t0 - W, ntile = U.span + 2 * W;
    LAS unsigned char* kimg = lds; LAS unsigned char* vimg = lds + ntile * 4096;
    const size_t qtok = tok0 + (size_t)(32 * tq + r32) * d;
    f32x16 o0 = {}, o1 = {};
    float mrun = U.m0, lrun = U.l0;
    const int jlo = (tq - W) < 0 ? 0 : (tq - W), jhi = (tq + W) > (L32 - 1) ? (L32 - 1) : (tq + W);
    const int vrd = (4 * hi + ((lane & 15) >> 2)) * 128 + (16 * ((lane >> 4) & 1) + 4 * (lane & 3)) * 2;
    const int krd = r32 * 128;
    int j = jlo;
    for (; j + 1 <= jhi; j += 2) attn_step<2>(j, jbase, tq, W, kimg, vimg, krd, vrd, r32, hi, qf, o0, o1, mrun, lrun);
    if (j <= jhi) attn_step<1>(j, jbase, tq, W, kimg, vimg, krd, vrd, r32, hi, qf, o0, o1, mrun, lrun);
    const float inv = 1.0f / lrun;
#pragma unroll
    for (int g4 = 0; g4 < 4; ++g4) {
        u32x2 w0, w1;
        w0.x = cvtpk(o0[4 * g4] * inv, o0[4 * g4 + 1] * inv); w0.y = cvtpk(o0[4 * g4 + 2] * inv, o0[4 * g4 + 3] * inv);
        w1.x = cvtpk(o1[4 * g4] * inv, o1[4 * g4 + 1] * inv); w1.y = cvtpk(o1[4 * g4 + 2] * inv, o1[4 * g4 + 3] * inv);
        *(LAS u32x2*)(stg + r32 * 144 + (8 * g4 + 4 * hi) * 2) = w0;
        *(LAS u32x2*)(stg + r32 * 144 + 64 + (8 * g4 + 4 * hi) * 2) = w1;
    }
#pragma unroll
    for (int i = 0; i < 4; ++i) {
        const int row = i * 8 + (lane >> 3), ch = lane & 7;
        const u32x4 v = *(const LAS u32x4*)(stg + row * 144 + ch * 16);
        *(u32x4*)(U.outp + (tok0 + (size_t)(32 * tq + row) * d) * U.opitch + ch * 8) = v;
    }
    if (U.lsep && hi == 0) U.lsep[qtok * 12] = (mrun + log2f(lrun)) * LN2;
}
__device__ __forceinline__ void attn_phase(const Frame& F, CArgs a, int l) {
    const int lane = otid(), tid = F.wave * 64 + lane; (void)tid; (void)lane;
    unsigned char* ws = a->ws;
    const bf16* P = (const bf16*)(ws + WS_PQ);
    bf16* ya = (bf16*)(ws + WS_YAB) + 256; bf16* ob = (bf16*)a->out; float* lse = (float*)(ws + WS_LSE);
    const int r32 = lane & 31, hi = lane >> 5;
    u32x4 buf[12];
    LAS unsigned char* stg = F.lds + 98304 + F.wave * 4608;
    AttnUnit U = attn_decode(0, F.G, F.bx, F.wave, l, a, ya, ob, lse);
    if (U.valid) attn_fetch(P, U, tid, buf);
    for (int idx = 0; U.valid; ++idx) {
        attn_stage(U, tid, buf, F.lds);
        u32x4 qv[4];
#pragma unroll
        for (int i = 0; i < 4; ++i) { const int row = i * 8 + (lane >> 3), ch = lane & 7;
            qv[i] = __builtin_nontemporal_load((const u32x4*)(P + ((size_t)U.b * SEQ + U.r + (size_t)(32 * U.tq + row) * U.d) * NQKV + U.qcol + ch * 8)); }
        const AttnUnit Un = attn_decode(idx + 1, F.G, F.bx, F.wave, l, a, ya, ob, lse);
#pragma unroll
        for (int i = 0; i < 4; ++i) { const int row = i * 8 + (lane >> 3), ch = lane & 7; *(LAS u32x4*)(stg + row * 144 + ch * 16) = qv[i]; }
        bf16x8 qf[4];
#pragma unroll
        for (int s = 0; s < 4; ++s) qf[s] = *(const LAS bf16x8*)(stg + r32 * 144 + (2 * s + hi) * 16);
        __syncthreads();
        if (Un.valid) attn_fetch(P, Un, tid, buf);
        attn_compute(P, U, qf, F.lds, stg, lane);
        __syncthreads();
        U = Un;
    }
    prep_experts(F, a, l, lane, 0, F.gw, F.ngw);
    prep_experts(F, a, l, lane, 1, F.gw, F.ngw);
}
__device__ __forceinline__ void comb_rows(const Frame& F, CArgs a, int row0, int tid) {
    unsigned char* ws = a->ws;
    const bf16* ob = (const bf16*)a->out; const float* lse = (const float*)(ws + WS_LSE); bf16* yb = (bf16*)(ws + WS_YAB);
#pragma unroll 4
    for (int it = 0; it < 16; ++it) {
        const int idx = tid + it * NTHREADS;
        const int tok = row0 + (idx >> 5), c = idx & 31, h = c >> 3;
        const float l0 = lse[tok * 12 + h], l1 = lse[tok * 12 + 4 + h], l2 = lse[tok * 12 + 8 + h];
        const u32x4 a0 = *(const u32x4*)(ob + (size_t)tok * 768 + c * 8), a1 = *(const u32x4*)(ob + (size_t)tok * 768 + 256 + c * 8), a2 = *(const u32x4*)(ob + (size_t)tok * 768 + 512 + c * 8);
        const float mx = fmaxf(l0, fmaxf(l1, l2));
        float w0 = __expf(l0 - mx), w1 = __expf(l1 - mx), w2 = __expf(l2 - mx);
        const float inv = 1.0f / (w0 + w1 + w2); w0 *= inv; w1 *= inv; w2 *= inv;
        u32x4 o;
#define CMB(f) o.f = cvtpk(w0 * bflo(a0.f) + w1 * bflo(a1.f) + w2 * bflo(a2.f), w0 * bfhi(a0.f) + w1 * bfhi(a1.f) + w2 * bfhi(a2.f))
        CMB(x); CMB(y); CMB(z); CMB(w);
#undef CMB
        *(u32x4*)(yb + (size_t)tok * 768 + c * 8) = o;
    }
}

__device__ __forceinline__ void route_phase(const Frame& F, CArgs a, int l, unsigned* waitp) {
    const int lane = otid(), tid = F.wave * 64 + lane;
    unsigned char* ws = a->ws;
    const bf16* xbf = (const bf16*)(ws + WS_XB); const u32x4* wrh = (const u32x4*)(ws + WS_WR + l * WR_LSTRIDE); const u32x4* wrl = (const u32x4*)(ws + WS_WR + l * WR_LSTRIDE + WR_LO);
    float* rs2 = (float*)(ws + WS_RS2); i32x4* tokinfo = (i32x4*)(ws + WS_TOKINFO); int* ltok = (int*)(ws + WS_LTOK); float* lw = (float*)(ws + WS_LW);
    int* cnt = (int*)(ws + WS_CTL) + CW_CNT + l * 32 * CNT_STRIDE;
    const float* brg = a->b_rg + l * 4; const float* bre = a->b_re + l * NEXP;
    LAS f32x4* part = (LAS f32x4*)(F.lds);
    LAS float* ssp = (LAS float*)(F.lds + 12288);
    LAS float* Lg = (LAS float*)(F.lds + 16384);
    LAS float* rsL = (LAS float*)(F.lds + 16384 + 12288);
    LAS int* lcnt = (LAS int*)(F.lds + 16384 + 12288 + 256);
    LAS int* lbase = lcnt + 32;
    const int rt = F.wave & 3, kh = F.wave >> 2;
    if (tid < 32) lcnt[tid] = 0;
    __syncthreads();
    for (int blk = F.bx; blk < MTOK / 64; blk += F.G) {
        if (waitp) {
            if (F.wave == 0) {
                unsigned* p = waitp + (blk >> 2) * PAN_STRIDE; unsigned spins = 0;
                while ((unsigned)__builtin_amdgcn_readfirstlane(__hip_atomic_load(p, __ATOMIC_RELAXED, __HIP_MEMORY_SCOPE_AGENT)) < 32u) {
                    __builtin_amdgcn_s_sleep(2);
                    if (++spins > (1u << 22)) { __hip_atomic_store((unsigned*)(ws + WS_CTL) + CW_ERR, 3u, __ATOMIC_RELAXED, __HIP_MEMORY_SCOPE_AGENT); break; }
                }
                __builtin_amdgcn_fence(__ATOMIC_ACQUIRE, "agent");
                asm volatile("s_waitcnt vmcnt(0)" ::: "memory");
            }
            __syncthreads();
        }
        const int row0 = blk * 64 + rt * 16;
        const u32x4* xr = (const u32x4*)(xbf + (size_t)(row0 + (lane & 15)) * DM + kh * 512) + (lane >> 4);
        const u32x4* wh = wrh + (size_t)(kh * 16) * 3 * 64 + lane; const u32x4* wl = wrl + (size_t)(kh * 16) * 3 * 64 + lane;
        f32x4 acc0 = {0.f, 0.f, 0.f, 0.f}, acc1 = acc0, acc2 = acc0; float ss = 0.f;
#pragma unroll 4
        for (int i = 0; i < 16; ++i) {
            const u32x4 xw = xr[4 * i];
            const u32x4 h0 = wh[(i * 3 + 0) * 64], h1 = wh[(i * 3 + 1) * 64], h2 = wh[(i * 3 + 2) * 64], l0 = wl[(i * 3 + 0) * 64], l1 = wl[(i * 3 + 1) * 64], l2 = wl[(i * 3 + 2) * 64];
            const float xv[8] = {bflo(xw.x), bfhi(xw.x), bflo(xw.y), bfhi(xw.y), bflo(xw.z), bfhi(xw.z), bflo(xw.w), bfhi(xw.w)};
#pragma unroll
            for (int j = 0; j < 8; ++j) ss += xv[j] * xv[j];
            const bf16x8 xf = __builtin_bit_cast(bf16x8, xw);
            acc0 = __builtin_amdgcn_mfma_f32_16x16x32_bf16(xf, __builtin_bit_cast(bf16x8, l0), acc0, 0, 0, 0);
            acc1 = __builtin_amdgcn_mfma_f32_16x16x32_bf16(xf, __builtin_bit_cast(bf16x8, l1), acc1, 0, 0, 0);
            acc2 = __builtin_amdgcn_mfma_f32_16x16x32_bf16(xf, __builtin_bit_cast(bf16x8, l2), acc2, 0, 0, 0);
            acc0 = __builtin_amdgcn_mfma_f32_16x16x32_bf16(xf, __builtin_bit_cast(bf16x8, h0), acc0, 0, 0, 0);
            acc1 = __builtin_amdgcn_mfma_f32_16x16x32_bf16(xf, __builtin_bit_cast(bf16x8, h1), acc1, 0, 0, 0);
            acc2 = __builtin_amdgcn_mfma_f32_16x16x32_bf16(xf, __builtin_bit_cast(bf16x8, h2), acc2, 0, 0, 0);
        }
        ss += shx(ss, 16, lane); ss += shx(ss, 32, lane);
        if (kh == 1) { part[(rt * 3 + 0) * 64 + lane] = acc0; part[(rt * 3 + 1) * 64 + lane] = acc1; part[(rt * 3 + 2) * 64 + lane] = acc2; if (lane < 16) ssp[rt * 16 + lane] = ss; }
        __syncthreads();
        if (kh == 0) {
            acc0 += part[(rt * 3 + 0) * 64 + lane]; acc1 += part[(rt * 3 + 1) * 64 + lane]; acc2 += part[(rt * 3 + 2) * 64 + lane];
            ss += ssp[rt * 16 + (lane & 15)];
#pragma unroll
            for (int g = 0; g < 4; ++g) { const int rw = rt * 16 + 4 * (lane >> 4) + g; Lg[rw * 48 + (lane & 15)] = acc0[g]; Lg[rw * 48 + 16 + (lane & 15)] = acc1[g]; Lg[rw * 48 + 32 + (lane & 15)] = acc2[g]; }
            if (lane < 16) rsL[rt * 16 + lane] = 1.0f / sqrtf(ss * (1.0f / DM) + NORM_EPS);
        }
        __syncthreads();
        int e1 = 0, e2 = 0, r1 = 0, r2 = 0; float w1 = 0.f, w2 = 0.f, rsv = 0.f;
        if (tid < 64) {
            const LAS float* Lr = Lg + tid * 48; rsv = rsL[tid];
            float gl[4];
#pragma unroll
            for (int g = 0; g < 4; ++g) gl[g] = Lr[g] * rsv + brg[g];
            int gi = 0; float gm = gl[0];
#pragma unroll
            for (int g = 1; g < 4; ++g) if (gl[g] > gm) { gm = gl[g]; gi = g; }
            float den = 0.f;
#pragma unroll
            for (int g = 0; g < 4; ++g) den += expf(gl[g] - gm);
            const float gw = 1.0f / den;
            float v1 = -INFINITY, v2 = -INFINITY; int i1 = 0, i2 = 0;
#pragma unroll
            for (int e = 0; e < 8; ++e) {
                const float v = Lr[4 + 8 * gi + e] * rsv + bre[8 * gi + e];
                if (v > v1) { v2 = v1; i2 = i1; v1 = v; i1 = e; } else if (v > v2) { v2 = v; i2 = e; }
            }
            const float p1 = 1.0f / (1.0f + expf(v2 - v1));
            e1 = 8 * gi + i1; e2 = 8 * gi + i2; w1 = p1 * gw; w2 = (1.0f - p1) * gw;
            r1 = __hip_atomic_fetch_add(&lcnt[e1], 1, __ATOMIC_RELAXED, __HIP_MEMORY_SCOPE_WORKGROUP); r2 = __hip_atomic_fetch_add(&lcnt[e2], 1, __ATOMIC_RELAXED, __HIP_MEMORY_SCOPE_WORKGROUP);
        }
        __syncthreads();
        if (tid < 32) { const int c = lcnt[tid]; lbase[tid] = c ? atomicAdd(&cnt[tid * CNT_STRIDE], c) : 0; lcnt[tid] = 0; }
        __syncthreads();
        if (tid < 64) {
            const int tok = blk * 64 + tid;
            const int pos1 = lbase[e1] + r1, pos2 = lbase[e2] + r2;
            ltok[e1 * MTOK + pos1] = tok; lw[e1 * MTOK + pos1] = w1;
            ltok[e2 * MTOK + pos2] = tok; lw[e2 * MTOK + pos2] = w2;
            tokinfo[tok] = (i32x4){e1, pos1, e2, pos2};
            rs2[tok] = rsv;
        }
        __syncthreads();
    }
}
__device__ __forceinline__ MoeTab moe_tables(const Frame& F, CArgs a, int l) {
    const int lane = otid(), tid = F.wave * 64 + lane; (void)tid; (void)lane;
    volatile LAS int* cntL = F.misc + 64; volatile LAS int* mtp = F.misc + 128; volatile LAS int* sp = F.misc + 192; volatile LAS int* te = F.misc + 256;
    const int* cnt = (const int*)(a->ws + WS_CTL) + CW_CNT + l * 32 * CNT_STRIDE;
    __syncthreads();
    if (tid < 32) cntL[tid] = __hip_atomic_load(cnt + tid * CNT_STRIDE, __ATOMIC_RELAXED, __HIP_MEMORY_SCOPE_AGENT);
    __syncthreads();
    if (tid <= 32) { int mt = 0, sl = 0; for (int e = 0; e < tid; ++e) { const int c = cntL[e]; mt += (c + 255) >> 8; sl += c; } mtp[tid] = mt; sp[tid] = sl; }
    __syncthreads();
    if (tid < 256) { int e = 0; for (int k = 1; k < 32; ++k) if (mtp[k] <= tid) e = k; te[tid] = e; }
    __syncthreads();
    MoeTab T; T.cnt = cntL; T.mtpref = mtp; T.spref = sp; T.tile_e = te; return T;
}
__device__ __forceinline__ void fin_phase(const Frame& F, CArgs a, int l, const MoeTab& T) {
    const int lane = otid(), tid = F.wave * 64 + lane; (void)tid;
    unsigned char* ws = a->ws;
    const i32x4* tokinfo = (const i32x4*)(ws + WS_TOKINFO); const bf16* Y = (const bf16*)(ws + WS_Y);
    bf16* xb = (bf16*)(ws + WS_XB); float* rs1 = (float*)(ws + WS_RS1);
    const int step = 2 * F.ngw;
    int m0 = 2 * F.gw;
    i32x4 tn0 = tokinfo[m0 < MTOK ? m0 : 0], tn1 = tokinfo[m0 + 1 < MTOK ? m0 + 1 : 0];
    for (; m0 < MTOK; m0 += step) {
        const i32x4 ti[2] = {tn0, tn1};
        const int mn = m0 + step;
        if (mn < MTOK) { tn0 = tokinfo[mn]; tn1 = tokinfo[mn + 1]; }
        u32x4 xv[2][2], p[2][2], q[2][2];
#pragma unroll
        for (int r = 0; r < 2; ++r) {
            const int m = m0 + r;
            const int s1 = T.spref[ti[r][0]] + ti[r][1], s2 = T.spref[ti[r][2]] + ti[r][3];
            const u32x4* xr = (const u32x4*)(xb + (size_t)m * DM) + lane;
            const u32x4* y1 = (const u32x4*)(Y + (size_t)s1 * DM) + lane; const u32x4* y2 = (const u32x4*)(Y + (size_t)s2 * DM) + lane;
#pragma unroll
            for (int j = 0; j < 2; ++j) { xv[r][j] = xr[64 * j]; p[r][j] = __builtin_nontemporal_load(y1 + 64 * j); q[r][j] = __builtin_nontemporal_load(y2 + 64 * j); }
        }
#pragma unroll
        for (int r = 0; r < 2; ++r) {
            const int m = m0 + r;
            float v[2][8]; float s = 0.f;
#pragma unroll
            for (int j = 0; j < 2; ++j) {
#define FINC(c, f) v[j][2 * c] = bflo(xv[r][j].f) + bflo(p[r][j].f) + bflo(q[r][j].f); v[j][2 * c + 1] = bfhi(xv[r][j].f) + bfhi(p[r][j].f) + bfhi(q[r][j].f);
                FINC(0, x) FINC(1, y) FINC(2, z) FINC(3, w)
#undef FINC
#pragma unroll
                for (int c = 0; c < 8; ++c) s += v[j][c] * v[j][c];
            }
            s = wave_sum(s, lane);
            const float rsv = 1.0f / sqrtf(s * (1.0f / DM) + NORM_EPS);
            if (l == DEPTH - 1) {
#pragma unroll
                for (int j = 0; j < 2; ++j) {
                    const f32x4* g = (const f32x4*)(a->fin_g + 512 * j + 8 * lane); f32x4* o = (f32x4*)(a->out + (size_t)m * DM + 512 * j + 8 * lane);
                    const f32x4 g0 = g[0], g1 = g[1];
                    __builtin_nontemporal_store((f32x4){v[j][0] * rsv * g0[0], v[j][1] * rsv * g0[1], v[j][2] * rsv * g0[2], v[j][3] * rsv * g0[3]}, o);
                    __builtin_nontemporal_store((f32x4){v[j][4] * rsv * g1[0], v[j][5] * rsv * g1[1], v[j][6] * rsv * g1[2], v[j][7] * rsv * g1[3]}, o + 1);
                }
            } else {
                u32x4* o = (u32x4*)(xb + (size_t)m * DM) + lane;
#pragma unroll
                for (int j = 0; j < 2; ++j) { u32x4 w; w.x = cvtpk(v[j][0], v[j][1]); w.y = cvtpk(v[j][2], v[j][3]); w.z = cvtpk(v[j][4], v[j][5]); w.w = cvtpk(v[j][6], v[j][7]); o[64 * j] = w; }
                if (lane == 0) rs1[m] = rsv;
            }
        }
    }
}

constexpr int PH_PREP = 0, PH_GEMM1 = 1, PH_ATTN = 2, PH_MID = 3, PH_MOE = 4, PH_FIN = 5, PH_PER_LAYER = 6, NPHASE = PH_PER_LAYER * DEPTH - 1;

__global__ void __launch_bounds__(NTHREADS, 2) fwd_kernel(Args a_by_value) {
    extern __shared__ __attribute__((aligned(16))) unsigned char lds_raw[];
    Frame F;
    F.lds = (LAS unsigned char*)lds_raw; F.misc = (volatile LAS int*)(F.lds + MISC_OFF);
    F.wave = __builtin_amdgcn_readfirstlane((int)threadIdx.x >> 6);
    F.G = gridDim.x; { const int bx = blockIdx.x; F.vcu = (F.G % 8 == 0) ? (bx % 8) * (F.G / 8) + bx / 8 : bx; }
    F.gw = blockIdx.x * NWAVES + F.wave; F.ngw = F.G * NWAVES;
    CArgs a = (CArgs)__builtin_amdgcn_kernarg_segment_ptr();
    unsigned char* ws = a->ws;
    const int ph_lo = a->ph_lo, ph_hi = a->ph_hi;
    for (int u = threadIdx.x; u < 1024; u += NTHREADS) F.misc[u] = 0;
    __syncthreads();
#if !MK_MULTI
    XcdBarrier bar = xcd_barrier_post((unsigned*)(ws + WS_CTL) + CW_BAR, (volatile LAS unsigned*)(F.misc + 8));
#define GRID_BAR() xcd_barrier(bar, F.wave)
#else
#define GRID_BAR() do { } while (0)
#endif
    for (int ph = ph_lo, rep = 0; ph < ph_hi; ) {
        const int l = ph >= PH_PER_LAYER ? 1 : 0, k = ph >= PH_PER_LAYER ? ph - (PH_PER_LAYER - 1) : ph;
        const size_t wlo = (size_t)l * WNE_LSTRIDE;
        {
            int bx = blockIdx.x; asm volatile("" : "+s"(bx)); asm volatile("" : "+s"(a)); ws = a->ws;
            int wv = F.wave; asm volatile("" : "+s"(wv)); F.gw = bx * NWAVES + wv; F.bx = bx;
        }
        if (k == PH_PREP && (PHMASK & 1)) {
            prep_phase(F, a);
        } else if (k == PH_GEMM1 && (PHMASK & 2)) {
            DenseSched S; S.A = (const char*)(ws + WS_XB); S.Bt = (const char*)(ws + wlo + WS_WIN); S.K = DM; S.lda = DM; S.ldb = DM; S.ksplit = 0; S.wave = F.wave; S.so.init(MTOK, DIN, F.G, F.bx); S.waitp = nullptr; S.need = 0; S.postp = nullptr; S.err = nullptr;
            EpiProj E{(bf16*)(ws + WS_PQ), (bf16*)(ws + WS_PG), (const float*)(ws + WS_RS1), (const f32x4*)(ws + WS_ROPE)};
            pg8::gemm_phase(F.lds, S, E);
        } else if (k == PH_ATTN && (PHMASK & 4)) {
            attn_phase(F, a, l);
        } else if (k == PH_MID) {
            unsigned* pan = (unsigned*)(ws + WS_CTL) + CW_PAN + l * 3 * 64 * PAN_STRIDE; unsigned* err = (unsigned*)(ws + WS_CTL) + CW_ERR;
            { pg8::StaticOrder so; so.init(MTOK, DM, F.G, F.bx); const int tid_ = F.wave * 64 + otid();
              for (int i = 0, pm, pn; so.next(i, pm, pn); ++i) comb_rows(F, a, pm * 256, tid_);
              VM_WAIT(); __syncthreads(); }
            { DenseSched S; S.A = (const char*)(ws + WS_YAB); S.Bt = (const char*)(ws + wlo + WS_WAB); S.K = 768; S.lda = 768; S.ldb = 768; S.ksplit = 256; S.wave = F.wave; S.so.init(MTOK, DM, F.G, F.bx);
              S.waitp = nullptr; S.need = 0; S.postp = pan; S.err = err;
              EpiMerge E{(const unsigned char*)(ws + WS_PG), (bf16*)(ws + WS_MRG)};
              pg8::gemm_phase(F.lds, S, E); }
            { DenseSched S; S.A = (const char*)(ws + WS_MRG); S.Bt = (const char*)(ws + wlo + WS_WOUT); S.K = DM; S.lda = DM; S.ldb = DM; S.ksplit = 0; S.wave = F.wave; S.so.init(MTOK, DM, F.G, F.bx);
              S.waitp = pan; S.need = 32; S.postp = pan + 64 * PAN_STRIDE; S.err = err;
              EpiResid E{(bf16*)(ws + WS_XB)};
              pg8::gemm_phase(F.lds, S, E); }
            route_phase(F, a, l, pan + 64 * PAN_STRIDE);
        } else if (k == PH_MOE) {
            const MoeTab T = moe_tables(F, a, l);
            const int mtT = T.mtpref[32], nU = 2 * mtT, nU1 = nU < F.G ? nU : F.G, nU2 = nU - nU1, tready = nU1 >> 1;
            const int bx = F.vcu;
            unsigned* upd = (unsigned*)(ws + WS_CTL) + CW_UPD + l * 256 * UPD_STRIDE; unsigned* err = (unsigned*)(ws + WS_CTL) + CW_ERR;
            MoeSched<true> SU; SU.A = (const char*)(ws + WS_XB); SU.Bt = (const char*)(ws + WS_WGU); SU.K = DM; SU.lda = DM; SU.ldb = DM; SU.wave = F.wave; SU.ntn = 2; SU.bstride_e = (size_t)512 * DM * 2; SU.ltok = (const int*)(ws + WS_LTOK); SU.T = T; SU.upd = upd; SU.err = err;
            MoeSched<false> SD; SD.A = (const char*)(ws + WS_H); SD.Bt = (const char*)(ws + WS_WD); SD.K = DEXP; SD.lda = DEXP; SD.ldb = DEXP; SD.wave = F.wave; SD.ntn = 4; SD.bstride_e = (size_t)DM * DEXP * 2; SD.ltok = nullptr; SD.T = T; SD.upd = upd; SD.err = err;
            EpiSwiglu EU{(const int*)(ws + WS_LTOK), (const float*)(ws + WS_LW), (const float*)(ws + WS_RS2), (bf16*)(ws + WS_H)};
            EpiY ED{(bf16*)(ws + WS_Y)};
            SU.G1 = F.G; SU.c1 = bx; SU.lo1 = 0; SU.hi1 = nU; SU.G2 = 1; SU.c2 = -1; SU.lo2 = 0; SU.hi2 = 0;
            pg8::gemm_phase(F.lds, SU, EU);
            SD.G1 = F.G - nU2; SD.c1 = bx - nU2; SD.lo1 = 0; SD.hi1 = 4 * tready;
            { const int extra = (4 * tready) % SD.G1;
              SD.G2 = SD.G1 - extra; SD.c2 = SD.c1 >= extra ? SD.c1 - extra : -1; SD.lo2 = 4 * tready; SD.hi2 = 4 * mtT; }
            pg8::gemm_phase(F.lds, SD, ED);
        } else if (k == PH_FIN && (PHMASK & 512)) {
            const MoeTab T = moe_tables(F, a, l);
            fin_phase(F, a, l, T);
        }
#if REP_MASK
        if (l == 0 && ((REP_MASK >> k) & 1) && rep < REP_N) { ++rep; GRID_BAR(); continue; }
        rep = 0;
#endif
        if (ph + 1 < ph_hi) { GRID_BAR();
#ifdef EXTRA_BAR
            for (int eb = 0; eb < EXTRA_BAR; ++eb) GRID_BAR();
#endif
        }
        ++ph;
    }
}

extern "C" void kernel_launch(void* const* d_in, const int* in_sizes, int n_in, void* d_out, int out_size, void* d_ws, size_t ws_size, hipStream_t stream) {
    static int grid = 0;
    if (grid == 0) {
        if (n_in != 16 || out_size != MTOK * DM || ws_size < WS_END) { fprintf(stderr, "kernel_launch: unexpected shapes (n_in %d out %d ws %zu)\n", n_in, out_size, ws_size); grid = -1; return; }
        int dev = 0, cus = 0, per_cu = 0;
        if (hipGetDevice(&dev) != hipSuccess || hipDeviceGetAttribute(&cus, hipDeviceAttributeMultiprocessorCount, dev) != hipSuccess) { grid = -1; return; }
        if (hipFuncSetAttribute((const void*)fwd_kernel, hipFuncAttributeMaxDynamicSharedMemorySize, LDS_BYTES) != hipSuccess) { fprintf(stderr, "kernel_launch: hipFuncSetAttribute failed\n"); grid = -1; return; }
        if (hipOccupancyMaxActiveBlocksPerMultiprocessor(&per_cu, (const void*)fwd_kernel, NTHREADS, LDS_BYTES) != hipSuccess || per_cu < 1) { fprintf(stderr, "kernel_launch: occupancy query says %d\n", per_cu); (void)hipGetLastError(); }
        grid = cus;
    }
    if (grid < 0) return;
    (void)hipMemsetAsync((char*)d_ws + WS_CTL, 0, CTL_BYTES, stream);
    Args a{};
    a.x = (const float*)d_in[0]; a.attn_g = (const float*)d_in[1]; a.w_in = (const float*)d_in[2]; a.a_sink = (const float*)d_in[3]; a.w_a = (const float*)d_in[4]; a.w_b = (const float*)d_in[5];
    a.w_out = (const float*)d_in[6]; a.ffn_g = (const float*)d_in[7]; a.w_rg = (const float*)d_in[8]; a.b_rg = (const float*)d_in[9]; a.w_re = (const float*)d_in[10]; a.b_re = (const float*)d_in[11];
    a.w_eg = (const float*)d_in[12]; a.w_eu = (const float*)d_in[13]; a.w_ed = (const float*)d_in[14]; a.fin_g = (const float*)d_in[15];
    a.out = (float*)d_out; a.ws = (unsigned char*)d_ws;
#if MK_MULTI
    for (int ph = 0; ph < NPHASE; ++ph) { a.ph_lo = ph; a.ph_hi = ph + 1; hipLaunchKernelGGL(fwd_kernel, dim3(grid), dim3(NTHREADS), LDS_BYTES, stream, a); }
#else
    a.ph_lo = 0; a.ph_hi = NPHASE;
    void* kargs[] = {&a};
    const hipError_t le = hipLaunchCooperativeKernel((const void*)fwd_kernel, dim3(grid), dim3(NTHREADS), kargs, LDS_BYTES, stream);
    if (le != hipSuccess) fprintf(stderr, "kernel_launch: cooperative launch failed: %s (grid %d)\n", hipGetErrorString(le), grid);
#endif
}
```

```cpp
#include <hip/hip_runtime.h>
#include <hip/hip_cooperative_groups.h>
#include <cstdio>
#include <cstdint>
namespace cg = cooperative_groups;

#ifndef REP_MASK
#define REP_MASK 0
#define REP_N 2
#endif
#ifndef PHMASK
#define PHMASK 1023
#endif
#ifndef MK_MULTI
#define MK_MULTI 0
#endif

#define LAS __attribute__((address_space(3)))
#define GAS __attribute__((address_space(1)))
typedef unsigned short bf16;
typedef short bf16x8 __attribute__((ext_vector_type(8)));
typedef short s16x4 __attribute__((ext_vector_type(4)));
typedef float f32x2 __attribute__((ext_vector_type(2)));
typedef float f32x4 __attribute__((ext_vector_type(4)));
typedef float f32x16 __attribute__((ext_vector_type(16)));
typedef unsigned u32x2 __attribute__((ext_vector_type(2)));
typedef unsigned u32x4 __attribute__((ext_vector_type(4)));
typedef int i32x4 __attribute__((ext_vector_type(4)));
typedef __bf16 bf16x2_t __attribute__((ext_vector_type(2)));

constexpr int BATCH = 4, SEQ = 4096, DM = 1024, DEPTH = 2, MTOK = BATCH * SEQ;
constexpr int NQKV = 3072, NGATE = 2048, DIN = NQKV + NGATE;
constexpr int NEXP = 32, DEXP = 256;
constexpr float NORM_EPS = 1e-6f;
constexpr float LOG2E = 1.4426950408889634f, LN2 = 0.6931471805599453f;
constexpr float QSCALE = 0.125f * LOG2E;
constexpr int NWAVES = 8, NTHREADS = 512;

constexpr size_t MiB = 1u << 20;
constexpr size_t WS_CTL = 0, CTL_BYTES = 1 * MiB;
constexpr size_t WS_ROPE = 1 * MiB;
constexpr size_t WS_WR = 2 * MiB, WR_LSTRIDE = 512 * 1024, WR_LO = 256 * 1024;
constexpr size_t WS_RS1 = 3 * MiB, WS_RS2 = 3 * MiB + 65536;
constexpr size_t WS_TOKINFO = 5 * MiB;
constexpr size_t WS_LTOK = 6 * MiB, WS_LW = 8 * MiB;
constexpr size_t WS_LSE = 10 * MiB;
constexpr size_t WS_WIN = 12 * MiB, WS_WAB = 22 * MiB, WS_WOUT = 24 * MiB, WNE_LSTRIDE = 14 * MiB;
constexpr size_t WS_WGU = 40 * MiB, WS_WD = 72 * MiB;
constexpr size_t WS_XB = 88 * MiB;
constexpr size_t WS_YAB = 120 * MiB;
constexpr size_t WS_PQ = 144 * MiB;
constexpr size_t WS_MRG = 176 * MiB, WS_H = 208 * MiB;
constexpr size_t WS_PG = 240 * MiB;
constexpr size_t WS_Y = 240 * MiB;
constexpr size_t WS_END = 304 * MiB;
constexpr int CW_CNT = 64, CNT_STRIDE = 64;
constexpr int CW_BAR = 8192;
constexpr int CW_UPD = 32768, UPD_STRIDE = 64;
constexpr int CW_ERR = 32;
constexpr int CW_PAN = 65536, PAN_STRIDE = 64;

constexpr int RING_BYTES = 131072;
constexpr int PREP_SCR = 16896;
constexpr int MISC_OFF = 8 * PREP_SCR;
constexpr int LDS_BYTES = 147456;

#define LDS_WAIT() asm volatile("s_waitcnt lgkmcnt(0)" ::: "memory")
#define VM_WAIT() asm volatile("s_waitcnt vmcnt(0)" ::: "memory")
__device__ __forceinline__ unsigned cvtpk(float lo, float hi) { f32x2 v = {lo, hi}; bf16x2_t b = __builtin_convertvector(v, bf16x2_t); return __builtin_bit_cast(unsigned, b); }
__device__ __forceinline__ float bf2f(unsigned short h) { return __uint_as_float(((unsigned)h) << 16); }
__device__ __forceinline__ float bflo(unsigned w) { return __uint_as_float(w << 16); }
__device__ __forceinline__ float bfhi(unsigned w) { return __uint_as_float(w & 0xffff0000u); }
__device__ __forceinline__ float fast_exp2(float x) { return __builtin_amdgcn_exp2f(x); }
__device__ __forceinline__ float fast_rcp(float x) { return __builtin_amdgcn_rcpf(x); }
__device__ __forceinline__ void store16_sc1(void* p, u32x4 v) { asm volatile("global_store_dwordx4 %0, %1, off sc1\n\ts_nop 1" :: "v"(p), "v"(v) : "memory"); }
__device__ __forceinline__ int olane() { unsigned z = 0u; asm volatile("" : "+v"(z)); return (int)__builtin_amdgcn_mbcnt_hi(~0u, __builtin_amdgcn_mbcnt_lo(~0u, z)); }
__device__ __forceinline__ float sigmoidf_fast(float v) { return fast_rcp(1.0f + fast_exp2(-v * LOG2E)); }

namespace pg8 {
constexpr int BM = 256, BK = 64, HALF = 128, HTB = HALF * BK * 2, STAGE_BYTES = 8 * HTB, NXCD = 8, WGM = 4;
__host__ __device__ __forceinline__ int lds_byte(int r, int c) { const int st = (r >> 4) * 2 + (c >> 5), rr = r & 15, cc = c & 31, ob = rr * 64 + cc * 2; return st * 1024 + (ob ^ (((ob >> 9) & 1) << 5)); }
__host__ __device__ __forceinline__ void stage_rc(int b, int& R, int& C) { const int st = b / 1024, sb = b % 1024, swz = sb ^ (((sb >> 9) & 1) << 5); R = (st >> 1) * 16 + swz / 64; C = (st & 1) * 32 + (swz % 64) / 2; }
__host__ __device__ __forceinline__ int perm32(int rho) { const int n = rho >> 4, i = rho & 15; return 8 * (i >> 2) + 4 * n + (i & 3); }

struct Unit { int pm, pn, e, nvalid, slot0, lpos0, nt, kofs, sub, waitk; };

struct StaticOrder {
    int nM, nN, nwg, G, c;
    __device__ void init(int M, int N, int G_, int c_) { nM = M / BM; nN = N / BM; nwg = nM * nN; G = G_; c = c_; }
    __device__ bool next(int i, int& pm, int& pn) const {
        const long L = (long)i * G + c; if (L >= nwg) return false;
        int wgid = (int)L; { const int q = nwg / NXCD, r = nwg % NXCD, xcd = wgid % NXCD, off = wgid / NXCD; wgid = (xcd < r ? xcd * (q + 1) : r * (q + 1) + (xcd - r) * q) + off; }
        const int nig = WGM * nN, gid = wgid / nig, fm = gid * WGM, gsz = (nM - fm) < WGM ? (nM - fm) : WGM;
        pm = fm + ((wgid % nig) % gsz); pn = (wgid % nig) / gsz; return true;
    }
};

template <class Epi, class Sched>
__device__ __forceinline__ void gemm_phase(LAS unsigned char* lds, const Sched& S, const Epi& E) {
    unsigned z_ = 0u; asm volatile("" : "+v"(z_)); const int tid_ = (int)__builtin_amdgcn_mbcnt_hi(~0u, __builtin_amdgcn_mbcnt_lo(~0u, z_)) + S.wave * 64;
    const int tid = tid_, wid = S.wave, lane = tid & 63, wr = wid >> 2, wc = wid & 3, fr = lane & 15, fq = lane >> 4;
    const int K = S.ldb;
    unsigned voffA[2], voffB[2];
#pragma unroll
    for (int i = 0; i < 2; ++i) { int R, C; stage_rc(tid * 16 + i * 8192, R, C); const int Rb = Epi::PERM ? ((R & ~31) + perm32(R & 31)) : R;
        voffA[i] = (unsigned)(R * S.lda + C) * 2u; voffB[i] = (unsigned)(Rb * K + C) * 2u; }
    const size_t kstep = (size_t)(BK * 2);
    const size_t hstepB = (size_t)HALF * K * 2, hstepA = (size_t)HALF * S.lda * 2;
    const unsigned ldsw = (unsigned)wid * 1024u;
    const int aoff = lds_byte(wr * 64 + fr, fq * 8), boff = lds_byte(wc * 32 + fr, fq * 8);
#define PG8_SA(b, h) (((b) * 2 + (h)) * HTB)
#define PG8_SB(b, h) ((4 + (b) * 2 + (h)) * HTB)
#define PG8_GLDS(src, dstoff) __builtin_amdgcn_global_load_lds((const unsigned*)(src), (LAS unsigned*)(lds + (dstoff)), 16, 0, 0)
#define PG8_STAGE_A(bufoff, up, h, VO) do { if constexpr (Sched::GATHER) { _Pragma("unroll") for (int _i = 0; _i < 2; ++_i) PG8_GLDS((up) + VO[_i], (bufoff) + ldsw + _i * 8192); } \
        else { const char* _b = (up) + (size_t)(h) * hstepA; _Pragma("unroll") for (int _i = 0; _i < 2; ++_i) PG8_GLDS(_b + voffA[_i], (bufoff) + ldsw + _i * 8192); } } while (0)
#define PG8_STAGE_B(bufoff, bp) do { _Pragma("unroll") for (int _i = 0; _i < 2; ++_i) PG8_GLDS((bp) + voffB[_i], (bufoff) + ldsw + _i * 8192); } while (0)
#define PG8_LDA(dst, b, h) do { _Pragma("unroll") for (int m = 0; m < 4; ++m) _Pragma("unroll") for (int k = 0; k < 2; ++k) dst[m][k] = *(const LAS bf16x8*)(lds + PG8_SA(b, h) + aoff + m * 2048 + k * 1024); } while (0)
#define PG8_LDB(dst, b, h) do { _Pragma("unroll") for (int n = 0; n < 2; ++n) _Pragma("unroll") for (int k = 0; k < 2; ++k) dst[n][k] = *(const LAS bf16x8*)(lds + PG8_SB(b, h) + boff + n * 2048 + k * 1024); } while (0)
#define PG8_MMA(ai, bj, At, Bt) do { __builtin_amdgcn_s_setprio(1); _Pragma("unroll") for (int m = 0; m < 4; ++m) _Pragma("unroll") for (int n = 0; n < 2; ++n) _Pragma("unroll") for (int k = 0; k < 2; ++k) \
        acc[ai][bj][m][n] = __builtin_amdgcn_mfma_f32_16x16x32_bf16(Bt[n][k], At[m][k], acc[ai][bj][m][n], 0, 0, 0); __builtin_amdgcn_s_setprio(0); } while (0)
#define PG8_WAIT_V(n) asm volatile("s_waitcnt vmcnt(" #n ")" ::: "memory")
#define PG8_WAIT_L(n) asm volatile("s_waitcnt lgkmcnt(" #n ")" ::: "memory")
#define PG8_BAR __builtin_amdgcn_s_barrier()
#define PG8_SCHED __builtin_amdgcn_sched_barrier(0)
    Unit cur, nxt; int ui = 0;
    if (!S.next(0, cur)) return;
    f32x4 acc[2][2][4][2];
#pragma unroll
    for (int a = 0; a < 2; ++a)
#pragma unroll
        for (int b = 0; b < 2; ++b)
#pragma unroll
            for (int m = 0; m < 4; ++m)
#pragma unroll
                for (int n = 0; n < 2; ++n) acc[a][b][m][n] = (f32x4){0.f, 0.f, 0.f, 0.f};
    bf16x8 At[4][2], B0[2][2], B1[2][2];
    const char* Ab = S.a_base();
    const char* cA = Ab; const char* cB = S.b_base(cur);
    unsigned vF0[2], vF1[2], vK[2];
    if constexpr (Sched::GATHER) {
#pragma unroll
        for (int i = 0; i < 2; ++i) { int R, C; stage_rc(tid * 16 + i * 8192, R, C); vF0[i] = S.a_off(cur, R) + (unsigned)(C * 2); vF1[i] = S.a_off(cur, HALF + R) + (unsigned)(C * 2); vK[i] = vF1[i]; }
    } else cA = Ab + S.a_unit_off(cur);
    S.a_ready(cur);
    PG8_STAGE_B(PG8_SB(0, 0), cB); PG8_STAGE_B(PG8_SB(0, 1), cB + hstepB); PG8_STAGE_A(PG8_SA(0, 0), cA, 0, vF0); PG8_STAGE_A(PG8_SA(0, 1), cA, 1, vF1);
    if (wr == 1) PG8_BAR;
    PG8_WAIT_V(2); PG8_BAR;
    PG8_STAGE_B(PG8_SB(1, 0), cB + kstep); PG8_STAGE_A(PG8_SA(1, 0), cA + kstep, 0, vF0); PG8_STAGE_B(PG8_SB(1, 1), cB + hstepB + kstep);
    PG8_WAIT_V(6); PG8_BAR;
    for (;;) {
        const bool has_next = S.next(ui + 1, nxt);
        const char* nA = cA; const char* nB = cB;
        if (has_next) { nB = S.b_base(nxt); if constexpr (!Sched::GATHER) nA = Ab + S.a_unit_off(nxt); }
        const int nt = cur.nt;
#pragma unroll 1
        for (int t = 0; t < nt; t += 2) {
            const bool last = (t == nt - 2);
            if (last && has_next) S.a_ready(nxt);
            const char* a1 = cA + (size_t)(t + 1) * kstep;
            const char* a2 = last ? nA : cA + (size_t)(t + 2) * kstep; const char* b2 = last ? nB : cB + (size_t)(t + 2) * kstep;
            const char* a3 = a2 + kstep; const char* b3 = b2 + kstep;
            if constexpr (Sched::GATHER) {
                if (last && has_next) {
#pragma unroll
                    for (int i = 0; i < 2; ++i) { int R, C; stage_rc(tid * 16 + i * 8192, R, C); vF0[i] = S.a_off(nxt, R) + (unsigned)(C * 2); vF1[i] = S.a_off(nxt, HALF + R) + (unsigned)(C * 2); }
                }
            }
            PG8_LDB(B0, 0, 0); PG8_LDB(B1, 0, 1); PG8_SCHED; PG8_LDA(At, 0, 0); PG8_STAGE_A(PG8_SA(1, 1), a1, 1, vK);
            PG8_WAIT_V(8); PG8_WAIT_L(0); PG8_BAR; PG8_MMA(0, 0, At, B0); PG8_MMA(0, 1, At, B1); PG8_BAR; PG8_SCHED;
            PG8_LDA(At, 0, 1); PG8_STAGE_B(PG8_SB(0, 0), b2); PG8_STAGE_B(PG8_SB(0, 1), b2 + hstepB); PG8_STAGE_A(PG8_SA(0, 0), a2, 0, vF0);
            PG8_WAIT_V(8); PG8_WAIT_L(0); PG8_BAR; PG8_MMA(1, 0, At, B0); PG8_MMA(1, 1, At, B1); PG8_BAR; PG8_SCHED;
            PG8_LDB(B0, 1, 0); PG8_LDB(B1, 1, 1); PG8_SCHED; PG8_LDA(At, 1, 0); PG8_STAGE_A(PG8_SA(0, 1), a2, 1, vF1);
            PG8_WAIT_V(8); PG8_WAIT_L(0); PG8_BAR; PG8_MMA(0, 0, At, B0); PG8_MMA(0, 1, At, B1); PG8_BAR; PG8_SCHED;
            PG8_LDA(At, 1, 1); PG8_STAGE_B(PG8_SB(1, 0), b3); PG8_STAGE_B(PG8_SB(1, 1), b3 + hstepB); PG8_STAGE_A(PG8_SA(1, 0), a3, 0, vF0);
            PG8_WAIT_V(8); PG8_WAIT_L(0); PG8_BAR; PG8_MMA(1, 0, At, B0); PG8_MMA(1, 1, At, B1); PG8_BAR; PG8_SCHED;
        }
        if (wr == 0) PG8_BAR;
        bool keep = false;
        if constexpr (Epi::HAS_MID) { if (cur.sub == 0) { E.mid(acc, cur, wr, wc, fr, fq); keep = true; } else E(acc, cur, wr, wc, fr, fq); }
        else E(acc, cur, wr, wc, fr, fq);
        S.done(cur);
        if (!has_next) break;
        if (!keep) {
#pragma unroll
        for (int a = 0; a < 2; ++a)
#pragma unroll
            for (int b = 0; b < 2; ++b)
#pragma unroll
                for (int m = 0; m < 4; ++m)
#pragma unroll
                    for (int n = 0; n < 2; ++n) acc[a][b][m][n] = (f32x4){0.f, 0.f, 0.f, 0.f};
        }
        cur = nxt; cA = nA; cB = nB; ++ui;
        if constexpr (Sched::GATHER) { vK[0] = vF1[0]; vK[1] = vF1[1]; }
        if (wr == 1) PG8_BAR;
    }
    PG8_WAIT_V(0);
    PG8_BAR;
#undef PG8_SA
#undef PG8_SB
#undef PG8_GLDS
#undef PG8_STAGE_A
#undef PG8_STAGE_B
#undef PG8_LDA
#undef PG8_LDB
#undef PG8_MMA
#undef PG8_WAIT_V
#undef PG8_WAIT_L
#undef PG8_BAR
#undef PG8_SCHED
}
}
using pg8::Unit;

struct DenseSched {
    static constexpr bool GATHER = false;
    const char* A; const char* Bt; int K; int lda; int ldb; int wave; int ksplit; pg8::StaticOrder so;
    __device__ __forceinline__ bool next(int i, Unit& u) const {
        int pm, pn; const int ti = ksplit ? (i >> 1) : i; if (!so.next(ti, pm, pn)) return false;
        u.pm = pm; u.pn = pn; u.e = 0; u.nvalid = 256; u.slot0 = pm * 256; u.lpos0 = 0; u.waitk = 1;
        if (ksplit) { u.sub = i & 1; u.kofs = u.sub ? ksplit : 0; u.nt = (u.sub ? K - ksplit : ksplit) / 64; } else { u.sub = 1; u.kofs = 0; u.nt = K / 64; }
        return true; }
    __device__ __forceinline__ const char* a_base() const { return A; }
    __device__ __forceinline__ unsigned a_off(const Unit& u, int r) const { return 0u; }
    __device__ __forceinline__ size_t a_unit_off(const Unit& u) const { return ((size_t)u.pm * 256 * lda + u.kofs) * 2; }
    __device__ __forceinline__ const char* b_base(const Unit& u) const { return Bt + ((size_t)u.pn * 256 * ldb + u.kofs) * 2; }
    unsigned* waitp; unsigned need; unsigned* postp; unsigned* err;
    __device__ __forceinline__ void a_ready(const Unit& u) const {
        if (waitp) {
            if (wave == 0) {
                unsigned* p = waitp + u.pm * PAN_STRIDE; unsigned spins = 0;
                while ((unsigned)__builtin_amdgcn_readfirstlane(__hip_atomic_load(p, __ATOMIC_RELAXED, __HIP_MEMORY_SCOPE_AGENT)) < need) {
                    __builtin_amdgcn_s_sleep(2);
                    if (++spins > (1u << 22)) { __hip_atomic_store(err, 2u, __ATOMIC_RELAXED, __HIP_MEMORY_SCOPE_AGENT); break; }
                }
                __builtin_amdgcn_fence(__ATOMIC_ACQUIRE, "agent");
                asm volatile("s_waitcnt vmcnt(0)" ::: "memory");
            }
            asm volatile("" ::: "memory"); __builtin_amdgcn_s_barrier(); asm volatile("" ::: "memory");
        }
    }
    __device__ __forceinline__ void done(const Unit& u) const {
        if (postp && u.sub == 1) {
            asm volatile("s_waitcnt vmcnt(0)" ::: "memory");
            if (olane() == 0) __hip_atomic_fetch_add(postp + u.pm * PAN_STRIDE, 1u, __ATOMIC_RELAXED, __HIP_MEMORY_SCOPE_AGENT);
        }
    }
};
struct MoeTab { const volatile LAS int* cnt; const volatile LAS int* mtpref; const volatile LAS int* spref; const volatile LAS int* tile_e; };
template <bool GATHER_> struct MoeSched {
    static constexpr bool GATHER = GATHER_;
    const char* A; const char* Bt; int K; int lda; int ldb; int wave; int ntn; size_t bstride_e; const int* ltok; MoeTab T;
    int G1, c1, lo1, hi1, G2, c2, lo2, hi2; unsigned* upd; unsigned* err;
    __device__ __forceinline__ bool next(int i, Unit& u) const {
        int L;
        const int n1 = (c1 >= 0 && lo1 + c1 < hi1) ? (hi1 - lo1 - c1 + G1 - 1) / G1 : 0;
        if (i < n1) { L = lo1 + c1 + i * G1; u.waitk = (i == 0) ? 2 : 0; }
        else { L = lo2 + c2 + (i - n1) * G2; if (c2 < 0 || L >= hi2) return false; u.waitk = 1; }
        const int tix = L / ntn; u.pn = L - tix * ntn; u.pm = tix;
        const int e = T.tile_e[tix];
        const int mt = tix - T.mtpref[e]; u.e = e; u.slot0 = T.spref[e] + 256 * mt; const int rem = T.cnt[e] - 256 * mt; u.nvalid = rem < 256 ? rem : 256; u.lpos0 = e * MTOK + 256 * mt; u.nt = K / 64; u.kofs = 0; u.sub = 1; return true;
    }
    __device__ __forceinline__ const char* a_base() const { return A; }
    __device__ __forceinline__ unsigned a_off(const Unit& u, int r) const { const int rr = r < u.nvalid ? r : u.nvalid - 1; return (unsigned)ltok[u.lpos0 + rr] * (unsigned)(lda * 2); }
    __device__ __forceinline__ size_t a_unit_off(const Unit& u) const { return (size_t)u.slot0 * lda * 2; }
    __device__ __forceinline__ const char* b_base(const Unit& u) const { return Bt + (size_t)u.e * bstride_e + (size_t)u.pn * 256 * K * 2; }
    __device__ __forceinline__ void a_ready(const Unit& u) const {
        if constexpr (!GATHER_) {
            if (u.waitk == 0) return;
            if (wave == 0) {
                const int n1 = (c1 >= 0 && lo1 + c1 < hi1) ? (hi1 - lo1 - c1 + G1 - 1) / G1 : 0;
                const int nw = (u.waitk == 2) ? n1 : 1;
                unsigned spins = 0;
                for (int q = 0; q < nw; ++q) {
                    const int tix = (u.waitk == 2) ? (lo1 + c1 + q * G1) / ntn : u.pm;
                    unsigned* p = upd + tix * UPD_STRIDE;
                    while ((unsigned)__builtin_amdgcn_readfirstlane(__hip_atomic_load(p, __ATOMIC_RELAXED, __HIP_MEMORY_SCOPE_AGENT)) < 16u) {
                        __builtin_amdgcn_s_sleep(2);
                        if (++spins > (1u << 22)) { __hip_atomic_store(err, 1u, __ATOMIC_RELAXED, __HIP_MEMORY_SCOPE_AGENT); break; }
                    }
                }
                __builtin_amdgcn_fence(__ATOMIC_ACQUIRE, "agent");
                asm volatile("s_waitcnt vmcnt(0)" ::: "memory");
            }
            asm volatile("" ::: "memory"); __builtin_amdgcn_s_barrier(); asm volatile("" ::: "memory");
        }
    }
    __device__ __forceinline__ void done(const Unit& u) const {
        if constexpr (GATHER_) {
            asm volatile("s_waitcnt vmcnt(0)" ::: "memory");
            if (olane() == 0) __hip_atomic_fetch_add(upd + u.pm * UPD_STRIDE, 1u, __ATOMIC_RELAXED, __HIP_MEMORY_SCOPE_AGENT);
        }
    }
};

#define OPAQUE(p) asm volatile("" : "+v"(p))
struct EpiProj {
    static constexpr bool PERM = true, REPEAT = true, HAS_MID = false;
    bf16* Pq; bf16* Pg; const float* rs; const f32x4* rope;
    __device__ __forceinline__ static void rot(f32x4& c, const f32x4& st) {
        const f32x4 o = c;
        c[0] = o[0] * st[0] - o[1] * st[1]; c[1] = o[1] * st[0] + o[0] * st[1];
        c[2] = o[2] * st[2] - o[3] * st[3]; c[3] = o[3] * st[2] + o[2] * st[3];
    }
    __device__ __forceinline__ void operator()(const f32x4 (&acc)[2][2][4][2], const Unit& u, int wr, int wc, int fr, int fq) const {
        const int colh = wc * 32 + fq * 8;
        const int ib = (colh & 63) >> 2;
        const int row0 = u.pm * 256 + wr * 64 + fr;
        int mode[2]; bf16* ob[2]; size_t ostep[2];
#pragma unroll
        for (int bj = 0; bj < 2; ++bj) {
            const int h128 = 2 * u.pn + bj;
            if (h128 >= 24) mode[bj] = 3;
            else if (h128 < 6) mode[bj] = h128 < 4 ? 1 : (h128 == 4 ? 2 : 0);
            else { const int j = (h128 - 6) % 6; mode[bj] = j < 2 ? 1 : (j < 4 ? 2 : 0); }
            if (h128 < 24) { ob[bj] = Pq + (size_t)(2 * h128 + (colh >> 6)) * ((size_t)MTOK * 64) + (size_t)row0 * 64 + (colh & 63); ostep[bj] = (size_t)64 * 16; }
            else { ob[bj] = Pg + (((h128 - 24) * 128 + colh) >> 1) + (size_t)row0 * (NGATE / 2); ostep[bj] = (size_t)(NGATE / 2) * 16; }
        }
        float rsv[8];
#pragma unroll
        for (int i = 0; i < 8; ++i) rsv[i] = rs[row0 + (i >> 2) * 128 + (i & 3) * 16];
        const f32x4* rp = rope + (size_t)(row0 & (SEQ - 1)) * 16 + ib;
        f32x4 c0 = rp[0], c1 = rp[1];
        const f32x4 s16a = rope[16 * 16 + ib], s16b = rope[16 * 16 + ib + 1], s80a = rope[80 * 16 + ib], s80b = rope[80 * 16 + ib + 1];
#pragma unroll
        for (int ai = 0; ai < 2; ++ai)
#pragma unroll
            for (int m = 0; m < 4; ++m) {
                OPAQUE(ob[0]); OPAQUE(ob[1]);
                const float s = rsv[ai * 4 + m];
#pragma unroll
                for (int bj = 0; bj < 2; ++bj) {
                    f32x4 v0 = acc[ai][bj][m][0] * s, v1 = acc[ai][bj][m][1] * s;
                    if (mode[bj] == 1 || mode[bj] == 2) {
                        f32x4 o0, o1;
                        o0[0] = v0[0] * c0[0] - v0[1] * c0[1]; o0[1] = v0[1] * c0[0] + v0[0] * c0[1];
                        o0[2] = v0[2] * c0[2] - v0[3] * c0[3]; o0[3] = v0[3] * c0[2] + v0[2] * c0[3];
                        o1[0] = v1[0] * c1[0] - v1[1] * c1[1]; o1[1] = v1[1] * c1[0] + v1[0] * c1[1];
                        o1[2] = v1[2] * c1[2] - v1[3] * c1[3]; o1[3] = v1[3] * c1[2] + v1[2] * c1[3];
                        const float qs = (mode[bj] == 1) ? QSCALE : 1.0f;
                        v0 = o0 * qs; v1 = o1 * qs;
                    } else if (mode[bj] == 3) {
#pragma unroll
                        for (int j = 0; j < 4; ++j) { v0[j] = sigmoidf_fast(v0[j]); v1[j] = sigmoidf_fast(v1[j]); }
                    }
                    if (mode[bj] == 3) {
                        unsigned q[8];
#pragma unroll
                        for (int j = 0; j < 4; ++j) { q[j] = (unsigned)fminf(v0[j] * 256.0f, 255.0f); q[4 + j] = (unsigned)fminf(v1[j] * 256.0f, 255.0f); }
                        u32x2 w; w.x = q[0] | (q[1] << 8) | (q[2] << 16) | (q[3] << 24); w.y = q[4] | (q[5] << 8) | (q[6] << 16) | (q[7] << 24);
                        *(u32x2*)(ob[bj]) = w;
                    } else {
                        u32x4 w; w.x = cvtpk(v0[0], v0[1]); w.y = cvtpk(v0[2], v0[3]); w.z = cvtpk(v1[0], v1[1]); w.w = cvtpk(v1[2], v1[3]);
                        *(u32x4*)(ob[bj]) = w;
                    }
                }
                if (m == 3) { rot(c0, s80a); rot(c1, s80b); } else { rot(c0, s16a); rot(c1, s16b); }
                const int adv = (m == 3) ? 5 : 1;
                ob[0] += ostep[0] * adv; ob[1] += ostep[1] * adv;
            }
    }
};
struct EpiMerge {
    static constexpr bool PERM = true, REPEAT = false, HAS_MID = true;
    const unsigned char* gate; bf16* out;
    __device__ __forceinline__ static float dq(unsigned w, int k) { return ((float)((w >> (8 * k)) & 255u) + 0.5f) * (1.0f / 256.0f); }
    __device__ __forceinline__ void mid(f32x4 (&acc)[2][2][4][2], const Unit& u, int wr, int wc, int fr, int fq) const {
        const int row0 = u.pm * 256 + wr * 64 + fr, col0 = u.pn * 256 + wc * 32 + fq * 8;
        const unsigned char* gp = gate + (size_t)row0 * NGATE + col0;
        u32x2 ga[2][2], gb[2][2];
#define EM_LOAD(slot, i) do { const size_t ro = (size_t)(16 * (i) + 64 * ((i) >> 2)) * NGATE; ga[slot][0] = *(const u32x2*)(gp + ro); ga[slot][1] = *(const u32x2*)(gp + ro + 128); \
        gb[slot][0] = *(const u32x2*)(gp + ro + 1024); gb[slot][1] = *(const u32x2*)(gp + ro + 1024 + 128); } while (0)
        EM_LOAD(0, 0);
#pragma unroll
        for (int i = 0; i < 8; ++i) {
            const int ai = i >> 2, m = i & 3, sl = i & 1;
            if (i + 1 < 8) { if (sl == 0) EM_LOAD(1, i + 1); else EM_LOAD(0, i + 1); }
#pragma unroll
            for (int bj = 0; bj < 2; ++bj) {
                const u32x2 A = ga[sl][bj], B = gb[sl][bj];
#pragma unroll
                for (int j = 0; j < 4; ++j) {
                    acc[ai][bj][m][0][j] *= dq(B.x, j) * fast_rcp(dq(A.x, j));
                    acc[ai][bj][m][1][j] *= dq(B.y, j) * fast_rcp(dq(A.y, j));
                }
            }
        }
#undef EM_LOAD
    }
    __device__ __forceinline__ void operator()(const f32x4 (&acc)[2][2][4][2], const Unit& u, int wr, int wc, int fr, int fq) const {
        const int row0 = u.pm * 256 + wr * 64 + fr, col0 = u.pn * 256 + wc * 32 + fq * 8;
        const unsigned char* gp = gate + (size_t)row0 * NGATE + col0; bf16* op = out + (size_t)row0 * DM + col0;
        u32x2 ga[2][2];
#define EF_LOAD(slot, i) do { const size_t ro = (size_t)(16 * (i) + 64 * ((i) >> 2)) * NGATE; ga[slot][0] = *(const u32x2*)(gp + ro); ga[slot][1] = *(const u32x2*)(gp + ro + 128); } while (0)
        EF_LOAD(0, 0);
#pragma unroll
        for (int i = 0; i < 8; ++i) {
            const int ai = i >> 2, m = i & 3, sl = i & 1;
            if (i + 1 < 8) { if (sl == 0) EF_LOAD(1, i + 1); else EF_LOAD(0, i + 1); }
            bf16* orow = op + (size_t)(16 * i + 64 * (i >> 2)) * DM;
#pragma unroll
            for (int bj = 0; bj < 2; ++bj) {
                const u32x2 A = ga[sl][bj];
                const f32x4 a0 = acc[ai][bj][m][0], a1 = acc[ai][bj][m][1];
                u32x4 w;
                w.x = cvtpk(a0[0] * dq(A.x, 0), a0[1] * dq(A.x, 1)); w.y = cvtpk(a0[2] * dq(A.x, 2), a0[3] * dq(A.x, 3));
                w.z = cvtpk(a1[0] * dq(A.y, 0), a1[1] * dq(A.y, 1)); w.w = cvtpk(a1[2] * dq(A.y, 2), a1[3] * dq(A.y, 3));
                store16_sc1(orow + bj * 128, w);
            }
            asm volatile("" ::: "memory");
        }
#undef EF_LOAD
    }
};
struct EpiResid {
    static constexpr bool PERM = true, REPEAT = false, HAS_MID = false;
    bf16* xb;
    __device__ __forceinline__ void operator()(const f32x4 (&acc)[2][2][4][2], const Unit& u, int wr, int wc, int fr, int fq) const {
        const int row0 = u.pm * 256 + wr * 64 + fr, col0 = u.pn * 256 + wc * 32 + fq * 8;
        bf16* xp = xb + (size_t)row0 * DM + col0;
        u32x4 p[2][2];
#define ER_LOAD(slot, i) do { const size_t ro = (size_t)(16 * (i) + 64 * ((i) >> 2)); p[slot][0] = *(const u32x4*)(xp + ro * DM); p[slot][1] = *(const u32x4*)(xp + ro * DM + 128); } while (0)
        ER_LOAD(0, 0);
#pragma unroll
        for (int i = 0; i < 8; ++i) {
            const int ai = i >> 2, m = i & 3, sl = i & 1;
            if (i + 1 < 8) { if (sl == 0) ER_LOAD(1, i + 1); else ER_LOAD(0, i + 1); }
            bf16* orow = xp + (size_t)(16 * i + 64 * (i >> 2)) * DM;
#pragma unroll
            for (int bj = 0; bj < 2; ++bj) {
                const u32x4 q = p[sl][bj];
                const f32x4 a0 = acc[ai][bj][m][0], a1 = acc[ai][bj][m][1];
                u32x4 w;
                w.x = cvtpk(a0[0] + bflo(q.x), a0[1] + bfhi(q.x)); w.y = cvtpk(a0[2] + bflo(q.y), a0[3] + bfhi(q.y));
                w.z = cvtpk(a1[0] + bflo(q.z), a1[1] + bfhi(q.z)); w.w = cvtpk(a1[2] + bflo(q.w), a1[3] + bfhi(q.w));
                store16_sc1(orow + bj * 128, w);
            }
            asm volatile("" ::: "memory");
        }
#undef ER_LOAD
    }
};
struct EpiSwiglu {
    static constexpr bool PERM = true, REPEAT = false, HAS_MID = false;
    const int* ltok; const float* lw; const float* rs; bf16* H;
    __device__ __forceinline__ void operator()(const f32x4 (&acc)[2][2][4][2], const Unit& u, int wr, int wc, int fr, int fq) const {
        int tok[8]; float w8[8], s8[8];
#pragma unroll
        for (int i = 0; i < 8; ++i) { const int rr = (i >> 2) * 128 + wr * 64 + (i & 3) * 16 + fr; const int rc = rr < u.nvalid ? rr : u.nvalid - 1; tok[i] = ltok[u.lpos0 + rc]; w8[i] = lw[u.lpos0 + rc]; }
#pragma unroll
        for (int i = 0; i < 8; ++i) s8[i] = rs[tok[i]];
#pragma unroll
        for (int ai = 0; ai < 2; ++ai)
#pragma unroll
            for (int m = 0; m < 4; ++m) {
                const int rr = ai * 128 + wr * 64 + m * 16 + fr;
                if (rr < u.nvalid) {
                    const float w = w8[ai * 4 + m], s = s8[ai * 4 + m];
#pragma unroll
                    for (int bj = 0; bj < 2; ++bj) {
                        const f32x4 a0 = acc[ai][bj][m][0] * s, a1 = acc[ai][bj][m][1] * s;
                        const float h0 = a0[0] * sigmoidf_fast(a0[0]) * a0[1] * w, h1 = a0[2] * sigmoidf_fast(a0[2]) * a0[3] * w;
                        const float h2 = a1[0] * sigmoidf_fast(a1[0]) * a1[1] * w, h3 = a1[2] * sigmoidf_fast(a1[2]) * a1[3] * w;
                        u32x2 o; o.x = cvtpk(h0, h1); o.y = cvtpk(h2, h3);
                        __hip_atomic_store((unsigned long long*)(H + (size_t)(u.slot0 + rr) * DEXP + u.pn * 128 + bj * 64 + wc * 16 + fq * 4), (unsigned long long)o.x | ((unsigned long long)o.y << 32), __ATOMIC_RELAXED, __HIP_MEMORY_SCOPE_AGENT);
                    }
                }
            }
    }
};
struct EpiY {
    static constexpr bool PERM = true, REPEAT = false, HAS_MID = false;
    bf16* Y;
    __device__ __forceinline__ void operator()(const f32x4 (&acc)[2][2][4][2], const Unit& u, int wr, int wc, int fr, int fq) const {
#pragma unroll
        for (int ai = 0; ai < 2; ++ai)
#pragma unroll
            for (int m = 0; m < 4; ++m) {
                const int rr = ai * 128 + wr * 64 + m * 16 + fr;
                if (rr < u.nvalid) {
#pragma unroll
                    for (int bj = 0; bj < 2; ++bj) {
                        const f32x4 a0 = acc[ai][bj][m][0], a1 = acc[ai][bj][m][1];
                        u32x4 w; w.x = cvtpk(a0[0], a0[1]); w.y = cvtpk(a0[2], a0[3]); w.z = cvtpk(a1[0], a1[1]); w.w = cvtpk(a1[2], a1[3]);
                        *(u32x4*)(Y + (size_t)(u.slot0 + rr) * DM + u.pn * 256 + bj * 128 + wc * 32 + fq * 8) = w;
                    }
                }
            }
    }
};

#define XB_TMO      128
#define XB_XCNT(j)  (256  + 64 * (j))
#define XB_XSUB(j)  (1280 + 64 * (j))
#define XB_XGEN(j)  (2304 + 64 * (j))
#define XB_TOP      3328
#define XB_TOPGEN   3392
#define XCD_BAR_WORDS 3456
#define XB_SPIN_CAP (1u << 18)
__device__ __forceinline__ unsigned xb_ld(unsigned* p)              { return __hip_atomic_load(p, __ATOMIC_RELAXED, __HIP_MEMORY_SCOPE_AGENT); }
__device__ __forceinline__ unsigned xb_add(unsigned* p, unsigned v) { return __hip_atomic_fetch_add(p, v, __ATOMIC_RELAXED, __HIP_MEMORY_SCOPE_AGENT); }
__device__ __forceinline__ unsigned xb_xcc_id() { return (unsigned)__builtin_amdgcn_s_getreg((3 << 11) | 20) & 0xFu; }
#define XB_SPIN(cond, bar) do { unsigned _sp = 0; while (cond) { __builtin_amdgcn_s_sleep(1); \
    if ((++_sp & 255u) == 0u) { if (xb_ld(&(bar)[XB_TMO])) break; if (_sp > XB_SPIN_CAP) { atomicAdd(&(bar)[XB_TMO], 1u); break; } } } } while (0)
struct XcdBarrier { unsigned* bar; unsigned x; volatile LAS unsigned* st; };
__device__ __forceinline__ XcdBarrier xcd_barrier_post(unsigned* bar, volatile LAS unsigned* st) {
    XcdBarrier b; b.bar = bar; b.x = xb_xcc_id(); b.st = st;
    if (threadIdx.x == 0) (void)xb_add(&bar[XB_XCNT(b.x)], 1u);
    return b;
}
__device__ __forceinline__ void xcd_barrier_complete(unsigned* bar, unsigned x, unsigned& nloc, unsigned& nx) {
    const unsigned G = gridDim.x * gridDim.y * gridDim.z;
    unsigned sum, cnt, mine, sp = 0u;
    for (;;) {
        sum = 0u; cnt = 0u; mine = 0u;
#pragma unroll
        for (unsigned j = 0; j < 16; ++j) { const unsigned c = xb_ld(&bar[XB_XCNT(j)]); sum += c; cnt += (c > 0u) ? 1u : 0u; mine = (j == x) ? c : mine; }
        if (sum == G) break;
        __builtin_amdgcn_s_sleep(1);
        if ((++sp & 255u) == 0u) { if (xb_ld(&bar[XB_TMO])) break; if (sp > XB_SPIN_CAP) { atomicAdd(&bar[XB_TMO], 1u); break; } }
    }
    nloc = mine > 0u ? mine : 1u; nx = cnt > 0u ? cnt : 1u;
}
__device__ __forceinline__ void xcd_barrier(const XcdBarrier& b, int wave) {
    asm volatile("s_waitcnt vmcnt(0)" ::: "memory");
    __syncthreads();
    unsigned zb_ = 0u; asm volatile("" : "+v"(zb_));
    if (wave == 0 && __builtin_amdgcn_mbcnt_hi(~0u, __builtin_amdgcn_mbcnt_lo(~0u, zb_)) == 0u) {
        unsigned* bar = b.bar;
        __builtin_amdgcn_s_waitcnt(0);
        unsigned nloc = b.st[0], nx = b.st[1];
        if (nloc == 0u) { xcd_barrier_complete(bar, b.x, nloc, nx); b.st[0] = nloc; b.st[1] = nx; }
        const unsigned old = xb_add(&bar[XB_XSUB(b.x)], 1u);
        const unsigned gen = old / nloc;
        if (old + 1u == (gen + 1u) * nloc) {
            __builtin_amdgcn_fence(__ATOMIC_RELEASE, "agent");
            asm volatile("s_waitcnt vmcnt(0)" ::: "memory");
            const unsigned og = xb_add(&bar[XB_TOP], 1u);
            const unsigned tg = og / nx;
            if (og + 1u == (tg + 1u) * nx) xb_add(&bar[XB_TOPGEN], 1u);
            else XB_SPIN(xb_ld(&bar[XB_TOPGEN]) == tg, bar);
            __builtin_amdgcn_fence(__ATOMIC_ACQUIRE, "agent");
            xb_add(&bar[XB_XGEN(b.x)], 1u);
            asm volatile("s_waitcnt vmcnt(0)" ::: "memory");
        } else {
            XB_SPIN(xb_ld(&bar[XB_XGEN(b.x)]) == gen, bar);
            __builtin_amdgcn_fence(__ATOMIC_ACQUIRE, "agent");
            asm volatile("s_waitcnt vmcnt(0)" ::: "memory");
        }
    }
    __syncthreads();
}

struct Args {
    const float* x; const float* attn_g; const float* w_in; const float* a_sink; const float* w_a; const float* w_b; const float* w_out; const float* ffn_g;
    const float* w_rg; const float* b_rg; const float* w_re; const float* b_re; const float* w_eg; const float* w_eu; const float* w_ed; const float* fin_g;
    float* out; unsigned char* ws; int ph_lo, ph_hi;
};
typedef const __attribute__((address_space(4))) Args* CArgs;
struct Frame {
    LAS unsigned char* lds; volatile LAS int* misc;
    int wave, G, vcu, gw, ngw, bx;
};
__device__ __forceinline__ int otid() { unsigned z = 0u; asm volatile("" : "+v"(z)); return (int)__builtin_amdgcn_mbcnt_hi(~0u, __builtin_amdgcn_mbcnt_lo(~0u, z)); }
__device__ __forceinline__ float shx(float v, int o, int lane) { return __int_as_float(__builtin_amdgcn_ds_bpermute((lane ^ o) << 2, __float_as_int(v))); }
__device__ __forceinline__ float wave_sum(float v, int lane) {
#pragma unroll
    for (int o = 1; o < 64; o <<= 1) v += shx(v, o, lane);
    return v;
}

struct MapPlain { __device__ __forceinline__ int operator()(int n) const { return n; } };
struct MapWin { __device__ __forceinline__ int operator()(int n) const {
        bool rope = false;
        if (n < 640) rope = true; else if (n >= 768 && n < NQKV) rope = ((n - 768) % 768) < 512;
        if (!rope) return n; const int d = n & 63; return (n & ~63) + 2 * (d & 31) + (d >> 5); } };
struct MapGU { int t; __device__ __forceinline__ int operator()(int n) const { return 2 * n + t; } };
template <class Map> __device__ __forceinline__ void transpose_item64(const float* W, int ldn, int k0, int n0, const float* gk, bf16* WT, int Kd, const Map& map, LAS float* scr, int lane) {
    const int kq = lane >> 4, n4 = (lane & 15) * 4;
    const float* src = W + (size_t)(k0 + kq) * ldn + n0 + n4;
    f32x4 v[16];
#pragma unroll
    for (int i = 0; i < 16; ++i) v[i] = __builtin_nontemporal_load((const f32x4*)(src + (size_t)(4 * i) * ldn));
    if (gk) {
#pragma unroll
        for (int i = 0; i < 16; ++i) v[i] = v[i] * gk[k0 + 4 * i + kq];
    }
#pragma unroll
    for (int i = 0; i < 16; ++i) { LAS float* d = scr + (4 * i + kq) * 65 + n4; d[0] = v[i][0]; d[1] = v[i][1]; d[2] = v[i][2]; d[3] = v[i][3]; }
    LDS_WAIT(); asm volatile("" ::: "memory");
    const int c = lane & 7;
#pragma unroll
    for (int j = 0; j < 8; ++j) { const int n = (lane >> 3) + 8 * j; const LAS float* p = scr + (8 * c) * 65 + n;
        u32x4 o; o.x = cvtpk(p[0 * 65], p[1 * 65]); o.y = cvtpk(p[2 * 65], p[3 * 65]); o.z = cvtpk(p[4 * 65], p[5 * 65]); o.w = cvtpk(p[6 * 65], p[7 * 65]);
        *(u32x4*)(WT + (size_t)map(n0 + n) * Kd + k0 + 8 * c) = o; }
    LDS_WAIT(); asm volatile("" ::: "memory");
}
__device__ __forceinline__ void prep_phase(const Frame& F, CArgs a) {
    const int lane = otid(), tid = F.wave * 64 + lane; (void)tid; (void)lane;
    unsigned char* ws = a->ws;
    LAS float* scr = (LAS float*)(F.lds + F.wave * PREP_SCR);
    constexpr int I_IN = 16 * 80, I_A = 8 * 16, I_B = 4 * 16, I_O = 16 * 16, I_L = I_IN + I_A + I_B + I_O;
    for (int it = F.gw; it < DEPTH * I_L; it += F.ngw) {
        const int l = it / I_L; int r = it - l * I_L;
        unsigned char* wl = ws + (size_t)l * WNE_LSTRIDE;
        if (r < I_IN) { transpose_item64(a->w_in + (size_t)l * DM * DIN, DIN, 64 * (r / 80), 64 * (r % 80), a->attn_g + l * DM, (bf16*)(wl + WS_WIN), DM, MapWin{}, scr, lane); continue; } r -= I_IN;
        if (r < I_A) { transpose_item64(a->w_a + (size_t)l * 512 * DM, DM, 64 * (r / 16), 64 * (r % 16), nullptr, (bf16*)(wl + WS_WAB) + 256, 768, MapPlain{}, scr, lane); continue; } r -= I_A;
        if (r < I_B) { transpose_item64(a->w_b + (size_t)l * 256 * DM, DM, 64 * (r / 16), 64 * (r % 16), nullptr, (bf16*)(wl + WS_WAB), 768, MapPlain{}, scr, lane); continue; } r -= I_B;
        transpose_item64(a->w_out + (size_t)l * DM * DM, DM, 64 * (r / 16), 64 * (r % 16), nullptr, (bf16*)(wl + WS_WOUT), DM, MapPlain{}, scr, lane);
    }
    for (int idx = F.bx * NTHREADS + tid; idx < DEPTH * 32 * 3 * 64 * 8; idx += F.G * NTHREADS) {
        const int l = idx / (32 * 3 * 64 * 8), id = idx - l * (32 * 3 * 64 * 8);
        const int j = id & 7, ln = (id >> 3) & 63, q = id >> 9, nt = q % 3, i = q / 3;
        const int k = 32 * i + 8 * (ln >> 4) + j, n = 16 * nt + (ln & 15);
        const float* wg = a->w_rg + (size_t)l * DM * 4; const float* we = a->w_re + (size_t)l * DM * NEXP;
        float v = 0.f; if (n < 4) v = wg[k * 4 + n]; else if (n < 36) v = we[k * NEXP + (n - 4)];
        v *= a->ffn_g[l * DM + k];
        const unsigned hb = cvtpk(v, 0.f) & 0xffffu; const float hf = __uint_as_float(hb << 16);
        const unsigned lb = cvtpk(v - hf, 0.f) & 0xffffu;
        ((bf16*)(ws + WS_WR + l * WR_LSTRIDE))[id] = (bf16)hb; ((bf16*)(ws + WS_WR + l * WR_LSTRIDE + WR_LO))[id] = (bf16)lb;
    }
    {
        float* rt = (float*)(ws + WS_ROPE);
        for (int idx = F.bx * NTHREADS + tid; idx < SEQ * 32; idx += F.G * NTHREADS) {
            const int pos = idx >> 5, i = idx & 31;
            const float inv = 1.0f / powf(10000.0f, (float)(2 * i) / 64.0f);
            const float ang = (float)pos * inv;
            const double ad = (double)ang, kd = __builtin_rint(ad * 0.15915494309189535);
            const float rf = (float)__builtin_fma(-kd, 6.283185307179586, ad);
            rt[idx * 2] = cosf(rf); rt[idx * 2 + 1] = sinf(rf);
        }
        bf16* xb = (bf16*)(ws + WS_XB); float* rs1 = (float*)(ws + WS_RS1);
        for (int m = F.gw; m < MTOK; m += F.ngw) {
            const f32x4* xr = (const f32x4*)(a->x + (size_t)m * DM) + lane;
            f32x4 v[4]; float s = 0.f;
#pragma unroll
            for (int j = 0; j < 4; ++j) { v[j] = __builtin_nontemporal_load(xr + 64 * j); s += (v[j][0] * v[j][0] + v[j][1] * v[j][1]) + (v[j][2] * v[j][2] + v[j][3] * v[j][3]); }
            s = wave_sum(s, lane);
            u32x2* o = (u32x2*)(xb + (size_t)m * DM) + lane;
#pragma unroll
            for (int j = 0; j < 4; ++j) { u32x2 w; w.x = cvtpk(v[j][0], v[j][1]); w.y = cvtpk(v[j][2], v[j][3]); o[64 * j] = w; }
            if (lane == 0) rs1[m] = 1.0f / sqrtf(s * (1.0f / DM) + NORM_EPS);
        }
    }
}
__device__ __forceinline__ void prep_experts(const Frame& F, CArgs a, int l, int lane, int part, int w, int nw) {
    unsigned char* ws = a->ws;
    LAS float* scr = (LAS float*)(F.lds + F.wave * PREP_SCR);
    constexpr int I_G = 16 * 4, I_D = 4 * 16;
    const float* fg = a->ffn_g + l * DM;
    if (part == 0) {
        for (int it = w; it < NEXP * 2 * I_G; it += nw) {
            const int e = it / (2 * I_G); int r = it - e * (2 * I_G); const int t = r / I_G; r -= t * I_G;
            const size_t eo = ((size_t)l * NEXP + e) * DM * DEXP; const float* W = (t ? a->w_eu : a->w_eg) + eo;
            transpose_item64(W, DEXP, 64 * (r / 4), 64 * (r % 4), fg, (bf16*)(ws + WS_WGU) + (size_t)e * 512 * DM, DM, MapGU{t}, scr, lane);
        }
    } else {
        for (int it = w; it < NEXP * I_D; it += nw) {
            const int e = it / I_D, r = it - e * I_D;
            const size_t eo = ((size_t)l * NEXP + e) * DM * DEXP;
            transpose_item64(a->w_ed + eo, DM, 64 * (r / 16), 64 * (r % 16), nullptr, (bf16*)(ws + WS_WD) + (size_t)e * DM * DEXP, DEXP, MapPlain{}, scr, lane);
        }
    }
}

__device__ __forceinline__ int crow(int r, int hi) { return (r & 3) + 8 * (r >> 2) + 4 * hi; }
struct AttnUnit { int kcol, vcol, b, d, r, t0, span, W, qcol, tq; float m0, l0; bf16* outp; int opitch; float* lsep; bool valid; };
__device__ __forceinline__ AttnUnit attn_decode(int idx, int G, int bx, int wave, int l, CArgs a, bf16* ya, bf16* ob, float* lse) {
    AttnUnit U; U.valid = false;
    const int nA = (BATCH * 2 * 64 - bx + G - 1) / G;
    if (idx < nA) {
        const int u = bx + idx * G; const int qb = u & 63, kvh = (u >> 6) & 1, b = u >> 7; const int g = wave >> 1, hq = kvh * 4 + g;
        U.kcol = 512 + kvh * 64; U.vcol = 640 + kvh * 64; U.b = b; U.d = 1; U.r = 0; U.t0 = 2 * qb; U.span = 2; U.W = 4; U.qcol = hq * 64; U.tq = 2 * qb + (wave & 1);
        U.m0 = a->a_sink[l * 8 + hq] * LOG2E; U.l0 = 1.0f; U.outp = ya + hq * 64; U.opitch = 768; U.lsep = nullptr; U.valid = true; return U;
    }
    const int u = bx + (idx - nA) * G;
    if (u < 3 * 256) {
        const int grp = u >> 8; int q = u & 255;
        const int d = grp == 0 ? 1 : (grp == 1 ? 4 : 16), bpr = 16 / d;
        const int blk = q % bpr; q /= bpr; const int res = q % d; q /= d; const int h = q & 3, b = q >> 2;
        const int base = 768 + 768 * grp;
        U.kcol = base + 256 + h * 64; U.vcol = base + 512 + h * 64; U.b = b; U.d = d; U.r = res; U.t0 = 8 * blk; U.span = 8; U.W = 2; U.qcol = base + h * 64; U.tq = 8 * blk + wave;
        U.m0 = -1e30f; U.l0 = 0.0f; U.outp = ob + grp * 256 + h * 64; U.opitch = 768; U.lsep = lse + grp * 4 + h; U.valid = true;
    }
    return U;
}
__device__ __forceinline__ void attn_fetch(const bf16* P, const AttnUnit& U, int tid, u32x4 (&buf)[12]) {
    const int L32 = (SEQ / U.d) >> 5, jbase = U.t0 - U.W, ntile = U.span + 2 * U.W, nch = ntile * 512;
    const size_t tok0 = (size_t)U.b * SEQ + U.r;
#pragma unroll
    for (int i = 0; i < 12; ++i) {
        const int c = tid + 512 * i;
        if (c < nch) {
            const int kv = c >= ntile * 256, cc = kv ? c - ntile * 256 : c, row = cc >> 3, ch = cc & 7, tile = row >> 5, rr = row & 31, j = jbase + tile;
            if (j >= 0 && j < L32) buf[i] = __builtin_nontemporal_load((const u32x4*)(P + (size_t)((kv ? U.vcol : U.kcol) >> 6) * ((size_t)MTOK * 64) + (tok0 + (size_t)(32 * j + rr) * U.d) * 64 + ch * 8));
        }
    }
}
__device__ __forceinline__ void attn_stage(const AttnUnit& U, int tid, const u32x4 (&buf)[12], LAS unsigned char* lds) {
    const int L32 = (SEQ / U.d) >> 5, jbase = U.t0 - U.W, ntile = U.span + 2 * U.W, nch = ntile * 512;
    LAS unsigned char* kimg = lds; LAS unsigned char* vimg = lds + ntile * 4096;
#pragma unroll
    for (int i = 0; i < 12; ++i) {
        const int c = tid + 512 * i;
        if (c < nch) {
            const int kv = c >= ntile * 256, cc = kv ? c - ntile * 256 : c, row = cc >> 3, ch = cc & 7, tile = row >> 5, rr = row & 31, j = jbase + tile;
            if (j >= 0 && j < L32) *(LAS u32x4*)((kv ? vimg : kimg) + tile * 4096 + rr * 128 + (kv ? ch : (ch ^ (rr & 7))) * 16) = buf[i];
        }
    }
}
template <int NT> __device__ __forceinline__ void attn_step(int j, int jbase, int tq, int W, const LAS unsigned char* kimg, const LAS unsigned char* vimg, int krd, int vrd, int r32, int hi,
                                                          const bf16x8 (&qf)[4], f32x16& o0, f32x16& o1, float& mrun, float& lrun) {
#define VTR(p, off) __builtin_bit_cast(s16x4, __builtin_amdgcn_ds_read_tr16_b64_v4i16((LAS s16x4*)((p) + (off))))
    bf16x8 kf[NT][4]; s16x4 va[NT][4], vb[NT][4];
#pragma unroll
    for (int t = 0; t < NT; ++t) {
        const LAS unsigned char* kl = kimg + (j + t - jbase) * 4096 + krd;
#pragma unroll
        for (int s = 0; s < 4; ++s) kf[t][s] = *(const LAS bf16x8*)(kl + (((2 * s + hi) ^ (r32 & 7)) * 16));
    }
#pragma unroll
    for (int t = 0; t < NT; ++t) {
        const LAS unsigned char* vl = vimg + (j + t - jbase) * 4096 + vrd;
#pragma unroll
        for (int q = 0; q < 4; ++q) { va[t][q] = VTR(vl, (16 * (q & 1)) * 128 + (q >> 1) * 64); vb[t][q] = VTR(vl, (16 * (q & 1) + 8) * 128 + (q >> 1) * 64); }
    }
    __builtin_amdgcn_sched_barrier(0);
    f32x16 sc[NT];
#pragma unroll
    for (int t = 0; t < NT; ++t) sc[t] = f32x16{};
#pragma unroll
    for (int s = 0; s < 4; ++s)
#pragma unroll
        for (int t = 0; t < NT; ++t) sc[t] = __builtin_amdgcn_mfma_f32_32x32x16_bf16(kf[t][s], qf[s], sc[t], 0, 0, 0);
#pragma unroll
    for (int t = 0; t < NT; ++t) {
        if (j + t == tq - W) {
#pragma unroll
            for (int g = 0; g < 16; ++g) if (crow(g, hi) < r32) sc[t][g] = -INFINITY;
        }
        if (j + t == tq + W) {
#pragma unroll
            for (int g = 0; g < 16; ++g) if (crow(g, hi) > r32) sc[t][g] = -INFINITY;
        }
    }
    float mx = -INFINITY;
#pragma unroll
    for (int t = 0; t < NT; ++t)
#pragma unroll
        for (int g = 0; g < 16; g += 4) mx = fmaxf(mx, fmaxf(fmaxf(sc[t][g], sc[t][g + 1]), fmaxf(sc[t][g + 2], sc[t][g + 3])));
    { const auto rr = __builtin_amdgcn_permlane32_swap(__float_as_uint(mx), __float_as_uint(mx), false, false); mx = fmaxf(__uint_as_float(rr[0]), __uint_as_float(rr[1])); }
    if (__any(mx > mrun + 8.0f)) {
        const float mnew = fmaxf(mrun, mx);
        const float alpha = fast_exp2(mrun - mnew);
        lrun *= alpha; mrun = mnew;
#pragma unroll
        for (int g = 0; g < 16; ++g) { o0[g] *= alpha; o1[g] *= alpha; }
    }
    float ps[4] = {0.f, 0.f, 0.f, 0.f};
#pragma unroll
    for (int t = 0; t < NT; ++t)
#pragma unroll
        for (int g = 0; g < 16; ++g) { sc[t][g] = fast_exp2(sc[t][g] - mrun); ps[g & 3] += sc[t][g]; }
    float psum = (ps[0] + ps[1]) + (ps[2] + ps[3]);
    { const auto rr = __builtin_amdgcn_permlane32_swap(__float_as_uint(psum), __float_as_uint(psum), false, false); psum = __uint_as_float(rr[0]) + __uint_as_float(rr[1]); }
    lrun += psum;
#define VFR(t, q) ((bf16x8){va[t][q][0], va[t][q][1], va[t][q][2], va[t][q][3], vb[t][q][0], vb[t][q][1], vb[t][q][2], vb[t][q][3]})
#pragma unroll
    for (int t = 0; t < NT; ++t) {
        u32x4 p0, p1;
        p0.x = cvtpk(sc[t][0], sc[t][1]); p0.y = cvtpk(sc[t][2], sc[t][3]); p0.z = cvtpk(sc[t][4], sc[t][5]); p0.w = cvtpk(sc[t][6], sc[t][7]);
        p1.x = cvtpk(sc[t][8], sc[t][9]); p1.y = cvtpk(sc[t][10], sc[t][11]); p1.z = cvtpk(sc[t][12], sc[t][13]); p1.w = cvtpk(sc[t][14], sc[t][15]);
        const bf16x8 pf0 = __builtin_bit_cast(bf16x8, p0), pf1 = __builtin_bit_cast(bf16x8, p1);
        o0 = __builtin_amdgcn_mfma_f32_32x32x16_bf16(VFR(t, 0), pf0, o0, 0, 0, 0);
        o1 = __builtin_amdgcn_mfma_f32_32x32x16_bf16(VFR(t, 2), pf0, o1, 0, 0, 0);
        o0 = __builtin_amdgcn_mfma_f32_32x32x16_bf16(VFR(t, 1), pf1, o0, 0, 0, 0);
        o1 = __builtin_amdgcn_mfma_f32_32x32x16_bf16(VFR(t, 3), pf1, o1, 0, 0, 0);
    }
#undef VFR
#undef VTR
}
__device__ __forceinline__ void attn_compute(const bf16* P, const AttnUnit& U, const bf16x8 (&qf)[4], LAS unsigned char* lds, LAS unsigned char* stg, int lane) {
    const int r32 = lane & 31, hi = lane >> 5;
    const int d = U.d, W = U.W, tq = U.tq;
    const int L32 = (SEQ / d) >> 5;
    const size_t tok0 = (size_t)U.b * SEQ + U.r;
    const int jbase = U.t0 - W, ntile = U.span + 2 * W;
    LAS unsigned char* kimg = lds; LAS unsigned char* vimg = lds + ntile * 4096;
    const size_t qtok = tok0 + (size_t)(32 * tq + r32) * d;
    f32x16 o0 = {}, o1 = {};
    float mrun = U.m0, lrun = U.l0;
    const int jlo = (tq - W) < 0 ? 0 : (tq - W), jhi = (tq + W) > (L32 - 1) ? (L32 - 1) : (tq + W);
    const int vrd = (4 * hi + ((lane & 15) >> 2)) * 128 + (16 * ((lane >> 4) & 1) + 4 * (lane & 3)) * 2;
    const int krd = r32 * 128;
    int j = jlo;
    for (; j + 1 <= jhi; j += 2) attn_step<2>(j, jbase, tq, W, kimg, vimg, krd, vrd, r32, hi, qf, o0, o1, mrun, lrun);
    if (j <= jhi) attn_step<1>(j, jbase, tq, W, kimg, vimg, krd, vrd, r32, hi, qf, o0, o1, mrun, lrun);
    const float inv = 1.0f / lrun;
#pragma unroll
    for (int g4 = 0; g4 < 4; ++g4) {
        u32x2 w0, w1;
        w0.x = cvtpk(o0[4 * g4] * inv, o0[4 * g4 + 1] * inv); w0.y = cvtpk(o0[4 * g4 + 2] * inv, o0[4 * g4 + 3] * inv);
        w1.x = cvtpk(o1[4 * g4] * inv, o1[4 * g4 + 1] * inv); w1.y = cvtpk(o1[4 * g4 + 2] * inv, o1[4 * g4 + 3] * inv);
        *(LAS u32x2*)(stg + r32 * 144 + (8 * g4 + 4 * hi) * 2) = w0;
        *(LAS u32x2*)(stg + r32 * 144 + 64 + (8 * g4 + 4 * hi) * 2) = w1;
    }
#pragma unroll
    for (int i = 0; i < 4; ++i) {
        const int row = i * 8 + (lane >> 3), ch = lane & 7;
        const u32x4 v = *(const LAS u32x4*)(stg + row * 144 + ch * 16);
        *(u32x4*)(U.outp + (tok0 + (size_t)(32 * tq + row) * d) * U.opitch + ch * 8) = v;
    }
    if (U.lsep && hi == 0) U.lsep[qtok * 12] = (mrun + log2f(lrun)) * LN2;
}
__device__ __forceinline__ void attn_phase(const Frame& F, CArgs a, int l) {
    const int lane = otid(), tid = F.wave * 64 + lane; (void)tid; (void)lane;
    unsigned char* ws = a->ws;
    const bf16* P = (const bf16*)(ws + WS_PQ);
    bf16* ya = (bf16*)(ws + WS_YAB) + 256; bf16* ob = (bf16*)a->out; float* lse = (float*)(ws + WS_LSE);
    const int r32 = lane & 31, hi = lane >> 5;
    u32x4 buf[12];
    LAS unsigned char* stg = F.lds + 98304 + F.wave * 4608;
    AttnUnit U = attn_decode(0, F.G, F.bx, F.wave, l, a, ya, ob, lse);
    if (U.valid) attn_fetch(P, U, tid, buf);
    for (int idx = 0; U.valid; ++idx) {
        attn_stage(U, tid, buf, F.lds);
        u32x4 qv[4];
#pragma unroll
        for (int i = 0; i < 4; ++i) { const int row = i * 8 + (lane >> 3), ch = lane & 7;
            qv[i] = __builtin_nontemporal_load((const u32x4*)(P + (size_t)(U.qcol >> 6) * ((size_t)MTOK * 64) + ((size_t)U.b * SEQ + U.r + (size_t)(32 * U.tq + row) * U.d) * 64 + ch * 8)); }
        const AttnUnit Un = attn_decode(idx + 1, F.G, F.bx, F.wave, l, a, ya, ob, lse);
#pragma unroll
        for (int i = 0; i < 4; ++i) { const int row = i * 8 + (lane >> 3), ch = lane & 7; *(LAS u32x4*)(stg + row * 144 + ch * 16) = qv[i]; }
        bf16x8 qf[4];
#pragma unroll
        for (int s = 0; s < 4; ++s) qf[s] = *(const LAS bf16x8*)(stg + r32 * 144 + (2 * s + hi) * 16);
        __syncthreads();
        if (Un.valid) attn_fetch(P, Un, tid, buf);
        attn_compute(P, U, qf, F.lds, stg, lane);
        __syncthreads();
        U = Un;
    }
    prep_experts(F, a, l, lane, 0, F.gw, F.ngw);
    prep_experts(F, a, l, lane, 1, F.gw, F.ngw);
}
__device__ __forceinline__ void comb_rows(const Frame& F, CArgs a, int row0, int tid) {
    unsigned char* ws = a->ws;
    const bf16* ob = (const bf16*)a->out; const float* lse = (const float*)(ws + WS_LSE); bf16* yb = (bf16*)(ws + WS_YAB);
#pragma unroll 4
    for (int it = 0; it < 16; ++it) {
        const int idx = tid + it * NTHREADS;
        const int tok = row0 + (idx >> 5), c = idx & 31, h = c >> 3;
        const float l0 = lse[tok * 12 + h], l1 = lse[tok * 12 + 4 + h], l2 = lse[tok * 12 + 8 + h];
        const u32x4 a0 = *(const u32x4*)(ob + (size_t)tok * 768 + c * 8), a1 = *(const u32x4*)(ob + (size_t)tok * 768 + 256 + c * 8), a2 = *(const u32x4*)(ob + (size_t)tok * 768 + 512 + c * 8);
        const float mx = fmaxf(l0, fmaxf(l1, l2));
        float w0 = __expf(l0 - mx), w1 = __expf(l1 - mx), w2 = __expf(l2 - mx);
        const float inv = 1.0f / (w0 + w1 + w2); w0 *= inv; w1 *= inv; w2 *= inv;
        u32x4 o;
#define CMB(f) o.f = cvtpk(w0 * bflo(a0.f) + w1 * bflo(a1.f) + w2 * bflo(a2.f), w0 * bfhi(a0.f) + w1 * bfhi(a1.f) + w2 * bfhi(a2.f))
        CMB(x); CMB(y); CMB(z); CMB(w);
#undef CMB
        *(u32x4*)(yb + (size_t)tok * 768 + c * 8) = o;
    }
}

__device__ __forceinline__ void route_phase(const Frame& F, CArgs a, int l, unsigned* waitp) {
    const int lane = otid(), tid = F.wave * 64 + lane;
    unsigned char* ws = a->ws;
    const bf16* xbf = (const bf16*)(ws + WS_XB); const u32x4* wrh = (const u32x4*)(ws + WS_WR + l * WR_LSTRIDE); const u32x4* wrl = (const u32x4*)(ws + WS_WR + l * WR_LSTRIDE + WR_LO);
    float* rs2 = (float*)(ws + WS_RS2); i32x4* tokinfo = (i32x4*)(ws + WS_TOKINFO); int* ltok = (int*)(ws + WS_LTOK); float* lw = (float*)(ws + WS_LW);
    int* cnt = (int*)(ws + WS_CTL) + CW_CNT + l * 32 * CNT_STRIDE;
    const float* brg = a->b_rg + l * 4; const float* bre = a->b_re + l * NEXP;
    LAS f32x4* part = (LAS f32x4*)(F.lds);
    LAS float* ssp = (LAS float*)(F.lds + 12288);
    LAS float* Lg = (LAS float*)(F.lds + 16384);
    LAS float* rsL = (LAS float*)(F.lds + 16384 + 12288);
    LAS int* lcnt = (LAS int*)(F.lds + 16384 + 12288 + 256);
    LAS int* lbase = lcnt + 32;
    const int rt = F.wave & 3, kh = F.wave >> 2;
    if (tid < 32) lcnt[tid] = 0;
    __syncthreads();
    for (int blk = F.bx; blk < MTOK / 64; blk += F.G) {
        if (waitp) {
            if (F.wave == 0) {
                unsigned* p = waitp + (blk >> 2) * PAN_STRIDE; unsigned spins = 0;
                while ((unsigned)__builtin_amdgcn_readfirstlane(__hip_atomic_load(p, __ATOMIC_RELAXED, __HIP_MEMORY_SCOPE_AGENT)) < 32u) {
                    __builtin_amdgcn_s_sleep(2);
                    if (++spins > (1u << 22)) { __hip_atomic_store((unsigned*)(ws + WS_CTL) + CW_ERR, 3u, __ATOMIC_RELAXED, __HIP_MEMORY_SCOPE_AGENT); break; }
                }
                __builtin_amdgcn_fence(__ATOMIC_ACQUIRE, "agent");
                asm volatile("s_waitcnt vmcnt(0)" ::: "memory");
            }
            __syncthreads();
        }
        const int row0 = blk * 64 + rt * 16;
        const u32x4* xr = (const u32x4*)(xbf + (size_t)(row0 + (lane & 15)) * DM + kh * 512) + (lane >> 4);
        const u32x4* wh = wrh + (size_t)(kh * 16) * 3 * 64 + lane; const u32x4* wl = wrl + (size_t)(kh * 16) * 3 * 64 + lane;
        f32x4 acc0 = {0.f, 0.f, 0.f, 0.f}, acc1 = acc0, acc2 = acc0; float ss = 0.f;
#pragma unroll 4
        for (int i = 0; i < 16; ++i) {
            const u32x4 xw = xr[4 * i];
            const u32x4 h0 = wh[(i * 3 + 0) * 64], h1 = wh[(i * 3 + 1) * 64], h2 = wh[(i * 3 + 2) * 64], l0 = wl[(i * 3 + 0) * 64], l1 = wl[(i * 3 + 1) * 64], l2 = wl[(i * 3 + 2) * 64];
            const float xv[8] = {bflo(xw.x), bfhi(xw.x), bflo(xw.y), bfhi(xw.y), bflo(xw.z), bfhi(xw.z), bflo(xw.w), bfhi(xw.w)};
#pragma unroll
            for (int j = 0; j < 8; ++j) ss += xv[j] * xv[j];
            const bf16x8 xf = __builtin_bit_cast(bf16x8, xw);
            acc0 = __builtin_amdgcn_mfma_f32_16x16x32_bf16(xf, __builtin_bit_cast(bf16x8, l0), acc0, 0, 0, 0);
            acc1 = __builtin_amdgcn_mfma_f32_16x16x32_bf16(xf, __builtin_bit_cast(bf16x8, l1), acc1, 0, 0, 0);
            acc2 = __builtin_amdgcn_mfma_f32_16x16x32_bf16(xf, __builtin_bit_cast(bf16x8, l2), acc2, 0, 0, 0);
            acc0 = __builtin_amdgcn_mfma_f32_16x16x32_bf16(xf, __builtin_bit_cast(bf16x8, h0), acc0, 0, 0, 0);
            acc1 = __builtin_amdgcn_mfma_f32_16x16x32_bf16(xf, __builtin_bit_cast(bf16x8, h1), acc1, 0, 0, 0);
            acc2 = __builtin_amdgcn_mfma_f32_16x16x32_bf16(xf, __builtin_bit_cast(bf16x8, h2), acc2, 0, 0, 0);
        }
        ss += shx(ss, 16, lane); ss += shx(ss, 32, lane);
        if (kh == 1) { part[(rt * 3 + 0) * 64 + lane] = acc0; part[(rt * 3 + 1) * 64 + lane] = acc1; part[(rt * 3 + 2) * 64 + lane] = acc2; if (lane < 16) ssp[rt * 16 + lane] = ss; }
        __syncthreads();
        if (kh == 0) {
            acc0 += part[(rt * 3 + 0) * 64 + lane]; acc1 += part[(rt * 3 + 1) * 64 + lane]; acc2 += part[(rt * 3 + 2) * 64 + lane];
            ss += ssp[rt * 16 + (lane & 15)];
#pragma unroll
            for (int g = 0; g < 4; ++g) { const int rw = rt * 16 + 4 * (lane >> 4) + g; Lg[rw * 48 + (lane & 15)] = acc0[g]; Lg[rw * 48 + 16 + (lane & 15)] = acc1[g]; Lg[rw * 48 + 32 + (lane & 15)] = acc2[g]; }
            if (lane < 16) rsL[rt * 16 + lane] = 1.0f / sqrtf(ss * (1.0f / DM) + NORM_EPS);
        }
        __syncthreads();
        int e1 = 0, e2 = 0, r1 = 0, r2 = 0; float w1 = 0.f, w2 = 0.f, rsv = 0.f;
        if (tid < 64) {
            const LAS float* Lr = Lg + tid * 48; rsv = rsL[tid];
            float gl[4];
#pragma unroll
            for (int g = 0; g < 4; ++g) gl[g] = Lr[g] * rsv + brg[g];
            int gi = 0; float gm = gl[0];
#pragma unroll
            for (int g = 1; g < 4; ++g) if (gl[g] > gm) { gm = gl[g]; gi = g; }
            float den = 0.f;
#pragma unroll
            for (int g = 0; g < 4; ++g) den += expf(gl[g] - gm);
            const float gw = 1.0f / den;
            float v1 = -INFINITY, v2 = -INFINITY; int i1 = 0, i2 = 0;
#pragma unroll
            for (int e = 0; e < 8; ++e) {
                const float v = Lr[4 + 8 * gi + e] * rsv + bre[8 * gi + e];
                if (v > v1) { v2 = v1; i2 = i1; v1 = v; i1 = e; } else if (v > v2) { v2 = v; i2 = e; }
            }
            const float p1 = 1.0f / (1.0f + expf(v2 - v1));
            e1 = 8 * gi + i1; e2 = 8 * gi + i2; w1 = p1 * gw; w2 = (1.0f - p1) * gw;
            r1 = __hip_atomic_fetch_add(&lcnt[e1], 1, __ATOMIC_RELAXED, __HIP_MEMORY_SCOPE_WORKGROUP); r2 = __hip_atomic_fetch_add(&lcnt[e2], 1, __ATOMIC_RELAXED, __HIP_MEMORY_SCOPE_WORKGROUP);
        }
        __syncthreads();
        if (tid < 32) { const int c = lcnt[tid]; lbase[tid] = c ? atomicAdd(&cnt[tid * CNT_STRIDE], c) : 0; lcnt[tid] = 0; }
        __syncthreads();
        if (tid < 64) {
            const int tok = blk * 64 + tid;
            const int pos1 = lbase[e1] + r1, pos2 = lbase[e2] + r2;
            ltok[e1 * MTOK + pos1] = tok; lw[e1 * MTOK + pos1] = w1;
            ltok[e2 * MTOK + pos2] = tok; lw[e2 * MTOK + pos2] = w2;
            tokinfo[tok] = (i32x4){e1, pos1, e2, pos2};
            rs2[tok] = rsv;
        }
        __syncthreads();
    }
}
__device__ __forceinline__ MoeTab moe_tables(const Frame& F, CArgs a, int l) {
    const int lane = otid(), tid = F.wave * 64 + lane; (void)tid; (void)lane;
    volatile LAS int* cntL = F.misc + 64; volatile LAS int* mtp = F.misc + 128; volatile LAS int* sp = F.misc + 192; volatile LAS int* te = F.misc + 256;
    const int* cnt = (const int*)(a->ws + WS_CTL) + CW_CNT + l * 32 * CNT_STRIDE;
    __syncthreads();
    if (tid < 32) cntL[tid] = __hip_atomic_load(cnt + tid * CNT_STRIDE, __ATOMIC_RELAXED, __HIP_MEMORY_SCOPE_AGENT);
    __syncthreads();
    if (tid <= 32) { int mt = 0, sl = 0; for (int e = 0; e < tid; ++e) { const int c = cntL[e]; mt += (c + 255) >> 8; sl += c; } mtp[tid] = mt; sp[tid] = sl; }
    __syncthreads();
    if (tid < 256) { int e = 0; for (int k = 1; k < 32; ++k) if (mtp[k] <= tid) e = k; te[tid] = e; }
    __syncthreads();
    MoeTab T; T.cnt = cntL; T.mtpref = mtp; T.spref = sp; T.tile_e = te; return T;
}
__device__ __forceinline__ void fin_phase(const Frame& F, CArgs a, int l, const MoeTab& T) {
    const int lane = otid(), tid = F.wave * 64 + lane; (void)tid;
    unsigned char* ws = a->ws;
    const i32x4* tokinfo = (const i32x4*)(ws + WS_TOKINFO); const bf16* Y = (const bf16*)(ws + WS_Y);
    bf16* xb = (bf16*)(ws + WS_XB); float* rs1 = (float*)(ws + WS_RS1);
    const int step = 2 * F.ngw;
    int m0 = 2 * F.gw;
    i32x4 tn0 = tokinfo[m0 < MTOK ? m0 : 0], tn1 = tokinfo[m0 + 1 < MTOK ? m0 + 1 : 0];
    for (; m0 < MTOK; m0 += step) {
        const i32x4 ti[2] = {tn0, tn1};
        const int mn = m0 + step;
        if (mn < MTOK) { tn0 = tokinfo[mn]; tn1 = tokinfo[mn + 1]; }
        u32x4 xv[2][2], p[2][2], q[2][2];
#pragma unroll
        for (int r = 0; r < 2; ++r) {
            const int m = m0 + r;
            const int s1 = T.spref[ti[r][0]] + ti[r][1], s2 = T.spref[ti[r][2]] + ti[r][3];
            const u32x4* xr = (const u32x4*)(xb + (size_t)m * DM) + lane;
            const u32x4* y1 = (const u32x4*)(Y + (size_t)s1 * DM) + lane; const u32x4* y2 = (const u32x4*)(Y + (size_t)s2 * DM) + lane;
#pragma unroll
            for (int j = 0; j < 2; ++j) { xv[r][j] = xr[64 * j]; p[r][j] = __builtin_nontemporal_load(y1 + 64 * j); q[r][j] = __builtin_nontemporal_load(y2 + 64 * j); }
        }
#pragma unroll
        for (int r = 0; r < 2; ++r) {
            const int m = m0 + r;
            float v[2][8]; float s = 0.f;
#pragma unroll
            for (int j = 0; j < 2; ++j) {
#define FINC(c, f) v[j][2 * c] = bflo(xv[r][j].f) + bflo(p[r][j].f) + bflo(q[r][j].f); v[j][2 * c + 1] = bfhi(xv[r][j].f) + bfhi(p[r][j].f) + bfhi(q[r][j].f);
                FINC(0, x) FINC(1, y) FINC(2, z) FINC(3, w)
#undef FINC
#pragma unroll
                for (int c = 0; c < 8; ++c) s += v[j][c] * v[j][c];
            }
            s = wave_sum(s, lane);
            const float rsv = 1.0f / sqrtf(s * (1.0f / DM) + NORM_EPS);
            if (l == DEPTH - 1) {
#pragma unroll
                for (int j = 0; j < 2; ++j) {
                    const f32x4* g = (const f32x4*)(a->fin_g + 512 * j + 8 * lane); f32x4* o = (f32x4*)(a->out + (size_t)m * DM + 512 * j + 8 * lane);
                    const f32x4 g0 = g[0], g1 = g[1];
                    __builtin_nontemporal_store((f32x4){v[j][0] * rsv * g0[0], v[j][1] * rsv * g0[1], v[j][2] * rsv * g0[2], v[j][3] * rsv * g0[3]}, o);
                    __builtin_nontemporal_store((f32x4){v[j][4] * rsv * g1[0], v[j][5] * rsv * g1[1], v[j][6] * rsv * g1[2], v[j][7] * rsv * g1[3]}, o + 1);
                }
            } else {
                u32x4* o = (u32x4*)(xb + (size_t)m * DM) + lane;
#pragma unroll
                for (int j = 0; j < 2; ++j) { u32x4 w; w.x = cvtpk(v[j][0], v[j][1]); w.y = cvtpk(v[j][2], v[j][3]); w.z = cvtpk(v[j][4], v[j][5]); w.w = cvtpk(v[j][6], v[j][7]); o[64 * j] = w; }
                if (lane == 0) rs1[m] = rsv;
            }
        }
    }
}

constexpr int PH_PREP = 0, PH_GEMM1 = 1, PH_ATTN = 2, PH_MID = 3, PH_MOE = 4, PH_FIN = 5, PH_PER_LAYER = 6, NPHASE = PH_PER_LAYER * DEPTH - 1;

__global__ void __launch_bounds__(NTHREADS, 2) fwd_kernel(Args a_by_value) {
    extern __shared__ __attribute__((aligned(16))) unsigned char lds_raw[];
    Frame F;
    F.lds = (LAS unsigned char*)lds_raw; F.misc = (volatile LAS int*)(F.lds + MISC_OFF);
    F.wave = __builtin_amdgcn_readfirstlane((int)threadIdx.x >> 6);
    F.G = gridDim.x; { const int bx = blockIdx.x; F.vcu = (F.G % 8 == 0) ? (bx % 8) * (F.G / 8) + bx / 8 : bx; }
    F.gw = blockIdx.x * NWAVES + F.wave; F.ngw = F.G * NWAVES;
    CArgs a = (CArgs)__builtin_amdgcn_kernarg_segment_ptr();
    unsigned char* ws = a->ws;
    const int ph_lo = a->ph_lo, ph_hi = a->ph_hi;
    for (int u = threadIdx.x; u < 1024; u += NTHREADS) F.misc[u] = 0;
    __syncthreads();
#if !MK_MULTI
    XcdBarrier bar = xcd_barrier_post((unsigned*)(ws + WS_CTL) + CW_BAR, (volatile LAS unsigned*)(F.misc + 8));
#define GRID_BAR() xcd_barrier(bar, F.wave)
#else
#define GRID_BAR() do { } while (0)
#endif
    for (int ph = ph_lo, rep = 0; ph < ph_hi; ) {
        const int l = ph >= PH_PER_LAYER ? 1 : 0, k = ph >= PH_PER_LAYER ? ph - (PH_PER_LAYER - 1) : ph;
        const size_t wlo = (size_t)l * WNE_LSTRIDE;
        {
            int bx = blockIdx.x; asm volatile("" : "+s"(bx)); asm volatile("" : "+s"(a)); ws = a->ws;
            int wv = F.wave; asm volatile("" : "+s"(wv)); F.gw = bx * NWAVES + wv; F.bx = bx;
        }
        if (k == PH_PREP && (PHMASK & 1)) {
            prep_phase(F, a);
        } else if (k == PH_GEMM1 && (PHMASK & 2)) {
            DenseSched S; S.A = (const char*)(ws + WS_XB); S.Bt = (const char*)(ws + wlo + WS_WIN); S.K = DM; S.lda = DM; S.ldb = DM; S.ksplit = 0; S.wave = F.wave; S.so.init(MTOK, DIN, F.G, F.bx); S.waitp = nullptr; S.need = 0; S.postp = nullptr; S.err = nullptr;
            EpiProj E{(bf16*)(ws + WS_PQ), (bf16*)(ws + WS_PG), (const float*)(ws + WS_RS1), (const f32x4*)(ws + WS_ROPE)};
            pg8::gemm_phase(F.lds, S, E);
        } else if (k == PH_ATTN && (PHMASK & 4)) {
            attn_phase(F, a, l);
        } else if (k == PH_MID) {
            unsigned* pan = (unsigned*)(ws + WS_CTL) + CW_PAN + l * 3 * 64 * PAN_STRIDE; unsigned* err = (unsigned*)(ws + WS_CTL) + CW_ERR;
            { pg8::StaticOrder so; so.init(MTOK, DM, F.G, F.bx); const int tid_ = F.wave * 64 + otid();
              for (int i = 0, pm, pn; so.next(i, pm, pn); ++i) comb_rows(F, a, pm * 256, tid_);
              VM_WAIT(); __syncthreads(); }
            { DenseSched S; S.A = (const char*)(ws + WS_YAB); S.Bt = (const char*)(ws + wlo + WS_WAB); S.K = 768; S.lda = 768; S.ldb = 768; S.ksplit = 256; S.wave = F.wave; S.so.init(MTOK, DM, F.G, F.bx);
              S.waitp = nullptr; S.need = 0; S.postp = pan; S.err = err;
              EpiMerge E{(const unsigned char*)(ws + WS_PG), (bf16*)(ws + WS_MRG)};
              pg8::gemm_phase(F.lds, S, E); }
            { DenseSched S; S.A = (const char*)(ws + WS_MRG); S.Bt = (const char*)(ws + wlo + WS_WOUT); S.K = DM; S.lda = DM; S.ldb = DM; S.ksplit = 0; S.wave = F.wave; S.so.init(MTOK, DM, F.G, F.bx);
              S.waitp = pan; S.need = 32; S.postp = pan + 64 * PAN_STRIDE; S.err = err;
              EpiResid E{(bf16*)(ws + WS_XB)};
              pg8::gemm_phase(F.lds, S, E); }
            route_phase(F, a, l, pan + 64 * PAN_STRIDE);
        } else if (k == PH_MOE) {
            const MoeTab T = moe_tables(F, a, l);
            const int mtT = T.mtpref[32], nU = 2 * mtT, nU1 = nU < F.G ? nU : F.G, nU2 = nU - nU1, tready = nU1 >> 1;
            const int bx = F.vcu;
            unsigned* upd = (unsigned*)(ws + WS_CTL) + CW_UPD + l * 256 * UPD_STRIDE; unsigned* err = (unsigned*)(ws + WS_CTL) + CW_ERR;
            MoeSched<true> SU; SU.A = (const char*)(ws + WS_XB); SU.Bt = (const char*)(ws + WS_WGU); SU.K = DM; SU.lda = DM; SU.ldb = DM; SU.wave = F.wave; SU.ntn = 2; SU.bstride_e = (size_t)512 * DM * 2; SU.ltok = (const int*)(ws + WS_LTOK); SU.T = T; SU.upd = upd; SU.err = err;
            MoeSched<false> SD; SD.A = (const char*)(ws + WS_H); SD.Bt = (const char*)(ws + WS_WD); SD.K = DEXP; SD.lda = DEXP; SD.ldb = DEXP; SD.wave = F.wave; SD.ntn = 4; SD.bstride_e = (size_t)DM * DEXP * 2; SD.ltok = nullptr; SD.T = T; SD.upd = upd; SD.err = err;
            EpiSwiglu EU{(const int*)(ws + WS_LTOK), (const float*)(ws + WS_LW), (const float*)(ws + WS_RS2), (bf16*)(ws + WS_H)};
            EpiY ED{(bf16*)(ws + WS_Y)};
            SU.G1 = F.G; SU.c1 = bx; SU.lo1 = 0; SU.hi1 = nU; SU.G2 = 1; SU.c2 = -1; SU.lo2 = 0; SU.hi2 = 0;
            pg8::gemm_phase(F.lds, SU, EU);
            SD.G1 = F.G - nU2; SD.c1 = bx - nU2; SD.lo1 = 0; SD.hi1 = 4 * tready;
            { const int extra = (4 * tready) % SD.G1;
              SD.G2 = SD.G1 - extra; SD.c2 = SD.c1 >= extra ? SD.c1 - extra : -1; SD.lo2 = 4 * tready; SD.hi2 = 4 * mtT; }
            pg8::gemm_phase(F.lds, SD, ED);
        } else if (k == PH_FIN && (PHMASK & 512)) {
            const MoeTab T = moe_tables(F, a, l);
            fin_phase(F, a, l, T);
        }
#if REP_MASK
        if (l == 0 && ((REP_MASK >> k) & 1) && rep < REP_N) { ++rep; GRID_BAR(); continue; }
        rep = 0;
#endif
        if (ph + 1 < ph_hi) { GRID_BAR();
#ifdef EXTRA_BAR
            for (int eb = 0; eb < EXTRA_BAR; ++eb) GRID_BAR();
#endif
        }
        ++ph;
    }
}

extern "C" void kernel_launch(void* const* d_in, const int* in_sizes, int n_in, void* d_out, int out_size, void* d_ws, size_t ws_size, hipStream_t stream) {
    static int grid = 0;
    if (grid == 0) {
        if (n_in != 16 || out_size != MTOK * DM || ws_size < WS_END) { fprintf(stderr, "kernel_launch: unexpected shapes (n_in %d out %d ws %zu)\n", n_in, out_size, ws_size); grid = -1; return; }
        int dev = 0, cus = 0, per_cu = 0;
        if (hipGetDevice(&dev) != hipSuccess || hipDeviceGetAttribute(&cus, hipDeviceAttributeMultiprocessorCount, dev) != hipSuccess) { grid = -1; return; }
        if (hipFuncSetAttribute((const void*)fwd_kernel, hipFuncAttributeMaxDynamicSharedMemorySize, LDS_BYTES) != hipSuccess) { fprintf(stderr, "kernel_launch: hipFuncSetAttribute failed\n"); grid = -1; return; }
        if (hipOccupancyMaxActiveBlocksPerMultiprocessor(&per_cu, (const void*)fwd_kernel, NTHREADS, LDS_BYTES) != hipSuccess || per_cu < 1) { fprintf(stderr, "kernel_launch: occupancy query says %d\n", per_cu); (void)hipGetLastError(); }
        grid = cus;
    }
    if (grid < 0) return;
    (void)hipMemsetAsync((char*)d_ws + WS_CTL, 0, CTL_BYTES, stream);
    Args a{};
    a.x = (const float*)d_in[0]; a.attn_g = (const float*)d_in[1]; a.w_in = (const float*)d_in[2]; a.a_sink = (const float*)d_in[3]; a.w_a = (const float*)d_in[4]; a.w_b = (const float*)d_in[5];
    a.w_out = (const float*)d_in[6]; a.ffn_g = (const float*)d_in[7]; a.w_rg = (const float*)d_in[8]; a.b_rg = (const float*)d_in[9]; a.w_re = (const float*)d_in[10]; a.b_re = (const float*)d_in[11];
    a.w_eg = (const float*)d_in[12]; a.w_eu = (const float*)d_in[13]; a.w_ed = (const float*)d_in[14]; a.fin_g = (const float*)d_in[15];
    a.out = (float*)d_out; a.ws = (unsigned char*)d_ws;
#if MK_MULTI
    for (int ph = 0; ph < NPHASE; ++ph) { a.ph_lo = ph; a.ph_hi = ph + 1; hipLaunchKernelGGL(fwd_kernel, dim3(grid), dim3(NTHREADS), LDS_BYTES, stream, a); }
#else
    a.ph_lo = 0; a.ph_hi = NPHASE;
    void* kargs[] = {&a};
    const hipError_t le = hipLaunchCooperativeKernel((const void*)fwd_kernel, dim3(grid), dim3(NTHREADS), kargs, LDS_BYTES, stream);
    if (le != hipSuccess) fprintf(stderr, "kernel_launch: cooperative launch failed: %s (grid %d)\n", hipGetErrorString(le), grid);
#endif
}
```
